# Optimizing an MI355X kernel written in HIP

```python
import jax, jax.numpy as jnp
from jax import lax
import numpy as np

D_MODEL = 1024
BATCH = 2
SEQ = 16384
DEPTH = 2

GRID_W = 64
CTX_LEN = 256
Q_BLOCK = 128
ROPE_THETA = 10000.0
RMS_EPS = 1e-6
N_MOD = 6

GQA_HEADS = 8
GQA_KV_HEADS = 2
GQA_GROUP = GQA_HEADS // GQA_KV_HEADS
GQA_HEAD_DIM = 64
GQA_Q_WIDTH = GQA_HEADS * GQA_HEAD_DIM
GQA_KV_WIDTH = GQA_KV_HEADS * GQA_HEAD_DIM

MLA_HEADS = 8
MLA_NOPE_DIM = 64
MLA_ROPE_DIM = 32
MLA_V_DIM = 64
MLA_Q_RANK = 256
MLA_KV_RANK = 128
MLA_V_WIDTH = MLA_HEADS * MLA_V_DIM

GMLP_GROUPS = 8
GMLP_GROUP_DIM = 64
GMLP_CHUNK = 128
GMLP_WIDTH = GMLP_GROUPS * GMLP_GROUP_DIM

N_BRANCHES = 3
BRANCH_WIDTH = 512

IN_SPLITS = (GQA_Q_WIDTH, GQA_KV_WIDTH, GQA_KV_WIDTH, MLA_Q_RANK, MLA_KV_RANK, MLA_ROPE_DIM,
             2 * GMLP_WIDTH, N_BRANCHES * D_MODEL)
IN_WIDTH = (GQA_Q_WIDTH + 2 * GQA_KV_WIDTH + MLA_Q_RANK + MLA_KV_RANK + MLA_ROPE_DIM
            + 2 * GMLP_WIDTH + N_BRANCHES * D_MODEL)

N_EXPERTS = 32
TOP_K = 4
D_EXPERT = 1024
SWIGLU_ALPHA = 1.702
SWIGLU_LIMIT = 7.0
MOE_BLOCK = 256

kernel_name = "hybrid_gqa_mla_gmlp_moe_dit_block"


def rms_norm(x, gain):
    xf = x.astype(jnp.float32)
    y = xf * lax.rsqrt(jnp.mean(xf * xf, axis=-1, keepdims=True) + RMS_EPS)
    return (y * gain.astype(jnp.float32)).astype(x.dtype)


def modulate(x, gain, shift, scale):
    return rms_norm(x, gain) * (1 + scale) + shift


def axial_rope_angles(rows, rot_dim):
    row = jnp.repeat(jnp.arange(rows, dtype=jnp.float32), GRID_W)
    col = jnp.tile(jnp.arange(GRID_W, dtype=jnp.float32), rows)
    quarter = rot_dim // 4
    inv_freq = ROPE_THETA ** (-jnp.arange(quarter, dtype=jnp.float32) / quarter)
    return jnp.concatenate([row[:, None] * inv_freq, col[:, None] * inv_freq], axis=-1)


def apply_rope(x, ang):
    half = x.shape[-1] // 2
    cos = jnp.cos(ang)[:, None, :]
    sin = jnp.sin(ang)[:, None, :]
    xf = x.astype(jnp.float32)
    x1, x2 = xf[..., :half], xf[..., half:]
    return jnp.concatenate([x1 * cos - x2 * sin, x2 * cos + x1 * sin], axis=-1).astype(x.dtype)


def sweep_query_blocks(fn, *qs):
    B, L = qs[0].shape[:2]
    nb = L // Q_BLOCK
    blocks = tuple(jnp.moveaxis(q.reshape(B, nb, Q_BLOCK, *q.shape[2:]), 1, 0) for q in qs)
    out = lax.map(lambda blk: fn(*blk), blocks)
    return jnp.moveaxis(out, 0, 1).reshape(B, L, *out.shape[3:])


def gqa_attend(q, k, v):
    s = jnp.einsum('bqhgd,bkhd->bhgqk', q, k, preferred_element_type=jnp.float32) * (GQA_HEAD_DIM ** -0.5)
    p = jax.nn.softmax(s, axis=-1).astype(v.dtype)
    return jnp.einsum('bhgqk,bkhd->bqhgd', p, v)


def mla_attend(q_nope, q_rope, k_nope, k_rope, v):
    s = (jnp.einsum('bqhd,bkhd->bhqk', q_nope, k_nope, preferred_element_type=jnp.float32)
         + jnp.einsum('bqhd,bkd->bhqk', q_rope, k_rope, preferred_element_type=jnp.float32))
    s = s * ((MLA_NOPE_DIM + MLA_ROPE_DIM) ** -0.5)
    p = jax.nn.softmax(s, axis=-1).astype(v.dtype)
    return jnp.einsum('bhqk,bkhd->bqhd', p, v)


def spatial_gate(u, v, v_norm, w_s, b_s):
    B, L, _ = v.shape
    vc = rms_norm(v, v_norm).reshape(B, L // GMLP_CHUNK, GMLP_CHUNK, GMLP_GROUPS, GMLP_GROUP_DIM)
    s = jnp.einsum('gpq,bcqgd->bcpgd', w_s, vc) + b_s.T[:, :, None]
    return u * s.reshape(B, L, GMLP_WIDTH)


def project_stream(h, w_in, qk_norm, mla_q_norm, mla_kv_norm, mla_w_uq, mla_w_ukv):
    B, L, _ = h.shape
    z = h @ w_in
    points = np.cumsum(IN_SPLITS)[:-1].tolist()
    q, k, v, cq, ckv, kr, uv, gates = jnp.split(z, points, axis=-1)
    out = {}
    out['q'] = rms_norm(q.reshape(B, L, GQA_HEADS, GQA_HEAD_DIM), qk_norm[0])
    out['k'] = rms_norm(k.reshape(B, L, GQA_KV_HEADS, GQA_HEAD_DIM), qk_norm[1])
    out['v'] = v.reshape(B, L, GQA_KV_HEADS, GQA_HEAD_DIM)
    qm = (rms_norm(cq, mla_q_norm) @ mla_w_uq).reshape(B, L, MLA_HEADS, MLA_NOPE_DIM + MLA_ROPE_DIM)
    out['q_nope'], out['q_rope'] = qm[..., :MLA_NOPE_DIM], qm[..., MLA_NOPE_DIM:]
    kv = (rms_norm(ckv, mla_kv_norm) @ mla_w_ukv).reshape(B, L, MLA_HEADS, MLA_NOPE_DIM + MLA_V_DIM)
    out['k_nope'], out['v_mla'] = kv[..., :MLA_NOPE_DIM], kv[..., MLA_NOPE_DIM:]
    out['k_rope'] = kr
    act = jax.nn.gelu(uv)
    out['u'], out['v_gmlp'] = act[..., :GMLP_WIDTH], act[..., GMLP_WIDTH:]
    out['gates'] = gates.reshape(B, L, N_BRANCHES, D_MODEL)
    return out


def branch_merge(outs, gates, w_branch, w_out):
    merged = jax.nn.sigmoid(gates[:, :, 0]) * (outs[0] @ w_branch[0])
    for i in range(1, N_BRANCHES):
        merged = merged + jax.nn.sigmoid(gates[:, :, i]) * (outs[i] @ w_branch[i])
    return merged @ w_out


def moe_ffn(tokens, router_w, router_b, w1, b1, w2, b2):
    T, D = tokens.shape
    logits = jnp.matmul(tokens, router_w, preferred_element_type=jnp.float32) + router_b.astype(jnp.float32)
    top_logit, top_idx = lax.top_k(logits, TOP_K)
    top_w = jax.nn.softmax(top_logit, axis=-1)
    P = T * TOP_K
    e_flat = top_idx.reshape(P)
    tok_flat = jnp.repeat(jnp.arange(T, dtype=jnp.int32), TOP_K)
    w_flat = top_w.reshape(P)
    order = jnp.argsort(e_flat, stable=True)
    e_s, tok_s, w_s = e_flat[order], tok_flat[order], w_flat[order]
    counts = jnp.zeros((N_EXPERTS,), jnp.int32).at[e_flat].add(1)
    padded = (counts + MOE_BLOCK - 1) // MOE_BLOCK * MOE_BLOCK
    pad_end = jnp.cumsum(padded)
    pad_start = pad_end - padded
    grp_start = jnp.cumsum(counts) - counts
    dest = pad_start[e_s] + (jnp.arange(P, dtype=jnp.int32) - grp_start[e_s])
    n_blocks = -(-(P + N_EXPERTS * (MOE_BLOCK - 1)) // MOE_BLOCK)
    buf = jnp.zeros((n_blocks * MOE_BLOCK, D), tokens.dtype).at[dest].set(tokens[tok_s])
    blk_start = jnp.arange(n_blocks, dtype=jnp.int32) * MOE_BLOCK
    blk_expert = jnp.minimum(jnp.searchsorted(pad_end, blk_start, side='right'), N_EXPERTS - 1)

    def run_block(args):
        xb, e = args
        a = xb @ w1[e] + b1[e]
        glu = jnp.minimum(a[..., :D_EXPERT], SWIGLU_LIMIT)
        lin = jnp.clip(a[..., D_EXPERT:], -SWIGLU_LIMIT, SWIGLU_LIMIT)
        act = glu * jax.nn.sigmoid(SWIGLU_ALPHA * glu) * (lin + 1)
        return act @ w2[e] + b2[e]

    y = lax.map(run_block, (buf.reshape(n_blocks, MOE_BLOCK, D), blk_expert)).reshape(n_blocks * MOE_BLOCK, D)
    contrib = y[dest] * w_s[:, None].astype(y.dtype)
    return jax.ops.segment_sum(contrib, tok_s, num_segments=T)


def hybrid_layer(x, xc, mod, mod_c, ang_head, ang_mla, params, update_ctx):
    (norms, w_in, qk_norm, mla_q_norm, mla_kv_norm, mla_w_uq, mla_w_ukv, gmlp_v_norm, gmlp_w_s,
     gmlp_b_s, w_branch, w_out, router_w, router_b, ew1, eb1, ew2, eb2) = params
    B, L, _ = x.shape
    C = xc.shape[1]
    sh1, sc1, g1, sh2, sc2, g2 = [mod[:, j, None, :] for j in range(N_MOD)]
    sh1c, sc1c, g1c, sh2c, sc2c, g2c = [mod_c[j] for j in range(N_MOD)]

    lat = project_stream(modulate(x, norms[0], sh1, sc1), w_in, qk_norm, mla_q_norm, mla_kv_norm, mla_w_uq, mla_w_ukv)
    cx = project_stream(modulate(xc, norms[0], sh1c, sc1c), w_in, qk_norm, mla_q_norm, mla_kv_norm, mla_w_uq, mla_w_ukv)

    q = apply_rope(lat['q'], ang_head)
    k_all = jnp.concatenate([apply_rope(lat['k'], ang_head), cx['k']], axis=1)
    v_all = jnp.concatenate([lat['v'], cx['v']], axis=1)
    gqa_o = sweep_query_blocks(lambda qb: gqa_attend(qb, k_all, v_all),
                               q.reshape(B, L, GQA_KV_HEADS, GQA_GROUP, GQA_HEAD_DIM)).reshape(B, L, GQA_Q_WIDTH)

    q_rope = apply_rope(lat['q_rope'], ang_mla)
    k_rope_lat = apply_rope(lat['k_rope'][:, :, None, :], ang_mla)[:, :, 0, :]
    kn_all = jnp.concatenate([lat['k_nope'], cx['k_nope']], axis=1)
    kr_all = jnp.concatenate([k_rope_lat, cx['k_rope']], axis=1)
    vm_all = jnp.concatenate([lat['v_mla'], cx['v_mla']], axis=1)
    mla_o = sweep_query_blocks(lambda qn, qr: mla_attend(qn, qr, kn_all, kr_all, vm_all),
                               lat['q_nope'], q_rope).reshape(B, L, MLA_V_WIDTH)

    gmlp_o = spatial_gate(lat['u'], lat['v_gmlp'], gmlp_v_norm, gmlp_w_s, gmlp_b_s)

    y = branch_merge([gqa_o, mla_o, gmlp_o], lat['gates'], w_branch, w_out)
    x_new = x + g1 * rms_norm(y, norms[1])

    if update_ctx:
        gqa_c = gqa_attend(cx['q'].reshape(B, C, GQA_KV_HEADS, GQA_GROUP, GQA_HEAD_DIM), cx['k'], cx['v']).reshape(B, C, GQA_Q_WIDTH)
        mla_c = mla_attend(cx['q_nope'], cx['q_rope'], cx['k_nope'], cx['k_rope'], cx['v_mla']).reshape(B, C, MLA_V_WIDTH)
        gmlp_c = spatial_gate(cx['u'], cx['v_gmlp'], gmlp_v_norm, gmlp_w_s, gmlp_b_s)
        yc = branch_merge([gqa_c, mla_c, gmlp_c], cx['gates'], w_branch, w_out)
        xc = xc + g1c * rms_norm(yc, norms[1])
    x = x_new

    tokens = modulate(x, norms[2], sh2, sc2).reshape(B * L, D_MODEL)
    if update_ctx:
        tokens = jnp.concatenate([tokens, modulate(xc, norms[2], sh2c, sc2c).reshape(B * C, D_MODEL)], axis=0)
    f = moe_ffn(tokens, router_w, router_b, ew1, eb1, ew2, eb2)
    x = x + g2 * rms_norm(f[:B * L].reshape(B, L, D_MODEL), norms[3])
    if update_ctx:
        xc = xc + g2c * rms_norm(f[B * L:].reshape(B, C, D_MODEL), norms[3])
    return x, xc


def setup_inputs(seed: int = 0) -> dict:
    key = jax.random.key(seed)
    ks = jax.random.split(key, 32)

    def nrm(k, shape, scale):
        return scale * jax.random.normal(k, shape, jnp.float32)

    D = D_MODEL
    return {
        "x": nrm(ks[0], (BATCH, SEQ, D), 1.0),
        "c": nrm(ks[1], (BATCH, D), 1.0),
        "ctx": nrm(ks[2], (BATCH, CTX_LEN, D), 1.0),
        "c_ctx": nrm(ks[3], (D,), 1.0),
        "w_mod": nrm(ks[4], (DEPTH, D, N_MOD * D), 0.5 * D ** -0.5),
        "b_mod": nrm(ks[5], (DEPTH, N_MOD * D), 0.02),
        "norm_gains": 1.0 + nrm(ks[6], (DEPTH, 4, D), 0.05),
        "w_in": nrm(ks[7], (DEPTH, D, IN_WIDTH), D ** -0.5),
        "qk_norm": 1.0 + nrm(ks[8], (DEPTH, 2, GQA_HEAD_DIM), 0.05),
        "mla_q_norm": 1.0 + nrm(ks[9], (DEPTH, MLA_Q_RANK), 0.05),
        "mla_kv_norm": 1.0 + nrm(ks[10], (DEPTH, MLA_KV_RANK), 0.05),
        "mla_w_uq": nrm(ks[11], (DEPTH, MLA_Q_RANK, MLA_HEADS * (MLA_NOPE_DIM + MLA_ROPE_DIM)), MLA_Q_RANK ** -0.5),
        "mla_w_ukv": nrm(ks[12], (DEPTH, MLA_KV_RANK, MLA_HEADS * (MLA_NOPE_DIM + MLA_V_DIM)), MLA_KV_RANK ** -0.5),
        "gmlp_v_norm": 1.0 + nrm(ks[13], (DEPTH, GMLP_WIDTH), 0.05),
        "gmlp_w_s": nrm(ks[14], (DEPTH, GMLP_GROUPS, GMLP_CHUNK, GMLP_CHUNK), GMLP_CHUNK ** -0.5),
        "gmlp_b_s": nrm(ks[15], (DEPTH, GMLP_GROUPS, GMLP_CHUNK), 0.02),
        "w_branch": nrm(ks[16], (DEPTH, N_BRANCHES, BRANCH_WIDTH, D), BRANCH_WIDTH ** -0.5),
        "w_out": nrm(ks[17], (DEPTH, D, D), D ** -0.5),
        "router_w": nrm(ks[18], (DEPTH, D, N_EXPERTS), D ** -0.5),
        "router_b": nrm(ks[19], (DEPTH, N_EXPERTS), 0.01),
        "expert_w1": nrm(ks[20], (DEPTH, N_EXPERTS, D, 2 * D_EXPERT), D ** -0.5),
        "expert_b1": nrm(ks[21], (DEPTH, N_EXPERTS, 2 * D_EXPERT), 0.02),
        "expert_w2": nrm(ks[22], (DEPTH, N_EXPERTS, D_EXPERT, D), D_EXPERT ** -0.5),
        "expert_b2": nrm(ks[23], (DEPTH, N_EXPERTS, D), 0.02),
    }


def reference(x, c, ctx, c_ctx, w_mod, b_mod, norm_gains, w_in, qk_norm, mla_q_norm, mla_kv_norm,
              mla_w_uq, mla_w_ukv, gmlp_v_norm, gmlp_w_s, gmlp_b_s, w_branch, w_out, router_w, router_b,
              expert_w1, expert_b1, expert_w2, expert_b2):
    n_lat = x.shape[1]
    rows = n_lat // GRID_W
    ang_head = axial_rope_angles(rows, GQA_HEAD_DIM)
    ang_mla = axial_rope_angles(rows, MLA_ROPE_DIM)
    s_c = jax.nn.silu(c)
    s_cc = jax.nn.silu(c_ctx)
    xc = ctx
    for i in range(DEPTH):
        mod = (s_c @ w_mod[i] + b_mod[i]).reshape(-1, N_MOD, D_MODEL)
        mod_c = (s_cc @ w_mod[i] + b_mod[i]).reshape(N_MOD, D_MODEL)
        params = (norm_gains[i], w_in[i], qk_norm[i], mla_q_norm[i], mla_kv_norm[i], mla_w_uq[i], mla_w_ukv[i],
                  gmlp_v_norm[i], gmlp_w_s[i], gmlp_b_s[i], w_branch[i], w_out[i], router_w[i], router_b[i],
                  expert_w1[i], expert_b1[i], expert_w2[i], expert_b2[i])
        x, xc = hybrid_layer(x, xc, mod, mod_c, ang_head, ang_mla, params, update_ctx=(i < DEPTH - 1))
    return x
```

```cpp
#include <hip/hip_runtime.h>
#include <cstdio>
#include <cstdint>

typedef unsigned short bf16;

constexpr int DM = 1024, NBATCH = 2, SEQ = 16384, CTX = 256, DEPTH = 2;
constexpr int TL = NBATCH * SEQ;
constexpr int TC = NBATCH * CTX;
constexpr int TA = TL + TC;
constexpr int KPB = SEQ + CTX;
constexpr int KR = NBATCH * KPB;
constexpr int ZW = 5376;
constexpr int Z_Q = 0, Z_K = 512, Z_V = 640, Z_CQ = 768, Z_CKV = 1024, Z_KR = 1152, Z_U = 1280, Z_VG = 1792, Z_GATE = 2304;
constexpr int NEXP = 32, TOPK = 4, DEXP = 1024, MOE_ROWS = 552 * 256;
constexpr float RMS_EPS = 1e-6f;
constexpr float LOG2E = 1.4426950408889634f;
constexpr float C2G = 0.125f * LOG2E;
constexpr float C2M = 0.10206207261596577f * LOG2E;

constexpr size_t MiB = 1u << 20;
constexpr size_t WS_CTL = 0, CTL_ZERO_BYTES = 1 * MiB;
constexpr size_t WS_MOD = 1 * MiB;
constexpr size_t WS_PTAB = 1 * MiB + 512 * 1024;
constexpr size_t WS_COSG = 2 * MiB, WS_SING = 4 * MiB, WS_COSM = 6 * MiB, WS_SINM = 7 * MiB;
constexpr size_t WS_WS = 8 * MiB;
constexpr size_t WS_RWT = 8 * MiB + 512 * 1024;
constexpr size_t WS_SSV = 1 * MiB + 640 * 1024;
static_assert(WS_SSV + (size_t)TA * 2 * 4 <= 2 * MiB && WS_RWT + (size_t)DEPTH * 2 * 32 * 1024 * 2 <= 9 * MiB, "ws map small regions");
constexpr size_t WS_WUQ = 9 * MiB;
constexpr size_t WS_WUKV = 10 * MiB;
constexpr size_t WS_WBR = 11 * MiB;
constexpr size_t WS_WOUT = 17 * MiB;
constexpr size_t WS_WIN = 21 * MiB;
constexpr size_t WS_W1 = 42 * MiB;
constexpr size_t WS_W2 = 298 * MiB;
constexpr size_t WS_XC = 426 * MiB;
constexpr size_t WS_RTE = 428 * MiB;
constexpr size_t WS_RTS = 429 * MiB;
constexpr size_t WS_LTOK = 430 * MiB;
constexpr size_t WS_LW = 435 * MiB;
constexpr size_t WS_XN = 441 * MiB;
constexpr size_t WS_QG = 506 * MiB;
constexpr size_t WS_KG = 539 * MiB;
constexpr size_t WS_VG = 548 * MiB;
constexpr size_t WS_CQN = 557 * MiB;
constexpr size_t WS_CKVN = 574 * MiB;
constexpr size_t WS_QM = 583 * MiB;
constexpr size_t WS_KM = 632 * MiB;
constexpr size_t WS_VM = 681 * MiB;
constexpr size_t WS_OG = 714 * MiB;
constexpr size_t WS_OM = 747 * MiB;
constexpr size_t WS_GM = 780 * MiB;
constexpr size_t WS_UACT = 813 * MiB;
constexpr size_t WS_VN = 846 * MiB;
constexpr size_t WS_MERGE = 879 * MiB;
constexpr size_t WS_MERGEB = 1009 * MiB;
constexpr size_t WS_Y = 1074 * MiB;
constexpr size_t WS_H = 1139 * MiB;
constexpr size_t WS_BIG = 1415 * MiB;
constexpr size_t WS_END = 1757 * MiB;
static_assert(WS_BIG + (size_t)TA * ZW * 2 <= WS_END && WS_BIG + (size_t)MOE_ROWS * 1024 * 2 <= WS_END && WS_H + (size_t)MOE_ROWS * 1024 * 2 <= WS_BIG, "ws map");
static_assert(WS_W1 + (size_t)DEPTH * 32 * 2048 * 1024 * 2 <= WS_W2 && WS_W2 + (size_t)DEPTH * 32 * 1024 * 1024 * 2 <= WS_XC, "ws map weights");
static_assert(WS_MERGE + (size_t)TA * 1024 * 4 <= WS_MERGEB && WS_XN + (size_t)TA * 1024 * 2 <= WS_QG && WS_QM + (size_t)TA * 768 * 2 <= WS_KM, "ws map acts");
constexpr int CW_BAR = 4096;
constexpr int CW_CNT = 16384;

constexpr int RING_OFF = 0, RING_BYTES = 131072;
constexpr int LDS_X = RING_BYTES + 4096;
constexpr int LDS_SVEC = LDS_X;
constexpr int LDS_ROWTOK = LDS_X;
constexpr int MISC_OFF = 159744;
constexpr int LDS_TAB = 160000;
constexpr int LDS_BYTES = 163840;
static_assert(LDS_SVEC + 3 * 1024 * 4 <= MISC_OFF && LDS_ROWTOK + 20 * 1024 <= MISC_OFF && LDS_TAB + 704 * 4 <= LDS_BYTES, "LDS map");

#define GAS __attribute__((address_space(1)))
#define LAS __attribute__((address_space(3)))
typedef unsigned v4u __attribute__((ext_vector_type(4)));
typedef float f32x4 __attribute__((ext_vector_type(4)));
typedef GAS unsigned gu32;
#define RLX_AGENT __ATOMIC_RELAXED, __HIP_MEMORY_SCOPE_AGENT
#define LDS_WAIT() asm volatile("s_waitcnt lgkmcnt(0)" ::: "memory")
#define VM_WAIT() asm volatile("s_waitcnt vmcnt(0)" ::: "memory")

__device__ __forceinline__ unsigned cvt_pk(float lo, float hi) { unsigned r; asm volatile("v_cvt_pk_bf16_f32 %0, %1, %2" : "=v"(r) : "v"(lo), "v"(hi)); return r; }
__device__ __forceinline__ float bf_lo(unsigned u) { return __uint_as_float(u << 16); }
__device__ __forceinline__ float bf_hi(unsigned u) { return __uint_as_float(u & 0xffff0000u); }
__device__ __forceinline__ void unpack8(v4u r, float (&f)[8]) { f[0] = bf_lo(r.x); f[1] = bf_hi(r.x); f[2] = bf_lo(r.y); f[3] = bf_hi(r.y); f[4] = bf_lo(r.z); f[5] = bf_hi(r.z); f[6] = bf_lo(r.w); f[7] = bf_hi(r.w); }
__device__ __forceinline__ v4u pack8(const float (&f)[8]) { v4u o; o.x = cvt_pk(f[0], f[1]); o.y = cvt_pk(f[2], f[3]); o.z = cvt_pk(f[4], f[5]); o.w = cvt_pk(f[6], f[7]); return o; }
__device__ __forceinline__ float sigmoidf_(float x) { return __builtin_amdgcn_rcpf(1.f + __builtin_amdgcn_exp2f(-LOG2E * x)); }
__device__ __forceinline__ float wave_sum(float v) {
#pragma unroll
    for (int o = 1; o < 64; o <<= 1) v += __shfl_xor(v, o);
    return v;
}
__device__ __forceinline__ float gelu_tanh(float x) { const float u = 1.5957691216057308f * (x + 0.044715f * x * x * x); return x * __builtin_amdgcn_rcpf(1.f + __builtin_amdgcn_exp2f(-LOG2E * u)); }
constexpr int NTILE = KPB / 64;
__device__ __forceinline__ void bpos_of(int r, int& b, int& pos) { if (r < TL) { b = r >> 14; pos = r & (SEQ - 1); } else { b = (r - TL) >> 8; pos = SEQ + ((r - TL) & (CTX - 1)); } }
__device__ __forceinline__ size_t ktile_off(int strm, int pos, int chunk, int nch) { return (((size_t)strm * NTILE + (pos >> 6)) * nch + chunk) * 512 + (size_t)(pos & 63) * 8; }
__device__ __forceinline__ size_t vtile_off(int strm, int pos, int d) { const int piece = (d >> 5) * 4 + ((pos & 63) >> 4), ln = (pos & 15) * 4 + ((d >> 3) & 3); return (((size_t)strm * NTILE + (pos >> 6)) * 8 + piece) * 512 + (size_t)ln * 8; }
__device__ __forceinline__ int krow_of(int r) { return r < TL ? (r >> 14) * KPB + (r & (SEQ - 1)) : ((r - TL) >> 8) * KPB + SEQ + ((r - TL) & (CTX - 1)); }

__device__ const float INVF16[16] = {1.0f, 0.5623413324356079f, 0.3162277638912201f, 0.17782793939113617f, 0.10000000149011612f, 0.05623413249850273f, 0.03162277489900589f, 0.017782794311642647f,
                                     0.009999999776482582f, 0.005623413249850273f, 0.003162277629598975f, 0.0017782794311642647f, 0.0010000000474974513f, 0.000562341301701963f, 0.0003162277571391314f, 0.00017782794020604342f};
namespace pg8 {
#define PG8_LAS __attribute__((address_space(3)))
typedef unsigned short bf16_t;
typedef short bf16x8 __attribute__((ext_vector_type(8)));
typedef float f32x4 __attribute__((ext_vector_type(4)));
typedef unsigned u32x4 __attribute__((ext_vector_type(4)));
constexpr int BM = 256, BK = 64, HALF = 128, HTB = HALF * BK * 2  , STAGE_BYTES = 8 * HTB, NXCD = 8, WGM = 8;

__host__ __device__ __forceinline__ int lds_byte(int r, int c) { const int st = (r >> 4) * 2 + (c >> 5), rr = r & 15, cc = c & 31, ob = rr * 64 + cc * 2; return st * 1024 + (ob ^ (((ob >> 9) & 1) << 5)); }
__host__ __device__ __forceinline__ void stage_rc(int b, int& R, int& C) { const int st = b / 1024, sb = b % 1024, swz = sb ^ (((sb >> 9) & 1) << 5); R = (st >> 1) * 16 + swz / 64; C = (st & 1) * 32 + (swz % 64) / 2; }
__host__ __device__ __forceinline__ int perm32(int rho) { const int n = rho >> 4, i = rho & 15; return 8 * (i >> 2) + 4 * n + (i & 3); }

struct Unit { int pm, pn; };
struct Gemm { const bf16_t* A; const bf16_t* Bt; int M, N, K; };

struct StaticOrder {
    int nM, nN, nwg, G, c;
    __device__ void init(int M, int N, int G_, int c_) { asm volatile("" : "+s"(M), "+s"(N));
        nM = M / BM; nN = N / BM; nwg = nM * nN; G = G_; c = c_; }
    __host__ __device__ bool next(int i, Unit& u) const {
        const long L = (long)i * G + c; if (L >= nwg) return false;
        int wgid = (int)L; { const int q = nwg / NXCD, r = nwg % NXCD, xcd = wgid % NXCD, off = wgid / NXCD; wgid = (xcd < r ? xcd * (q + 1) : r * (q + 1) + (xcd - r) * q) + off; }
        const int nig = WGM * nN, gid = wgid / nig, fm = gid * WGM, gsz = (nM - fm) < WGM ? (nM - fm) : WGM;
        u.pm = fm + ((wgid % nig) % gsz); u.pn = (wgid % nig) / gsz; return true;
    }
    __device__ __forceinline__ void a_ready(const Unit&) const {}
    __device__ __forceinline__ void done(const Unit&) const {}
};

template <class Epi, class Sched, bool ALIGN_EPI = false, bool SP2 = false, bool GATHER = false>
__device__ __forceinline__ void gemm_phase(PG8_LAS unsigned char* lds, const Gemm g, const Sched& S, const Epi& E) {
    static_assert(!GATHER || SP2, "GATHER is implemented for the SP2 loop only");
    int tid_ = threadIdx.x; asm volatile("" : "+v"(tid_));
    const int tid = tid_, wid = __builtin_amdgcn_readfirstlane(tid >> 6), lane = tid & 63, wr = wid >> 2, wc = wid & 3, fr = lane & 15, fq = lane >> 4;
    int K_ = g.K; asm volatile("" : "+s"(K_));
    const int K = K_, nt = K / BK;
    unsigned voffA[2], voffB[2];
#pragma unroll
    for (int i = 0; i < 2; ++i) { int R, C; stage_rc(tid * 16 + i * 8192, R, C); const int Rb = Epi::PERM ? ((R & ~31) + perm32(R & 31)) : R;
        voffA[i] = (unsigned)(R * K + C) * 2u; voffB[i] = (unsigned)(Rb * K + C) * 2u; }
    unsigned vAc0[2] = {0u, 0u}, vAc1[2] = {0u, 0u}, vAn0[2] = {0u, 0u}, vAn1[2] = {0u, 0u}, vsel0[2] = {0u, 0u}, vsel1[2] = {0u, 0u};
#define PG8_GOFF(dst0, dst1, uidx) do { _Pragma("unroll") for (int i_ = 0; i_ < 2; ++i_) { int R_, C_; stage_rc(tid * 16 + i_ * 8192, R_, C_); \
        dst0[i_] = ((unsigned)S.tok((uidx), R_) * (unsigned)K + (unsigned)C_) * 2u; dst1[i_] = ((unsigned)S.tok((uidx), HALF + R_) * (unsigned)K + (unsigned)C_) * 2u; } } while (0)
#define PG8_STG_A(bufoff, base, H, SEL) do { if constexpr (GATHER) { if (SEL) { PG8_STAGE(bufoff, base, vsel##H); } else { PG8_STAGE(bufoff, base, vAc##H); } } else { PG8_STAGE(bufoff, (base) + (H) * hstep, voffA); } } while (0)
    const size_t kstep = (size_t)(BK * 2);
    const size_t hstep = (size_t)HALF * K * 2;
    const size_t tstep = 2 * hstep;
    const unsigned ldsw = (unsigned)wid * 1024u;
    const int aoff = lds_byte(wr * 64 + fr, fq * 8), boff = lds_byte(wc * 32 + fr, fq * 8);
#define PG8_SA(b, h) (((b) * 2 + (h)) * HTB)
#define PG8_SB(b, h) ((4 + (b) * 2 + (h)) * HTB)
#define PG8_STAGE(bufoff, gbase, voff) do { _Pragma("unroll") for (int _i = 0; _i < 2; ++_i) \
        __builtin_amdgcn_global_load_lds((const unsigned*)((const char*)(gbase) + (voff)[_i]), (PG8_LAS unsigned*)(lds + (bufoff) + ldsw + _i * 8192), 16, 0, 0); } while (0)
#define PG8_LDA(dst, b, h) do { _Pragma("unroll") for (int m = 0; m < 4; ++m) _Pragma("unroll") for (int k = 0; k < 2; ++k) dst[m][k] = *(const PG8_LAS bf16x8*)(lds + PG8_SA(b, h) + aoff + m * 2048 + k * 1024); } while (0)
#define PG8_LDB(dst, b, h) do { _Pragma("unroll") for (int n = 0; n < 2; ++n) _Pragma("unroll") for (int k = 0; k < 2; ++k) dst[n][k] = *(const PG8_LAS bf16x8*)(lds + PG8_SB(b, h) + boff + n * 2048 + k * 1024); } while (0)
#define PG8_MMA(ai, bj, At, Bt) do { __builtin_amdgcn_s_setprio(1); _Pragma("unroll") for (int m = 0; m < 4; ++m) _Pragma("unroll") for (int n = 0; n < 2; ++n) _Pragma("unroll") for (int k = 0; k < 2; ++k) \
        acc[ai][bj][m][n] = __builtin_amdgcn_mfma_f32_16x16x32_bf16(Bt[n][k], At[m][k], acc[ai][bj][m][n], 0, 0, 0); __builtin_amdgcn_s_setprio(0); } while (0)
#define PG8_WAIT_V(n) asm volatile("s_waitcnt vmcnt(" #n ")" ::: "memory")
#define PG8_WAIT_L(n) asm volatile("s_waitcnt lgkmcnt(" #n ")" ::: "memory")
#define PG8_BAR __builtin_amdgcn_s_barrier()
#define PG8_SCHED __builtin_amdgcn_sched_barrier(0)
    Unit cur, nxt; int ui = 0;
    if (!S.next(0, cur)) return;
    f32x4 acc[2][2][4][2];
#pragma unroll
    for (int a = 0; a < 2; ++a)
#pragma unroll
        for (int b = 0; b < 2; ++b)
#pragma unroll
            for (int m = 0; m < 4; ++m)
#pragma unroll
                for (int n = 0; n < 2; ++n) acc[a][b][m][n] = (f32x4){0.f, 0.f, 0.f, 0.f};
    bf16x8 At[4][2], B0[2][2], B1[2][2];
    const char* cA = GATHER ? (const char*)g.A : (const char*)g.A + (size_t)cur.pm * tstep; const char* cB = (const char*)g.Bt + (size_t)cur.pn * tstep;
    if constexpr (GATHER) { PG8_GOFF(vAc0, vAc1, 0); }
    S.a_ready(cur);
    if constexpr (SP2) {
        PG8_STAGE(PG8_SB(0, 0), cB, voffB); PG8_STAGE(PG8_SB(0, 1), cB + hstep, voffB); PG8_STG_A(PG8_SA(0, 0), cA, 0, false); PG8_STG_A(PG8_SA(0, 1), cA, 1, false);
        if (wr == 1) PG8_BAR;
        PG8_WAIT_V(2); PG8_BAR;
        PG8_STAGE(PG8_SB(1, 0), cB + kstep, voffB); PG8_STG_A(PG8_SA(1, 0), cA + kstep, 0, false); PG8_STAGE(PG8_SB(1, 1), cB + hstep + kstep, voffB);
        PG8_WAIT_V(6); PG8_BAR;
    } else {
        PG8_STAGE(PG8_SB(0, 0), cB, voffB); PG8_STAGE(PG8_SA(0, 0), cA, voffA); PG8_STAGE(PG8_SB(0, 1), cB + hstep, voffB); PG8_STAGE(PG8_SA(0, 1), cA + hstep, voffA);
        if (wr == 1) PG8_BAR;
        PG8_WAIT_V(4); PG8_BAR;
        PG8_STAGE(PG8_SB(1, 0), cB + kstep, voffB); PG8_STAGE(PG8_SA(1, 0), cA + kstep, voffA); PG8_STAGE(PG8_SB(1, 1), cB + hstep + kstep, voffB);
        PG8_WAIT_V(6); PG8_BAR;
    }
    for (;;) {
        const bool has_next = S.next(ui + 1, nxt);
        const char* nA = GATHER ? (const char*)g.A : (has_next ? (const char*)g.A + (size_t)nxt.pm * tstep : cA);
        if constexpr (GATHER) { if (has_next) { PG8_GOFF(vAn0, vAn1, ui + 1); } else { vAn0[0] = vAc0[0]; vAn0[1] = vAc0[1]; vAn1[0] = vAc1[0]; vAn1[1] = vAc1[1]; } } const char* nB = has_next ? (const char*)g.Bt + (size_t)nxt.pn * tstep : cB;
        for (int t = 0; t < nt; t += 2) {
            const bool last = (t == nt - 2);
            const char* a1 = cA + (size_t)(t + 1) * kstep;
            const char* a2 = last ? nA : cA + (size_t)(t + 2) * kstep; const char* b2 = last ? nB : cB + (size_t)(t + 2) * kstep;
            const char* a3 = a2 + kstep; const char* b3 = b2 + kstep;
            if (last && has_next) S.a_ready(nxt);
            if constexpr (GATHER) { vsel0[0] = last ? vAn0[0] : vAc0[0]; vsel0[1] = last ? vAn0[1] : vAc0[1]; vsel1[0] = last ? vAn1[0] : vAc1[0]; vsel1[1] = last ? vAn1[1] : vAc1[1]; }
            if constexpr (SP2) {
            PG8_LDB(B0, 0, 0); PG8_LDB(B1, 0, 1); PG8_SCHED; PG8_LDA(At, 0, 0); PG8_STG_A(PG8_SA(1, 1), a1, 1, false);
            PG8_WAIT_V(8); PG8_WAIT_L(0); PG8_BAR; PG8_MMA(0, 0, At, B0); PG8_MMA(0, 1, At, B1); PG8_BAR; PG8_SCHED;
            PG8_LDA(At, 0, 1); PG8_STAGE(PG8_SB(0, 0), b2, voffB); PG8_STAGE(PG8_SB(0, 1), b2 + hstep, voffB); PG8_STG_A(PG8_SA(0, 0), a2, 0, true);
            PG8_WAIT_V(8); PG8_WAIT_L(0); PG8_BAR; PG8_MMA(1, 0, At, B0); PG8_MMA(1, 1, At, B1); PG8_BAR; PG8_SCHED;
            PG8_LDB(B0, 1, 0); PG8_LDB(B1, 1, 1); PG8_SCHED; PG8_LDA(At, 1, 0); PG8_STG_A(PG8_SA(0, 1), a2, 1, true);
            PG8_WAIT_V(8); PG8_WAIT_L(0); PG8_BAR; PG8_MMA(0, 0, At, B0); PG8_MMA(0, 1, At, B1); PG8_BAR; PG8_SCHED;
            PG8_LDA(At, 1, 1); PG8_STAGE(PG8_SB(1, 0), b3, voffB); PG8_STAGE(PG8_SB(1, 1), b3 + hstep, voffB); PG8_STG_A(PG8_SA(1, 0), a3, 0, true);
            PG8_WAIT_V(8); PG8_WAIT_L(0); PG8_BAR; PG8_MMA(1, 0, At, B0); PG8_MMA(1, 1, At, B1); PG8_BAR; PG8_SCHED;
            } else {
            PG8_LDB(B0, 0, 0); PG8_SCHED; PG8_LDA(At, 0, 0); PG8_STAGE(PG8_SA(1, 1), a1 + hstep, voffA);
            PG8_WAIT_L(8); PG8_BAR; PG8_WAIT_L(0); PG8_MMA(0, 0, At, B0); PG8_BAR; PG8_SCHED;
            PG8_LDB(B1, 0, 1); PG8_STAGE(PG8_SB(0, 0), b2, voffB);
            PG8_BAR; PG8_WAIT_L(0); PG8_MMA(0, 1, At, B1); PG8_BAR;
            PG8_LDA(At, 0, 1); PG8_STAGE(PG8_SA(0, 0), a2, voffA);
            PG8_BAR; PG8_WAIT_L(0); PG8_MMA(1, 0, At, B0); PG8_BAR; PG8_SCHED;
            PG8_STAGE(PG8_SB(0, 1), b2 + hstep, voffB);
            PG8_WAIT_V(6); PG8_BAR; PG8_MMA(1, 1, At, B1); PG8_BAR;
            PG8_LDB(B0, 1, 0); PG8_SCHED; PG8_LDA(At, 1, 0); PG8_STAGE(PG8_SA(0, 1), a2 + hstep, voffA);
            PG8_WAIT_L(8); PG8_BAR; PG8_WAIT_L(0); PG8_MMA(0, 0, At, B0); PG8_BAR; PG8_SCHED;
            PG8_LDB(B1, 1, 1); PG8_STAGE(PG8_SB(1, 0), b3, voffB);
            PG8_BAR; PG8_WAIT_L(0); PG8_MMA(0, 1, At, B1); PG8_BAR;
            PG8_LDA(At, 1, 1); PG8_STAGE(PG8_SA(1, 0), a3, voffA);
            PG8_BAR; PG8_WAIT_L(0); PG8_MMA(1, 0, At, B0); PG8_BAR; PG8_SCHED;
            PG8_STAGE(PG8_SB(1, 1), b3 + hstep, voffB);
            PG8_WAIT_V(6); PG8_BAR; PG8_MMA(1, 1, At, B1); PG8_BAR;
            }
        }
        if constexpr (ALIGN_EPI) { if (wr == 0) PG8_BAR; }
        if constexpr (!Epi::AFTER_DRAIN) { E(acc, cur, wr, wc, fr, fq); S.done(cur); }
        if (!has_next) break;
#pragma unroll
        for (int a = 0; a < 2; ++a)
#pragma unroll
            for (int b = 0; b < 2; ++b)
#pragma unroll
                for (int m = 0; m < 4; ++m)
#pragma unroll
                    for (int n = 0; n < 2; ++n) acc[a][b][m][n] = (f32x4){0.f, 0.f, 0.f, 0.f};
        cur = nxt; cA = nA; cB = nB; ++ui;
        if constexpr (GATHER) { vAc0[0] = vAn0[0]; vAc0[1] = vAn0[1]; vAc1[0] = vAn1[0]; vAc1[1] = vAn1[1]; }
        if constexpr (ALIGN_EPI) { if (wr == 1) PG8_BAR; }
    }
    PG8_WAIT_V(0);
    if constexpr (!ALIGN_EPI) { if (wr == 0) PG8_BAR; }
    PG8_BAR;
    if constexpr (Epi::AFTER_DRAIN) { E.fused(acc, cur, wr, wc, fr, fq, lds, wid, lane); S.done(cur); }
#undef PG8_SA
#undef PG8_SB
#undef PG8_STAGE
#undef PG8_LDA
#undef PG8_LDB
#undef PG8_MMA
#undef PG8_WAIT_V
#undef PG8_WAIT_L
#undef PG8_BAR
#undef PG8_SCHED
#undef PG8_GOFF
#undef PG8_STG_A
}
}
namespace pg8 {
#define EPI_ROWS(u, wr, fr) const int row00 = (u).pm * BM + (wr) * 64 + (fr)
#define EPI_GET8(v, ai, bj, m) float v[8] = {acc[ai][bj][m][0][0], acc[ai][bj][m][0][1], acc[ai][bj][m][0][2], acc[ai][bj][m][0][3], acc[ai][bj][m][1][0], acc[ai][bj][m][1][1], acc[ai][bj][m][1][2], acc[ai][bj][m][1][3]}

struct EpiPlain {
    static constexpr bool PERM = true, AFTER_DRAIN = false;
    bf16_t* O; int ldc;
    __device__ __forceinline__ void operator()(const f32x4 (&acc)[2][2][4][2], const Unit& u, int wr, int wc, int fr, int fq) const {
        asm volatile("" : "+v"(fr), "+v"(fq));
        EPI_ROWS(u, wr, fr); const int col0 = u.pn * BM + wc * 32 + 8 * fq;
#pragma unroll
        for (int ai = 0; ai < 2; ++ai)
#pragma unroll
            for (int m = 0; m < 4; ++m) { bf16_t* rowp = O + (size_t)(row00 + ai * HALF + m * 16) * ldc + col0;
#pragma unroll
                for (int bj = 0; bj < 2; ++bj) { EPI_GET8(v, ai, bj, m); *(u32x4*)(rowp + bj * HALF) = pack8(v); } }
    }
};

struct EpiInproj {
    static constexpr bool PERM = true, AFTER_DRAIN = false;
    unsigned char* ws; const float *qkn, *mqn, *mkvn; PG8_LAS float* xs;
    __device__ __forceinline__ void operator()(const f32x4 (&acc)[2][2][4][2], const Unit& u, int wr, int wc, int fr, int fq) const {
        asm volatile("" : "+v"(fr), "+v"(fq));
        EPI_ROWS(u, wr, fr); const int pn = u.pn; const bool lat = (u.pm * BM) < TL;
        if (pn >= 9) {
            const int col0 = (pn - 9) * BM + wc * 32 + 8 * fq;
#pragma unroll
            for (int ai = 0; ai < 2; ++ai)
#pragma unroll
                for (int m = 0; m < 4; ++m) { bf16_t* rowp = (bf16_t*)(ws + WS_BIG) + (size_t)(row00 + ai * HALF + m * 16) * 3072 + col0;
#pragma unroll
                    for (int bj = 0; bj < 2; ++bj) { EPI_GET8(v, ai, bj, m); *(u32x4*)(rowp + bj * HALF) = pack8(v); } }
        } else if (pn <= 2) {
            if (pn == 2 && wc >= 2) {
#pragma unroll
                for (int ai = 0; ai < 2; ++ai)
#pragma unroll
                    for (int m = 0; m < 4; ++m) { const int row = row00 + ai * HALF + m * 16; int b_, pos_; bpos_of(row, b_, pos_); bf16_t* vb = (bf16_t*)(ws + WS_VG); const int st = b_ * 2 + (wc - 2);
                        EPI_GET8(x1, ai, 0, m); EPI_GET8(x2, ai, 1, m); *(u32x4*)(vb + vtile_off(st, pos_, 8 * fq)) = pack8(x1); *(u32x4*)(vb + vtile_off(st, pos_, 32 + 8 * fq)) = pack8(x2); }
            } else {
                const bool isq = pn < 2; const float* gn = qkn + (isq ? 0 : 64) + 8 * fq;
                const f32x4 ga0 = *(const f32x4*)gn, ga1 = *(const f32x4*)(gn + 4), gb0 = *(const f32x4*)(gn + 32), gb1 = *(const f32x4*)(gn + 36);
                const float g1[8] = {ga0[0], ga0[1], ga0[2], ga0[3], ga1[0], ga1[1], ga1[2], ga1[3]}, g2[8] = {gb0[0], gb0[1], gb0[2], gb0[3], gb1[0], gb1[1], gb1[2], gb1[3]};
                const float sc = isq ? C2G : 1.f;
#pragma unroll
                for (int ai = 0; ai < 2; ++ai)
#pragma unroll
                    for (int m = 0; m < 4; ++m) { const int row = row00 + ai * HALF + m * 16; f32x4 c0, c1, s0, s1;
                        if (lat) { const int pos = row & (SEQ - 1); const f32x4* cp = (const f32x4*)((const float*)(ws + WS_COSG) + (size_t)pos * 32 + 8 * fq); const f32x4* sp = (const f32x4*)((const float*)(ws + WS_SING) + (size_t)pos * 32 + 8 * fq); c0 = cp[0]; c1 = cp[1]; s0 = sp[0]; s1 = sp[1]; }
                        EPI_GET8(x1, ai, 0, m); EPI_GET8(x2, ai, 1, m); float ss = 0.f;
#pragma unroll
                        for (int i = 0; i < 8; ++i) ss += x1[i] * x1[i] + x2[i] * x2[i];
                        ss += __shfl_xor(ss, 16); ss += __shfl_xor(ss, 32);
                        const float rstd = __builtin_amdgcn_rsqf(ss * (1.f / 64.f) + RMS_EPS); float o1[8], o2[8];
#pragma unroll
                        for (int i = 0; i < 8; ++i) { const float y1 = x1[i] * rstd * g1[i], y2 = x2[i] * rstd * g2[i]; const float c = lat ? (i < 4 ? c0[i & 3] : c1[i & 3]) : 1.f, s = lat ? (i < 4 ? s0[i & 3] : s1[i & 3]) : 0.f;
                            o1[i] = (y1 * c - y2 * s) * sc; o2[i] = (y2 * c + y1 * s) * sc; }
                        if (isq) { bf16_t* p = (bf16_t*)(ws + WS_QG) + (size_t)row * 512 + (4 * pn + wc) * 64 + 8 * fq; *(u32x4*)p = pack8(o1); *(u32x4*)(p + 32) = pack8(o2); }
                        else { int b_, pos_; bpos_of(row, b_, pos_); bf16_t* kb = (bf16_t*)(ws + WS_KG); const int st = b_ * 2 + wc; *(u32x4*)(kb + ktile_off(st, pos_, fq, 8)) = pack8(o1); *(u32x4*)(kb + ktile_off(st, pos_, 4 + fq, 8)) = pack8(o2); }
                        asm volatile("" ::: "memory"); }
            }
        } else if (pn == 3 || pn == 4 || pn == 7 || pn == 8) {
            const bool vg = pn >= 7; const bool part = (pn == 4) ? (wc < 2) : true;
            float ssr[2][4];
#pragma unroll
            for (int ai = 0; ai < 2; ++ai)
#pragma unroll
                for (int m = 0; m < 4; ++m) { float ss = 0.f;
#pragma unroll
                    for (int bj = 0; bj < 2; ++bj) { EPI_GET8(v, ai, bj, m);
#pragma unroll
                        for (int i = 0; i < 8; ++i) { const float t = vg ? gelu_tanh(v[i]) : v[i]; ss += t * t; } }
                    ss += __shfl_xor(ss, 16); ss += __shfl_xor(ss, 32); ssr[ai][m] = part ? ss : 0.f;
                    if (fq == 0) xs[(ai * HALF + wr * 64 + m * 16 + fr) * 4 + wc] = ssr[ai][m]; }
            asm volatile("s_waitcnt lgkmcnt(0)\n\ts_barrier" ::: "memory");
#pragma unroll
            for (int ai = 0; ai < 2; ++ai)
#pragma unroll
                for (int m = 0; m < 4; ++m) { const f32x4 t = *(const PG8_LAS f32x4*)(xs + (ai * HALF + wr * 64 + m * 16 + fr) * 4); ssr[ai][m] = (t[0] + t[1]) + (t[2] + t[3]); }
            asm volatile("s_waitcnt lgkmcnt(0)\n\ts_barrier" ::: "memory");
            if (pn == 3) {
                const int col0 = wc * 32 + 8 * fq;
#pragma unroll
                for (int ai = 0; ai < 2; ++ai)
#pragma unroll
                    for (int m = 0; m < 4; ++m) { const int row = row00 + ai * HALF + m * 16; const float rstd = __builtin_amdgcn_rsqf(ssr[ai][m] * (1.f / 256.f) + RMS_EPS);
#pragma unroll
                        for (int bj = 0; bj < 2; ++bj) { EPI_GET8(v, ai, bj, m); const int col = col0 + bj * HALF; const f32x4 ga = *(const f32x4*)(mqn + col), gb = *(const f32x4*)(mqn + col + 4);
#pragma unroll
                            for (int i = 0; i < 8; ++i) v[i] *= rstd * (i < 4 ? ga[i] : gb[i - 4]);
                            *(u32x4*)((bf16_t*)(ws + WS_CQN) + (size_t)row * 256 + col) = pack8(v); } }
            } else if (pn == 4) {
                if (wc < 2) {
#pragma unroll
                    for (int ai = 0; ai < 2; ++ai)
#pragma unroll
                        for (int m = 0; m < 4; ++m) { const int row = row00 + ai * HALF + m * 16; const float rstd = __builtin_amdgcn_rsqf(ssr[ai][m] * (1.f / 128.f) + RMS_EPS);
#pragma unroll
                            for (int bj = 0; bj < 2; ++bj) { EPI_GET8(v, ai, bj, m); const int col = wc * 64 + bj * 32 + 8 * fq; const f32x4 ga = *(const f32x4*)(mkvn + col), gb = *(const f32x4*)(mkvn + col + 4);
#pragma unroll
                                for (int i = 0; i < 8; ++i) v[i] *= rstd * (i < 4 ? ga[i] : gb[i - 4]);
                                *(u32x4*)((bf16_t*)(ws + WS_CKVN) + (size_t)row * 128 + col) = pack8(v); } }
                } else if (wc == 2 && fq < 2) {
#pragma unroll
                    for (int ai = 0; ai < 2; ++ai)
#pragma unroll
                        for (int m = 0; m < 4; ++m) { const int row = row00 + ai * HALF + m * 16; const int pos = row & (SEQ - 1);
                            EPI_GET8(x1, ai, 0, m); EPI_GET8(x2, ai, 1, m); float o1[8], o2[8];
                            if (lat) { const f32x4* cp = (const f32x4*)((const float*)(ws + WS_COSM) + (size_t)pos * 16 + 8 * fq); const f32x4* sp = (const f32x4*)((const float*)(ws + WS_SINM) + (size_t)pos * 16 + 8 * fq); const f32x4 c0 = cp[0], c1 = cp[1], s0 = sp[0], s1 = sp[1];
#pragma unroll
                                for (int i = 0; i < 8; ++i) { const float c = i < 4 ? c0[i] : c1[i - 4], s = i < 4 ? s0[i] : s1[i - 4]; o1[i] = x1[i] * c - x2[i] * s; o2[i] = x2[i] * c + x1[i] * s; } }
                            else {
#pragma unroll
                                for (int i = 0; i < 8; ++i) { o1[i] = x1[i]; o2[i] = x2[i]; } }
                            const u32x4 p1 = pack8(o1), p2 = pack8(o2); int b_, pos_; bpos_of(row, b_, pos_); bf16_t* kb = (bf16_t*)(ws + WS_KM);
#pragma unroll
                            for (int h = 0; h < 8; ++h) { *(u32x4*)(kb + ktile_off(b_ * 8 + h, pos_, 8 + fq, 12)) = p1; *(u32x4*)(kb + ktile_off(b_ * 8 + h, pos_, 10 + fq, 12)) = p2; } }
                }
            } else {
                const int half = pn - 7, col0 = half * BM + wc * 32 + 8 * fq;
#pragma unroll
                for (int ai = 0; ai < 2; ++ai)
#pragma unroll
                    for (int m = 0; m < 4; ++m) { const int row = row00 + ai * HALF + m * 16;
#pragma unroll
                        for (int bj = 0; bj < 2; ++bj) { EPI_GET8(v, ai, bj, m);
#pragma unroll
                            for (int i = 0; i < 8; ++i) v[i] = gelu_tanh(v[i]);
                            *(u32x4*)((bf16_t*)(ws + WS_VN) + (size_t)row * 512 + col0 + bj * HALF) = pack8(v); }
                        if (wc == 0 && fq == 0) ((float*)(ws + WS_SSV))[(size_t)row * 2 + half] = ssr[ai][m]; }
            }
        } else {
            const int col0 = (pn - 5) * BM + wc * 32 + 8 * fq;
#pragma unroll
            for (int ai = 0; ai < 2; ++ai)
#pragma unroll
                for (int m = 0; m < 4; ++m) { const int row = row00 + ai * HALF + m * 16;
#pragma unroll
                    for (int bj = 0; bj < 2; ++bj) { EPI_GET8(v, ai, bj, m);
#pragma unroll
                        for (int i = 0; i < 8; ++i) v[i] = gelu_tanh(v[i]);
                        *(u32x4*)((bf16_t*)(ws + WS_UACT) + (size_t)row * 512 + col0 + bj * HALF) = pack8(v); } }
        }
    }
};

struct EpiUq {
    static constexpr bool PERM = true, AFTER_DRAIN = false;
    bf16_t* Qm; const float* cosM; const float* sinM;
    __device__ __forceinline__ void operator()(const f32x4 (&acc)[2][2][4][2], const Unit& u, int wr, int wc, int fr, int fq) const {
        asm volatile("" : "+v"(fr), "+v"(fq));
        EPI_ROWS(u, wr, fr);
        if (u.pn < 2) {
#pragma unroll
            for (int ai = 0; ai < 2; ++ai)
#pragma unroll
                for (int m = 0; m < 4; ++m) { const int row = row00 + ai * HALF + m * 16;
#pragma unroll
                    for (int bj = 0; bj < 2; ++bj) { const int col = u.pn * BM + bj * HALF + wc * 32 + 8 * fq; const int head = col >> 6, d = col & 63;
                        EPI_GET8(v, ai, bj, m);
#pragma unroll
                        for (int i = 0; i < 8; ++i) v[i] *= C2M;
                        *(u32x4*)(Qm + (size_t)row * 768 + head * 96 + d) = pack8(v); } asm volatile("" ::: "memory"); }
        } else {
            const int cc = wc * 32 + 8 * fq, hh = cc >> 4, j0 = cc & 15;
            const bool lat = (u.pm * BM) < TL;
#pragma unroll
            for (int ai = 0; ai < 2; ++ai)
#pragma unroll
                for (int m = 0; m < 4; ++m) { const int row = row00 + ai * HALF + m * 16;
                    EPI_GET8(x1, ai, 0, m); EPI_GET8(x2, ai, 1, m);
                    float cs[8], sn[8];
                    if (lat) { const int pos = row & (SEQ - 1); const f32x4* cp = (const f32x4*)(cosM + (size_t)pos * 16 + j0); const f32x4* sp = (const f32x4*)(sinM + (size_t)pos * 16 + j0);
                        const f32x4 c0 = cp[0], c1 = cp[1], s0 = sp[0], s1 = sp[1];
                        cs[0] = c0[0]; cs[1] = c0[1]; cs[2] = c0[2]; cs[3] = c0[3]; cs[4] = c1[0]; cs[5] = c1[1]; cs[6] = c1[2]; cs[7] = c1[3];
                        sn[0] = s0[0]; sn[1] = s0[1]; sn[2] = s0[2]; sn[3] = s0[3]; sn[4] = s1[0]; sn[5] = s1[1]; sn[6] = s1[2]; sn[7] = s1[3]; }
                    else {
#pragma unroll
                        for (int i = 0; i < 8; ++i) { cs[i] = 1.f; sn[i] = 0.f; } }
                    float o1[8], o2[8];
#pragma unroll
                    for (int i = 0; i < 8; ++i) { o1[i] = (x1[i] * cs[i] - x2[i] * sn[i]) * C2M; o2[i] = (x2[i] * cs[i] + x1[i] * sn[i]) * C2M; }
                    bf16_t* qp = Qm + (size_t)row * 768 + hh * 96 + 64 + j0;
                    *(u32x4*)(qp) = pack8(o1); *(u32x4*)(qp + 16) = pack8(o2); asm volatile("" ::: "memory"); }
        }
    }
};

struct EpiUkv {
    static constexpr bool PERM = true, AFTER_DRAIN = false;
    bf16_t* Km; bf16_t* Vm;
    __device__ __forceinline__ void operator()(const f32x4 (&acc)[2][2][4][2], const Unit& u, int wr, int wc, int fr, int fq) const {
        asm volatile("" : "+v"(fr), "+v"(fq));
        EPI_ROWS(u, wr, fr); const int within = wc * 32 + 8 * fq;
#pragma unroll
        for (int ai = 0; ai < 2; ++ai)
#pragma unroll
            for (int m = 0; m < 4; ++m) { const int row = row00 + ai * HALF + m * 16; int b_, pos_; bpos_of(row, b_, pos_);
#pragma unroll
                for (int bj = 0; bj < 2; ++bj) { const int head = u.pn * 2 + bj; EPI_GET8(v, ai, bj, m);
                    bf16_t* p = (within < 64) ? (Km + ktile_off(b_ * 8 + head, pos_, within >> 3, 12)) : (Vm + vtile_off(b_ * 8 + head, pos_, within - 64));
                    *(u32x4*)p = pack8(v); } asm volatile("" ::: "memory"); }
    }
};

template <int IDX> struct EpiBranch {
    static constexpr bool PERM = true, AFTER_DRAIN = false;
    const bf16_t* Z; bf16_t* MERGEB;
    __device__ __forceinline__ void operator()(const f32x4 (&acc)[2][2][4][2], const Unit& u, int wr, int wc, int fr, int fq) const {
        asm volatile("" : "+v"(fr), "+v"(fq));
        EPI_ROWS(u, wr, fr); const int col0 = u.pn * BM + wc * 32 + 8 * fq;
#pragma unroll
        for (int ai = 0; ai < 2; ++ai) {
            u32x4 gr[4][2], mr[4][2];
#pragma unroll
            for (int m = 0; m < 4; ++m) { const int row = row00 + ai * HALF + m * 16;
#pragma unroll
                for (int bj = 0; bj < 2; ++bj) { const int col = col0 + bj * HALF; gr[m][bj] = *(const u32x4*)(Z + (size_t)row * 3072 + IDX * 1024 + col);
                    if (IDX != 0) mr[m][bj] = *(const u32x4*)(MERGEB + (size_t)row * 1024 + col); } }
#pragma unroll
            for (int m = 0; m < 4; ++m) { const int row = row00 + ai * HALF + m * 16;
#pragma unroll
                for (int bj = 0; bj < 2; ++bj) { const int col = col0 + bj * HALF; EPI_GET8(v, ai, bj, m); float g[8], a[8], r[8]; unpack8(gr[m][bj], g);
                    if (IDX != 0) unpack8(mr[m][bj], a);
#pragma unroll
                    for (int i = 0; i < 8; ++i) r[i] = (IDX != 0 ? a[i] : 0.f) + sigmoidf_(g[i]) * v[i];
                    *(u32x4*)(MERGEB + (size_t)row * 1024 + col) = pack8(r); } }
            asm volatile("" ::: "memory"); }
    }
};

struct EpiMoe1 {
    static constexpr bool PERM = true, AFTER_DRAIN = false;
    bf16_t* H; const float* b1;
    __device__ __forceinline__ void operator()(const f32x4 (&acc)[2][2][4][2], const Unit& u, int wr, int wc, int fr, int fq) const {
        asm volatile("" : "+v"(fr), "+v"(fq));
        EPI_ROWS(u, wr, fr); const int e = u.pn >> 3, pnl = u.pn & 7, cc = pnl * 128 + wc * 32 + 8 * fq;
        const float* bp = b1 + (size_t)e * 2048 + cc;
        const f32x4 bg0 = *(const f32x4*)bp, bg1 = *(const f32x4*)(bp + 4), bl0 = *(const f32x4*)(bp + 1024), bl1 = *(const f32x4*)(bp + 1028);
        float lim = 7.0f; asm volatile("" : "+v"(lim));
#pragma unroll
        for (int ai = 0; ai < 2; ++ai)
#pragma unroll
            for (int m = 0; m < 4; ++m) { const int row = row00 + ai * HALF + m * 16;
                EPI_GET8(g, ai, 0, m); EPI_GET8(l, ai, 1, m); float r[8];
#pragma unroll
                for (int i = 0; i < 8; ++i) { float glu = g[i] + (i < 4 ? bg0[i] : bg1[i - 4]); float lin = l[i] + (i < 4 ? bl0[i] : bl1[i - 4]);
                    glu = fminf(glu, lim); lin = fminf(fmaxf(lin, -lim), lim);
                    r[i] = glu * sigmoidf_(1.702f * glu) * (lin + 1.0f); }
                *(u32x4*)(H + (size_t)row * 1024 + cc) = pack8(r); }
    }
};

struct EpiMoe2 {
    static constexpr bool PERM = true, AFTER_DRAIN = false;
    bf16_t* Yp; const float* b2; const float* lw; const PG8_LAS int* tab;
    __device__ __forceinline__ void operator()(const f32x4 (&acc)[2][2][4][2], const Unit& u, int wr, int wc, int fr, int fq) const {
        asm volatile("" : "+v"(fr), "+v"(fq));
        EPI_ROWS(u, wr, fr); const int e = u.pn >> 2, pnl = u.pn & 3, col0 = pnl * BM + wc * 32 + 8 * fq;
        f32x4 bv[2][2];
#pragma unroll
        for (int bj = 0; bj < 2; ++bj) { bv[bj][0] = *(const f32x4*)(b2 + (size_t)e * 1024 + col0 + bj * HALF); bv[bj][1] = *(const f32x4*)(b2 + (size_t)e * 1024 + col0 + bj * HALF + 4); }
#pragma unroll
        for (int ai = 0; ai < 2; ++ai)
#pragma unroll
            for (int m = 0; m < 4; ++m) { const int row = row00 + ai * HALF + m * 16; const int slot = row - tab[600 + e]; const float w = (slot < tab[640 + e]) ? lw[(size_t)e * TA + slot] : 0.f;
#pragma unroll
                for (int bj = 0; bj < 2; ++bj) { EPI_GET8(v, ai, bj, m); float r[8];
#pragma unroll
                    for (int i = 0; i < 8; ++i) r[i] = (v[i] + (i < 4 ? bv[bj][0][i] : bv[bj][1][i - 4])) * w;
                    *(u32x4*)(Yp + (size_t)row * 1024 + col0 + bj * HALF) = pack8(r); } }
    }
};

template <int NPN> struct MoeOrder {
    int nunits, G, v; const PG8_LAS int* tab; const PG8_LAS int* rowtok;
    __device__ __forceinline__ int tok(int i, int r) const { return rowtok[i * 256 + r]; }
    __device__ __forceinline__ bool next(int i, Unit& u) const {
        const long L = (long)i * G + v; if (L >= nunits) return false;
        const int blk = (int)L / NPN, pnl = (int)L % NPN; const int e = __builtin_amdgcn_readfirstlane(tab[blk]);
        u.pm = blk; u.pn = e * NPN + pnl; return true;
    }
    __device__ __forceinline__ void a_ready(const Unit&) const {}
    __device__ __forceinline__ void done(const Unit&) const {}
};
}
namespace attn_body {
using bf16x8=__attribute__((ext_vector_type(8)))short;
using s16x4=__attribute__((ext_vector_type(4)))short;
using f32x16=__attribute__((ext_vector_type(16)))float;
using u32x4=__attribute__((ext_vector_type(4)))unsigned;
constexpr int NW=8,QBLK=32,QB=QBLK*NW,KVBLK=64;
__device__ __forceinline__ int crow(int r,int hi){return (r&3)+8*(r>>2)+4*hi;}
#define SBAR() __builtin_amdgcn_sched_barrier(0)
constexpr int NSLOT=3, SLOTB=8192;
__device__ __forceinline__ void glds16(const void*gsrc,unsigned lds_dst){unsigned keep;
  asm volatile("s_mov_b32 %0, m0\n\ts_mov_b32 m0, %2\n\ts_nop 0\n\tglobal_load_lds_dwordx4 %1, off\n\ts_mov_b32 m0, %0":"=&s"(keep):"v"(gsrc),"s"(lds_dst):"memory");}
__device__ __forceinline__ float max3f(float a,float b,float c){float r;asm("v_max3_f32 %0, %1, %2, %3":"=v"(r):"v"(a),"v"(b),"v"(c));return r;}
__device__ __forceinline__ float max2f(float a,float b){float r;asm("v_max_f32_e32 %0, %1, %2":"=v"(r):"v"(a),"v"(b));return r;}
__device__ __forceinline__ float fadd_s(float a,float b){float r;asm("v_add_f32_e32 %0, %1, %2":"=v"(r):"v"(a),"v"(b));return r;}
__device__ __forceinline__ float fsub_s(float a,float b){float r;asm("v_sub_f32_e32 %0, %1, %2":"=v"(r):"v"(a),"v"(b));return r;}
typedef float f32x2_t __attribute__((ext_vector_type(2))); typedef __bf16 bf16x2_t __attribute__((ext_vector_type(2)));
__device__ __forceinline__ unsigned cvtpk_s(float lo,float hi){f32x2_t v={lo,hi};bf16x2_t b=__builtin_convertvector(v,bf16x2_t);return __builtin_bit_cast(unsigned,b);}
#define WAIT_BAR(N) asm volatile("s_waitcnt vmcnt(" #N ") lgkmcnt(0)\n\ts_barrier":::"memory")
typedef __attribute__((address_space(3))) const char* lds_cptr;
typedef short v4i16_t __attribute__((ext_vector_type(4)));
__device__ __forceinline__ void kload2(bf16x8*kf,lds_cptr kp,int j){ kf[2*j]=*(const __attribute__((address_space(3))) bf16x8*)(kp+j*2048); kf[2*j+1]=*(const __attribute__((address_space(3))) bf16x8*)(kp+j*2048+512); }
__device__ __forceinline__ s16x4 vtr(lds_cptr p){ return __builtin_bit_cast(s16x4,__builtin_amdgcn_ds_read_tr16_b64_v4i16((__attribute__((address_space(3))) v4i16_t*)p)); }
__device__ __forceinline__ float rowmax(const f32x16&p0,const f32x16&p1){
  float a=max3f(p0[0],p0[1],p1[0]),b=max3f(p0[2],p0[3],p1[1]);a=max3f(a,p1[2],p1[3]);
  #pragma unroll
  for(int r=4;r<16;r+=4){a=max3f(a,p0[r],p0[r+1]);b=max3f(b,p0[r+2],p0[r+3]);a=max3f(a,p1[r],p1[r+1]);b=max3f(b,p1[r+2],p1[r+3]);}
  const float m=max2f(a,b);
  auto rr=__builtin_amdgcn_permlane32_swap(__float_as_uint(m),__float_as_uint(m),false,false);
  return max2f(__uint_as_float(rr[0]),__uint_as_float(rr[1]));
}
__device__ __forceinline__ void pv(f32x16*o,int vb,bf16x8 pa0,bf16x8 pa1,bf16x8 pa2,bf16x8 pa3){
  #pragma unroll
  for(int d0=0;d0<2;++d0){s16x4 lo[4],hi[4];
    #pragma unroll
    for(int ks=0;ks<4;++ks){
      asm volatile("ds_read_b64_tr_b16 %0,%1 offset:%c2":"=&v"(lo[ks]):"v"(vb),"i"(d0*4096+ks*1024):"memory");
      asm volatile("ds_read_b64_tr_b16 %0,%1 offset:%c2":"=&v"(hi[ks]):"v"(vb),"i"(d0*4096+ks*1024+512):"memory");}
    asm volatile("s_waitcnt lgkmcnt(0)":::"memory");SBAR();
    #define PK(k) (bf16x8){lo[k][0],lo[k][1],lo[k][2],lo[k][3],hi[k][0],hi[k][1],hi[k][2],hi[k][3]}
    o[d0]=__builtin_amdgcn_mfma_f32_32x32x16_bf16(pa0,PK(0),o[d0],0,0,0);
    o[d0]=__builtin_amdgcn_mfma_f32_32x32x16_bf16(pa1,PK(1),o[d0],0,0,0);
    o[d0]=__builtin_amdgcn_mfma_f32_32x32x16_bf16(pa2,PK(2),o[d0],0,0,0);
    o[d0]=__builtin_amdgcn_mfma_f32_32x32x16_bf16(pa3,PK(3),o[d0],0,0,0);
    #undef PK
  }
}
template<int NKS> struct AttnLds {
  static constexpr int SLOTK=NKS*2048;
  static constexpr int LDS_K=0, LDS_V=NSLOT*SLOTK, LDS_WS=LDS_V+NSLOT*SLOTB, LDS_OST=LDS_WS+NW*64*4, LDS_BYTES=LDS_OST+NW*4096;
};
template<int NKS,int QP,int KP,int VP,int OP,int THRL,bool LS,bool SK>
__device__ __forceinline__ void attn_unit(const bf16*Qu,const bf16*__restrict__ Ku,const bf16*__restrict__ Vu,bf16*Ou,const int NT,char*shm){
  using L=AttnLds<NKS>;
  constexpr int SLOTK=L::SLOTK, LDS_K=L::LDS_K, LDS_V=L::LDS_V, LDS_WS=L::LDS_WS, LDS_OST=L::LDS_OST;
  int tid_=threadIdx.x; asm volatile("":"+v"(tid_));
  const int tid=tid_,lane=tid&63,r32=lane&31,hi=lane>>5; const int wid=__builtin_amdgcn_readfirstlane(tid>>6);
  const bf16*Qw=Qu+(long)(wid*QBLK)*QP;
  const unsigned lds0=(unsigned)(uintptr_t)shm;
  float*wsf=(float*)(shm+LDS_WS)+wid*64;
  const bf16*ksrc=Ku+wid*512+lane*8;
  const bf16*ksrc2=Ku+(8+(wid&3))*512+lane*8;
  const bf16*vsrc=Vu+wid*512+lane*8;
  const unsigned kdst=lds0+LDS_K+wid*1024, kdst2=lds0+LDS_K+(8+(wid&3))*1024, vdst=lds0+LDS_V+wid*1024;
  #define DMA_K(t,slot) do{ glds16(ksrc+(long)(t)*(NKS*1024),(unsigned)__builtin_amdgcn_readfirstlane(kdst+(slot))); \
      if constexpr(NKS==6){ glds16(ksrc2+(long)(t)*(NKS*1024),(unsigned)__builtin_amdgcn_readfirstlane(kdst2+(slot))); } }while(0)
  #define DMA_V(t,slot) glds16(vsrc+(long)(t)*4096,(unsigned)__builtin_amdgcn_readfirstlane(vdst+(slot)))
  #define WAIT_C()  do{ if constexpr(NKS==6){WAIT_BAR(3);}else{WAIT_BAR(2);} }while(0)
  #define WAIT_P()  do{ if constexpr(NKS==6){WAIT_BAR(5);}else{WAIT_BAR(3);} }while(0)
  #define WAITA_K() do{ if constexpr(NKS==6){WAIT_BAR(2);}else{WAIT_BAR(1);} }while(0)
  #define BARONLY() asm volatile("s_barrier":::"memory")
  const int vb0=(int)(lds0+LDS_V)+((lane>>4)&1)*32+(lane&3)*8+(4*hi+((lane&15)>>2))*64;
  const char*Kbase=shm+LDS_K; bf16x8 kf[2*NKS];
  const lds_cptr shm3=(lds_cptr)shm; const lds_cptr kp0=shm3+LDS_K+hi*1024+r32*16; const lds_cptr vp0=shm3+LDS_V+((lane>>4)&1)*32+(lane&3)*8+(4*hi+((lane&15)>>2))*64;
  DMA_K(0,0);DMA_V(0,0);DMA_K(1,SLOTK);
  bf16x8 qr[NKS];
  #pragma unroll
  for(int d0=0;d0<NKS;++d0)qr[d0]=*reinterpret_cast<const bf16x8*>(&Qw[(long)r32*QP+d0*16+hi*8]);
  float mhat=0.f,l_reg=0.f;f32x16 o[2];o[0]=f32x16{};o[1]=f32x16{};f32x16 negm=f32x16{};asm volatile("":"+v"(negm));
  f32x16 o2=f32x16{}; const bf16x8 ONES=(bf16x8){(short)0x3F80,(short)0x3F80,(short)0x3F80,(short)0x3F80,(short)0x3F80,(short)0x3F80,(short)0x3F80,(short)0x3F80};
  bool resc=false;
  #define START(P0,P1) do{ const float rm=rowmax(P0,P1); resc=false; \
    { const float dl=rm; mhat=fadd_s(mhat,dl); \
      _Pragma("unroll") for(int r=0;r<16;++r){P0[r]=fsub_s(P0[r],dl);P1[r]=fsub_s(P1[r],dl);} \
      _Pragma("unroll") for(int r=0;r<16;++r)negm[r]=-mhat; asm volatile("":"+v"(negm)); } \
    _Pragma("unroll") for(int r=0;r<16;++r)P0[r]=__builtin_amdgcn_exp2f(P0[r]); }while(0)
  #define RESC() do{ if(resc){ asm volatile("s_waitcnt lgkmcnt(0)":::"memory"); \
      _Pragma("unroll") for(int d_=0;d_<2;++d_) _Pragma("unroll") for(int r=0;r<16;++r)o[d_][r]*=wsf[crow(r,hi)]; \
      if constexpr(LS){ _Pragma("unroll") for(int r=0;r<16;++r)o2[r]*=wsf[crow(r,hi)]; } } }while(0)
  f32x16 pA0,pA1,pB0,pB1;
  int kl_cur=0,kl_next=SLOTK;
  int sl_prev=0,sl_cur=0,sl_next=SLOTB;
  #define ROT() do{sl_prev=sl_cur;sl_cur=sl_next;sl_next=(sl_next==(NSLOT-1)*SLOTB)?0:sl_next+SLOTB; kl_cur=kl_next;kl_next=(kl_next==(NSLOT-1)*SLOTK)?0:kl_next+SLOTK;}while(0)
  DMA_K(2,2*SLOTK);
  WAIT_P();
  { const char*kb=Kbase+hi*1024+r32*16;
    #pragma unroll
    for(int d0=0;d0<NKS;++d0){
      const bf16x8 b0=*reinterpret_cast<const bf16x8*>(kb+d0*2048);
      const bf16x8 b1=*reinterpret_cast<const bf16x8*>(kb+d0*2048+512);
      if(d0==0){pA0=__builtin_amdgcn_mfma_f32_32x32x16_bf16(b0,qr[0],negm,0,0,0);pA1=__builtin_amdgcn_mfma_f32_32x32x16_bf16(b1,qr[0],negm,0,0,0);}
      else{pA0=__builtin_amdgcn_mfma_f32_32x32x16_bf16(b0,qr[d0],pA0,0,0,0);pA1=__builtin_amdgcn_mfma_f32_32x32x16_bf16(b1,qr[d0],pA1,0,0,0);}} }
  asm volatile("s_nop 15\n\ts_nop 7":"+v"(pA0),"+v"(pA1));
  START(pA0,pA1);
  _Pragma("unroll") for(int r=0;r<16;++r)pA1[r]=__builtin_amdgcn_exp2f(pA1[r]);
  WAIT_BAR(0);
  if constexpr(SK){ DMA_V(1,SLOTB);DMA_K(3,0); } else { DMA_K(3,0);DMA_V(1,SLOTB); }
  ROT();
  _Pragma("unroll") for(int j=0;j<NKS;++j)kload2(kf,kp0+kl_cur,j);
  WAIT_C();
  if constexpr(SK){ if(wid>=4){ BARONLY(); } }
  s16x4 vlo[8],vhi[8]; u32x4 pw0,pw1,pw2,pw3;
  #define PKW(P,B) cvtpk_s(P[B],P[B+1])
  #define PAF(k) __builtin_bit_cast(bf16x8,pw##k)
  #define VFR(i) (bf16x8){vlo[i][0],vlo[i][1],vlo[i][2],vlo[i][3],vhi[i][0],vhi[i][1],vhi[i][2],vhi[i][3]}
  #define PIN(x) asm volatile("":"+v"(x))
  #define MX3(a,b,c) __builtin_fmaxf(__builtin_fmaxf((a),(b)),(c))
  #define GAPA(MF,A0,A1,A2,A3,W0,W1,PW) do{ MF; if constexpr(!LS){ sacc+=A0; sacc+=A1; sacc+=A2; sacc+=A3; PIN(sacc); } W0; W1; PIN(PW); SBAR(); }while(0)
  #define LSM(k) do{ if constexpr(LS){ o2=MF32(PAF(k),ONES,o2); SBAR(); } }while(0)
  #define EX(v) __builtin_amdgcn_exp2f(v)
  #define GAPB(MF,X,B) do{ MF; X[B]=EX(X[B]); X[B+1]=EX(X[B+1]); X[B+2]=EX(X[B+2]); X[B+3]=EX(X[B+3]); PIN(X); SBAR(); }while(0)
  #define VRD(i) do{ vlo[i]=vtr(vp_+(((i)>>2)*4096+((i)&3)*1024)); vhi[i]=vtr(vp_+(((i)>>2)*4096+((i)&3)*1024+512)); }while(0)
  #define KRD(G,j) do{ if(G){ kload2(kf,kp0+kl_next,j); SBAR(); } }while(0)
  #define MF32(a,b,c) __builtin_amdgcn_mfma_f32_32x32x16_bf16(a,b,c,0,0,0)
  #define STEP(C0,C1,P0,P1,t,GK,GV,GL,CK,MW) do{ SBAR(); \
    const lds_cptr vp_=vp0+sl_prev; \
    VRD(0); SBAR(); float sacc=LS?0.f:(P0[0]+P0[1]); \
    GAPA(C0=MF32(kf[0],qr[0],negm), P0[2],P0[3],P0[4],P0[5],     pw0[0]=PKW(P0,0), pw0[1]=PKW(P0,2), pw0); \
    VRD(4); SBAR(); GAPA(C1=MF32(kf[1],qr[0],negm), P0[6],P0[7],P0[8],P0[9],     pw0[2]=PKW(P0,4), pw0[3]=PKW(P0,6), pw0); \
    VRD(1); SBAR(); GAPA(C0=MF32(kf[2],qr[1],C0),   P0[10],P0[11],P0[12],P0[13], pw1[0]=PKW(P0,8), pw1[1]=PKW(P0,10), pw1); \
    VRD(5); SBAR(); GAPA(C1=MF32(kf[3],qr[1],C1),   P0[14],P0[15],P1[0],P1[1],   pw1[2]=PKW(P0,12),pw1[3]=PKW(P0,14), pw1); \
    VRD(2); SBAR(); GAPA(C0=MF32(kf[4],qr[2],C0),   P1[2],P1[3],P1[4],P1[5],     pw2[0]=PKW(P1,0), pw2[1]=PKW(P1,2), pw2); \
    VRD(6); SBAR(); GAPA(C1=MF32(kf[5],qr[2],C1),   P1[6],P1[7],P1[8],P1[9],     pw2[2]=PKW(P1,4), pw2[3]=PKW(P1,6), pw2); \
    VRD(3); SBAR(); GAPA(C0=MF32(kf[6],qr[3],C0),   P1[10],P1[11],P1[12],P1[13], pw3[0]=PKW(P1,8), pw3[1]=PKW(P1,10), pw3); \
    VRD(7); SBAR(); GAPA(C1=MF32(kf[7],qr[3],C1),   P1[14],P1[15],0.f,0.f,       pw3[2]=PKW(P1,12),pw3[3]=PKW(P1,14), pw3); \
    if constexpr(NKS==6){ C0=MF32(kf[8],qr[4],C0); SBAR(); C1=MF32(kf[9],qr[4],C1); SBAR(); C0=MF32(kf[10],qr[5],C0); SBAR(); C1=MF32(kf[11],qr[5],C1); SBAR(); } \
    if constexpr(!LS){ l_reg+=sacc; } \
    if constexpr(SK){ MW; if(GV){DMA_V((t)+1,sl_next);} if(GK){DMA_K((t)+3,kl_cur);} } else { if(GK){DMA_K((t)+3,kl_cur);} if(GV){DMA_V((t)+1,sl_next);} } \
    if(CK){ float a=MX3(C0[0],C0[1],C1[0]),b=MX3(C0[2],C0[3],C1[1]); a=MX3(a,C1[2],C1[3]); \
      _Pragma("unroll") for(int r=4;r<16;r+=4){a=MX3(a,C0[r],C0[r+1]);b=MX3(b,C0[r+2],C0[r+3]);a=MX3(a,C1[r],C1[r+1]);b=MX3(b,C1[r+2],C1[r+3]);} \
      float rm=__builtin_fmaxf(a,b); { auto rr=__builtin_amdgcn_permlane32_swap(__float_as_uint(rm),__float_as_uint(rm),false,false); rm=__builtin_fmaxf(__uint_as_float(rr[0]),__uint_as_float(rr[1])); } \
      resc=false; \
      if(__builtin_expect(__any(rm>(float)THRL),0)){ const float dl=__builtin_fmaxf(rm,0.f); mhat+=dl; \
        _Pragma("unroll") for(int r=0;r<16;++r){C0[r]-=dl;C1[r]-=dl;} \
        _Pragma("unroll") for(int r=0;r<16;++r)negm[r]=-mhat; asm volatile("":"+v"(negm)); \
        const float f=__builtin_amdgcn_exp2f(-dl); l_reg*=f; if(hi==0)wsf[r32]=f; resc=true; } } else { resc=false; } \
    SBAR(); \
    GAPB(o[0]=MF32(PAF(0),VFR(0),o[0]), C0,0); \
    GAPB(o[1]=MF32(PAF(0),VFR(4),o[1]), C0,4); LSM(0); \
    KRD(GL,0); GAPB(o[0]=MF32(PAF(1),VFR(1),o[0]), C0,8); \
    KRD(GL,1); GAPB(o[1]=MF32(PAF(1),VFR(5),o[1]), C0,12); LSM(1); \
    KRD(GL,2); GAPB(o[0]=MF32(PAF(2),VFR(2),o[0]), C1,0); \
    KRD(GL,3); GAPB(o[1]=MF32(PAF(2),VFR(6),o[1]), C1,4); LSM(2); \
    if constexpr(NKS==6){ KRD(GL,4); } GAPB(o[0]=MF32(PAF(3),VFR(3),o[0]), C1,8); \
    if constexpr(NKS==6){ KRD(GL,5); } GAPB(o[1]=MF32(PAF(3),VFR(7),o[1]), C1,12); LSM(3); \
    }while(0)
  int t=1;
  for(;t+11<NT;t+=8){
    STEP(pB0,pB1,pA0,pA1,t,true,true,true,true,WAITA_K());      WAIT_C(); RESC(); ROT();
    STEP(pA0,pA1,pB0,pB1,t+1,true,true,true,false,WAITA_K());   WAIT_C(); ROT();
    STEP(pB0,pB1,pA0,pA1,t+2,true,true,true,false,WAITA_K());   WAIT_C(); ROT();
    STEP(pA0,pA1,pB0,pB1,t+3,true,true,true,false,WAITA_K());   WAIT_C(); ROT();
    STEP(pB0,pB1,pA0,pA1,t+4,true,true,true,false,WAITA_K());   WAIT_C(); ROT();
    STEP(pA0,pA1,pB0,pB1,t+5,true,true,true,false,WAITA_K());   WAIT_C(); ROT();
    STEP(pB0,pB1,pA0,pA1,t+6,true,true,true,false,WAITA_K());   WAIT_C(); ROT();
    STEP(pA0,pA1,pB0,pB1,t+7,true,true,true,false,WAITA_K());   WAIT_C(); ROT();
  }
  for(;t+5<NT;t+=2){
    STEP(pB0,pB1,pA0,pA1,t,true,true,true,true,WAITA_K());     WAIT_C(); RESC(); ROT();
    STEP(pA0,pA1,pB0,pB1,t+1,true,true,true,true,WAITA_K());   WAIT_C(); RESC(); ROT();
  }
  #define ENDW(tt) do{ if constexpr(SK){ if((tt)+3<NT){WAIT_C();} else if((tt)+1<NT){WAIT_BAR(1);} else {WAIT_BAR(0);} } \
                       else { if((tt)+3<NT){WAIT_C();} else if((tt)+2<NT){WAIT_BAR(1);} else {WAIT_BAR(0);} } }while(0)
  #define ENDA(tt) do{ if((tt)+2<NT){WAITA_K();} else {WAIT_BAR(0);} }while(0)
  for(;t+1<NT;t+=2){
    STEP(pB0,pB1,pA0,pA1,t,(t+3<NT),(t+1<NT),(t+1<NT),true,ENDA(t));         ENDW(t);   RESC(); ROT();
    STEP(pA0,pA1,pB0,pB1,t+1,(t+4<NT),(t+2<NT),(t+2<NT),true,ENDA(t+1));     ENDW(t+1); RESC(); ROT();
  }
  STEP(pB0,pB1,pA0,pA1,NT-1,false,false,false,true,WAIT_BAR(0)); if constexpr(SK){ WAIT_BAR(0); } RESC();
  { if constexpr(!LS){ float sacc=pB0[0]+pB0[1]; _Pragma("unroll") for(int r=2;r<16;++r)sacc+=pB0[r]; _Pragma("unroll") for(int r=0;r<16;++r)sacc+=pB1[r]; l_reg+=sacc; }
    pw0=(u32x4){PKW(pB0,0),PKW(pB0,2),PKW(pB0,4),PKW(pB0,6)};pw1=(u32x4){PKW(pB0,8),PKW(pB0,10),PKW(pB0,12),PKW(pB0,14)};pw2=(u32x4){PKW(pB1,0),PKW(pB1,2),PKW(pB1,4),PKW(pB1,6)};pw3=(u32x4){PKW(pB1,8),PKW(pB1,10),PKW(pB1,12),PKW(pB1,14)};
    SBAR(); pv(o,vb0+sl_cur,PAF(0),PAF(1),PAF(2),PAF(3)); LSM(0); LSM(1); LSM(2); LSM(3); }
  if constexpr(SK){ if(wid<4){ BARONLY(); } }
  #undef PKW
  #undef PAF
  #undef VFR
  #undef PIN
  #undef MX3
  #undef GAPA
  #undef GAPB
  #undef EX
  #undef VRD
  #undef KRD
  #undef LSM
  #undef MF32
  #undef STEP
  #undef ENDW
  #undef ENDA
  float rli[16];
  if constexpr(LS){
    #pragma unroll
    for(int r=0;r<16;++r)rli[r]=__builtin_amdgcn_rcpf(o2[r]);
  } else {
    {auto rr=__builtin_amdgcn_permlane32_swap(__float_as_uint(l_reg),__float_as_uint(l_reg),false,false);l_reg=__uint_as_float(rr[0])+__uint_as_float(rr[1]);}
    if(hi==0)wsf[32+r32]=l_reg;asm volatile("s_waitcnt lgkmcnt(0)":::"memory");
    #pragma unroll
    for(int r=0;r<16;++r)rli[r]=__builtin_amdgcn_rcpf(wsf[32+crow(r,hi)]);
  }
  bf16*Ow=Ou+(long)(wid*QBLK)*OP;
  { bf16*stg=(bf16*)(shm+LDS_OST)+wid*2048;
    #pragma unroll
    for(int r=0;r<16;++r){const int orow=crow(r,hi);
      #pragma unroll
      for(int d0=0;d0<2;++d0)stg[orow*64+d0*32+r32]=(bf16)(cvtpk_s(o[d0][r]*rli[r],0.f)&0xffffu);}
    asm volatile("s_waitcnt lgkmcnt(0)":::"memory");
    #pragma unroll
    for(int i=0;i<4;++i){const int row=i*8+(lane>>3),ch=lane&7; const u32x4 v=*(const u32x4*)(stg+row*64+ch*8); *(u32x4*)(Ow+(long)row*OP+ch*8)=v;} }
  asm volatile("s_waitcnt lgkmcnt(0)\n\ts_barrier":::"memory");
  #undef DMA_K
  #undef DMA_V
  #undef WAIT_C
  #undef WAIT_P
  #undef WAITA_K
  #undef BARONLY
  #undef START
  #undef RESC
  #undef ROT
}
#undef SBAR
#undef WAIT_BAR
}
#define XB_TMO      128
#define XB_XCNT(j)  (256  + 64 * (j))
#define XB_XSUB(j)  (1280 + 64 * (j))
#define XB_XGEN(j)  (2304 + 64 * (j))
#define XB_TOP      3328
#define XB_TOPGEN   3392
#define XCD_BAR_WORDS 3456
#define XB_SPIN_CAP (1u << 20)

__device__ __forceinline__ unsigned xb_ld(unsigned* p)              { return __hip_atomic_load(p, __ATOMIC_RELAXED, __HIP_MEMORY_SCOPE_AGENT); }
__device__ __forceinline__ unsigned xb_add(unsigned* p, unsigned v) { return __hip_atomic_fetch_add(p, v, __ATOMIC_RELAXED, __HIP_MEMORY_SCOPE_AGENT); }
__device__ __forceinline__ unsigned xb_xcc_id() { return (unsigned)__builtin_amdgcn_s_getreg((3 << 11) | 20) & 0xFu; }
#define XB_SPIN(cond, bar) do { unsigned _sp = 0; while (cond) { __builtin_amdgcn_s_sleep(1); \
    if ((++_sp & 255u) == 0u) { if (xb_ld(&(bar)[XB_TMO])) break; if (_sp > XB_SPIN_CAP) { atomicAdd(&(bar)[XB_TMO], 1u); break; } } } } while (0)

struct XcdBarrier {
    unsigned* bar; unsigned x;
    volatile LAS unsigned* st;
};
__device__ __forceinline__ XcdBarrier xcd_barrier_post(unsigned* bar, volatile LAS unsigned* st) {
    XcdBarrier b; b.bar = bar; b.x = xb_xcc_id(); b.st = st;
    if (threadIdx.x == 0) (void)xb_add(&bar[XB_XCNT(b.x)], 1u);
    return b;
}
__device__ __forceinline__ void xcd_barrier_complete(unsigned* bar, unsigned x, unsigned& nloc, unsigned& nx) {
    const unsigned G = gridDim.x * gridDim.y * gridDim.z;
    unsigned sum, cnt, mine, sp = 0u;
    for (;;) {
        sum = 0u; cnt = 0u; mine = 0u;
#pragma unroll
        for (unsigned j = 0; j < 16; ++j) { const unsigned c = xb_ld(&bar[XB_XCNT(j)]); sum += c; cnt += (c > 0u) ? 1u : 0u; mine = (j == x) ? c : mine; }
        if (sum == G) break;
        __builtin_amdgcn_s_sleep(1);
        if ((++sp & 255u) == 0u) { if (xb_ld(&bar[XB_TMO])) break; if (sp > XB_SPIN_CAP) { atomicAdd(&bar[XB_TMO], 1u); break; } }
    }
    nloc = mine > 0u ? mine : 1u; nx = cnt > 0u ? cnt : 1u;
}
__device__ __forceinline__ void xcd_barrier(const XcdBarrier& b) {
    asm volatile("s_waitcnt vmcnt(0)" ::: "memory");
    __syncthreads();
    if (threadIdx.x == 0) {
        unsigned* bar = b.bar;
        __builtin_amdgcn_s_waitcnt(0);
        unsigned nloc = b.st[0], nx = b.st[1];
        if (nloc == 0u) { xcd_barrier_complete(bar, b.x, nloc, nx); b.st[0] = nloc; b.st[1] = nx; }
        const unsigned old = xb_add(&bar[XB_XSUB(b.x)], 1u);
        const unsigned gen = old / nloc;
        if (old + 1u == (gen + 1u) * nloc) {
            __builtin_amdgcn_fence(__ATOMIC_RELEASE, "agent");
            asm volatile("s_waitcnt vmcnt(0)" ::: "memory");
            const unsigned og = xb_add(&bar[XB_TOP], 1u);
            const unsigned tg = og / nx;
            if (og + 1u == (tg + 1u) * nx) xb_add(&bar[XB_TOPGEN], 1u);
            else XB_SPIN(xb_ld(&bar[XB_TOPGEN]) == tg, bar);
            __builtin_amdgcn_fence(__ATOMIC_ACQUIRE, "agent");
            xb_add(&bar[XB_XGEN(b.x)], 1u);
            asm volatile("s_waitcnt vmcnt(0)" ::: "memory");
        } else {
            XB_SPIN(xb_ld(&bar[XB_XGEN(b.x)]) == gen, bar);
            __builtin_amdgcn_fence(__ATOMIC_ACQUIRE, "agent");
            asm volatile("s_waitcnt vmcnt(0)" ::: "memory");
        }
    }
    __syncthreads();
}

struct Args { const float* in[24]; float* out; unsigned char* ws; };
enum { I_X = 0, I_C, I_CTX, I_CCTX, I_WMOD, I_BMOD, I_NORMS, I_WIN, I_QKN, I_MQN, I_MKVN, I_WUQ, I_WUKV, I_GVN, I_GWS, I_GBS, I_WBR, I_WOUT, I_RW, I_RB, I_EW1, I_EB1, I_EW2, I_EB2 };

struct Frame {
    LAS unsigned char* lds;
    volatile LAS unsigned* MISC;
    gu32* ctl;
    int tid, lane, wave, G, bx;
    unsigned char* ws;
    __device__ __forceinline__ const float* in(int i) const { const unsigned long long v = __hip_atomic_load((const unsigned long long*)(ws + WS_PTAB) + i, __ATOMIC_RELAXED, __HIP_MEMORY_SCOPE_AGENT);
        const unsigned lo = __builtin_amdgcn_readfirstlane((unsigned)v), hi = __builtin_amdgcn_readfirstlane((unsigned)(v >> 32)); return (const float*)(((unsigned long long)hi << 32) | lo); }
    __device__ __forceinline__ float* out() const { return (float*)in(24); }
};

__device__ __forceinline__ int map_col(int kind, int n) {
    if (kind == 1) { const int pn = n >> 8, c = n & 255, bj = (c >> 7) & 1, wc = (c >> 5) & 3, j = c & 31;
        if (pn < 2) return (4 * pn + wc) * 64 + 32 * bj + j;
        if (pn == 2) return 512 + wc * 64 + 32 * bj + j;
        if (pn == 3) return 768 + c;
        if (pn == 4) { if (wc < 2) return 1024 + wc * 64 + 32 * bj + j; if (wc == 2 && j < 16) return 1152 + 16 * bj + j; return -1; }
        if (pn < 9) return 1184 + (pn - 5) * 256 + c;
        return 2208 + (pn - 9) * 256 + c; }
    if (kind == 2) { if (n < 512) return (n >> 6) * 96 + (n & 63); const int t = n - 512; return ((t & 127) >> 4) * 96 + 64 + 16 * (t >> 7) + (t & 15); }
    if (kind == 3) { return ((n >> 7) & 1) * 1024 + (n >> 8) * 128 + (n & 127); }
    return n;
}
__device__ __forceinline__ void transpose_item(const float* W, int K, int Nsrc, bf16* WT, int nblk, int kind, LAS float* scr, int item, int lane) {
    const int kb = item / nblk, nb = item % nblk, k0 = 64 * kb, n0 = 64 * nb;
    const int src = map_col(kind, n0 + 4 * (lane & 15));
    f32x4 v[16];
#pragma unroll
    for (int i = 0; i < 16; ++i) { const int kk = 4 * i + (lane >> 4); v[i] = (src >= 0) ? *(const f32x4*)(W + (size_t)(k0 + kk) * Nsrc + src) : (f32x4){0.f, 0.f, 0.f, 0.f}; }
#pragma unroll
    for (int i = 0; i < 16; ++i) { const int kk = 4 * i + (lane >> 4); LAS float* d = scr + kk * 65 + 4 * (lane & 15); d[0] = v[i][0]; d[1] = v[i][1]; d[2] = v[i][2]; d[3] = v[i][3]; }
    LDS_WAIT(); asm volatile("" ::: "memory");
    const int c = lane & 7;
#pragma unroll
    for (int j = 0; j < 8; ++j) { const int n = (lane >> 3) + 8 * j; const LAS float* s = scr + (8 * c) * 65 + n;
        v4u o; o.x = cvt_pk(s[0 * 65], s[1 * 65]); o.y = cvt_pk(s[2 * 65], s[3 * 65]); o.z = cvt_pk(s[4 * 65], s[5 * 65]); o.w = cvt_pk(s[6 * 65], s[7 * 65]);
        *(GAS v4u*)(WT + (size_t)(n0 + n) * K + k0 + 8 * c) = o; }
    LDS_WAIT(); asm volatile("" ::: "memory");
}
__device__ __forceinline__ void sincos_acc(float ang, float& c, float& s) {
    const double x = (double)ang; const double n = __builtin_rint(x * 0.6366197723675814);
    double r = __builtin_fma(-n, 1.5707963267948966, x); r = __builtin_fma(-n, 6.123233995736766e-17, r);
    const double r2 = r * r;
    double sp = -2.5052108385441720e-08; sp = sp * r2 + 2.7557319223985893e-06; sp = sp * r2 - 1.9841269841269841e-04; sp = sp * r2 + 8.3333333333333332e-03; sp = sp * r2 - 1.6666666666666666e-01; sp = sp * r2 * r + r;
    double cp = 2.0876756987868099e-09; cp = cp * r2 - 2.7557319223985888e-07; cp = cp * r2 + 2.4801587301587302e-05; cp = cp * r2 - 1.3888888888888889e-03; cp = cp * r2 + 4.1666666666666664e-02; cp = cp * r2 - 0.5; cp = cp * r2 + 1.0;
    const int q = ((int)n) & 3;
    const double sv = (q == 0) ? sp : (q == 1) ? cp : (q == 2) ? -sp : -cp;
    const double cv = (q == 0) ? cp : (q == 1) ? -sp : (q == 2) ? -cp : sp;
    c = (float)cv; s = (float)sv;
}

__device__ __forceinline__ void p_prologue(Frame& F, const Args& A) {
    const int gw = F.bx * 8 + F.wave, NGW = F.G * 8, lane = F.lane;
    if (F.bx == 0 && F.tid < 25) { ((unsigned long long*)(F.ws + WS_PTAB))[F.tid] = (F.tid < 24) ? (unsigned long long)(uintptr_t)A.in[F.tid] : (unsigned long long)(uintptr_t)A.out; }
    { LAS float* sv = (LAS float*)(F.lds + LDS_SVEC);
      for (int i = F.tid; i < 3 * 1024; i += 512) { const float v = (i < 2048) ? A.in[I_C][i] : A.in[I_CCTX][i - 2048]; sv[i] = v * sigmoidf_(v); }
      __syncthreads(); }
    { const LAS float* sv = (const LAS float*)(F.lds + LDS_SVEC); float* mod = (float*)(F.ws + WS_MOD);
      for (int it = gw; it < 3 * DEPTH * 384; it += NGW) { if (it % 3) continue; const int itm = it / 3; const int l = itm / 384, col = (itm % 384) * 16 + (lane & 15), kq = lane >> 4;
          const float* W = A.in[I_WMOD] + (size_t)l * 1024 * 6144 + col; float a0 = 0.f, a1 = 0.f, a2 = 0.f;
#pragma unroll 16
          for (int k = kq * 256; k < kq * 256 + 256; ++k) { const float w = W[(size_t)k * 6144]; a0 += sv[k] * w; a1 += sv[1024 + k] * w; a2 += sv[2048 + k] * w; }
          a0 += __shfl_xor(a0, 16); a1 += __shfl_xor(a1, 16); a2 += __shfl_xor(a2, 16); a0 += __shfl_xor(a0, 32); a1 += __shfl_xor(a1, 32); a2 += __shfl_xor(a2, 32);
          if (lane < 16) { const float b = A.in[I_BMOD][l * 6144 + col]; float* mp = mod + (size_t)l * 3 * 6144 + col; mp[0] = a0 + b; mp[6144] = a1 + b; mp[2 * 6144] = a2 + b; } } }
    { float* cg = (float*)(F.ws + WS_COSG); float* sg = (float*)(F.ws + WS_SING); float* cm = (float*)(F.ws + WS_COSM); float* sm = (float*)(F.ws + WS_SINM);
      const int gt = F.bx * 512 + F.tid, NT_ = F.G * 512;
      for (int i = gt; i < SEQ * 48; i += NT_) { const int pos = i / 48, j = i % 48; const float rowf = (float)(pos >> 6), colf = (float)(pos & 63); float c, s;
          if (j < 32) { const float ang = (j < 16) ? rowf * INVF16[j] : colf * INVF16[j - 16]; sincos_acc(ang, c, s); cg[pos * 32 + j] = c; sg[pos * 32 + j] = s; }
          else { const int jj = j - 32; const float ang = (jj < 8) ? rowf * INVF16[2 * jj] : colf * INVF16[2 * (jj - 8)]; sincos_acc(ang, c, s); cm[pos * 16 + jj] = c; sm[pos * 16 + jj] = s; } } }
    { bf16* wsb = (bf16*)(F.ws + WS_WS); const float* src = A.in[I_GWS]; const int gt = F.bx * 512 + F.tid, NT_ = F.G * 512;
      for (int i = gt; i < DEPTH * 8 * 128 * 128 / 2; i += NT_) { ((unsigned*)wsb)[i] = cvt_pk(src[2 * i], src[2 * i + 1]); } }
    { bf16* rwt = (bf16*)(F.ws + WS_RWT); const float* src = A.in[I_RW]; const int gt = F.bx * 512 + F.tid, NT_ = F.G * 512;
      for (int i = gt; i < DEPTH * 32 * 1024; i += NT_) { const int l = i >> 15, e = (i >> 10) & 31, d = i & 1023; const float w = src[(size_t)l * 32768 + d * 32 + e];
          const unsigned h16 = cvt_pk(w, 0.f) & 0xffffu; const float back = __uint_as_float(h16 << 16);
          rwt[(size_t)l * 65536 + e * 1024 + d] = (bf16)h16; rwt[(size_t)l * 65536 + 32768 + e * 1024 + d] = (bf16)(cvt_pk(w - back, 0.f) & 0xffffu); } }
    { LAS float* scr = (LAS float*)(F.lds + RING_OFF + F.wave * 16640);
      constexpr int I_IN = 16 * 84, I_UQ = 4 * 12, I_UKV = 2 * 16, I_BR = 8 * 16, I_OUT = 16 * 16, I_W1 = 16 * 32, I_W2 = 16 * 16;
      constexpr int PER_LAYER = I_IN + I_UQ + I_UKV + 3 * I_BR + I_OUT + 32 * I_W1 + 32 * I_W2;
      for (int it = gw; it < DEPTH * PER_LAYER; it += NGW) { const int l = it / PER_LAYER; int r = it % PER_LAYER;
          if (r < I_IN) { transpose_item(A.in[I_WIN] + (size_t)l * 1024 * 5280, 1024, 5280, (bf16*)(F.ws + WS_WIN) + (size_t)l * ZW * 1024, 84, 1, scr, r, lane); continue; } r -= I_IN;
          if (r < I_UQ) { transpose_item(A.in[I_WUQ] + (size_t)l * 256 * 768, 256, 768, (bf16*)(F.ws + WS_WUQ) + (size_t)l * 768 * 256, 12, 2, scr, r, lane); continue; } r -= I_UQ;
          if (r < I_UKV) { transpose_item(A.in[I_WUKV] + (size_t)l * 128 * 1024, 128, 1024, (bf16*)(F.ws + WS_WUKV) + (size_t)l * 1024 * 128, 16, 0, scr, r, lane); continue; } r -= I_UKV;
          if (r < 3 * I_BR) { const int i = r / I_BR; transpose_item(A.in[I_WBR] + (size_t)(l * 3 + i) * 512 * 1024, 512, 1024, (bf16*)(F.ws + WS_WBR) + (size_t)(l * 3 + i) * 1024 * 512, 16, 0, scr, r % I_BR, lane); continue; } r -= 3 * I_BR;
          if (r < I_OUT) { transpose_item(A.in[I_WOUT] + (size_t)l * 1024 * 1024, 1024, 1024, (bf16*)(F.ws + WS_WOUT) + (size_t)l * 1024 * 1024, 16, 0, scr, r, lane); continue; } r -= I_OUT;
          if (r < 32 * I_W1) { const int e = r / I_W1; transpose_item(A.in[I_EW1] + (size_t)(l * 32 + e) * 1024 * 2048, 1024, 2048, (bf16*)(F.ws + WS_W1) + (size_t)(l * 32 + e) * 2048 * 1024, 32, 3, scr, r % I_W1, lane); continue; } r -= 32 * I_W1;
          { const int e = r / I_W2; transpose_item(A.in[I_EW2] + (size_t)(l * 32 + e) * 1024 * 1024, 1024, 1024, (bf16*)(F.ws + WS_W2) + (size_t)(l * 32 + e) * 1024 * 1024, 16, 0, scr, r % I_W2, lane); } } }
}

__device__ __forceinline__ void mod_row_to_bf16(const float* xrow, const float* gain, const float* sc, const float* sh, bf16* orow, int lane) {
    const f32x4* xr = (const f32x4*)xrow + lane; f32x4 v[4]; float ss = 0.f;
#pragma unroll
    for (int j = 0; j < 4; ++j) { v[j] = xr[64 * j]; ss += (v[j].x * v[j].x + v[j].y * v[j].y) + (v[j].z * v[j].z + v[j].w * v[j].w); }
    const float rstd = __builtin_amdgcn_rsqf(wave_sum(ss) * (1.f / DM) + RMS_EPS);
    unsigned long long* o8 = (unsigned long long*)orow + lane;
#pragma unroll
    for (int j = 0; j < 4; ++j) { const f32x4 g = ((const f32x4*)gain)[64 * j + lane], s = ((const f32x4*)sc)[64 * j + lane], h = ((const f32x4*)sh)[64 * j + lane];
        const float y0 = v[j].x * rstd * g.x * (1.f + s.x) + h.x, y1 = v[j].y * rstd * g.y * (1.f + s.y) + h.y, y2 = v[j].z * rstd * g.z * (1.f + s.z) + h.z, y3 = v[j].w * rstd * g.w * (1.f + s.w) + h.w;
        o8[64 * j] = (unsigned long long)cvt_pk(y0, y1) | ((unsigned long long)cvt_pk(y2, y3) << 32); }
}

typedef short bf16x8_t __attribute__((ext_vector_type(8)));
typedef float f32x16_t __attribute__((ext_vector_type(16)));
__device__ __forceinline__ void gmlp_unit(Frame& F, const float* gbs, const float* gvn, int l, int chunk, int nt) {
    const int lane = F.lane, g = F.wave, r32 = lane & 31, hi = lane >> 5;
    const bf16* vn = (const bf16*)(F.ws + WS_VN) + (size_t)chunk * 128 * 512 + g * 64; const float* ssv = (const float*)(F.ws + WS_SSV);
    const bf16* ua = (const bf16*)(F.ws + WS_UACT) + (size_t)chunk * 128 * 512 + g * 64;
    bf16* go = (bf16*)(F.ws + WS_GM) + (size_t)chunk * 128 * 512 + g * 64;
    const bf16* wsb = (const bf16*)(F.ws + WS_WS) + (size_t)(l * 8 + g) * 128 * 128;
    const float* bs = gbs + (size_t)(l * 8 + g) * 128;
    LAS bf16* vt = (LAS bf16*)(F.lds + RING_OFF + g * 16384);
    {
        { const int dd = (lane & 3) * 8; const f32x4 ga = *(const f32x4*)(gvn + l * 512 + g * 64 + nt * 32 + dd), gb = *(const f32x4*)(gvn + l * 512 + g * 64 + nt * 32 + dd + 4);
#pragma unroll
          for (int ps = 0; ps < 8; ++ps) { const int q = ps * 16 + (lane >> 2);
            const v4u raw = *(const v4u*)(vn + (size_t)q * 512 + nt * 32 + dd); float fv[8]; unpack8(raw, fv);
            const float* sp = ssv + ((size_t)chunk * 128 + q) * 2; const float rstd = __builtin_amdgcn_rsqf((sp[0] + sp[1]) * (1.f / 512.f) + RMS_EPS);
#pragma unroll
            for (int i = 0; i < 8; ++i) vt[(dd + i) * 136 + q] = (bf16)(cvt_pk(fv[i] * rstd * (i < 4 ? ga[i] : gb[i - 4]), 0.f) & 0xffffu); } }
        LDS_WAIT(); asm volatile("" ::: "memory");
#pragma unroll 1
        for (int mh = 0; mh < 2; ++mh) {
            f32x16_t acc[2]; acc[0] = (f32x16_t){}; acc[1] = (f32x16_t){};
            float uv[2][16], bv[2][16];
#pragma unroll
            for (int mt = 0; mt < 2; ++mt)
#pragma unroll
                for (int rg = 0; rg < 16; ++rg) { const int p = mh * 64 + mt * 32 + (rg & 3) + 8 * (rg >> 2) + 4 * hi;
                    uv[mt][rg] = __uint_as_float((unsigned)ua[(size_t)p * 512 + nt * 32 + r32] << 16); bv[mt][rg] = bs[p]; }
            const bf16* wsl = wsb + (size_t)mh * 64 * 128; asm volatile("" : "+v"(wsl));
#pragma unroll
            for (int ks = 0; ks < 8; ++ks) { const bf16x8_t bfr = *(const LAS bf16x8_t*)(vt + r32 * 136 + ks * 16 + hi * 8);
#pragma unroll
                for (int mt = 0; mt < 2; ++mt) { const bf16x8_t afr = *(const bf16x8_t*)(wsl + (size_t)(mt * 32 + r32) * 128 + ks * 16 + hi * 8);
                    acc[mt] = __builtin_amdgcn_mfma_f32_32x32x16_bf16(afr, bfr, acc[mt], 0, 0, 0); } }
#pragma unroll
            for (int mt = 0; mt < 2; ++mt)
#pragma unroll
                for (int rg = 0; rg < 16; ++rg) { const int p = mh * 64 + mt * 32 + (rg & 3) + 8 * (rg >> 2) + 4 * hi; const size_t off = (size_t)p * 512 + nt * 32 + r32;
                    go[off] = (bf16)(cvt_pk(uv[mt][rg] * (acc[mt][rg] + bv[mt][rg]), 0.f) & 0xffffu); } }
        LDS_WAIT(); asm volatile("" ::: "memory");
    }
}
constexpr int T3_REC_E = 0, T3_REC_W = 8192, T3_REC_S = 16384, T3_HIST = 24576, T3_BASE = T3_HIST + 128;
__device__ __forceinline__ void t3_phase(Frame& F, int l, int T_l, const float* xin_lat, const float* xin_ctx, int cofs, bool dry) {
    float* const outp = F.out();
    const int lane = F.lane, tid = F.tid;
    LAS int* rec_e = (LAS int*)(F.lds + RING_OFF + T3_REC_E); LAS float* rec_w = (LAS float*)(F.lds + RING_OFF + T3_REC_W); LAS int* rec_s = (LAS int*)(F.lds + RING_OFF + T3_REC_S);
    LAS int* hist = (LAS int*)(F.lds + RING_OFF + T3_HIST); LAS int* base = (LAS int*)(F.lds + RING_OFF + T3_BASE);
    if (tid < 32) hist[tid] = 0;
    const int per = (T_l + F.G - 1) / F.G; const int r0 = F.bx * per; int ntok = T_l - r0; ntok = ntok < 0 ? 0 : (ntok > per ? per : ntok);
    const float* norms = F.in(I_NORMS) + (size_t)l * 4 * 1024; const float* modl = (const float*)(F.ws + WS_MOD) + (size_t)l * 3 * 6144;
    const bf16* Y = (const bf16*)(F.ws + WS_Y); bf16* XN = (bf16*)(F.ws + (dry ? WS_H : WS_XN)); bf16* XNL = (bf16*)(F.ws + WS_MERGEB);
    for (int j = F.wave; j < ntok; j += 8) {
        const int r = r0 + j; const bool lat = r < TL; const int who = lat ? (r >> 14) : 2;
        const float* xrow = lat ? xin_lat + (size_t)r * 1024 : xin_ctx + (size_t)(r - TL) * 1024;
        float* orow = dry ? (float*)(F.ws + WS_MERGE) + (size_t)r * 1024 : (lat ? outp + (size_t)r * 1024 : (float*)(F.ws + WS_XC) + (size_t)(r - TL) * 1024);
        const float* mo = modl + (size_t)who * 6144;
        float yv[16], xv[16];
        { const v4u* yp = (const v4u*)(Y + (size_t)r * 1024); float a[8], b[8]; unpack8(yp[lane], a); unpack8(yp[64 + lane], b);
#pragma unroll
          for (int i = 0; i < 8; ++i) { yv[i] = a[i]; yv[8 + i] = b[i]; } }
#pragma unroll
        for (int h = 0; h < 2; ++h)
#pragma unroll
            for (int q = 0; q < 2; ++q) { const f32x4 t = *(const f32x4*)(xrow + h * 512 + 8 * lane + 4 * q);
#pragma unroll
                for (int i = 0; i < 4; ++i) xv[h * 8 + q * 4 + i] = t[i]; }
        float ss = 0.f;
#pragma unroll
        for (int i = 0; i < 16; ++i) ss += yv[i] * yv[i];
        const float rstd = __builtin_amdgcn_rsqf(wave_sum(ss) * (1.f / DM) + RMS_EPS);
        float ss2 = 0.f;
#pragma unroll
        for (int h = 0; h < 2; ++h)
#pragma unroll
            for (int q = 0; q < 2; ++q) { const int d0 = h * 512 + 8 * lane + 4 * q; const f32x4 g1 = *(const f32x4*)(mo + 2 * 1024 + d0), gn = *(const f32x4*)(norms + 1024 + d0); f32x4 o;
#pragma unroll
                for (int i = 0; i < 4; ++i) { const int k = h * 8 + q * 4 + i; const float xn = xv[k] + g1[i] * (yv[k] * rstd * gn[i]); xv[k] = xn; o[i] = xn; ss2 += xn * xn; }
                *(f32x4*)(orow + d0) = o; }
        const float rstd2 = __builtin_amdgcn_rsqf(wave_sum(ss2) * (1.f / DM) + RMS_EPS);
#pragma unroll
        for (int h = 0; h < 2; ++h) { float hi8[8], lo8[8];
#pragma unroll
            for (int q = 0; q < 2; ++q) { const int d0 = h * 512 + 8 * lane + 4 * q; const f32x4 gn = *(const f32x4*)(norms + 2048 + d0), sc = *(const f32x4*)(mo + 4 * 1024 + d0), sh = *(const f32x4*)(mo + 3 * 1024 + d0);
#pragma unroll
                for (int i = 0; i < 4; ++i) hi8[q * 4 + i] = xv[h * 8 + q * 4 + i] * rstd2 * gn[i] * (1.f + sc[i]) + sh[i]; }
            const v4u ph = pack8(hi8); float back[8]; unpack8(ph, back);
#pragma unroll
            for (int i = 0; i < 8; ++i) lo8[i] = hi8[i] - back[i];
            *(v4u*)(XN + (size_t)r * 1024 + h * 512 + 8 * lane) = ph; *(v4u*)(XNL + (size_t)r * 1024 + h * 512 + 8 * lane) = pack8(lo8); }
    }
    asm volatile("s_waitcnt vmcnt(0)" ::: "memory");
    __syncthreads();
    { const int r32 = lane & 31, hi = lane >> 5, w = F.wave; const int ntiles = (ntok + 31) >> 5;
      if (w < ntiles) {
        const int tloc = 32 * w + r32; const int rr = r0 + (tloc < ntok ? tloc : ntok - 1);
        const bf16* whi = (const bf16*)(F.ws + WS_RWT) + (size_t)l * 2 * 32 * 1024 + (size_t)r32 * 1024 + hi * 8; const bf16* wlo = whi + 32 * 1024;
        const bf16* thi = XN + (size_t)rr * 1024 + hi * 8; const bf16* tlo = XNL + (size_t)rr * 1024 + hi * 8;
        f32x16_t acc = (f32x16_t){};
#pragma unroll 8
        for (int ks = 0; ks < 64; ++ks) { const bf16x8_t ah = *(const bf16x8_t*)(whi + ks * 16), al = *(const bf16x8_t*)(wlo + ks * 16), bh = *(const bf16x8_t*)(thi + ks * 16), bl = *(const bf16x8_t*)(tlo + ks * 16);
            acc = __builtin_amdgcn_mfma_f32_32x32x16_bf16(ah, bh, acc, 0, 0, 0); acc = __builtin_amdgcn_mfma_f32_32x32x16_bf16(ah, bl, acc, 0, 0, 0); acc = __builtin_amdgcn_mfma_f32_32x32x16_bf16(al, bh, acc, 0, 0, 0); }
        const float* rb = F.in(I_RB) + l * 32; float v[16]; float ninf = -INFINITY; asm volatile("" : "+v"(ninf));
#pragma unroll
        for (int i = 0; i < 16; ++i) v[i] = acc[i] + rb[(i & 3) + 8 * (i >> 2) + 4 * hi];
        float cm[8]; int cid[8];
#pragma unroll
        for (int k = 0; k < 4; ++k) { float m = v[0];
#pragma unroll
            for (int i = 1; i < 16; ++i) m = fmaxf(m, v[i]);
            int sel = 15;
#pragma unroll
            for (int i = 14; i >= 0; --i) sel = (v[i] == m) ? i : sel;
            sel = (v[15] == m && sel == 15) ? 15 : sel;
            cm[k] = m; cid[k] = (sel & 3) + 8 * (sel >> 2) + 4 * hi;
#pragma unroll
            for (int i = 0; i < 16; ++i) v[i] = (i == sel) ? ninf : v[i]; }
#pragma unroll
        for (int k = 0; k < 4; ++k) { cm[4 + k] = __shfl_xor(cm[k], 32); cid[4 + k] = __shfl_xor(cid[k], 32); }
        float tl[4]; int te[4];
#pragma unroll
        for (int k = 0; k < 4; ++k) { float best = cm[0]; int bid = cid[0]; int bc = 0;
#pragma unroll
            for (int c = 1; c < 8; ++c) { const bool better = (cm[c] > best) || (cm[c] == best && cid[c] < bid); best = better ? cm[c] : best; bid = better ? cid[c] : bid; bc = better ? c : bc; }
            tl[k] = best; te[k] = bid;
#pragma unroll
            for (int c = 0; c < 8; ++c) cm[c] = (c == bc) ? ninf : cm[c]; }
        const float e1 = __expf(tl[1] - tl[0]), e2 = __expf(tl[2] - tl[0]), e3 = __expf(tl[3] - tl[0]); const float inv = 1.f / (1.f + e1 + e2 + e3);
        if (hi == 0 && tloc < ntok) { const float wv[4] = {inv, e1 * inv, e2 * inv, e3 * inv};
#pragma unroll
            for (int k = 0; k < 4; ++k) { const int ls = __hip_atomic_fetch_add(&hist[te[k]], 1, __ATOMIC_RELAXED, __HIP_MEMORY_SCOPE_WORKGROUP);
                rec_e[tloc * 4 + k] = te[k]; rec_w[tloc * 4 + k] = wv[k]; rec_s[tloc * 4 + k] = ls; } }
      } }
    __syncthreads();
    if (tid < 32) { const int n = hist[tid]; base[tid] = n ? (int)__hip_atomic_fetch_add((unsigned*)(F.ctl + CW_CNT + cofs + l * 32 + tid), (unsigned)n, RLX_AGENT) : 0; }
    __syncthreads();
    { int* rte = (int*)(F.ws + WS_RTE); int* rts = (int*)(F.ws + WS_RTS); int* ltok = (int*)(F.ws + WS_LTOK); float* lw = (float*)(F.ws + WS_LW);
      for (int i = tid; i < ntok * 4; i += 512) { const int e = rec_e[i], slot = base[e] + rec_s[i]; const int r = r0 + (i >> 2);
          rte[(size_t)r * 4 + (i & 3)] = e; rts[(size_t)r * 4 + (i & 3)] = slot; ltok[(size_t)e * TA + slot] = r; lw[(size_t)e * TA + slot] = rec_w[i]; } }
}

__device__ __forceinline__ void moe_tables(Frame& F, int l, int cofs) {
    LAS int* tab = (LAS int*)(F.lds + LDS_TAB);
    if (F.tid == 0) { int nb = 0;
#pragma unroll 1
        for (int e = 0; e < 32; ++e) { const int c = (int)__hip_atomic_load((unsigned*)(F.ctl + CW_CNT + cofs + l * 32 + e), RLX_AGENT); const int n = (c + 255) >> 8; tab[600 + e] = nb * 256; tab[640 + e] = c;
            for (int b = 0; b < n; ++b) tab[nb + b] = e; nb += n; }
        tab[632] = nb; }
    __syncthreads();
}
__device__ __forceinline__ void t4_phase(Frame& F, int l, int T_l, bool dummy) {
    float* const outp = F.out();
    const bool nextmod = (l + 1 < DEPTH);
    const float* ngain = F.in(I_NORMS) + (size_t)(l + 1 < DEPTH ? l + 1 : l) * 4 * 1024; const float* nmod = (const float*)(F.ws + WS_MOD) + (size_t)(l + 1 < DEPTH ? l + 1 : l) * 3 * 6144; bf16* XN = (bf16*)(F.ws + WS_XN);
    const LAS int* tab = (const LAS int*)(F.lds + LDS_TAB); const int gw = F.bx * 8 + F.wave, NGW = F.G * 8, lane = F.lane;
    const int* rte = (const int*)(F.ws + WS_RTE); const int* rts = (const int*)(F.ws + WS_RTS); const bf16* Yp = (const bf16*)(F.ws + WS_BIG);
    const float* gain = F.in(I_NORMS) + (size_t)l * 4 * 1024 + 3 * 1024; const float* modl = (const float*)(F.ws + WS_MOD) + (size_t)l * 3 * 6144;
    for (int r = gw; r < T_l; r += NGW) { const bool lat = r < TL; const int who = lat ? (r >> 14) : 2; const float* g2 = modl + (size_t)who * 6144 + 5 * 1024;
        float* xrow = lat ? outp + (size_t)r * 1024 : (float*)(F.ws + WS_XC) + (size_t)(r - TL) * 1024;
        float f[16];
#pragma unroll
        for (int i = 0; i < 16; ++i) f[i] = 0.f;
#pragma unroll
        for (int k = 0; k < 4; ++k) { const int e = rte[(size_t)r * 4 + k], slot = rts[(size_t)r * 4 + k]; const size_t dst = (size_t)(tab[600 + e] + slot);
            const v4u* yp = (const v4u*)(Yp + dst * 1024); float a[8], b[8]; unpack8(yp[lane], a); unpack8(yp[64 + lane], b);
#pragma unroll
            for (int i = 0; i < 8; ++i) { f[i] += a[i]; f[8 + i] += b[i]; } }
        float ss = 0.f;
#pragma unroll
        for (int i = 0; i < 16; ++i) ss += f[i] * f[i];
        const float rstd = __builtin_amdgcn_rsqf(wave_sum(ss) * (1.f / DM) + RMS_EPS);
        float ssn = 0.f;
#pragma unroll
        for (int h = 0; h < 2; ++h) { const int d0 = h * 512 + 8 * lane;
#pragma unroll
            for (int q = 0; q < 2; ++q) { f32x4 xv = *(const f32x4*)(xrow + d0 + 4 * q); const f32x4 gv = *(const f32x4*)(gain + d0 + 4 * q), mv = *(const f32x4*)(g2 + d0 + 4 * q);
#pragma unroll
                for (int i = 0; i < 4; ++i) { xv[i] += mv[i] * (f[h * 8 + q * 4 + i] * rstd * gv[i]); f[h * 8 + q * 4 + i] = xv[i]; ssn += xv[i] * xv[i]; }
                *(f32x4*)((dummy ? (float*)(F.ws + WS_MERGE) + (size_t)r * 1024 : xrow) + d0 + 4 * q) = xv; } }
        if (nextmod) { const float rstdn = __builtin_amdgcn_rsqf(wave_sum(ssn) * (1.f / DM) + RMS_EPS); const float* mo = nmod + (size_t)who * 6144;
#pragma unroll
            for (int h = 0; h < 2; ++h) { const int d0 = h * 512 + 8 * lane; float y[8];
#pragma unroll
                for (int q = 0; q < 2; ++q) { const f32x4 gv = *(const f32x4*)(ngain + d0 + 4 * q), sc = *(const f32x4*)(mo + 1024 + d0 + 4 * q), sh = *(const f32x4*)(mo + d0 + 4 * q);
#pragma unroll
                    for (int i = 0; i < 4; ++i) y[q * 4 + i] = f[h * 8 + q * 4 + i] * rstdn * gv[i] * (1.f + sc[i]) + sh[i]; }
                *(v4u*)(XN + (size_t)r * 1024 + d0) = pack8(y); } } }
}

#ifndef PH_MASK
#define PH_MASK 0xFFFFFFFFu
#endif
#define PH(k) ((PH_MASK >> (k)) & 1u)
#ifndef PH_TWICE
#define PH_TWICE 0u
#endif
#define REP(k) _Pragma("unroll") for (int rep_ = 0; rep_ < (((PH_TWICE >> (k)) & 1u) ? 2 : 1); ++rep_)
__global__ void __launch_bounds__(512, 2) fwd_kernel(Args A) {
    extern __shared__ __attribute__((aligned(16))) unsigned char lds[];
    Frame F;
    F.lds = (LAS unsigned char*)lds; F.MISC = (volatile LAS unsigned*)(F.lds + MISC_OFF);
    F.tid = threadIdx.x; F.lane = F.tid & 63; F.wave = __builtin_amdgcn_readfirstlane(F.tid >> 6);
    F.G = gridDim.x; F.bx = blockIdx.x; F.ws = A.ws; F.ctl = (gu32*)(A.ws + WS_CTL);
    int vcu = (F.G % 8 == 0) ? (F.bx % 8) * (F.G / 8) + F.bx / 8 : F.bx;
    if (F.tid < 64) F.MISC[F.tid] = 0u;
    __syncthreads();
    XcdBarrier bar = xcd_barrier_post((unsigned*)(F.ctl + CW_BAR), F.MISC + 8);
#define GRID_BAR() do { { unsigned* bp_ = (unsigned*)(F.ctl + CW_BAR); unsigned x_ = bar.x; asm volatile("" : "+s"(bp_), "+s"(x_)); bar.bar = bp_; bar.x = x_; } xcd_barrier(bar); \
        { int t_ = threadIdx.x; asm volatile("" : "+v"(t_)); F.tid = t_; F.lane = t_ & 63; unsigned char* w_ = A.ws; int g_ = gridDim.x, b_ = blockIdx.x; asm volatile("" : "+s"(w_), "+s"(g_), "+s"(b_)); \
          F.ws = w_; ws = w_; F.ctl = (gu32*)(w_ + WS_CTL); F.G = g_; F.bx = b_; vcu = (g_ % 8 == 0) ? (b_ % 8) * (g_ / 8) + b_ / 8 : b_; gw = b_ * 8 + F.wave; NGW = g_ * 8; } } while (0)
    int gw = F.bx * 8 + F.wave, NGW = F.G * 8;
    unsigned char* ws = A.ws;

    if (PH(0)) REP(0) p_prologue(F, A);
    GRID_BAR();

#pragma unroll
    for (int l = 0; l < DEPTH; ++l) {
        const int T_l = (l == 0) ? TA : TL;

        if (PH(1) && l == 0) REP(1) { const float* xin_lat = (l == 0) ? F.in(I_X) : F.out(); const float* xin_ctx = (l == 0) ? F.in(I_CTX) : (const float*)(ws + WS_XC);
          const float* norms = F.in(I_NORMS) + (size_t)l * 4 * 1024; const float* modl = (const float*)(ws + WS_MOD) + (size_t)l * 3 * 6144;
          for (int r = gw; r < TA; r += NGW) { const bool lat = r < TL; const int who = lat ? (r >> 14) : 2; const float* mo = modl + (size_t)who * 6144;
            mod_row_to_bf16(lat ? xin_lat + (size_t)r * 1024 : xin_ctx + (size_t)(r - TL) * 1024, norms, mo + 1024, mo, (bf16*)(ws + WS_XN) + (size_t)r * 1024, F.lane); } }
        if (l == 0) GRID_BAR();

        if (PH(2)) REP(2) { pg8::Gemm g{(const bf16*)(ws + WS_XN), (const bf16*)(ws + WS_WIN) + (size_t)l * ZW * 1024, TA, ZW, 1024}; pg8::StaticOrder S; S.init(TA, ZW, F.G, F.bx);
          pg8::EpiInproj E{ws, F.in(I_QKN) + (size_t)l * 128, F.in(I_MQN) + (size_t)l * 256, F.in(I_MKVN) + (size_t)l * 128, (LAS float*)(F.lds + LDS_X)};
          pg8::gemm_phase<pg8::EpiInproj, pg8::StaticOrder, true, true>(F.lds + RING_OFF, g, S, E); }
        GRID_BAR();

        if (PH(4)) REP(4) { pg8::Gemm g{(const bf16*)(ws + WS_CQN), (const bf16*)(ws + WS_WUQ) + (size_t)l * 768 * 256, T_l, 768, 256}; pg8::StaticOrder S; S.init(T_l, 768, F.G, F.bx);
          pg8::EpiUq E{(bf16*)(ws + WS_QM), (const float*)(ws + WS_COSM), (const float*)(ws + WS_SINM)};
          pg8::gemm_phase<pg8::EpiUq, pg8::StaticOrder, true, true>(F.lds + RING_OFF, g, S, E); }
        if (PH(5)) REP(5) { pg8::Gemm g{(const bf16*)(ws + WS_CKVN), (const bf16*)(ws + WS_WUKV) + (size_t)l * 1024 * 128, TA, 1024, 128}; pg8::StaticOrder S; S.init(TA, 1024, F.G, (F.bx + F.G / 2) % F.G);
          pg8::EpiUkv E{(bf16*)(ws + WS_KM), (bf16*)(ws + WS_VM)};
          pg8::gemm_phase<pg8::EpiUkv, pg8::StaticOrder, true, true>(F.lds + RING_OFF, g, S, E); }
        if (PH(6)) REP(6) { const float* gbs = F.in(I_GBS); const float* gvn = F.in(I_GVN); for (int hu = (F.bx + F.G / 4) % F.G; hu < 2 * (T_l / 128); hu += F.G) gmlp_unit(F, gbs, gvn, l, hu >> 1, hu & 1); }
        GRID_BAR();

        { const int per = (1024 + F.G - 1) / F.G; char* shm = (char*)lds + RING_OFF;
          if (PH(7)) REP(7) for (int i = 0; i <= per; ++i) { size_t row0; int b, h, nt, t0;
              if (i < per) { const int L = vcu * per + i; if (L >= 1024) continue; const int bh = L >> 6, qb = L & 63; b = bh >> 3; h = bh & 7; row0 = (size_t)b * SEQ + (size_t)qb * 256; t0 = 0; nt = NTILE; }
              else { if (l != 0 || F.bx >= 16) continue; const int bh = F.bx; b = bh >> 3; h = bh & 7; row0 = (size_t)TL + (size_t)b * CTX; t0 = SEQ / 64; nt = CTX / 64; }
              attn_body::attn_unit<4, 512, 128, 128, 512, 8, false, false>((const bf16*)(ws + WS_QG) + row0 * 512 + h * 64, (const bf16*)(ws + WS_KG) + ((size_t)(b * 2 + (h >> 2)) * NTILE + t0) * 4096, (const bf16*)(ws + WS_VG) + ((size_t)(b * 2 + (h >> 2)) * NTILE + t0) * 4096,
                                                             (bf16*)(ws + WS_OG) + row0 * 512 + h * 64, nt, shm); }
          if (PH(8)) REP(8) for (int i = 0; i <= per; ++i) { size_t row0; int b, h, nt, t0;
              if (i < per) { const int L = vcu * per + i; if (L >= 1024) continue; const int bh = L >> 6, qb = L & 63; b = bh >> 3; h = bh & 7; row0 = (size_t)b * SEQ + (size_t)qb * 256; t0 = 0; nt = NTILE; }
              else { if (l != 0 || F.bx < 16 || F.bx >= 32) continue; const int bh = F.bx - 16; b = bh >> 3; h = bh & 7; row0 = (size_t)TL + (size_t)b * CTX; t0 = SEQ / 64; nt = CTX / 64; }
              attn_body::attn_unit<6, 768, 768, 512, 512, 8, false, false>((const bf16*)(ws + WS_QM) + row0 * 768 + h * 96, (const bf16*)(ws + WS_KM) + ((size_t)(b * 8 + h) * NTILE + t0) * 6144, (const bf16*)(ws + WS_VM) + ((size_t)(b * 8 + h) * NTILE + t0) * 4096,
                                                             (bf16*)(ws + WS_OM) + row0 * 512 + h * 64, nt, shm); } }
        GRID_BAR();

        if (PH(10)) REP(10) { pg8::StaticOrder S; S.init(T_l, 1024, F.G, F.bx); const bf16* wbr = (const bf16*)(ws + WS_WBR) + (size_t)l * 3 * 1024 * 512;
          { pg8::Gemm g{(const bf16*)(ws + WS_OG), wbr, T_l, 1024, 512}; pg8::EpiBranch<0> E{(const bf16*)(ws + WS_BIG), (bf16*)(ws + WS_MERGEB)};
            pg8::gemm_phase<pg8::EpiBranch<0>, pg8::StaticOrder, true, true>(F.lds + RING_OFF, g, S, E); }
          { pg8::Gemm g{(const bf16*)(ws + WS_OM), wbr + (size_t)1024 * 512, T_l, 1024, 512}; pg8::EpiBranch<1> E{(const bf16*)(ws + WS_BIG), (bf16*)(ws + WS_MERGEB)};
            pg8::gemm_phase<pg8::EpiBranch<1>, pg8::StaticOrder, true, true>(F.lds + RING_OFF, g, S, E); }
          { pg8::Gemm g{(const bf16*)(ws + WS_GM), wbr + (size_t)2 * 1024 * 512, T_l, 1024, 512}; pg8::EpiBranch<2> E{(const bf16*)(ws + WS_BIG), (bf16*)(ws + WS_MERGEB)};
            pg8::gemm_phase<pg8::EpiBranch<2>, pg8::StaticOrder, true, true>(F.lds + RING_OFF, g, S, E); } }
        GRID_BAR();

        if (PH(11)) REP(11) { pg8::Gemm g{(const bf16*)(ws + WS_MERGEB), (const bf16*)(ws + WS_WOUT) + (size_t)l * 1024 * 1024, T_l, 1024, 1024}; pg8::StaticOrder S; S.init(T_l, 1024, F.G, F.bx);
          pg8::EpiPlain E{(bf16*)(ws + WS_Y), 1024};
          pg8::gemm_phase<pg8::EpiPlain, pg8::StaticOrder, true, true>(F.lds + RING_OFF, g, S, E); }
        GRID_BAR();

        if (PH(12)) REP(12) { const float* xin_lat = (l == 0) ? F.in(I_X) : F.out(); const float* xin_ctx = (l == 0) ? F.in(I_CTX) : (const float*)(ws + WS_XC); t3_phase(F, l, T_l, xin_lat, xin_ctx, (((PH_TWICE >> 12) & 1u) && rep_ == 0) ? 64 : 0, ((PH_TWICE >> 12) & 1u) && rep_ == 0); }
        GRID_BAR();

        moe_tables(F, l, 0);

        if (PH(14)) REP(14) { const LAS int* tab = (const LAS int*)(F.lds + LDS_TAB); const int nblk = __builtin_amdgcn_readfirstlane(tab[632]);
          LAS int* rowtok = (LAS int*)(F.lds + LDS_ROWTOK);
          { const int* ltok = (const int*)(ws + WS_LTOK); const int nun = nblk * 8;
            for (int idx = F.tid; idx < 20 * 256; idx += 512) { const int i = idx >> 8, r = idx & 255; const long L = (long)i * F.G + vcu; int tk = 0;
                if (L < nun) { const int blk = (int)(L >> 3), e = tab[blk], slot = blk * 256 + r - tab[600 + e]; if (slot < tab[640 + e]) tk = ltok[(size_t)e * TA + slot]; }
                rowtok[idx] = tk; }
            __syncthreads(); }
          pg8::Gemm g{(const bf16*)(ws + WS_XN), (const bf16*)(ws + WS_W1) + (size_t)l * 32 * 2048 * 1024, TA, 32 * 2048, 1024};
          pg8::MoeOrder<8> S{nblk * 8, F.G, vcu, tab, rowtok}; pg8::EpiMoe1 E{(bf16*)(ws + WS_H), F.in(I_EB1) + (size_t)l * 32 * 2048};
          pg8::gemm_phase<pg8::EpiMoe1, pg8::MoeOrder<8>, true, true, true>(F.lds + RING_OFF, g, S, E); }
        GRID_BAR();

        if (PH(15)) REP(15) { const LAS int* tab = (const LAS int*)(F.lds + LDS_TAB); const int nblk = __builtin_amdgcn_readfirstlane(tab[632]);
          pg8::Gemm g{(const bf16*)(ws + WS_H), (const bf16*)(ws + WS_W2) + (size_t)l * 32 * 1024 * 1024, MOE_ROWS, 32 * 1024, 1024};
          pg8::MoeOrder<4> S{nblk * 4, F.G, vcu, tab, tab}; pg8::EpiMoe2 E{(bf16*)(ws + WS_BIG), F.in(I_EB2) + (size_t)l * 32 * 1024, (const float*)(ws + WS_LW), tab};
          pg8::gemm_phase<pg8::EpiMoe2, pg8::MoeOrder<4>, true, true>(F.lds + RING_OFF, g, S, E); }
        GRID_BAR();

        if (PH(16)) REP(16) t4_phase(F, l, T_l, ((PH_TWICE >> 16) & 1u) && rep_ == 0);
        GRID_BAR();
    }
#undef GRID_BAR
}

extern "C" void kernel_launch(void* const* d_in, const int* in_sizes, int n_in, void* d_out, int out_size, void* d_ws, size_t ws_size, hipStream_t stream) {
    static int grid = 0;
    if (grid == 0) {
        if (n_in != 24 || out_size != TL * DM || ws_size < WS_END) { fprintf(stderr, "kernel_launch: unexpected problem: n_in %d out %d ws %zu (need %zu)\n", n_in, out_size, ws_size, (size_t)WS_END); grid = -1; return; }
        int dev = 0, cus = 0;
        if (hipGetDevice(&dev) != hipSuccess || hipDeviceGetAttribute(&cus, hipDeviceAttributeMultiprocessorCount, dev) != hipSuccess) { grid = -1; return; }
        if (hipFuncSetAttribute((const void*)fwd_kernel, hipFuncAttributeMaxDynamicSharedMemorySize, LDS_BYTES) != hipSuccess) { fprintf(stderr, "kernel_launch: hipFuncSetAttribute failed\n"); grid = -1; return; }
        int per_cu = 0;
        if (hipOccupancyMaxActiveBlocksPerMultiprocessor(&per_cu, (const void*)fwd_kernel, 512, LDS_BYTES) != hipSuccess || per_cu < 1) fprintf(stderr, "kernel_launch: occupancy query reports %d\n", per_cu);
        (void)hipGetLastError();
        grid = cus > 256 ? 256 : cus;
    }
    if (grid < 0) return;
    if (hipMemsetAsync((char*)d_ws + WS_CTL, 0, CTL_ZERO_BYTES, stream) != hipSuccess) return;
    Args a{};
    for (int i = 0; i < 24; ++i) a.in[i] = (const float*)d_in[i];
    a.out = (float*)d_out; a.ws = (unsigned char*)d_ws;
    hipLaunchKernelGGL(fwd_kernel, dim3(grid), dim3(512), LDS_BYTES, stream, a);
}
```

```cpp
#include <hip/hip_runtime.h>
#include <cstdio>
#include <cstdint>

typedef unsigned short bf16;

constexpr int DM = 1024, NBATCH = 2, SEQ = 16384, CTX = 256, DEPTH = 2;
constexpr int TL = NBATCH * SEQ;
constexpr int TC = NBATCH * CTX;
constexpr int TA = TL + TC;
constexpr int KPB = SEQ + CTX;
constexpr int KR = NBATCH * KPB;
constexpr int ZW = 5376;
constexpr int Z_Q = 0, Z_K = 512, Z_V = 640, Z_CQ = 768, Z_CKV = 1024, Z_KR = 1152, Z_U = 1280, Z_VG = 1792, Z_GATE = 2304;
constexpr int NEXP = 32, TOPK = 4, DEXP = 1024, MOE_ROWS = 552 * 256;
constexpr float RMS_EPS = 1e-6f;
constexpr float LOG2E = 1.4426950408889634f;
constexpr float C2G = 0.125f * LOG2E;
constexpr float C2M = 0.10206207261596577f * LOG2E;

constexpr size_t MiB = 1u << 20;
constexpr size_t WS_CTL = 0, CTL_ZERO_BYTES = 1 * MiB;
constexpr size_t WS_MOD = 1 * MiB;
constexpr size_t WS_PTAB = 1 * MiB + 512 * 1024;
constexpr size_t WS_COSG = 2 * MiB, WS_SING = 4 * MiB, WS_COSM = 6 * MiB, WS_SINM = 7 * MiB;
constexpr size_t WS_WS = 8 * MiB;
constexpr size_t WS_RWT = 8 * MiB + 512 * 1024;
constexpr size_t WS_SSV = 1 * MiB + 640 * 1024;
static_assert(WS_SSV + (size_t)TA * 2 * 4 <= 2 * MiB && WS_RWT + (size_t)DEPTH * 2 * 32 * 1024 * 2 <= 9 * MiB, "ws map small regions");
constexpr size_t WS_WUQ = 9 * MiB;
constexpr size_t WS_WUKV = 10 * MiB;
constexpr size_t WS_WBR = 11 * MiB;
constexpr size_t WS_WOUT = 17 * MiB;
constexpr size_t WS_WIN = 21 * MiB;
constexpr size_t WS_W1 = 42 * MiB;
constexpr size_t WS_W2 = 298 * MiB;
constexpr size_t WS_XC = 426 * MiB;
constexpr size_t WS_RTE = 428 * MiB;
constexpr size_t WS_RTS = 429 * MiB;
constexpr size_t WS_LTOK = 430 * MiB;
constexpr size_t WS_LW = 435 * MiB;
constexpr size_t WS_XN = 441 * MiB;
constexpr size_t WS_QG = 506 * MiB;
constexpr size_t WS_KG = 539 * MiB;
constexpr size_t WS_VG = 548 * MiB;
constexpr size_t WS_CQN = 557 * MiB;
constexpr size_t WS_CKVN = 574 * MiB;
constexpr size_t WS_QM = 583 * MiB;
constexpr size_t WS_KM = 632 * MiB;
constexpr size_t WS_VM = 681 * MiB;
constexpr size_t WS_OG = 714 * MiB;
constexpr size_t WS_OM = 747 * MiB;
constexpr size_t WS_GM = 780 * MiB;
constexpr size_t WS_UACT = 813 * MiB;
constexpr size_t WS_VN = 846 * MiB;
constexpr size_t WS_MERGE = 879 * MiB;
constexpr size_t WS_MERGEB = 1009 * MiB;
constexpr size_t WS_Y = 1074 * MiB;
constexpr size_t WS_H = 1139 * MiB;
constexpr size_t WS_BIG = 1415 * MiB;
constexpr size_t WS_END = 1757 * MiB;
static_assert(WS_BIG + (size_t)TA * ZW * 2 <= WS_END && WS_BIG + (size_t)MOE_ROWS * 1024 * 2 <= WS_END && WS_H + (size_t)MOE_ROWS * 1024 * 2 <= WS_BIG, "ws map");
static_assert(WS_W1 + (size_t)DEPTH * 32 * 2048 * 1024 * 2 <= WS_W2 && WS_W2 + (size_t)DEPTH * 32 * 1024 * 1024 * 2 <= WS_XC, "ws map weights");
static_assert(WS_MERGE + (size_t)TA * 1024 * 4 <= WS_MERGEB && WS_XN + (size_t)TA * 1024 * 2 <= WS_QG && WS_QM + (size_t)TA * 768 * 2 <= WS_KM, "ws map acts");
constexpr int CW_BAR = 4096;
constexpr int CW_CNT = 16384;

constexpr int RING_OFF = 0, RING_BYTES = 131072;
constexpr int LDS_X = RING_BYTES + 4096;
constexpr int LDS_SVEC = LDS_X;
constexpr int LDS_ROWTOK = LDS_X;
constexpr int MISC_OFF = 159744;
constexpr int LDS_TAB = 160000;
constexpr int LDS_BYTES = 163840;
static_assert(LDS_SVEC + 3 * 1024 * 4 <= MISC_OFF && LDS_ROWTOK + 20 * 1024 <= MISC_OFF && LDS_TAB + 704 * 4 <= LDS_BYTES, "LDS map");

#define GAS __attribute__((address_space(1)))
#define LAS __attribute__((address_space(3)))
typedef unsigned v4u __attribute__((ext_vector_type(4)));
typedef float f32x4 __attribute__((ext_vector_type(4)));
typedef GAS unsigned gu32;
#define RLX_AGENT __ATOMIC_RELAXED, __HIP_MEMORY_SCOPE_AGENT
#define LDS_WAIT() asm volatile("s_waitcnt lgkmcnt(0)" ::: "memory")
#define VM_WAIT() asm volatile("s_waitcnt vmcnt(0)" ::: "memory")

__device__ __forceinline__ unsigned cvt_pk(float lo, float hi) { unsigned r; asm volatile("v_cvt_pk_bf16_f32 %0, %1, %2" : "=v"(r) : "v"(lo), "v"(hi)); return r; }
__device__ __forceinline__ float bf_lo(unsigned u) { return __uint_as_float(u << 16); }
__device__ __forceinline__ float bf_hi(unsigned u) { return __uint_as_float(u & 0xffff0000u); }
__device__ __forceinline__ void unpack8(v4u r, float (&f)[8]) { f[0] = bf_lo(r.x); f[1] = bf_hi(r.x); f[2] = bf_lo(r.y); f[3] = bf_hi(r.y); f[4] = bf_lo(r.z); f[5] = bf_hi(r.z); f[6] = bf_lo(r.w); f[7] = bf_hi(r.w); }
__device__ __forceinline__ v4u pack8(const float (&f)[8]) { v4u o; o.x = cvt_pk(f[0], f[1]); o.y = cvt_pk(f[2], f[3]); o.z = cvt_pk(f[4], f[5]); o.w = cvt_pk(f[6], f[7]); return o; }
__device__ __forceinline__ float sigmoidf_(float x) { return __builtin_amdgcn_rcpf(1.f + __builtin_amdgcn_exp2f(-LOG2E * x)); }
__device__ __forceinline__ float wave_sum(float v) {
#pragma unroll
    for (int o = 1; o < 64; o <<= 1) v += __shfl_xor(v, o);
    return v;
}
__device__ __forceinline__ float gelu_tanh(float x) { const float u = 1.5957691216057308f * (x + 0.044715f * x * x * x); return x * __builtin_amdgcn_rcpf(1.f + __builtin_amdgcn_exp2f(-LOG2E * u)); }
constexpr int NTILE = KPB / 64;
__device__ __forceinline__ void bpos_of(int r, int& b, int& pos) { if (r < TL) { b = r >> 14; pos = r & (SEQ - 1); } else { b = (r - TL) >> 8; pos = SEQ + ((r - TL) & (CTX - 1)); } }
__device__ __forceinline__ size_t ktile_off(int strm, int pos, int chunk, int nch) { return (((size_t)strm * NTILE + (pos >> 6)) * nch + chunk) * 512 + (size_t)(pos & 63) * 8; }
__device__ __forceinline__ size_t vtile_off(int strm, int pos, int d) { const int piece = (d >> 5) * 4 + ((pos & 63) >> 4), ln = (pos & 15) * 4 + ((d >> 3) & 3); return (((size_t)strm * NTILE + (pos >> 6)) * 8 + piece) * 512 + (size_t)ln * 8; }
__device__ __forceinline__ int krow_of(int r) { return r < TL ? (r >> 14) * KPB + (r & (SEQ - 1)) : ((r - TL) >> 8) * KPB + SEQ + ((r - TL) & (CTX - 1)); }

__device__ const float INVF16[16] = {1.0f, 0.5623413324356079f, 0.3162277638912201f, 0.17782793939113617f, 0.10000000149011612f, 0.05623413249850273f, 0.03162277489900589f, 0.017782794311642647f,
                                     0.009999999776482582f, 0.005623413249850273f, 0.003162277629598975f, 0.0017782794311642647f, 0.0010000000474974513f, 0.000562341301701963f, 0.0003162277571391314f, 0.00017782794020604342f};
namespace pg8 {
#define PG8_LAS __attribute__((address_space(3)))
typedef unsigned short bf16_t;
typedef short bf16x8 __attribute__((ext_vector_type(8)));
typedef float f32x4 __attribute__((ext_vector_type(4)));
typedef unsigned u32x4 __attribute__((ext_vector_type(4)));
constexpr int BM = 256, BK = 64, HALF = 128, HTB = HALF * BK * 2  , STAGE_BYTES = 8 * HTB, NXCD = 8, WGM = 8;

__host__ __device__ __forceinline__ int lds_byte(int r, int c) { const int st = (r >> 4) * 2 + (c >> 5), rr = r & 15, cc = c & 31, ob = rr * 64 + cc * 2; return st * 1024 + (ob ^ (((ob >> 9) & 1) << 5)); }
__host__ __device__ __forceinline__ void stage_rc(int b, int& R, int& C) { const int st = b / 1024, sb = b % 1024, swz = sb ^ (((sb >> 9) & 1) << 5); R = (st >> 1) * 16 + swz / 64; C = (st & 1) * 32 + (swz % 64) / 2; }
__host__ __device__ __forceinline__ int perm32(int rho) { const int n = rho >> 4, i = rho & 15; return 8 * (i >> 2) + 4 * n + (i & 3); }

struct Unit { int pm, pn; };
struct Gemm { const bf16_t* A; const bf16_t* Bt; int M, N, K; };

struct StaticOrder {
    int nM, nN, nwg, G, c;
    __device__ void init(int M, int N, int G_, int c_) { asm volatile("" : "+s"(M), "+s"(N));
        nM = M / BM; nN = N / BM; nwg = nM * nN; G = G_; c = c_; }
    __host__ __device__ bool next(int i, Unit& u) const {
        const long L = (long)i * G + c; if (L >= nwg) return false;
        int wgid = (int)L; { const int q = nwg / NXCD, r = nwg % NXCD, xcd = wgid % NXCD, off = wgid / NXCD; wgid = (xcd < r ? xcd * (q + 1) : r * (q + 1) + (xcd - r) * q) + off; }
        const int nig = WGM * nN, gid = wgid / nig, fm = gid * WGM, gsz = (nM - fm) < WGM ? (nM - fm) : WGM;
        u.pm = fm + ((wgid % nig) % gsz); u.pn = (wgid % nig) / gsz; return true;
    }
    __device__ __forceinline__ void a_ready(const Unit&) const {}
    __device__ __forceinline__ void done(const Unit&) const {}
};

template <class Epi, class Sched, bool ALIGN_EPI = false, bool SP2 = false, bool GATHER = false>
__device__ __forceinline__ void gemm_phase(PG8_LAS unsigned char* lds, const Gemm g, const Sched& S, const Epi& E) {
    static_assert(!GATHER || SP2, "GATHER is implemented for the SP2 loop only");
    int tid_ = threadIdx.x; asm volatile("" : "+v"(tid_));
    const int tid = tid_, wid = __builtin_amdgcn_readfirstlane(tid >> 6), lane = tid & 63, wr = wid >> 2, wc = wid & 3, fr = lane & 15, fq = lane >> 4;
    int K_ = g.K; asm volatile("" : "+s"(K_));
    const int K = K_, nt = K / BK;
    unsigned voffA[2], voffB[2];
#pragma unroll
    for (int i = 0; i < 2; ++i) { int R, C; stage_rc(tid * 16 + i * 8192, R, C); const int Rb = Epi::PERM ? ((R & ~31) + perm32(R & 31)) : R;
        voffA[i] = (unsigned)(R * K + C) * 2u; voffB[i] = (unsigned)(Rb * K + C) * 2u; }
    unsigned vAc0[2] = {0u, 0u}, vAc1[2] = {0u, 0u}, vAn0[2] = {0u, 0u}, vAn1[2] = {0u, 0u}, vsel0[2] = {0u, 0u}, vsel1[2] = {0u, 0u};
#define PG8_GOFF(dst0, dst1, uidx) do { _Pragma("unroll") for (int i_ = 0; i_ < 2; ++i_) { int R_, C_; stage_rc(tid * 16 + i_ * 8192, R_, C_); \
        dst0[i_] = ((unsigned)S.tok((uidx), R_) * (unsigned)K + (unsigned)C_) * 2u; dst1[i_] = ((unsigned)S.tok((uidx), HALF + R_) * (unsigned)K + (unsigned)C_) * 2u; } } while (0)
#define PG8_STG_A(bufoff, base, H, SEL) do { if constexpr (GATHER) { if (SEL) { PG8_STAGE(bufoff, base, vsel##H); } else { PG8_STAGE(bufoff, base, vAc##H); } } else { PG8_STAGE(bufoff, (base) + (H) * hstep, voffA); } } while (0)
    const size_t kstep = (size_t)(BK * 2);
    const size_t hstep = (size_t)HALF * K * 2;
    const size_t tstep = 2 * hstep;
    const unsigned ldsw = (unsigned)wid * 1024u;
    const int aoff = lds_byte(wr * 64 + fr, fq * 8), boff = lds_byte(wc * 32 + fr, fq * 8);
#define PG8_SA(b, h) (((b) * 2 + (h)) * HTB)
#define PG8_SB(b, h) ((4 + (b) * 2 + (h)) * HTB)
#define PG8_STAGE(bufoff, gbase, voff) do { _Pragma("unroll") for (int _i = 0; _i < 2; ++_i) \
        __builtin_amdgcn_global_load_lds((const unsigned*)((const char*)(gbase) + (voff)[_i]), (PG8_LAS unsigned*)(lds + (bufoff) + ldsw + _i * 8192), 16, 0, 0); } while (0)
#define PG8_LDA(dst, b, h) do { _Pragma("unroll") for (int m = 0; m < 4; ++m) _Pragma("unroll") for (int k = 0; k < 2; ++k) dst[m][k] = *(const PG8_LAS bf16x8*)(lds + PG8_SA(b, h) + aoff + m * 2048 + k * 1024); } while (0)
#define PG8_LDB(dst, b, h) do { _Pragma("unroll") for (int n = 0; n < 2; ++n) _Pragma("unroll") for (int k = 0; k < 2; ++k) dst[n][k] = *(const PG8_LAS bf16x8*)(lds + PG8_SB(b, h) + boff + n * 2048 + k * 1024); } while (0)
#define PG8_MMA(ai, bj, At, Bt) do { __builtin_amdgcn_s_setprio(1); _Pragma("unroll") for (int m = 0; m < 4; ++m) _Pragma("unroll") for (int n = 0; n < 2; ++n) _Pragma("unroll") for (int k = 0; k < 2; ++k) \
        acc[ai][bj][m][n] = __builtin_amdgcn_mfma_f32_16x16x32_bf16(Bt[n][k], At[m][k], acc[ai][bj][m][n], 0, 0, 0); __builtin_amdgcn_s_setprio(0); } while (0)
#define PG8_WAIT_V(n) asm volatile("s_waitcnt vmcnt(" #n ")" ::: "memory")
#define PG8_WAIT_L(n) asm volatile("s_waitcnt lgkmcnt(" #n ")" ::: "memory")
#define PG8_BAR __builtin_amdgcn_s_barrier()
#define PG8_SCHED __builtin_amdgcn_sched_barrier(0)
    Unit cur, nxt; int ui = 0;
    if (!S.next(0, cur)) return;
    f32x4 acc[2][2][4][2];
#pragma unroll
    for (int a = 0; a < 2; ++a)
#pragma unroll
        for (int b = 0; b < 2; ++b)
#pragma unroll
            for (int m = 0; m < 4; ++m)
#pragma unroll
                for (int n = 0; n < 2; ++n) acc[a][b][m][n] = (f32x4){0.f, 0.f, 0.f, 0.f};
    bf16x8 At[4][2], B0[2][2], B1[2][2];
    const char* cA = GATHER ? (const char*)g.A : (const char*)g.A + (size_t)cur.pm * tstep; const char* cB = (const char*)g.Bt + (size_t)cur.pn * tstep;
    if constexpr (GATHER) { PG8_GOFF(vAc0, vAc1, 0); }
    S.a_ready(cur);
    if constexpr (SP2) {
        PG8_STAGE(PG8_SB(0, 0), cB, voffB); PG8_STAGE(PG8_SB(0, 1), cB + hstep, voffB); PG8_STG_A(PG8_SA(0, 0), cA, 0, false); PG8_STG_A(PG8_SA(0, 1), cA, 1, false);
        if (wr == 1) PG8_BAR;
        PG8_WAIT_V(2); PG8_BAR;
        PG8_STAGE(PG8_SB(1, 0), cB + kstep, voffB); PG8_STG_A(PG8_SA(1, 0), cA + kstep, 0, false); PG8_STAGE(PG8_SB(1, 1), cB + hstep + kstep, voffB);
        PG8_WAIT_V(6); PG8_BAR;
    } else {
        PG8_STAGE(PG8_SB(0, 0), cB, voffB); PG8_STAGE(PG8_SA(0, 0), cA, voffA); PG8_STAGE(PG8_SB(0, 1), cB + hstep, voffB); PG8_STAGE(PG8_SA(0, 1), cA + hstep, voffA);
        if (wr == 1) PG8_BAR;
        PG8_WAIT_V(4); PG8_BAR;
        PG8_STAGE(PG8_SB(1, 0), cB + kstep, voffB); PG8_STAGE(PG8_SA(1, 0), cA + kstep, voffA); PG8_STAGE(PG8_SB(1, 1), cB + hstep + kstep, voffB);
        PG8_WAIT_V(6); PG8_BAR;
    }
    for (;;) {
        const bool has_next = S.next(ui + 1, nxt);
        const char* nA = GATHER ? (const char*)g.A : (has_next ? (const char*)g.A + (size_t)nxt.pm * tstep : cA);
        if constexpr (GATHER) { if (has_next) { PG8_GOFF(vAn0, vAn1, ui + 1); } else { vAn0[0] = vAc0[0]; vAn0[1] = vAc0[1]; vAn1[0] = vAc1[0]; vAn1[1] = vAc1[1]; } } const char* nB = has_next ? (const char*)g.Bt + (size_t)nxt.pn * tstep : cB;
        for (int t = 0; t < nt; t += 2) {
            const bool last = (t == nt - 2);
            const char* a1 = cA + (size_t)(t + 1) * kstep;
            const char* a2 = last ? nA : cA + (size_t)(t + 2) * kstep; const char* b2 = last ? nB : cB + (size_t)(t + 2) * kstep;
            const char* a3 = a2 + kstep; const char* b3 = b2 + kstep;
            if (last && has_next) S.a_ready(nxt);
            if constexpr (GATHER) { vsel0[0] = last ? vAn0[0] : vAc0[0]; vsel0[1] = last ? vAn0[1] : vAc0[1]; vsel1[0] = last ? vAn1[0] : vAc1[0]; vsel1[1] = last ? vAn1[1] : vAc1[1]; }
            if constexpr (SP2) {
            PG8_LDB(B0, 0, 0); PG8_LDB(B1, 0, 1); PG8_SCHED; PG8_LDA(At, 0, 0); PG8_STG_A(PG8_SA(1, 1), a1, 1, false);
            PG8_WAIT_V(8); PG8_WAIT_L(0); PG8_BAR; PG8_MMA(0, 0, At, B0); PG8_MMA(0, 1, At, B1); PG8_BAR; PG8_SCHED;
            PG8_LDA(At, 0, 1); PG8_STAGE(PG8_SB(0, 0), b2, voffB); PG8_STAGE(PG8_SB(0, 1), b2 + hstep, voffB); PG8_STG_A(PG8_SA(0, 0), a2, 0, true);
            PG8_WAIT_V(8); PG8_WAIT_L(0); PG8_BAR; PG8_MMA(1, 0, At, B0); PG8_MMA(1, 1, At, B1); PG8_BAR; PG8_SCHED;
            PG8_LDB(B0, 1, 0); PG8_LDB(B1, 1, 1); PG8_SCHED; PG8_LDA(At, 1, 0); PG8_STG_A(PG8_SA(0, 1), a2, 1, true);
            PG8_WAIT_V(8); PG8_WAIT_L(0); PG8_BAR; PG8_MMA(0, 0, At, B0); PG8_MMA(0, 1, At, B1); PG8_BAR; PG8_SCHED;
            PG8_LDA(At, 1, 1); PG8_STAGE(PG8_SB(1, 0), b3, voffB); PG8_STAGE(PG8_SB(1, 1), b3 + hstep, voffB); PG8_STG_A(PG8_SA(1, 0), a3, 0, true);
            PG8_WAIT_V(8); PG8_WAIT_L(0); PG8_BAR; PG8_MMA(1, 0, At, B0); PG8_MMA(1, 1, At, B1); PG8_BAR; PG8_SCHED;
            } else {
            PG8_LDB(B0, 0, 0); PG8_SCHED; PG8_LDA(At, 0, 0); PG8_STAGE(PG8_SA(1, 1), a1 + hstep, voffA);
            PG8_WAIT_L(8); PG8_BAR; PG8_WAIT_L(0); PG8_MMA(0, 0, At, B0); PG8_BAR; PG8_SCHED;
            PG8_LDB(B1, 0, 1); PG8_STAGE(PG8_SB(0, 0), b2, voffB);
            PG8_BAR; PG8_WAIT_L(0); PG8_MMA(0, 1, At, B1); PG8_BAR;
            PG8_LDA(At, 0, 1); PG8_STAGE(PG8_SA(0, 0), a2, voffA);
            PG8_BAR; PG8_WAIT_L(0); PG8_MMA(1, 0, At, B0); PG8_BAR; PG8_SCHED;
            PG8_STAGE(PG8_SB(0, 1), b2 + hstep, voffB);
            PG8_WAIT_V(6); PG8_BAR; PG8_MMA(1, 1, At, B1); PG8_BAR;
            PG8_LDB(B0, 1, 0); PG8_SCHED; PG8_LDA(At, 1, 0); PG8_STAGE(PG8_SA(0, 1), a2 + hstep, voffA);
            PG8_WAIT_L(8); PG8_BAR; PG8_WAIT_L(0); PG8_MMA(0, 0, At, B0); PG8_BAR; PG8_SCHED;
            PG8_LDB(B1, 1, 1); PG8_STAGE(PG8_SB(1, 0), b3, voffB);
            PG8_BAR; PG8_WAIT_L(0); PG8_MMA(0, 1, At, B1); PG8_BAR;
            PG8_LDA(At, 1, 1); PG8_STAGE(PG8_SA(1, 0), a3, voffA);
            PG8_BAR; PG8_WAIT_L(0); PG8_MMA(1, 0, At, B0); PG8_BAR; PG8_SCHED;
            PG8_STAGE(PG8_SB(1, 1), b3 + hstep, voffB);
            PG8_WAIT_V(6); PG8_BAR; PG8_MMA(1, 1, At, B1); PG8_BAR;
            }
        }
        if constexpr (ALIGN_EPI) { if (wr == 0) PG8_BAR; }
        if constexpr (!Epi::AFTER_DRAIN) { E(acc, cur, wr, wc, fr, fq); S.done(cur); }
        if (!has_next) break;
#pragma unroll
        for (int a = 0; a < 2; ++a)
#pragma unroll
            for (int b = 0; b < 2; ++b)
#pragma unroll
                for (int m = 0; m < 4; ++m)
#pragma unroll
                    for (int n = 0; n < 2; ++n) acc[a][b][m][n] = (f32x4){0.f, 0.f, 0.f, 0.f};
        cur = nxt; cA = nA; cB = nB; ++ui;
        if constexpr (GATHER) { vAc0[0] = vAn0[0]; vAc0[1] = vAn0[1]; vAc1[0] = vAn1[0]; vAc1[1] = vAn1[1]; }
        if constexpr (ALIGN_EPI) { if (wr == 1) PG8_BAR; }
    }
    PG8_WAIT_V(0);
    if constexpr (!ALIGN_EPI) { if (wr == 0) PG8_BAR; }
    PG8_BAR;
    if constexpr (Epi::AFTER_DRAIN) { E.fused(acc, cur, wr, wc, fr, fq, lds, wid, lane); S.done(cur); }
#undef PG8_SA
#undef PG8_SB
#undef PG8_STAGE
#undef PG8_LDA
#undef PG8_LDB
#undef PG8_MMA
#undef PG8_WAIT_V
#undef PG8_WAIT_L
#undef PG8_BAR
#undef PG8_SCHED
#undef PG8_GOFF
#undef PG8_STG_A
}
}
namespace pg8 {
#define EPI_ROWS(u, wr, fr) const int row00 = (u).pm * BM + (wr) * 64 + (fr)
#define EPI_GET8(v, ai, bj, m) float v[8] = {acc[ai][bj][m][0][0], acc[ai][bj][m][0][1], acc[ai][bj][m][0][2], acc[ai][bj][m][0][3], acc[ai][bj][m][1][0], acc[ai][bj][m][1][1], acc[ai][bj][m][1][2], acc[ai][bj][m][1][3]}

struct EpiPlain {
    static constexpr bool PERM = true, AFTER_DRAIN = false;
    bf16_t* O; int ldc;
    __device__ __forceinline__ void operator()(const f32x4 (&acc)[2][2][4][2], const Unit& u, int wr, int wc, int fr, int fq) const {
        asm volatile("" : "+v"(fr), "+v"(fq));
        EPI_ROWS(u, wr, fr); const int col0 = u.pn * BM + wc * 32 + 8 * fq;
#pragma unroll
        for (int ai = 0; ai < 2; ++ai)
#pragma unroll
            for (int m = 0; m < 4; ++m) { bf16_t* rowp = O + (size_t)(row00 + ai * HALF + m * 16) * ldc + col0;
#pragma unroll
                for (int bj = 0; bj < 2; ++bj) { EPI_GET8(v, ai, bj, m); *(u32x4*)(rowp + bj * HALF) = pack8(v); } }
    }
};

struct EpiInproj {
    static constexpr bool PERM = true, AFTER_DRAIN = false;
    unsigned char* ws; const float *qkn, *mqn, *mkvn; PG8_LAS float* xs;
    __device__ __forceinline__ void operator()(const f32x4 (&acc)[2][2][4][2], const Unit& u, int wr, int wc, int fr, int fq) const {
        asm volatile("" : "+v"(fr), "+v"(fq));
        EPI_ROWS(u, wr, fr); const int pn = u.pn; const bool lat = (u.pm * BM) < TL;
        if (pn >= 9) {
            const int col0 = (pn - 9) * BM + wc * 32 + 8 * fq;
#pragma unroll
            for (int ai = 0; ai < 2; ++ai)
#pragma unroll
                for (int m = 0; m < 4; ++m) { bf16_t* rowp = (bf16_t*)(ws + WS_BIG) + (size_t)(row00 + ai * HALF + m * 16) * 3072 + col0;
#pragma unroll
                    for (int bj = 0; bj < 2; ++bj) { EPI_GET8(v, ai, bj, m); *(u32x4*)(rowp + bj * HALF) = pack8(v); } }
        } else if (pn <= 2) {
            if (pn == 2 && wc >= 2) {
#pragma unroll
                for (int ai = 0; ai < 2; ++ai)
#pragma unroll
                    for (int m = 0; m < 4; ++m) { const int row = row00 + ai * HALF + m * 16; int b_, pos_; bpos_of(row, b_, pos_); bf16_t* vb = (bf16_t*)(ws + WS_VG); const int st = b_ * 2 + (wc - 2);
                        EPI_GET8(x1, ai, 0, m); EPI_GET8(x2, ai, 1, m); *(u32x4*)(vb + vtile_off(st, pos_, 8 * fq)) = pack8(x1); *(u32x4*)(vb + vtile_off(st, pos_, 32 + 8 * fq)) = pack8(x2); }
            } else {
                const bool isq = pn < 2; const float* gn = qkn + (isq ? 0 : 64) + 8 * fq;
                const f32x4 ga0 = *(const f32x4*)gn, ga1 = *(const f32x4*)(gn + 4), gb0 = *(const f32x4*)(gn + 32), gb1 = *(const f32x4*)(gn + 36);
                const float g1[8] = {ga0[0], ga0[1], ga0[2], ga0[3], ga1[0], ga1[1], ga1[2], ga1[3]}, g2[8] = {gb0[0], gb0[1], gb0[2], gb0[3], gb1[0], gb1[1], gb1[2], gb1[3]};
                const float sc = isq ? C2G : 1.f;
#pragma unroll
                for (int ai = 0; ai < 2; ++ai)
#pragma unroll
                    for (int m = 0; m < 4; ++m) { const int row = row00 + ai * HALF + m * 16; f32x4 c0, c1, s0, s1;
                        if (lat) { const int pos = row & (SEQ - 1); const f32x4* cp = (const f32x4*)((const float*)(ws + WS_COSG) + (size_t)pos * 32 + 8 * fq); const f32x4* sp = (const f32x4*)((const float*)(ws + WS_SING) + (size_t)pos * 32 + 8 * fq); c0 = cp[0]; c1 = cp[1]; s0 = sp[0]; s1 = sp[1]; }
                        EPI_GET8(x1, ai, 0, m); EPI_GET8(x2, ai, 1, m); float ss = 0.f;
#pragma unroll
                        for (int i = 0; i < 8; ++i) ss += x1[i] * x1[i] + x2[i] * x2[i];
                        ss += __shfl_xor(ss, 16); ss += __shfl_xor(ss, 32);
                        const float rstd = __builtin_amdgcn_rsqf(ss * (1.f / 64.f) + RMS_EPS); float o1[8], o2[8];
#pragma unroll
                        for (int i = 0; i < 8; ++i) { const float y1 = x1[i] * rstd * g1[i], y2 = x2[i] * rstd * g2[i]; const float c = lat ? (i < 4 ? c0[i & 3] : c1[i & 3]) : 1.f, s = lat ? (i < 4 ? s0[i & 3] : s1[i & 3]) : 0.f;
                            o1[i] = (y1 * c - y2 * s) * sc; o2[i] = (y2 * c + y1 * s) * sc; }
                        if (isq) { bf16_t* p = (bf16_t*)(ws + WS_QG) + (size_t)row * 512 + (4 * pn + wc) * 64 + 8 * fq; *(u32x4*)p = pack8(o1); *(u32x4*)(p + 32) = pack8(o2); }
                        else { int b_, pos_; bpos_of(row, b_, pos_); bf16_t* kb = (bf16_t*)(ws + WS_KG); const int st = b_ * 2 + wc; *(u32x4*)(kb + ktile_off(st, pos_, fq, 8)) = pack8(o1); *(u32x4*)(kb + ktile_off(st, pos_, 4 + fq, 8)) = pack8(o2); }
                        asm volatile("" ::: "memory"); }
            }
        } else if (pn == 3 || pn == 4 || pn == 7 || pn == 8) {
            const bool vg = pn >= 7; const bool part = (pn == 4) ? (wc < 2) : true;
            float ssr[2][4];
#pragma unroll
            for (int ai = 0; ai < 2; ++ai)
#pragma unroll
                for (int m = 0; m < 4; ++m) { float ss = 0.f;
#pragma unroll
                    for (int bj = 0; bj < 2; ++bj) { EPI_GET8(v, ai, bj, m);
#pragma unroll
                        for (int i = 0; i < 8; ++i) { const float t = vg ? gelu_tanh(v[i]) : v[i]; ss += t * t; } }
                    ss += __shfl_xor(ss, 16); ss += __shfl_xor(ss, 32); ssr[ai][m] = part ? ss : 0.f;
                    if (fq == 0) xs[(ai * HALF + wr * 64 + m * 16 + fr) * 4 + wc] = ssr[ai][m]; }
            asm volatile("s_waitcnt lgkmcnt(0)\n\ts_barrier" ::: "memory");
#pragma unroll
            for (int ai = 0; ai < 2; ++ai)
#pragma unroll
                for (int m = 0; m < 4; ++m) { const f32x4 t = *(const PG8_LAS f32x4*)(xs + (ai * HALF + wr * 64 + m * 16 + fr) * 4); ssr[ai][m] = (t[0] + t[1]) + (t[2] + t[3]); }
            asm volatile("s_waitcnt lgkmcnt(0)\n\ts_barrier" ::: "memory");
            if (pn == 3) {
                const int col0 = wc * 32 + 8 * fq;
#pragma unroll
                for (int ai = 0; ai < 2; ++ai)
#pragma unroll
                    for (int m = 0; m < 4; ++m) { const int row = row00 + ai * HALF + m * 16; const float rstd = __builtin_amdgcn_rsqf(ssr[ai][m] * (1.f / 256.f) + RMS_EPS);
#pragma unroll
                        for (int bj = 0; bj < 2; ++bj) { EPI_GET8(v, ai, bj, m); const int col = col0 + bj * HALF; const f32x4 ga = *(const f32x4*)(mqn + col), gb = *(const f32x4*)(mqn + col + 4);
#pragma unroll
                            for (int i = 0; i < 8; ++i) v[i] *= rstd * (i < 4 ? ga[i] : gb[i - 4]);
                            *(u32x4*)((bf16_t*)(ws + WS_CQN) + (size_t)row * 256 + col) = pack8(v); } }
            } else if (pn == 4) {
                if (wc < 2) {
#pragma unroll
                    for (int ai = 0; ai < 2; ++ai)
#pragma unroll
                        for (int m = 0; m < 4; ++m) { const int row = row00 + ai * HALF + m * 16; const float rstd = __builtin_amdgcn_rsqf(ssr[ai][m] * (1.f / 128.f) + RMS_EPS);
#pragma unroll
                            for (int bj = 0; bj < 2; ++bj) { EPI_GET8(v, ai, bj, m); const int col = wc * 64 + bj * 32 + 8 * fq; const f32x4 ga = *(const f32x4*)(mkvn + col), gb = *(const f32x4*)(mkvn + col + 4);
#pragma unroll
                                for (int i = 0; i < 8; ++i) v[i] *= rstd * (i < 4 ? ga[i] : gb[i - 4]);
                                *(u32x4*)((bf16_t*)(ws + WS_CKVN) + (size_t)row * 128 + col) = pack8(v); } }
                } else if (wc == 2 && fq < 2) {
#pragma unroll
                    for (int ai = 0; ai < 2; ++ai)
#pragma unroll
                        for (int m = 0; m < 4; ++m) { const int row = row00 + ai * HALF + m * 16; const int pos = row & (SEQ - 1);
                            EPI_GET8(x1, ai, 0, m); EPI_GET8(x2, ai, 1, m); float o1[8], o2[8];
                            if (lat) { const f32x4* cp = (const f32x4*)((const float*)(ws + WS_COSM) + (size_t)pos * 16 + 8 * fq); const f32x4* sp = (const f32x4*)((const float*)(ws + WS_SINM) + (size_t)pos * 16 + 8 * fq); const f32x4 c0 = cp[0], c1 = cp[1], s0 = sp[0], s1 = sp[1];
#pragma unroll
                                for (int i = 0; i < 8; ++i) { const float c = i < 4 ? c0[i] : c1[i - 4], s = i < 4 ? s0[i] : s1[i - 4]; o1[i] = x1[i] * c - x2[i] * s; o2[i] = x2[i] * c + x1[i] * s; } }
                            else {
#pragma unroll
                                for (int i = 0; i < 8; ++i) { o1[i] = x1[i]; o2[i] = x2[i]; } }
                            const u32x4 p1 = pack8(o1), p2 = pack8(o2); int b_, pos_; bpos_of(row, b_, pos_); bf16_t* kb = (bf16_t*)(ws + WS_KM);
#pragma unroll
                            for (int h = 0; h < 8; ++h) { *(u32x4*)(kb + ktile_off(b_ * 8 + h, pos_, 8 + fq, 12)) = p1; *(u32x4*)(kb + ktile_off(b_ * 8 + h, pos_, 10 + fq, 12)) = p2; } }
                }
            } else {
                const int half = pn - 7, col0 = half * BM + wc * 32 + 8 * fq;
#pragma unroll
                for (int ai = 0; ai < 2; ++ai)
#pragma unroll
                    for (int m = 0; m < 4; ++m) { const int row = row00 + ai * HALF + m * 16;
#pragma unroll
                        for (int bj = 0; bj < 2; ++bj) { EPI_GET8(v, ai, bj, m);
#pragma unroll
                            for (int i = 0; i < 8; ++i) v[i] = gelu_tanh(v[i]);
                            *(u32x4*)((bf16_t*)(ws + WS_VN) + (size_t)row * 512 + col0 + bj * HALF) = pack8(v); }
                        if (wc == 0 && fq == 0) ((float*)(ws + WS_SSV))[(size_t)row * 2 + half] = ssr[ai][m]; }
            }
        } else {
            const int col0 = (pn - 5) * BM + wc * 32 + 8 * fq;
#pragma unroll
            for (int ai = 0; ai < 2; ++ai)
#pragma unroll
                for (int m = 0; m < 4; ++m) { const int row = row00 + ai * HALF + m * 16;
#pragma unroll
                    for (int bj = 0; bj < 2; ++bj) { EPI_GET8(v, ai, bj, m);
#pragma unroll
                        for (int i = 0; i < 8; ++i) v[i] = gelu_tanh(v[i]);
                        *(u32x4*)((bf16_t*)(ws + WS_UACT) + (size_t)row * 512 + col0 + bj * HALF) = pack8(v); } }
        }
    }
};

struct EpiUq {
    static constexpr bool PERM = true, AFTER_DRAIN = false;
    bf16_t* Qm; const float* cosM; const float* sinM;
    __device__ __forceinline__ void operator()(const f32x4 (&acc)[2][2][4][2], const Unit& u, int wr, int wc, int fr, int fq) const {
        asm volatile("" : "+v"(fr), "+v"(fq));
        EPI_ROWS(u, wr, fr);
        if (u.pn < 2) {
#pragma unroll
            for (int ai = 0; ai < 2; ++ai)
#pragma unroll
                for (int m = 0; m < 4; ++m) { const int row = row00 + ai * HALF + m * 16;
#pragma unroll
                    for (int bj = 0; bj < 2; ++bj) { const int col = u.pn * BM + bj * HALF + wc * 32 + 8 * fq; const int head = col >> 6, d = col & 63;
                        EPI_GET8(v, ai, bj, m);
#pragma unroll
                        for (int i = 0; i < 8; ++i) v[i] *= C2M;
                        *(u32x4*)(Qm + (size_t)row * 768 + head * 96 + d) = pack8(v); } asm volatile("" ::: "memory"); }
        } else {
            const int cc = wc * 32 + 8 * fq, hh = cc >> 4, j0 = cc & 15;
            const bool lat = (u.pm * BM) < TL;
#pragma unroll
            for (int ai = 0; ai < 2; ++ai)
#pragma unroll
                for (int m = 0; m < 4; ++m) { const int row = row00 + ai * HALF + m * 16;
                    EPI_GET8(x1, ai, 0, m); EPI_GET8(x2, ai, 1, m);
                    float cs[8], sn[8];
                    if (lat) { const int pos = row & (SEQ - 1); const f32x4* cp = (const f32x4*)(cosM + (size_t)pos * 16 + j0); const f32x4* sp = (const f32x4*)(sinM + (size_t)pos * 16 + j0);
                        const f32x4 c0 = cp[0], c1 = cp[1], s0 = sp[0], s1 = sp[1];
                        cs[0] = c0[0]; cs[1] = c0[1]; cs[2] = c0[2]; cs[3] = c0[3]; cs[4] = c1[0]; cs[5] = c1[1]; cs[6] = c1[2]; cs[7] = c1[3];
                        sn[0] = s0[0]; sn[1] = s0[1]; sn[2] = s0[2]; sn[3] = s0[3]; sn[4] = s1[0]; sn[5] = s1[1]; sn[6] = s1[2]; sn[7] = s1[3]; }
                    else {
#pragma unroll
                        for (int i = 0; i < 8; ++i) { cs[i] = 1.f; sn[i] = 0.f; } }
                    float o1[8], o2[8];
#pragma unroll
                    for (int i = 0; i < 8; ++i) { o1[i] = (x1[i] * cs[i] - x2[i] * sn[i]) * C2M; o2[i] = (x2[i] * cs[i] + x1[i] * sn[i]) * C2M; }
                    bf16_t* qp = Qm + (size_t)row * 768 + hh * 96 + 64 + j0;
                    *(u32x4*)(qp) = pack8(o1); *(u32x4*)(qp + 16) = pack8(o2); asm volatile("" ::: "memory"); }
        }
    }
};

struct EpiUkv {
    static constexpr bool PERM = true, AFTER_DRAIN = false;
    bf16_t* Km; bf16_t* Vm;
    __device__ __forceinline__ void operator()(const f32x4 (&acc)[2][2][4][2], const Unit& u, int wr, int wc, int fr, int fq) const {
        asm volatile("" : "+v"(fr), "+v"(fq));
        EPI_ROWS(u, wr, fr); const int within = wc * 32 + 8 * fq;
#pragma unroll
        for (int ai = 0; ai < 2; ++ai)
#pragma unroll
            for (int m = 0; m < 4; ++m) { const int row = row00 + ai * HALF + m * 16; int b_, pos_; bpos_of(row, b_, pos_);
#pragma unroll
                for (int bj = 0; bj < 2; ++bj) { const int head = u.pn * 2 + bj; EPI_GET8(v, ai, bj, m);
                    bf16_t* p = (within < 64) ? (Km + ktile_off(b_ * 8 + head, pos_, within >> 3, 12)) : (Vm + vtile_off(b_ * 8 + head, pos_, within - 64));
                    *(u32x4*)p = pack8(v); } asm volatile("" ::: "memory"); }
    }
};

template <int IDX> struct EpiBranch {
    static constexpr bool PERM = true, AFTER_DRAIN = false;
    const bf16_t* Z; bf16_t* MERGEB;
    __device__ __forceinline__ void operator()(const f32x4 (&acc)[2][2][4][2], const Unit& u, int wr, int wc, int fr, int fq) const {
        asm volatile("" : "+v"(fr), "+v"(fq));
        EPI_ROWS(u, wr, fr); const int col0 = u.pn * BM + wc * 32 + 8 * fq;
#pragma unroll
        for (int ai = 0; ai < 2; ++ai) {
            u32x4 gr[4][2], mr[4][2];
#pragma unroll
            for (int m = 0; m < 4; ++m) { const int row = row00 + ai * HALF + m * 16;
#pragma unroll
                for (int bj = 0; bj < 2; ++bj) { const int col = col0 + bj * HALF; gr[m][bj] = *(const u32x4*)(Z + (size_t)row * 3072 + IDX * 1024 + col);
                    if (IDX != 0) mr[m][bj] = *(const u32x4*)(MERGEB + (size_t)row * 1024 + col); } }
#pragma unroll
            for (int m = 0; m < 4; ++m) { const int row = row00 + ai * HALF + m * 16;
#pragma unroll
                for (int bj = 0; bj < 2; ++bj) { const int col = col0 + bj * HALF; EPI_GET8(v, ai, bj, m); float g[8], a[8], r[8]; unpack8(gr[m][bj], g);
                    if (IDX != 0) unpack8(mr[m][bj], a);
#pragma unroll
                    for (int i = 0; i < 8; ++i) r[i] = (IDX != 0 ? a[i] : 0.f) + sigmoidf_(g[i]) * v[i];
                    *(u32x4*)(MERGEB + (size_t)row * 1024 + col) = pack8(r); } }
            asm volatile("" ::: "memory"); }
    }
};

struct EpiMoe1 {
    static constexpr bool PERM = true, AFTER_DRAIN = false;
    bf16_t* H; const float* b1;
    __device__ __forceinline__ void operator()(const f32x4 (&acc)[2][2][4][2], const Unit& u, int wr, int wc, int fr, int fq) const {
        asm volatile("" : "+v"(fr), "+v"(fq));
        EPI_ROWS(u, wr, fr); const int e = u.pn >> 3, pnl = u.pn & 7, cc = pnl * 128 + wc * 32 + 8 * fq;
        const float* bp = b1 + (size_t)e * 2048 + cc;
        const f32x4 bg0 = *(const f32x4*)bp, bg1 = *(const f32x4*)(bp + 4), bl0 = *(const f32x4*)(bp + 1024), bl1 = *(const f32x4*)(bp + 1028);
        float lim = 7.0f; asm volatile("" : "+v"(lim));
#pragma unroll
        for (int ai = 0; ai < 2; ++ai)
#pragma unroll
            for (int m = 0; m < 4; ++m) { const int row = row00 + ai * HALF + m * 16;
                EPI_GET8(g, ai, 0, m); EPI_GET8(l, ai, 1, m); float r[8];
#pragma unroll
                for (int i = 0; i < 8; ++i) { float glu = g[i] + (i < 4 ? bg0[i] : bg1[i - 4]); float lin = l[i] + (i < 4 ? bl0[i] : bl1[i - 4]);
                    glu = fminf(glu, lim); lin = fminf(fmaxf(lin, -lim), lim);
                    r[i] = glu * sigmoidf_(1.702f * glu) * (lin + 1.0f); }
                *(u32x4*)(H + (size_t)row * 1024 + cc) = pack8(r); }
    }
};

struct EpiMoe2 {
    static constexpr bool PERM = true, AFTER_DRAIN = false;
    bf16_t* Yp; const float* b2; const float* lw; const PG8_LAS int* tab;
    __device__ __forceinline__ void operator()(const f32x4 (&acc)[2][2][4][2], const Unit& u, int wr, int wc, int fr, int fq) const {
        asm volatile("" : "+v"(fr), "+v"(fq));
        EPI_ROWS(u, wr, fr); const int e = u.pn >> 2, pnl = u.pn & 3, col0 = pnl * BM + wc * 32 + 8 * fq;
        f32x4 bv[2][2];
#pragma unroll
        for (int bj = 0; bj < 2; ++bj) { bv[bj][0] = *(const f32x4*)(b2 + (size_t)e * 1024 + col0 + bj * HALF); bv[bj][1] = *(const f32x4*)(b2 + (size_t)e * 1024 + col0 + bj * HALF + 4); }
#pragma unroll
        for (int ai = 0; ai < 2; ++ai)
#pragma unroll
            for (int m = 0; m < 4; ++m) { const int row = row00 + ai * HALF + m * 16; const int slot = row - tab[600 + e]; const float w = (slot < tab[640 + e]) ? lw[(size_t)e * TA + slot] : 0.f;
#pragma unroll
                for (int bj = 0; bj < 2; ++bj) { EPI_GET8(v, ai, bj, m); float r[8];
#pragma unroll
                    for (int i = 0; i < 8; ++i) r[i] = (v[i] + (i < 4 ? bv[bj][0][i] : bv[bj][1][i - 4])) * w;
                    *(u32x4*)(Yp + (size_t)row * 1024 + col0 + bj * HALF) = pack8(r); } }
    }
};

template <int NPN> struct MoeOrder {
    int nunits, G, v; const PG8_LAS int* tab; const PG8_LAS int* rowtok;
    __device__ __forceinline__ int tok(int i, int r) const { return rowtok[i * 256 + r]; }
    __device__ __forceinline__ bool next(int i, Unit& u) const {
        const long L = (long)i * G + v; if (L >= nunits) return false;
        const int blk = (int)L / NPN, pnl = (int)L % NPN; const int e = __builtin_amdgcn_readfirstlane(tab[blk]);
        u.pm = blk; u.pn = e * NPN + pnl; return true;
    }
    __device__ __forceinline__ void a_ready(const Unit&) const {}
    __device__ __forceinline__ void done(const Unit&) const {}
};
}
namespace attn_body {
using bf16x8=__attribute__((ext_vector_type(8)))short;
using s16x4=__attribute__((ext_vector_type(4)))short;
using f32x16=__attribute__((ext_vector_type(16)))float;
using u32x4=__attribute__((ext_vector_type(4)))unsigned;
constexpr int NW=8,QBLK=32,QB=QBLK*NW,KVBLK=64;
__device__ __forceinline__ int crow(int r,int hi){return (r&3)+8*(r>>2)+4*hi;}
#define SBAR() __builtin_amdgcn_sched_barrier(0)
constexpr int NSLOT=3, SLOTB=8192;
__device__ __forceinline__ void glds16(const void*gsrc,unsigned lds_dst){unsigned keep;
  asm volatile("s_mov_b32 %0, m0\n\ts_mov_b32 m0, %2\n\ts_nop 0\n\tglobal_load_lds_dwordx4 %1, off\n\ts_mov_b32 m0, %0":"=&s"(keep):"v"(gsrc),"s"(lds_dst):"memory");}
__device__ __forceinline__ float max3f(float a,float b,float c){float r;asm("v_max3_f32 %0, %1, %2, %3":"=v"(r):"v"(a),"v"(b),"v"(c));return r;}
__device__ __forceinline__ float max2f(float a,float b){float r;asm("v_max_f32_e32 %0, %1, %2":"=v"(r):"v"(a),"v"(b));return r;}
__device__ __forceinline__ float fadd_s(float a,float b){float r;asm("v_add_f32_e32 %0, %1, %2":"=v"(r):"v"(a),"v"(b));return r;}
__device__ __forceinline__ float fsub_s(float a,float b){float r;asm("v_sub_f32_e32 %0, %1, %2":"=v"(r):"v"(a),"v"(b));return r;}
typedef float f32x2_t __attribute__((ext_vector_type(2))); typedef __bf16 bf16x2_t __attribute__((ext_vector_type(2)));
__device__ __forceinline__ unsigned cvtpk_s(float lo,float hi){f32x2_t v={lo,hi};bf16x2_t b=__builtin_convertvector(v,bf16x2_t);return __builtin_bit_cast(unsigned,b);}
#define WAIT_BAR(N) asm volatile("s_waitcnt vmcnt(" #N ") lgkmcnt(0)\n\ts_barrier":::"memory")
typedef __attribute__((address_space(3))) const char* lds_cptr;
typedef short v4i16_t __attribute__((ext_vector_type(4)));
__device__ __forceinline__ void kload2(bf16x8*kf,lds_cptr kp,int j){ kf[2*j]=*(const __attribute__((address_space(3))) bf16x8*)(kp+j*2048); kf[2*j+1]=*(const __attribute__((address_space(3))) bf16x8*)(kp+j*2048+512); }
__device__ __forceinline__ s16x4 vtr(lds_cptr p){ return __builtin_bit_cast(s16x4,__builtin_amdgcn_ds_read_tr16_b64_v4i16((__attribute__((address_space(3))) v4i16_t*)p)); }
__device__ __forceinline__ float rowmax(const f32x16&p0,const f32x16&p1){
  float a=max3f(p0[0],p0[1],p1[0]),b=max3f(p0[2],p0[3],p1[1]);a=max3f(a,p1[2],p1[3]);
  #pragma unroll
  for(int r=4;r<16;r+=4){a=max3f(a,p0[r],p0[r+1]);b=max3f(b,p0[r+2],p0[r+3]);a=max3f(a,p1[r],p1[r+1]);b=max3f(b,p1[r+2],p1[r+3]);}
  const float m=max2f(a,b);
  auto rr=__builtin_amdgcn_permlane32_swap(__float_as_uint(m),__float_as_uint(m),false,false);
  return max2f(__uint_as_float(rr[0]),__uint_as_float(rr[1]));
}
__device__ __forceinline__ void pv(f32x16*o,int vb,bf16x8 pa0,bf16x8 pa1,bf16x8 pa2,bf16x8 pa3){
  #pragma unroll
  for(int d0=0;d0<2;++d0){s16x4 lo[4],hi[4];
    #pragma unroll
    for(int ks=0;ks<4;++ks){
      asm volatile("ds_read_b64_tr_b16 %0,%1 offset:%c2":"=&v"(lo[ks]):"v"(vb),"i"(d0*4096+ks*1024):"memory");
      asm volatile("ds_read_b64_tr_b16 %0,%1 offset:%c2":"=&v"(hi[ks]):"v"(vb),"i"(d0*4096+ks*1024+512):"memory");}
    asm volatile("s_waitcnt lgkmcnt(0)":::"memory");SBAR();
    #define PK(k) (bf16x8){lo[k][0],lo[k][1],lo[k][2],lo[k][3],hi[k][0],hi[k][1],hi[k][2],hi[k][3]}
    o[d0]=__builtin_amdgcn_mfma_f32_32x32x16_bf16(pa0,PK(0),o[d0],0,0,0);
    o[d0]=__builtin_amdgcn_mfma_f32_32x32x16_bf16(pa1,PK(1),o[d0],0,0,0);
    o[d0]=__builtin_amdgcn_mfma_f32_32x32x16_bf16(pa2,PK(2),o[d0],0,0,0);
    o[d0]=__builtin_amdgcn_mfma_f32_32x32x16_bf16(pa3,PK(3),o[d0],0,0,0);
    #undef PK
  }
}
template<int NKS> struct AttnLds {
  static constexpr int SLOTK=NKS*2048;
  static constexpr int LDS_K=0, LDS_V=NSLOT*SLOTK, LDS_WS=LDS_V+NSLOT*SLOTB, LDS_OST=LDS_WS+NW*64*4, LDS_BYTES=LDS_OST+NW*4096;
};
template<int NKS,int QP,int KP,int VP,int OP,int THRL,bool LS,bool SK>
__device__ __forceinline__ void attn_unit(const bf16*Qu,const bf16*__restrict__ Ku,const bf16*__restrict__ Vu,bf16*Ou,const int NT,char*shm){
  using L=AttnLds<NKS>;
  constexpr int SLOTK=L::SLOTK, LDS_K=L::LDS_K, LDS_V=L::LDS_V, LDS_WS=L::LDS_WS, LDS_OST=L::LDS_OST;
  int tid_=threadIdx.x; asm volatile("":"+v"(tid_));
  const int tid=tid_,lane=tid&63,r32=lane&31,hi=lane>>5; const int wid=__builtin_amdgcn_readfirstlane(tid>>6);
  const bf16*Qw=Qu+(long)(wid*QBLK)*QP;
  const unsigned lds0=(unsigned)(uintptr_t)shm;
  float*wsf=(float*)(shm+LDS_WS)+wid*64;
  const bf16*ksrc=Ku+wid*512+lane*8;
  const bf16*ksrc2=Ku+(8+(wid&3))*512+lane*8;
  const bf16*vsrc=Vu+wid*512+lane*8;
  const unsigned kdst=lds0+LDS_K+wid*1024, kdst2=lds0+LDS_K+(8+(wid&3))*1024, vdst=lds0+LDS_V+wid*1024;
  #define DMA_K(t,slot) do{ glds16(ksrc+(long)(t)*(NKS*1024),(unsigned)__builtin_amdgcn_readfirstlane(kdst+(slot))); \
      if constexpr(NKS==6){ glds16(ksrc2+(long)(t)*(NKS*1024),(unsigned)__builtin_amdgcn_readfirstlane(kdst2+(slot))); } }while(0)
  #define DMA_V(t,slot) glds16(vsrc+(long)(t)*4096,(unsigned)__builtin_amdgcn_readfirstlane(vdst+(slot)))
  #define WAIT_C()  do{ if constexpr(NKS==6){WAIT_BAR(3);}else{WAIT_BAR(2);} }while(0)
  #define WAIT_P()  do{ if constexpr(NKS==6){WAIT_BAR(5);}else{WAIT_BAR(3);} }while(0)
  #define WAITA_K() do{ if constexpr(NKS==6){WAIT_BAR(2);}else{WAIT_BAR(1);} }while(0)
  #define BARONLY() asm volatile("s_barrier":::"memory")
  const int vb0=(int)(lds0+LDS_V)+((lane>>4)&1)*32+(lane&3)*8+(4*hi+((lane&15)>>2))*64;
  const char*Kbase=shm+LDS_K; bf16x8 kf[2*NKS];
  const lds_cptr shm3=(lds_cptr)shm; const lds_cptr kp0=shm3+LDS_K+hi*1024+r32*16; const lds_cptr vp0=shm3+LDS_V+((lane>>4)&1)*32+(lane&3)*8+(4*hi+((lane&15)>>2))*64;
  DMA_K(0,0);DMA_V(0,0);DMA_K(1,SLOTK);
  bf16x8 qr[NKS];
  #pragma unroll
  for(int d0=0;d0<NKS;++d0)qr[d0]=*reinterpret_cast<const bf16x8*>(&Qw[(long)r32*QP+d0*16+hi*8]);
  float mhat=0.f,l_reg=0.f;f32x16 o[2];o[0]=f32x16{};o[1]=f32x16{};f32x16 negm=f32x16{};asm volatile("":"+v"(negm));
  f32x16 o2=f32x16{}; const bf16x8 ONES=(bf16x8){(short)0x3F80,(short)0x3F80,(short)0x3F80,(short)0x3F80,(short)0x3F80,(short)0x3F80,(short)0x3F80,(short)0x3F80};
  bool resc=false;
  #define START(P0,P1) do{ const float rm=rowmax(P0,P1); resc=false; \
    { const float dl=rm; mhat=fadd_s(mhat,dl); \
      _Pragma("unroll") for(int r=0;r<16;++r){P0[r]=fsub_s(P0[r],dl);P1[r]=fsub_s(P1[r],dl);} \
      _Pragma("unroll") for(int r=0;r<16;++r)negm[r]=-mhat; asm volatile("":"+v"(negm)); } \
    _Pragma("unroll") for(int r=0;r<16;++r)P0[r]=__builtin_amdgcn_exp2f(P0[r]); }while(0)
  #define RESC() do{ if(resc){ asm volatile("s_waitcnt lgkmcnt(0)":::"memory"); \
      _Pragma("unroll") for(int d_=0;d_<2;++d_) _Pragma("unroll") for(int r=0;r<16;++r)o[d_][r]*=wsf[crow(r,hi)]; \
      if constexpr(LS){ _Pragma("unroll") for(int r=0;r<16;++r)o2[r]*=wsf[crow(r,hi)]; } } }while(0)
  f32x16 pA0,pA1,pB0,pB1;
  int kl_cur=0,kl_next=SLOTK;
  int sl_prev=0,sl_cur=0,sl_next=SLOTB;
  #define ROT() do{sl_prev=sl_cur;sl_cur=sl_next;sl_next=(sl_next==(NSLOT-1)*SLOTB)?0:sl_next+SLOTB; kl_cur=kl_next;kl_next=(kl_next==(NSLOT-1)*SLOTK)?0:kl_next+SLOTK;}while(0)
  DMA_K(2,2*SLOTK);
  WAIT_P();
  { const char*kb=Kbase+hi*1024+r32*16;
    #pragma unroll
    for(int d0=0;d0<NKS;++d0){
      const bf16x8 b0=*reinterpret_cast<const bf16x8*>(kb+d0*2048);
      const bf16x8 b1=*reinterpret_cast<const bf16x8*>(kb+d0*2048+512);
      if(d0==0){pA0=__builtin_amdgcn_mfma_f32_32x32x16_bf16(b0,qr[0],negm,0,0,0);pA1=__builtin_amdgcn_mfma_f32_32x32x16_bf16(b1,qr[0],negm,0,0,0);}
      else{pA0=__builtin_amdgcn_mfma_f32_32x32x16_bf16(b0,qr[d0],pA0,0,0,0);pA1=__builtin_amdgcn_mfma_f32_32x32x16_bf16(b1,qr[d0],pA1,0,0,0);}} }
  asm volatile("s_nop 15\n\ts_nop 7":"+v"(pA0),"+v"(pA1));
  START(pA0,pA1);
  _Pragma("unroll") for(int r=0;r<16;++r)pA1[r]=__builtin_amdgcn_exp2f(pA1[r]);
  WAIT_BAR(0);
  if constexpr(SK){ DMA_V(1,SLOTB);DMA_K(3,0); } else { DMA_K(3,0);DMA_V(1,SLOTB); }
  ROT();
  _Pragma("unroll") for(int j=0;j<NKS;++j)kload2(kf,kp0+kl_cur,j);
  WAIT_C();
  if constexpr(SK){ if(wid>=4){ BARONLY(); } }
  s16x4 vlo[8],vhi[8]; u32x4 pw0,pw1,pw2,pw3;
  #define PKW(P,B) cvtpk_s(P[B],P[B+1])
  #define PAF(k) __builtin_bit_cast(bf16x8,pw##k)
  #define VFR(i) (bf16x8){vlo[i][0],vlo[i][1],vlo[i][2],vlo[i][3],vhi[i][0],vhi[i][1],vhi[i][2],vhi[i][3]}
  #define PIN(x) asm volatile("":"+v"(x))
  #define MX3(a,b,c) __builtin_fmaxf(__builtin_fmaxf((a),(b)),(c))
  #define GAPA(MF,A0,A1,A2,A3,W0,W1,PW) do{ MF; if constexpr(!LS){ sacc+=A0; sacc+=A1; sacc+=A2; sacc+=A3; PIN(sacc); } W0; W1; PIN(PW); SBAR(); }while(0)
  #define LSM(k) do{ if constexpr(LS){ o2=MF32(PAF(k),ONES,o2); SBAR(); } }while(0)
  #define EX(v) __builtin_amdgcn_exp2f(v)
  #define GAPB(MF,X,B) do{ MF; X[B]=EX(X[B]); X[B+1]=EX(X[B+1]); X[B+2]=EX(X[B+2]); X[B+3]=EX(X[B+3]); PIN(X); SBAR(); }while(0)
  #define VRD(i) do{ vlo[i]=vtr(vp_+(((i)>>2)*4096+((i)&3)*1024)); vhi[i]=vtr(vp_+(((i)>>2)*4096+((i)&3)*1024+512)); }while(0)
  #define KRD(G,j) do{ if(G){ kload2(kf,kp0+kl_next,j); SBAR(); } }while(0)
  #define MF32(a,b,c) __builtin_amdgcn_mfma_f32_32x32x16_bf16(a,b,c,0,0,0)
  #define STEP(C0,C1,P0,P1,t,GK,GV,GL,CK,MW) do{ SBAR(); \
    const lds_cptr vp_=vp0+sl_prev; \
    VRD(0); SBAR(); float sacc=LS?0.f:(P0[0]+P0[1]); \
    GAPA(C0=MF32(kf[0],qr[0],negm), P0[2],P0[3],P0[4],P0[5],     pw0[0]=PKW(P0,0), pw0[1]=PKW(P0,2), pw0); \
    VRD(4); SBAR(); GAPA(C1=MF32(kf[1],qr[0],negm), P0[6],P0[7],P0[8],P0[9],     pw0[2]=PKW(P0,4), pw0[3]=PKW(P0,6), pw0); \
    VRD(1); SBAR(); GAPA(C0=MF32(kf[2],qr[1],C0),   P0[10],P0[11],P0[12],P0[13], pw1[0]=PKW(P0,8), pw1[1]=PKW(P0,10), pw1); \
    VRD(5); SBAR(); GAPA(C1=MF32(kf[3],qr[1],C1),   P0[14],P0[15],P1[0],P1[1],   pw1[2]=PKW(P0,12),pw1[3]=PKW(P0,14), pw1); \
    VRD(2); SBAR(); GAPA(C0=MF32(kf[4],qr[2],C0),   P1[2],P1[3],P1[4],P1[5],     pw2[0]=PKW(P1,0), pw2[1]=PKW(P1,2), pw2); \
    VRD(6); SBAR(); GAPA(C1=MF32(kf[5],qr[2],C1),   P1[6],P1[7],P1[8],P1[9],     pw2[2]=PKW(P1,4), pw2[3]=PKW(P1,6), pw2); \
    VRD(3); SBAR(); GAPA(C0=MF32(kf[6],qr[3],C0),   P1[10],P1[11],P1[12],P1[13], pw3[0]=PKW(P1,8), pw3[1]=PKW(P1,10), pw3); \
    VRD(7); SBAR(); GAPA(C1=MF32(kf[7],qr[3],C1),   P1[14],P1[15],0.f,0.f,       pw3[2]=PKW(P1,12),pw3[3]=PKW(P1,14), pw3); \
    if constexpr(NKS==6){ C0=MF32(kf[8],qr[4],C0); SBAR(); C1=MF32(kf[9],qr[4],C1); SBAR(); C0=MF32(kf[10],qr[5],C0); SBAR(); C1=MF32(kf[11],qr[5],C1); SBAR(); } \
    if constexpr(!LS){ l_reg+=sacc; } \
    if constexpr(SK){ MW; if(GV){DMA_V((t)+1,sl_next);} if(GK){DMA_K((t)+3,kl_cur);} } else { if(GK){DMA_K((t)+3,kl_cur);} if(GV){DMA_V((t)+1,sl_next);} } \
    if(CK){ float a=MX3(C0[0],C0[1],C1[0]),b=MX3(C0[2],C0[3],C1[1]); a=MX3(a,C1[2],C1[3]); \
      _Pragma("unroll") for(int r=4;r<16;r+=4){a=MX3(a,C0[r],C0[r+1]);b=MX3(b,C0[r+2],C0[r+3]);a=MX3(a,C1[r],C1[r+1]);b=MX3(b,C1[r+2],C1[r+3]);} \
      float rm=__builtin_fmaxf(a,b); { auto rr=__builtin_amdgcn_permlane32_swap(__float_as_uint(rm),__float_as_uint(rm),false,false); rm=__builtin_fmaxf(__uint_as_float(rr[0]),__uint_as_float(rr[1])); } \
      resc=false; \
      if(__builtin_expect(__any(rm>(float)THRL),0)){ const float dl=__builtin_fmaxf(rm,0.f); mhat+=dl; \
        _Pragma("unroll") for(int r=0;r<16;++r){C0[r]-=dl;C1[r]-=dl;} \
        _Pragma("unroll") for(int r=0;r<16;++r)negm[r]=-mhat; asm volatile("":"+v"(negm)); \
        const float f=__builtin_amdgcn_exp2f(-dl); l_reg*=f; if(hi==0)wsf[r32]=f; resc=true; } } else { resc=false; } \
    SBAR(); \
    GAPB(o[0]=MF32(PAF(0),VFR(0),o[0]), C0,0); \
    GAPB(o[1]=MF32(PAF(0),VFR(4),o[1]), C0,4); LSM(0); \
    KRD(GL,0); GAPB(o[0]=MF32(PAF(1),VFR(1),o[0]), C0,8); \
    KRD(GL,1); GAPB(o[1]=MF32(PAF(1),VFR(5),o[1]), C0,12); LSM(1); \
    KRD(GL,2); GAPB(o[0]=MF32(PAF(2),VFR(2),o[0]), C1,0); \
    KRD(GL,3); GAPB(o[1]=MF32(PAF(2),VFR(6),o[1]), C1,4); LSM(2); \
    if constexpr(NKS==6){ KRD(GL,4); } GAPB(o[0]=MF32(PAF(3),VFR(3),o[0]), C1,8); \
    if constexpr(NKS==6){ KRD(GL,5); } GAPB(o[1]=MF32(PAF(3),VFR(7),o[1]), C1,12); LSM(3); \
    }while(0)
  int t=1;
  for(;t+11<NT;t+=8){
    STEP(pB0,pB1,pA0,pA1,t,true,true,true,true,WAITA_K());      WAIT_C(); RESC(); ROT();
    STEP(pA0,pA1,pB0,pB1,t+1,true,true,true,false,WAITA_K());   WAIT_C(); ROT();
    STEP(pB0,pB1,pA0,pA1,t+2,true,true,true,false,WAITA_K());   WAIT_C(); ROT();
    STEP(pA0,pA1,pB0,pB1,t+3,true,true,true,false,WAITA_K());   WAIT_C(); ROT();
    STEP(pB0,pB1,pA0,pA1,t+4,true,true,true,false,WAITA_K());   WAIT_C(); ROT();
    STEP(pA0,pA1,pB0,pB1,t+5,true,true,true,false,WAITA_K());   WAIT_C(); ROT();
    STEP(pB0,pB1,pA0,pA1,t+6,true,true,true,false,WAITA_K());   WAIT_C(); ROT();
    STEP(pA0,pA1,pB0,pB1,t+7,true,true,true,false,WAITA_K());   WAIT_C(); ROT();
  }
  for(;t+5<NT;t+=2){
    STEP(pB0,pB1,pA0,pA1,t,true,true,true,true,WAITA_K());     WAIT_C(); RESC(); ROT();
    STEP(pA0,pA1,pB0,pB1,t+1,true,true,true,true,WAITA_K());   WAIT_C(); RESC(); ROT();
  }
  #define ENDW(tt) do{ if constexpr(SK){ if((tt)+3<NT){WAIT_C();} else if((tt)+1<NT){WAIT_BAR(1);} else {WAIT_BAR(0);} } \
                       else { if((tt)+3<NT){WAIT_C();} else if((tt)+2<NT){WAIT_BAR(1);} else {WAIT_BAR(0);} } }while(0)
  #define ENDA(tt) do{ if((tt)+2<NT){WAITA_K();} else {WAIT_BAR(0);} }while(0)
  for(;t+1<NT;t+=2){
    STEP(pB0,pB1,pA0,pA1,t,(t+3<NT),(t+1<NT),(t+1<NT),true,ENDA(t));         ENDW(t);   RESC(); ROT();
    STEP(pA0,pA1,pB0,pB1,t+1,(t+4<NT),(t+2<NT),(t+2<NT),true,ENDA(t+1));     ENDW(t+1); RESC(); ROT();
  }
  STEP(pB0,pB1,pA0,pA1,NT-1,false,false,false,true,WAIT_BAR(0)); if constexpr(SK){ WAIT_BAR(0); } RESC();
  { if constexpr(!LS){ float sacc=pB0[0]+pB0[1]; _Pragma("unroll") for(int r=2;r<16;++r)sacc+=pB0[r]; _Pragma("unroll") for(int r=0;r<16;++r)sacc+=pB1[r]; l_reg+=sacc; }
    pw0=(u32x4){PKW(pB0,0),PKW(pB0,2),PKW(pB0,4),PKW(pB0,6)};pw1=(u32x4){PKW(pB0,8),PKW(pB0,10),PKW(pB0,12),PKW(pB0,14)};pw2=(u32x4){PKW(pB1,0),PKW(pB1,2),PKW(pB1,4),PKW(pB1,6)};pw3=(u32x4){PKW(pB1,8),PKW(pB1,10),PKW(pB1,12),PKW(pB1,14)};
    SBAR(); pv(o,vb0+sl_cur,PAF(0),PAF(1),PAF(2),PAF(3)); LSM(0); LSM(1); LSM(2); LSM(3); }
  if constexpr(SK){ if(wid<4){ BARONLY(); } }
  #undef PKW
  #undef PAF
  #undef VFR
  #undef PIN
  #undef MX3
  #undef GAPA
  #undef GAPB
  #undef EX
  #undef VRD
  #undef KRD
  #undef LSM
  #undef MF32
  #undef STEP
  #undef ENDW
  #undef ENDA
  float rli[16];
  if constexpr(LS){
    #pragma unroll
    for(int r=0;r<16;++r)rli[r]=__builtin_amdgcn_rcpf(o2[r]);
  } else {
    {auto rr=__builtin_amdgcn_permlane32_swap(__float_as_uint(l_reg),__float_as_uint(l_reg),false,false);l_reg=__uint_as_float(rr[0])+__uint_as_float(rr[1]);}
    if(hi==0)wsf[32+r32]=l_reg;asm volatile("s_waitcnt lgkmcnt(0)":::"memory");
    #pragma unroll
    for(int r=0;r<16;++r)rli[r]=__builtin_amdgcn_rcpf(wsf[32+crow(r,hi)]);
  }
  bf16*Ow=Ou+(long)(wid*QBLK)*OP;
  { bf16*stg=(bf16*)(shm+LDS_OST)+wid*2048;
    #pragma unroll
    for(int r=0;r<16;++r){const int orow=crow(r,hi);
      #pragma unroll
      for(int d0=0;d0<2;++d0)stg[orow*64+d0*32+r32]=(bf16)(cvtpk_s(o[d0][r]*rli[r],0.f)&0xffffu);}
    asm volatile("s_waitcnt lgkmcnt(0)":::"memory");
    #pragma unroll
    for(int i=0;i<4;++i){const int row=i*8+(lane>>3),ch=lane&7; const u32x4 v=*(const u32x4*)(stg+row*64+ch*8); *(u32x4*)(Ow+(long)row*OP+ch*8)=v;} }
  asm volatile("s_waitcnt lgkmcnt(0)\n\ts_barrier":::"memory");
  #undef DMA_K
  #undef DMA_V
  #undef WAIT_C
  #undef WAIT_P
  #undef WAITA_K
  #undef BARONLY
  #undef START
  #undef RESC
  #undef ROT
}
#undef SBAR
#undef WAIT_BAR
}
#define XB_TMO      128
#define XB_XCNT(j)  (256  + 64 * (j))
#define XB_XSUB(j)  (1280 + 64 * (j))
#define XB_XGEN(j)  (2304 + 64 * (j))
#define XB_TOP      3328
#define XB_TOPGEN   3392
#define XCD_BAR_WORDS 3456
#define XB_SPIN_CAP (1u << 20)

__device__ __forceinline__ unsigned xb_ld(unsigned* p)              { return __hip_atomic_load(p, __ATOMIC_RELAXED, __HIP_MEMORY_SCOPE_AGENT); }
__device__ __forceinline__ unsigned xb_add(unsigned* p, unsigned v) { return __hip_atomic_fetch_add(p, v, __ATOMIC_RELAXED, __HIP_MEMORY_SCOPE_AGENT); }
__device__ __forceinline__ unsigned xb_xcc_id() { return (unsigned)__builtin_amdgcn_s_getreg((3 << 11) | 20) & 0xFu; }
#define XB_SPIN(cond, bar) do { unsigned _sp = 0; while (cond) { __builtin_amdgcn_s_sleep(1); \
    if ((++_sp & 255u) == 0u) { if (xb_ld(&(bar)[XB_TMO])) break; if (_sp > XB_SPIN_CAP) { atomicAdd(&(bar)[XB_TMO], 1u); break; } } } } while (0)

struct XcdBarrier {
    unsigned* bar; unsigned x;
    volatile LAS unsigned* st;
};
__device__ __forceinline__ XcdBarrier xcd_barrier_post(unsigned* bar, volatile LAS unsigned* st) {
    XcdBarrier b; b.bar = bar; b.x = xb_xcc_id(); b.st = st;
    if (threadIdx.x == 0) (void)xb_add(&bar[XB_XCNT(b.x)], 1u);
    return b;
}
__device__ __forceinline__ void xcd_barrier_complete(unsigned* bar, unsigned x, unsigned& nloc, unsigned& nx) {
    const unsigned G = gridDim.x * gridDim.y * gridDim.z;
    unsigned sum, cnt, mine, sp = 0u;
    for (;;) {
        sum = 0u; cnt = 0u; mine = 0u;
#pragma unroll
        for (unsigned j = 0; j < 16; ++j) { const unsigned c = xb_ld(&bar[XB_XCNT(j)]); sum += c; cnt += (c > 0u) ? 1u : 0u; mine = (j == x) ? c : mine; }
        if (sum == G) break;
        __builtin_amdgcn_s_sleep(1);
        if ((++sp & 255u) == 0u) { if (xb_ld(&bar[XB_TMO])) break; if (sp > XB_SPIN_CAP) { atomicAdd(&bar[XB_TMO], 1u); break; } }
    }
    nloc = mine > 0u ? mine : 1u; nx = cnt > 0u ? cnt : 1u;
}
__device__ __forceinline__ void xcd_barrier(const XcdBarrier& b) {
    asm volatile("s_waitcnt vmcnt(0)" ::: "memory");
    __syncthreads();
    if (threadIdx.x == 0) {
        unsigned* bar = b.bar;
        __builtin_amdgcn_s_waitcnt(0);
        unsigned nloc = b.st[0], nx = b.st[1];
        if (nloc == 0u) { xcd_barrier_complete(bar, b.x, nloc, nx); b.st[0] = nloc; b.st[1] = nx; }
        const unsigned old = xb_add(&bar[XB_XSUB(b.x)], 1u);
        const unsigned gen = old / nloc;
        if (old + 1u == (gen + 1u) * nloc) {
            __builtin_amdgcn_fence(__ATOMIC_RELEASE, "agent");
            asm volatile("s_waitcnt vmcnt(0)" ::: "memory");
            const unsigned og = xb_add(&bar[XB_TOP], 1u);
            const unsigned tg = og / nx;
            if (og + 1u == (tg + 1u) * nx) xb_add(&bar[XB_TOPGEN], 1u);
            else XB_SPIN(xb_ld(&bar[XB_TOPGEN]) == tg, bar);
            __builtin_amdgcn_fence(__ATOMIC_ACQUIRE, "agent");
            xb_add(&bar[XB_XGEN(b.x)], 1u);
            asm volatile("s_waitcnt vmcnt(0)" ::: "memory");
        } else {
            XB_SPIN(xb_ld(&bar[XB_XGEN(b.x)]) == gen, bar);
            __builtin_amdgcn_fence(__ATOMIC_ACQUIRE, "agent");
            asm volatile("s_waitcnt vmcnt(0)" ::: "memory");
        }
    }
    __syncthreads();
}

struct Args { const float* in[24]; float* out; unsigned char* ws; };
enum { I_X = 0, I_C, I_CTX, I_CCTX, I_WMOD, I_BMOD, I_NORMS, I_WIN, I_QKN, I_MQN, I_MKVN, I_WUQ, I_WUKV, I_GVN, I_GWS, I_GBS, I_WBR, I_WOUT, I_RW, I_RB, I_EW1, I_EB1, I_EW2, I_EB2 };

struct Frame {
    LAS unsigned char* lds;
    volatile LAS unsigned* MISC;
    gu32* ctl;
    int tid, lane, wave, G, bx;
    unsigned char* ws;
    __device__ __forceinline__ const float* in(int i) const { const unsigned long long v = __hip_atomic_load((const unsigned long long*)(ws + WS_PTAB) + i, __ATOMIC_RELAXED, __HIP_MEMORY_SCOPE_AGENT);
        const unsigned lo = __builtin_amdgcn_readfirstlane((unsigned)v), hi = __builtin_amdgcn_readfirstlane((unsigned)(v >> 32));
        return (const float*)(const GAS float*)(((unsigned long long)hi << 32) | lo); }
    __device__ __forceinline__ float* out() const { return (float*)in(24); }
};

__device__ __forceinline__ int map_col(int kind, int n) {
    if (kind == 1) { const int pn = n >> 8, c = n & 255, bj = (c >> 7) & 1, wc = (c >> 5) & 3, j = c & 31;
        if (pn < 2) return (4 * pn + wc) * 64 + 32 * bj + j;
        if (pn == 2) return 512 + wc * 64 + 32 * bj + j;
        if (pn == 3) return 768 + c;
        if (pn == 4) { if (wc < 2) return 1024 + wc * 64 + 32 * bj + j; if (wc == 2 && j < 16) return 1152 + 16 * bj + j; return -1; }
        if (pn < 9) return 1184 + (pn - 5) * 256 + c;
        return 2208 + (pn - 9) * 256 + c; }
    if (kind == 2) { if (n < 512) return (n >> 6) * 96 + (n & 63); const int t = n - 512; return ((t & 127) >> 4) * 96 + 64 + 16 * (t >> 7) + (t & 15); }
    if (kind == 3) { return ((n >> 7) & 1) * 1024 + (n >> 8) * 128 + (n & 127); }
    return n;
}
__device__ __forceinline__ void transpose_item(const float* W, int K, int Nsrc, bf16* WT, int nblk, int kind, LAS float* scr, int item, int lane) {
    const int kb = item / nblk, nb = item % nblk, k0 = 64 * kb, n0 = 64 * nb;
    const int src = map_col(kind, n0 + 4 * (lane & 15));
    f32x4 v[16];
#pragma unroll
    for (int i = 0; i < 16; ++i) { const int kk = 4 * i + (lane >> 4); v[i] = (src >= 0) ? *(const f32x4*)(W + (size_t)(k0 + kk) * Nsrc + src) : (f32x4){0.f, 0.f, 0.f, 0.f}; }
#pragma unroll
    for (int i = 0; i < 16; ++i) { const int kk = 4 * i + (lane >> 4); LAS float* d = scr + kk * 65 + 4 * (lane & 15); d[0] = v[i][0]; d[1] = v[i][1]; d[2] = v[i][2]; d[3] = v[i][3]; }
    LDS_WAIT(); asm volatile("" ::: "memory");
    const int c = lane & 7;
#pragma unroll
    for (int j = 0; j < 8; ++j) { const int n = (lane >> 3) + 8 * j; const LAS float* s = scr + (8 * c) * 65 + n;
        v4u o; o.x = cvt_pk(s[0 * 65], s[1 * 65]); o.y = cvt_pk(s[2 * 65], s[3 * 65]); o.z = cvt_pk(s[4 * 65], s[5 * 65]); o.w = cvt_pk(s[6 * 65], s[7 * 65]);
        *(GAS v4u*)(WT + (size_t)(n0 + n) * K + k0 + 8 * c) = o; }
    LDS_WAIT(); asm volatile("" ::: "memory");
}
__device__ __forceinline__ void sincos_acc(float ang, float& c, float& s) {
    const double x = (double)ang; const double n = __builtin_rint(x * 0.6366197723675814);
    double r = __builtin_fma(-n, 1.5707963267948966, x); r = __builtin_fma(-n, 6.123233995736766e-17, r);
    const double r2 = r * r;
    double sp = -2.5052108385441720e-08; sp = sp * r2 + 2.7557319223985893e-06; sp = sp * r2 - 1.9841269841269841e-04; sp = sp * r2 + 8.3333333333333332e-03; sp = sp * r2 - 1.6666666666666666e-01; sp = sp * r2 * r + r;
    double cp = 2.0876756987868099e-09; cp = cp * r2 - 2.7557319223985888e-07; cp = cp * r2 + 2.4801587301587302e-05; cp = cp * r2 - 1.3888888888888889e-03; cp = cp * r2 + 4.1666666666666664e-02; cp = cp * r2 - 0.5; cp = cp * r2 + 1.0;
    const int q = ((int)n) & 3;
    const double sv = (q == 0) ? sp : (q == 1) ? cp : (q == 2) ? -sp : -cp;
    const double cv = (q == 0) ? cp : (q == 1) ? -sp : (q == 2) ? -cp : sp;
    c = (float)cv; s = (float)sv;
}

__device__ __forceinline__ void p_prologue(Frame& F, const Args& A) {
    const int gw = F.bx * 8 + F.wave, NGW = F.G * 8, lane = F.lane;
    if (F.bx == 0 && F.tid < 25) { ((unsigned long long*)(F.ws + WS_PTAB))[F.tid] = (F.tid < 24) ? (unsigned long long)(uintptr_t)A.in[F.tid] : (unsigned long long)(uintptr_t)A.out; }
    { LAS float* sv = (LAS float*)(F.lds + LDS_SVEC);
      for (int i = F.tid; i < 3 * 1024; i += 512) { const float v = (i < 2048) ? A.in[I_C][i] : A.in[I_CCTX][i - 2048]; sv[i] = v * sigmoidf_(v); }
      __syncthreads(); }
    { const LAS float* sv = (const LAS float*)(F.lds + LDS_SVEC); float* mod = (float*)(F.ws + WS_MOD);
      for (int it = gw; it < 3 * DEPTH * 384; it += NGW) { if (it % 3) continue; const int itm = it / 3; const int l = itm / 384, col = (itm % 384) * 16 + (lane & 15), kq = lane >> 4;
          const float* W = A.in[I_WMOD] + (size_t)l * 1024 * 6144 + col; float a0 = 0.f, a1 = 0.f, a2 = 0.f;
#pragma unroll 16
          for (int k = kq * 256; k < kq * 256 + 256; ++k) { const float w = W[(size_t)k * 6144]; a0 += sv[k] * w; a1 += sv[1024 + k] * w; a2 += sv[2048 + k] * w; }
          a0 += __shfl_xor(a0, 16); a1 += __shfl_xor(a1, 16); a2 += __shfl_xor(a2, 16); a0 += __shfl_xor(a0, 32); a1 += __shfl_xor(a1, 32); a2 += __shfl_xor(a2, 32);
          if (lane < 16) { const float b = A.in[I_BMOD][l * 6144 + col]; float* mp = mod + (size_t)l * 3 * 6144 + col; mp[0] = a0 + b; mp[6144] = a1 + b; mp[2 * 6144] = a2 + b; } } }
    { float* cg = (float*)(F.ws + WS_COSG); float* sg = (float*)(F.ws + WS_SING); float* cm = (float*)(F.ws + WS_COSM); float* sm = (float*)(F.ws + WS_SINM);
      const int gt = F.bx * 512 + F.tid, NT_ = F.G * 512;
      for (int i = gt; i < SEQ * 48; i += NT_) { const int pos = i / 48, j = i % 48; const float rowf = (float)(pos >> 6), colf = (float)(pos & 63); float c, s;
          if (j < 32) { const float ang = (j < 16) ? rowf * INVF16[j] : colf * INVF16[j - 16]; sincos_acc(ang, c, s); cg[pos * 32 + j] = c; sg[pos * 32 + j] = s; }
          else { const int jj = j - 32; const float ang = (jj < 8) ? rowf * INVF16[2 * jj] : colf * INVF16[2 * (jj - 8)]; sincos_acc(ang, c, s); cm[pos * 16 + jj] = c; sm[pos * 16 + jj] = s; } } }
    { bf16* wsb = (bf16*)(F.ws + WS_WS); const float* src = A.in[I_GWS]; const int gt = F.bx * 512 + F.tid, NT_ = F.G * 512;
      for (int i = gt; i < DEPTH * 8 * 128 * 128 / 2; i += NT_) { ((unsigned*)wsb)[i] = cvt_pk(src[2 * i], src[2 * i + 1]); } }
    { bf16* rwt = (bf16*)(F.ws + WS_RWT); const float* src = A.in[I_RW]; const int gt = F.bx * 512 + F.tid, NT_ = F.G * 512;
      for (int i = gt; i < DEPTH * 32 * 1024; i += NT_) { const int l = i >> 15, e = (i >> 10) & 31, d = i & 1023; const float w = src[(size_t)l * 32768 + d * 32 + e];
          const unsigned h16 = cvt_pk(w, 0.f) & 0xffffu; const float back = __uint_as_float(h16 << 16);
          rwt[(size_t)l * 65536 + e * 1024 + d] = (bf16)h16; rwt[(size_t)l * 65536 + 32768 + e * 1024 + d] = (bf16)(cvt_pk(w - back, 0.f) & 0xffffu); } }
    { LAS float* scr = (LAS float*)(F.lds + RING_OFF + F.wave * 16640);
      constexpr int I_IN = 16 * 84, I_UQ = 4 * 12, I_UKV = 2 * 16, I_BR = 8 * 16, I_OUT = 16 * 16, I_W1 = 16 * 32, I_W2 = 16 * 16;
      constexpr int PER_LAYER = I_IN + I_UQ + I_UKV + 3 * I_BR + I_OUT + 32 * I_W1 + 32 * I_W2;
      for (int it = gw; it < DEPTH * PER_LAYER; it += NGW) { const int l = it / PER_LAYER; int r = it % PER_LAYER;
          if (r < I_IN) { transpose_item(A.in[I_WIN] + (size_t)l * 1024 * 5280, 1024, 5280, (bf16*)(F.ws + WS_WIN) + (size_t)l * ZW * 1024, 84, 1, scr, r, lane); continue; } r -= I_IN;
          if (r < I_UQ) { transpose_item(A.in[I_WUQ] + (size_t)l * 256 * 768, 256, 768, (bf16*)(F.ws + WS_WUQ) + (size_t)l * 768 * 256, 12, 2, scr, r, lane); continue; } r -= I_UQ;
          if (r < I_UKV) { transpose_item(A.in[I_WUKV] + (size_t)l * 128 * 1024, 128, 1024, (bf16*)(F.ws + WS_WUKV) + (size_t)l * 1024 * 128, 16, 0, scr, r, lane); continue; } r -= I_UKV;
          if (r < 3 * I_BR) { const int i = r / I_BR; transpose_item(A.in[I_WBR] + (size_t)(l * 3 + i) * 512 * 1024, 512, 1024, (bf16*)(F.ws + WS_WBR) + (size_t)(l * 3 + i) * 1024 * 512, 16, 0, scr, r % I_BR, lane); continue; } r -= 3 * I_BR;
          if (r < I_OUT) { transpose_item(A.in[I_WOUT] + (size_t)l * 1024 * 1024, 1024, 1024, (bf16*)(F.ws + WS_WOUT) + (size_t)l * 1024 * 1024, 16, 0, scr, r, lane); continue; } r -= I_OUT;
          if (r < 32 * I_W1) { const int e = r / I_W1; transpose_item(A.in[I_EW1] + (size_t)(l * 32 + e) * 1024 * 2048, 1024, 2048, (bf16*)(F.ws + WS_W1) + (size_t)(l * 32 + e) * 2048 * 1024, 32, 3, scr, r % I_W1, lane); continue; } r -= 32 * I_W1;
          { const int e = r / I_W2; transpose_item(A.in[I_EW2] + (size_t)(l * 32 + e) * 1024 * 1024, 1024, 1024, (bf16*)(F.ws + WS_W2) + (size_t)(l * 32 + e) * 1024 * 1024, 16, 0, scr, r % I_W2, lane); } } }
}

__device__ __forceinline__ void mod_row_to_bf16(const float* xrow, const float* gain, const float* sc, const float* sh, bf16* orow, int lane) {
    const f32x4* xr = (const f32x4*)xrow + lane; f32x4 v[4]; float ss = 0.f;
#pragma unroll
    for (int j = 0; j < 4; ++j) { v[j] = xr[64 * j]; ss += (v[j].x * v[j].x + v[j].y * v[j].y) + (v[j].z * v[j].z + v[j].w * v[j].w); }
    const float rstd = __builtin_amdgcn_rsqf(wave_sum(ss) * (1.f / DM) + RMS_EPS);
    unsigned long long* o8 = (unsigned long long*)orow + lane;
#pragma unroll
    for (int j = 0; j < 4; ++j) { const f32x4 g = ((const f32x4*)gain)[64 * j + lane], s = ((const f32x4*)sc)[64 * j + lane], h = ((const f32x4*)sh)[64 * j + lane];
        const float y0 = v[j].x * rstd * g.x * (1.f + s.x) + h.x, y1 = v[j].y * rstd * g.y * (1.f + s.y) + h.y, y2 = v[j].z * rstd * g.z * (1.f + s.z) + h.z, y3 = v[j].w * rstd * g.w * (1.f + s.w) + h.w;
        o8[64 * j] = (unsigned long long)cvt_pk(y0, y1) | ((unsigned long long)cvt_pk(y2, y3) << 32); }
}

typedef short bf16x8_t __attribute__((ext_vector_type(8)));
typedef float f32x16_t __attribute__((ext_vector_type(16)));
__device__ __forceinline__ void gmlp_unit(Frame& F, const float* gbs, const float* gvn, int l, int chunk, int nt) {
    const int lane = F.lane, g = F.wave, r32 = lane & 31, hi = lane >> 5;
    const bf16* vn = (const bf16*)(F.ws + WS_VN) + (size_t)chunk * 128 * 512 + g * 64; const float* ssv = (const float*)(F.ws + WS_SSV);
    const bf16* ua = (const bf16*)(F.ws + WS_UACT) + (size_t)chunk * 128 * 512 + g * 64;
    bf16* go = (bf16*)(F.ws + WS_GM) + (size_t)chunk * 128 * 512 + g * 64;
    const bf16* wsb = (const bf16*)(F.ws + WS_WS) + (size_t)(l * 8 + g) * 128 * 128;
    const float* bs = gbs + (size_t)(l * 8 + g) * 128;
    LAS bf16* vt = (LAS bf16*)(F.lds + RING_OFF + g * 16384);
    {
        { const int dd = (lane & 3) * 8; const f32x4 ga = *(const f32x4*)(gvn + l * 512 + g * 64 + nt * 32 + dd), gb = *(const f32x4*)(gvn + l * 512 + g * 64 + nt * 32 + dd + 4);
#pragma unroll
          for (int ps = 0; ps < 8; ++ps) { const int q = ps * 16 + (lane >> 2);
            const v4u raw = *(const v4u*)(vn + (size_t)q * 512 + nt * 32 + dd); float fv[8]; unpack8(raw, fv);
            const float* sp = ssv + ((size_t)chunk * 128 + q) * 2; const float rstd = __builtin_amdgcn_rsqf((sp[0] + sp[1]) * (1.f / 512.f) + RMS_EPS);
#pragma unroll
            for (int i = 0; i < 8; ++i) vt[(dd + i) * 136 + q] = (bf16)(cvt_pk(fv[i] * rstd * (i < 4 ? ga[i] : gb[i - 4]), 0.f) & 0xffffu); } }
        LDS_WAIT(); asm volatile("" ::: "memory");
#pragma unroll 1
        for (int mh = 0; mh < 2; ++mh) {
            f32x16_t acc[2]; acc[0] = (f32x16_t){}; acc[1] = (f32x16_t){};
            float uv[2][16], bv[2][16];
#pragma unroll
            for (int mt = 0; mt < 2; ++mt)
#pragma unroll
                for (int rg = 0; rg < 16; ++rg) { const int p = mh * 64 + mt * 32 + (rg & 3) + 8 * (rg >> 2) + 4 * hi;
                    uv[mt][rg] = __uint_as_float((unsigned)ua[(size_t)p * 512 + nt * 32 + r32] << 16); bv[mt][rg] = bs[p]; }
            const bf16* wsl = wsb + (size_t)mh * 64 * 128; asm volatile("" : "+v"(wsl));
#pragma unroll
            for (int ks = 0; ks < 8; ++ks) { const bf16x8_t bfr = *(const LAS bf16x8_t*)(vt + r32 * 136 + ks * 16 + hi * 8);
#pragma unroll
                for (int mt = 0; mt < 2; ++mt) { const bf16x8_t afr = *(const bf16x8_t*)(wsl + (size_t)(mt * 32 + r32) * 128 + ks * 16 + hi * 8);
                    acc[mt] = __builtin_amdgcn_mfma_f32_32x32x16_bf16(afr, bfr, acc[mt], 0, 0, 0); } }
#pragma unroll
            for (int mt = 0; mt < 2; ++mt)
#pragma unroll
                for (int rg = 0; rg < 16; ++rg) { const int p = mh * 64 + mt * 32 + (rg & 3) + 8 * (rg >> 2) + 4 * hi; const size_t off = (size_t)p * 512 + nt * 32 + r32;
                    go[off] = (bf16)(cvt_pk(uv[mt][rg] * (acc[mt][rg] + bv[mt][rg]), 0.f) & 0xffffu); } }
        LDS_WAIT(); asm volatile("" ::: "memory");
    }
}
constexpr int T3_REC_E = 0, T3_REC_W = 8192, T3_REC_S = 16384, T3_HIST = 24576, T3_BASE = T3_HIST + 128;
__device__ __forceinline__ void t3_phase(Frame& F, int l, int T_l, const float* xin_lat, const float* xin_ctx, int cofs, bool dry) {
    float* const outp = F.out();
    const int lane = F.lane, tid = F.tid;
    LAS int* rec_e = (LAS int*)(F.lds + RING_OFF + T3_REC_E); LAS float* rec_w = (LAS float*)(F.lds + RING_OFF + T3_REC_W); LAS int* rec_s = (LAS int*)(F.lds + RING_OFF + T3_REC_S);
    LAS int* hist = (LAS int*)(F.lds + RING_OFF + T3_HIST); LAS int* base = (LAS int*)(F.lds + RING_OFF + T3_BASE);
    if (tid < 32) hist[tid] = 0;
    const int per = (T_l + F.G - 1) / F.G; const int r0 = F.bx * per; int ntok = T_l - r0; ntok = ntok < 0 ? 0 : (ntok > per ? per : ntok);
    const float* norms = F.in(I_NORMS) + (size_t)l * 4 * 1024; const float* modl = (const float*)(F.ws + WS_MOD) + (size_t)l * 3 * 6144;
    const bf16* Y = (const bf16*)(F.ws + WS_Y); bf16* XN = (bf16*)(F.ws + (dry ? WS_H : WS_XN)); bf16* XNL = (bf16*)(F.ws + WS_MERGEB);
    for (int j = F.wave; j < ntok; j += 8) {
        const int r = r0 + j; const bool lat = r < TL; const int who = lat ? (r >> 14) : 2;
        const float* xrow = lat ? xin_lat + (size_t)r * 1024 : xin_ctx + (size_t)(r - TL) * 1024;
        float* orow = dry ? (float*)(F.ws + WS_MERGE) + (size_t)r * 1024 : (lat ? outp + (size_t)r * 1024 : (float*)(F.ws + WS_XC) + (size_t)(r - TL) * 1024);
        const float* mo = modl + (size_t)who * 6144;
        float yv[16], xv[16];
        { const v4u* yp = (const v4u*)(Y + (size_t)r * 1024); float a[8], b[8]; unpack8(yp[lane], a); unpack8(yp[64 + lane], b);
#pragma unroll
          for (int i = 0; i < 8; ++i) { yv[i] = a[i]; yv[8 + i] = b[i]; } }
#pragma unroll
        for (int h = 0; h < 2; ++h)
#pragma unroll
            for (int q = 0; q < 2; ++q) { const f32x4 t = *(const f32x4*)(xrow + h * 512 + 8 * lane + 4 * q);
#pragma unroll
                for (int i = 0; i < 4; ++i) xv[h * 8 + q * 4 + i] = t[i]; }
        float ss = 0.f;
#pragma unroll
        for (int i = 0; i < 16; ++i) ss += yv[i] * yv[i];
        const float rstd = __builtin_amdgcn_rsqf(wave_sum(ss) * (1.f / DM) + RMS_EPS);
        float ss2 = 0.f;
#pragma unroll
        for (int h = 0; h < 2; ++h)
#pragma unroll
            for (int q = 0; q < 2; ++q) { const int d0 = h * 512 + 8 * lane + 4 * q; const f32x4 g1 = *(const f32x4*)(mo + 2 * 1024 + d0), gn = *(const f32x4*)(norms + 1024 + d0); f32x4 o;
#pragma unroll
                for (int i = 0; i < 4; ++i) { const int k = h * 8 + q * 4 + i; const float xn = xv[k] + g1[i] * (yv[k] * rstd * gn[i]); xv[k] = xn; o[i] = xn; ss2 += xn * xn; }
                *(f32x4*)(orow + d0) = o; }
        const float rstd2 = __builtin_amdgcn_rsqf(wave_sum(ss2) * (1.f / DM) + RMS_EPS);
#pragma unroll
        for (int h = 0; h < 2; ++h) { float hi8[8], lo8[8];
#pragma unroll
            for (int q = 0; q < 2; ++q) { const int d0 = h * 512 + 8 * lane + 4 * q; const f32x4 gn = *(const f32x4*)(norms + 2048 + d0), sc = *(const f32x4*)(mo + 4 * 1024 + d0), sh = *(const f32x4*)(mo + 3 * 1024 + d0);
#pragma unroll
                for (int i = 0; i < 4; ++i) hi8[q * 4 + i] = xv[h * 8 + q * 4 + i] * rstd2 * gn[i] * (1.f + sc[i]) + sh[i]; }
            const v4u ph = pack8(hi8); float back[8]; unpack8(ph, back);
#pragma unroll
            for (int i = 0; i < 8; ++i) lo8[i] = hi8[i] - back[i];
            *(v4u*)(XN + (size_t)r * 1024 + h * 512 + 8 * lane) = ph; *(v4u*)(XNL + (size_t)r * 1024 + h * 512 + 8 * lane) = pack8(lo8); }
    }
    asm volatile("s_waitcnt vmcnt(0)" ::: "memory");
    __syncthreads();
    { const int r32 = lane & 31, hi = lane >> 5, w = F.wave; const int ntiles = (ntok + 31) >> 5;
      if (w < ntiles) {
        const int tloc = 32 * w + r32; const int rr = r0 + (tloc < ntok ? tloc : ntok - 1);
        const bf16* whi = (const bf16*)(F.ws + WS_RWT) + (size_t)l * 2 * 32 * 1024 + (size_t)r32 * 1024 + hi * 8; const bf16* wlo = whi + 32 * 1024;
        const bf16* thi = XN + (size_t)rr * 1024 + hi * 8; const bf16* tlo = XNL + (size_t)rr * 1024 + hi * 8;
        f32x16_t acc = (f32x16_t){};
#pragma unroll 8
        for (int ks = 0; ks < 64; ++ks) { const bf16x8_t ah = *(const bf16x8_t*)(whi + ks * 16), al = *(const bf16x8_t*)(wlo + ks * 16), bh = *(const bf16x8_t*)(thi + ks * 16), bl = *(const bf16x8_t*)(tlo + ks * 16);
            acc = __builtin_amdgcn_mfma_f32_32x32x16_bf16(ah, bh, acc, 0, 0, 0); acc = __builtin_amdgcn_mfma_f32_32x32x16_bf16(ah, bl, acc, 0, 0, 0); acc = __builtin_amdgcn_mfma_f32_32x32x16_bf16(al, bh, acc, 0, 0, 0); }
        const float* rb = F.in(I_RB) + l * 32; float v[16]; float ninf = -INFINITY; asm volatile("" : "+v"(ninf));
#pragma unroll
        for (int i = 0; i < 16; ++i) v[i] = acc[i] + rb[(i & 3) + 8 * (i >> 2) + 4 * hi];
        float cm[8]; int cid[8];
#pragma unroll
        for (int k = 0; k < 4; ++k) { float m = v[0];
#pragma unroll
            for (int i = 1; i < 16; ++i) m = fmaxf(m, v[i]);
            int sel = 15;
#pragma unroll
            for (int i = 14; i >= 0; --i) sel = (v[i] == m) ? i : sel;
            sel = (v[15] == m && sel == 15) ? 15 : sel;
            cm[k] = m; cid[k] = (sel & 3) + 8 * (sel >> 2) + 4 * hi;
#pragma unroll
            for (int i = 0; i < 16; ++i) v[i] = (i == sel) ? ninf : v[i]; }
#pragma unroll
        for (int k = 0; k < 4; ++k) { cm[4 + k] = __shfl_xor(cm[k], 32); cid[4 + k] = __shfl_xor(cid[k], 32); }
        float tl[4]; int te[4];
#pragma unroll
        for (int k = 0; k < 4; ++k) { float best = cm[0]; int bid = cid[0]; int bc = 0;
#pragma unroll
            for (int c = 1; c < 8; ++c) { const bool better = (cm[c] > best) || (cm[c] == best && cid[c] < bid); best = better ? cm[c] : best; bid = better ? cid[c] : bid; bc = better ? c : bc; }
            tl[k] = best; te[k] = bid;
#pragma unroll
            for (int c = 0; c < 8; ++c) cm[c] = (c == bc) ? ninf : cm[c]; }
        const float e1 = __expf(tl[1] - tl[0]), e2 = __expf(tl[2] - tl[0]), e3 = __expf(tl[3] - tl[0]); const float inv = 1.f / (1.f + e1 + e2 + e3);
        if (hi == 0 && tloc < ntok) { const float wv[4] = {inv, e1 * inv, e2 * inv, e3 * inv};
#pragma unroll
            for (int k = 0; k < 4; ++k) { const int ls = __hip_atomic_fetch_add(&hist[te[k]], 1, __ATOMIC_RELAXED, __HIP_MEMORY_SCOPE_WORKGROUP);
                rec_e[tloc * 4 + k] = te[k]; rec_w[tloc * 4 + k] = wv[k]; rec_s[tloc * 4 + k] = ls; } }
      } }
    __syncthreads();
    if (tid < 32) { const int n = hist[tid]; base[tid] = n ? (int)__hip_atomic_fetch_add((unsigned*)(F.ctl + CW_CNT + cofs + l * 32 + tid), (unsigned)n, RLX_AGENT) : 0; }
    __syncthreads();
    { int* rte = (int*)(F.ws + WS_RTE); int* rts = (int*)(F.ws + WS_RTS); int* ltok = (int*)(F.ws + WS_LTOK); float* lw = (float*)(F.ws + WS_LW);
      for (int i = tid; i < ntok * 4; i += 512) { const int e = rec_e[i], slot = base[e] + rec_s[i]; const int r = r0 + (i >> 2);
          rte[(size_t)r * 4 + (i & 3)] = e; rts[(size_t)r * 4 + (i & 3)] = slot; ltok[(size_t)e * TA + slot] = r; lw[(size_t)e * TA + slot] = rec_w[i]; } }
}

__device__ __forceinline__ void moe_tables(Frame& F, int l, int cofs) {
    LAS int* tab = (LAS int*)(F.lds + LDS_TAB);
    if (F.tid == 0) { int nb = 0;
#pragma unroll 1
        for (int e = 0; e < 32; ++e) { const int c = (int)__hip_atomic_load((unsigned*)(F.ctl + CW_CNT + cofs + l * 32 + e), RLX_AGENT); const int n = (c + 255) >> 8; tab[600 + e] = nb * 256; tab[640 + e] = c;
            for (int b = 0; b < n; ++b) tab[nb + b] = e; nb += n; }
        tab[632] = nb; }
    __syncthreads();
}
__device__ __forceinline__ void t4_phase(Frame& F, int l, int T_l, bool dummy) {
    float* const outp = F.out();
    const bool nextmod = (l + 1 < DEPTH);
    const float* ngain = F.in(I_NORMS) + (size_t)(l + 1 < DEPTH ? l + 1 : l) * 4 * 1024; const float* nmod = (const float*)(F.ws + WS_MOD) + (size_t)(l + 1 < DEPTH ? l + 1 : l) * 3 * 6144; bf16* XN = (bf16*)(F.ws + WS_XN);
    const LAS int* tab = (const LAS int*)(F.lds + LDS_TAB); const int gw = F.bx * 8 + F.wave, NGW = F.G * 8, lane = F.lane;
    const int* rte = (const int*)(F.ws + WS_RTE); const int* rts = (const int*)(F.ws + WS_RTS); const bf16* Yp = (const bf16*)(F.ws + WS_BIG);
    const float* gain = F.in(I_NORMS) + (size_t)l * 4 * 1024 + 3 * 1024; const float* modl = (const float*)(F.ws + WS_MOD) + (size_t)l * 3 * 6144;
    for (int r = gw; r < T_l; r += NGW) { const bool lat = r < TL; const int who = lat ? (r >> 14) : 2; const float* g2 = modl + (size_t)who * 6144 + 5 * 1024;
        float* xrow = lat ? outp + (size_t)r * 1024 : (float*)(F.ws + WS_XC) + (size_t)(r - TL) * 1024;
        float f[16];
#pragma unroll
        for (int i = 0; i < 16; ++i) f[i] = 0.f;
#pragma unroll
        for (int k = 0; k < 4; ++k) { const int e = rte[(size_t)r * 4 + k], slot = rts[(size_t)r * 4 + k]; const size_t dst = (size_t)(tab[600 + e] + slot);
            const v4u* yp = (const v4u*)(Yp + dst * 1024); float a[8], b[8]; unpack8(yp[lane], a); unpack8(yp[64 + lane], b);
#pragma unroll
            for (int i = 0; i < 8; ++i) { f[i] += a[i]; f[8 + i] += b[i]; } }
        float ss = 0.f;
#pragma unroll
        for (int i = 0; i < 16; ++i) ss += f[i] * f[i];
        const float rstd = __builtin_amdgcn_rsqf(wave_sum(ss) * (1.f / DM) + RMS_EPS);
        float ssn = 0.f;
#pragma unroll
        for (int h = 0; h < 2; ++h) { const int d0 = h * 512 + 8 * lane;
#pragma unroll
            for (int q = 0; q < 2; ++q) { f32x4 xv = *(const f32x4*)(xrow + d0 + 4 * q); const f32x4 gv = *(const f32x4*)(gain + d0 + 4 * q), mv = *(const f32x4*)(g2 + d0 + 4 * q);
#pragma unroll
                for (int i = 0; i < 4; ++i) { xv[i] += mv[i] * (f[h * 8 + q * 4 + i] * rstd * gv[i]); f[h * 8 + q * 4 + i] = xv[i]; ssn += xv[i] * xv[i]; }
                *(f32x4*)((dummy ? (float*)(F.ws + WS_MERGE) + (size_t)r * 1024 : xrow) + d0 + 4 * q) = xv; } }
        if (nextmod) { const float rstdn = __builtin_amdgcn_rsqf(wave_sum(ssn) * (1.f / DM) + RMS_EPS); const float* mo = nmod + (size_t)who * 6144;
#pragma unroll
            for (int h = 0; h < 2; ++h) { const int d0 = h * 512 + 8 * lane; float y[8];
#pragma unroll
                for (int q = 0; q < 2; ++q) { const f32x4 gv = *(const f32x4*)(ngain + d0 + 4 * q), sc = *(const f32x4*)(mo + 1024 + d0 + 4 * q), sh = *(const f32x4*)(mo + d0 + 4 * q);
#pragma unroll
                    for (int i = 0; i < 4; ++i) y[q * 4 + i] = f[h * 8 + q * 4 + i] * rstdn * gv[i] * (1.f + sc[i]) + sh[i]; }
                *(v4u*)(XN + (size_t)r * 1024 + d0) = pack8(y); } } }
}

#ifndef PH_MASK
#define PH_MASK 0xFFFFFFFFu
#endif
#define PH(k) ((PH_MASK >> (k)) & 1u)
#ifndef PH_TWICE
#define PH_TWICE 0u
#endif
#define REP(k) _Pragma("unroll") for (int rep_ = 0; rep_ < (((PH_TWICE >> (k)) & 1u) ? 2 : 1); ++rep_)
__global__ void __launch_bounds__(512, 2) fwd_kernel(Args A) {
    extern __shared__ __attribute__((aligned(16))) unsigned char lds[];
    Frame F;
    F.lds = (LAS unsigned char*)lds; F.MISC = (volatile LAS unsigned*)(F.lds + MISC_OFF);
    F.tid = threadIdx.x; F.lane = F.tid & 63; F.wave = __builtin_amdgcn_readfirstlane(F.tid >> 6);
    F.G = gridDim.x; F.bx = blockIdx.x; F.ws = (unsigned char*)(GAS unsigned char*)(unsigned long long)(uintptr_t)A.ws; F.ctl = (gu32*)(A.ws + WS_CTL);
    int vcu = (F.G % 8 == 0) ? (F.bx % 8) * (F.G / 8) + F.bx / 8 : F.bx;
    if (F.tid < 64) F.MISC[F.tid] = 0u;
    __syncthreads();
    XcdBarrier bar = xcd_barrier_post((unsigned*)(F.ctl + CW_BAR), F.MISC + 8);
#define GRID_BAR() do { { unsigned* bp_ = (unsigned*)(F.ctl + CW_BAR); unsigned x_ = bar.x; asm volatile("" : "+s"(bp_), "+s"(x_)); bar.bar = bp_; bar.x = x_; } xcd_barrier(bar); \
        { int t_ = threadIdx.x; asm volatile("" : "+v"(t_)); F.tid = t_; F.lane = t_ & 63; unsigned long long w_ = (unsigned long long)(uintptr_t)A.ws; int g_ = gridDim.x, b_ = blockIdx.x; asm volatile("" : "+s"(w_), "+s"(g_), "+s"(b_)); \
          F.ws = (unsigned char*)(GAS unsigned char*)w_; ws = F.ws; F.ctl = (gu32*)(w_ + WS_CTL * 1ull); F.G = g_; F.bx = b_; vcu = (g_ % 8 == 0) ? (b_ % 8) * (g_ / 8) + b_ / 8 : b_; gw = b_ * 8 + F.wave; NGW = g_ * 8; } } while (0)
    int gw = F.bx * 8 + F.wave, NGW = F.G * 8;
    unsigned char* ws = F.ws;

    if (PH(0)) REP(0) p_prologue(F, A);
    GRID_BAR();

#pragma unroll
    for (int l = 0; l < DEPTH; ++l) {
        const int T_l = (l == 0) ? TA : TL;

        if (PH(1) && l == 0) REP(1) { const float* xin_lat = (l == 0) ? F.in(I_X) : F.out(); const float* xin_ctx = (l == 0) ? F.in(I_CTX) : (const float*)(ws + WS_XC);
          const float* norms = F.in(I_NORMS) + (size_t)l * 4 * 1024; const float* modl = (const float*)(ws + WS_MOD) + (size_t)l * 3 * 6144;
          for (int r = gw; r < TA; r += NGW) { const bool lat = r < TL; const int who = lat ? (r >> 14) : 2; const float* mo = modl + (size_t)who * 6144;
            mod_row_to_bf16(lat ? xin_lat + (size_t)r * 1024 : xin_ctx + (size_t)(r - TL) * 1024, norms, mo + 1024, mo, (bf16*)(ws + WS_XN) + (size_t)r * 1024, F.lane); } }
        if (l == 0) GRID_BAR();

        if (PH(2)) REP(2) { pg8::Gemm g{(const bf16*)(ws + WS_XN), (const bf16*)(ws + WS_WIN) + (size_t)l * ZW * 1024, TA, ZW, 1024}; pg8::StaticOrder S; S.init(TA, ZW, F.G, F.bx);
          pg8::EpiInproj E{ws, F.in(I_QKN) + (size_t)l * 128, F.in(I_MQN) + (size_t)l * 256, F.in(I_MKVN) + (size_t)l * 128, (LAS float*)(F.lds + LDS_X)};
          pg8::gemm_phase<pg8::EpiInproj, pg8::StaticOrder, true, true>(F.lds + RING_OFF, g, S, E); }
        GRID_BAR();

        if (PH(4)) REP(4) { pg8::Gemm g{(const bf16*)(ws + WS_CQN), (const bf16*)(ws + WS_WUQ) + (size_t)l * 768 * 256, T_l, 768, 256}; pg8::StaticOrder S; S.init(T_l, 768, F.G, F.bx);
          pg8::EpiUq E{(bf16*)(ws + WS_QM), (const float*)(ws + WS_COSM), (const float*)(ws + WS_SINM)};
          pg8::gemm_phase<pg8::EpiUq, pg8::StaticOrder, true, true>(F.lds + RING_OFF, g, S, E); }
        if (PH(5)) REP(5) { pg8::Gemm g{(const bf16*)(ws + WS_CKVN), (const bf16*)(ws + WS_WUKV) + (size_t)l * 1024 * 128, TA, 1024, 128}; pg8::StaticOrder S; S.init(TA, 1024, F.G, (F.bx + F.G / 2) % F.G);
          pg8::EpiUkv E{(bf16*)(ws + WS_KM), (bf16*)(ws + WS_VM)};
          pg8::gemm_phase<pg8::EpiUkv, pg8::StaticOrder, true, true>(F.lds + RING_OFF, g, S, E); }
        if (PH(6)) REP(6) { const float* gbs = F.in(I_GBS); const float* gvn = F.in(I_GVN); for (int hu = (F.bx + F.G / 4) % F.G; hu < 2 * (T_l / 128); hu += F.G) gmlp_unit(F, gbs, gvn, l, hu >> 1, hu & 1); }
        GRID_BAR();

        { const int per = (1024 + F.G - 1) / F.G; char* shm = (char*)lds + RING_OFF;
          if (PH(7)) REP(7) for (int i = 0; i <= per; ++i) { size_t row0; int b, h, nt, t0;
              if (i < per) { const int L = vcu * per + i; if (L >= 1024) continue; const int bh = L >> 6, qb = L & 63; b = bh >> 3; h = bh & 7; row0 = (size_t)b * SEQ + (size_t)qb * 256; t0 = 0; nt = NTILE; }
              else { if (l != 0 || F.bx >= 16) continue; const int bh = F.bx; b = bh >> 3; h = bh & 7; row0 = (size_t)TL + (size_t)b * CTX; t0 = SEQ / 64; nt = CTX / 64; }
              attn_body::attn_unit<4, 512, 128, 128, 512, 8, false, false>((const bf16*)(ws + WS_QG) + row0 * 512 + h * 64, (const bf16*)(ws + WS_KG) + ((size_t)(b * 2 + (h >> 2)) * NTILE + t0) * 4096, (const bf16*)(ws + WS_VG) + ((size_t)(b * 2 + (h >> 2)) * NTILE + t0) * 4096,
                                                             (bf16*)(ws + WS_OG) + row0 * 512 + h * 64, nt, shm); }
          if (PH(8)) REP(8) for (int i = 0; i <= per; ++i) { size_t row0; int b, h, nt, t0;
              if (i < per) { const int L = vcu * per + i; if (L >= 1024) continue; const int bh = L >> 6, qb = L & 63; b = bh >> 3; h = bh & 7; row0 = (size_t)b * SEQ + (size_t)qb * 256; t0 = 0; nt = NTILE; }
              else { if (l != 0 || F.bx < 16 || F.bx >= 32) continue; const int bh = F.bx - 16; b = bh >> 3; h = bh & 7; row0 = (size_t)TL + (size_t)b * CTX; t0 = SEQ / 64; nt = CTX / 64; }
              attn_body::attn_unit<6, 768, 768, 512, 512, 8, false, false>((const bf16*)(ws + WS_QM) + row0 * 768 + h * 96, (const bf16*)(ws + WS_KM) + ((size_t)(b * 8 + h) * NTILE + t0) * 6144, (const bf16*)(ws + WS_VM) + ((size_t)(b * 8 + h) * NTILE + t0) * 4096,
                                                             (bf16*)(ws + WS_OM) + row0 * 512 + h * 64, nt, shm); } }
        GRID_BAR();

        if (PH(10)) REP(10) { pg8::StaticOrder S; S.init(T_l, 1024, F.G, F.bx); const bf16* wbr = (const bf16*)(ws + WS_WBR) + (size_t)l * 3 * 1024 * 512;
          { pg8::Gemm g{(const bf16*)(ws + WS_OG), wbr, T_l, 1024, 512}; pg8::EpiBranch<0> E{(const bf16*)(ws + WS_BIG), (bf16*)(ws + WS_MERGEB)};
            pg8::gemm_phase<pg8::EpiBranch<0>, pg8::StaticOrder, true, true>(F.lds + RING_OFF, g, S, E); }
          { pg8::Gemm g{(const bf16*)(ws + WS_OM), wbr + (size_t)1024 * 512, T_l, 1024, 512}; pg8::EpiBranch<1> E{(const bf16*)(ws + WS_BIG), (bf16*)(ws + WS_MERGEB)};
            pg8::gemm_phase<pg8::EpiBranch<1>, pg8::StaticOrder, true, true>(F.lds + RING_OFF, g, S, E); }
          { pg8::Gemm g{(const bf16*)(ws + WS_GM), wbr + (size_t)2 * 1024 * 512, T_l, 1024, 512}; pg8::EpiBranch<2> E{(const bf16*)(ws + WS_BIG), (bf16*)(ws + WS_MERGEB)};
            pg8::gemm_phase<pg8::EpiBranch<2>, pg8::StaticOrder, true, true>(F.lds + RING_OFF, g, S, E); } }
        GRID_BAR();

        if (PH(11)) REP(11) { pg8::Gemm g{(const bf16*)(ws + WS_MERGEB), (const bf16*)(ws + WS_WOUT) + (size_t)l * 1024 * 1024, T_l, 1024, 1024}; pg8::StaticOrder S; S.init(T_l, 1024, F.G, F.bx);
          pg8::EpiPlain E{(bf16*)(ws + WS_Y), 1024};
          pg8::gemm_phase<pg8::EpiPlain, pg8::StaticOrder, true, true>(F.lds + RING_OFF, g, S, E); }
        GRID_BAR();

        if (PH(12)) REP(12) { const float* xin_lat = (l == 0) ? F.in(I_X) : F.out(); const float* xin_ctx = (l == 0) ? F.in(I_CTX) : (const float*)(ws + WS_XC); t3_phase(F, l, T_l, xin_lat, xin_ctx, (((PH_TWICE >> 12) & 1u) && rep_ == 0) ? 64 : 0, ((PH_TWICE >> 12) & 1u) && rep_ == 0); }
        GRID_BAR();

        moe_tables(F, l, 0);

        if (PH(14)) REP(14) { const LAS int* tab = (const LAS int*)(F.lds + LDS_TAB); const int nblk = __builtin_amdgcn_readfirstlane(tab[632]);
          LAS int* rowtok = (LAS int*)(F.lds + LDS_ROWTOK);
          { const int* ltok = (const int*)(ws + WS_LTOK); const int nun = nblk * 8;
            for (int idx = F.tid; idx < 20 * 256; idx += 512) { const int i = idx >> 8, r = idx & 255; const long L = (long)i * F.G + vcu; int tk = 0;
                if (L < nun) { const int blk = (int)(L >> 3), e = tab[blk], slot = blk * 256 + r - tab[600 + e]; if (slot < tab[640 + e]) tk = ltok[(size_t)e * TA + slot]; }
                rowtok[idx] = tk; }
            __syncthreads(); }
          pg8::Gemm g{(const bf16*)(ws + WS_XN), (const bf16*)(ws + WS_W1) + (size_t)l * 32 * 2048 * 1024, TA, 32 * 2048, 1024};
          pg8::MoeOrder<8> S{nblk * 8, F.G, vcu, tab, rowtok}; pg8::EpiMoe1 E{(bf16*)(ws + WS_H), F.in(I_EB1) + (size_t)l * 32 * 2048};
          pg8::gemm_phase<pg8::EpiMoe1, pg8::MoeOrder<8>, true, true, true>(F.lds + RING_OFF, g, S, E); }
        GRID_BAR();

        if (PH(15)) REP(15) { const LAS int* tab = (const LAS int*)(F.lds + LDS_TAB); const int nblk = __builtin_amdgcn_readfirstlane(tab[632]);
          pg8::Gemm g{(const bf16*)(ws + WS_H), (const bf16*)(ws + WS_W2) + (size_t)l * 32 * 1024 * 1024, MOE_ROWS, 32 * 1024, 1024};
          pg8::MoeOrder<4> S{nblk * 4, F.G, vcu, tab, tab}; pg8::EpiMoe2 E{(bf16*)(ws + WS_BIG), F.in(I_EB2) + (size_t)l * 32 * 1024, (const float*)(ws + WS_LW), tab};
          pg8::gemm_phase<pg8::EpiMoe2, pg8::MoeOrder<4>, true, true>(F.lds + RING_OFF, g, S, E); }
        GRID_BAR();

        if (PH(16)) REP(16) t4_phase(F, l, T_l, ((PH_TWICE >> 16) & 1u) && rep_ == 0);
        GRID_BAR();
    }
#undef GRID_BAR
}

extern "C" void kernel_launch(void* const* d_in, const int* in_sizes, int n_in, void* d_out, int out_size, void* d_ws, size_t ws_size, hipStream_t stream) {
    static int grid = 0;
    if (grid == 0) {
        if (n_in != 24 || out_size != TL * DM || ws_size < WS_END) { fprintf(stderr, "kernel_launch: unexpected problem: n_in %d out %d ws %zu (need %zu)\n", n_in, out_size, ws_size, (size_t)WS_END); grid = -1; return; }
        int dev = 0, cus = 0;
        if (hipGetDevice(&dev) != hipSuccess || hipDeviceGetAttribute(&cus, hipDeviceAttributeMultiprocessorCount, dev) != hipSuccess) { grid = -1; return; }
        if (hipFuncSetAttribute((const void*)fwd_kernel, hipFuncAttributeMaxDynamicSharedMemorySize, LDS_BYTES) != hipSuccess) { fprintf(stderr, "kernel_launch: hipFuncSetAttribute failed\n"); grid = -1; return; }
        int per_cu = 0;
        if (hipOccupancyMaxActiveBlocksPerMultiprocessor(&per_cu, (const void*)fwd_kernel, 512, LDS_BYTES) != hipSuccess || per_cu < 1) fprintf(stderr, "kernel_launch: occupancy query reports %d\n", per_cu);
        (void)hipGetLastError();
        grid = cus > 256 ? 256 : cus;
    }
    if (grid < 0) return;
    if (hipMemsetAsync((char*)d_ws + WS_CTL, 0, CTL_ZERO_BYTES, stream) != hipSuccess) return;
    Args a{};
    for (int i = 0; i < 24; ++i) a.in[i] = (const float*)d_in[i];
    a.out = (float*)d_out; a.ws = (unsigned char*)d_ws;
    hipLaunchKernelGGL(fwd_kernel, dim3(grid), dim3(512), LDS_BYTES, stream, a);
}
```

```cpp
#include <hip/hip_runtime.h>
#include <cstdio>
#include <cstdint>

typedef unsigned short bf16;

constexpr int DM = 1024, NBATCH = 2, SEQ = 16384, CTX = 256, DEPTH = 2;
constexpr int TL = NBATCH * SEQ;
constexpr int TC = NBATCH * CTX;
constexpr int TA = TL + TC;
constexpr int KPB = SEQ + CTX;
constexpr int KR = NBATCH * KPB;
constexpr int ZW = 5376;
constexpr int Z_Q = 0, Z_K = 512, Z_V = 640, Z_CQ = 768, Z_CKV = 1024, Z_KR = 1152, Z_U = 1280, Z_VG = 1792, Z_GATE = 2304;
constexpr int NEXP = 32, TOPK = 4, DEXP = 1024, MOE_ROWS = 552 * 256;
constexpr float RMS_EPS = 1e-6f;
constexpr float LOG2E = 1.4426950408889634f;
constexpr float C2G = 0.125f * LOG2E;
constexpr float C2M = 0.10206207261596577f * LOG2E;

constexpr size_t MiB = 1u << 20;
constexpr size_t WS_CTL = 0, CTL_ZERO_BYTES = 1 * MiB;
constexpr size_t WS_MOD = 1 * MiB;
constexpr size_t WS_PTAB = 1 * MiB + 512 * 1024;
constexpr size_t WS_COSG = 2 * MiB, WS_SING = 4 * MiB, WS_COSM = 6 * MiB, WS_SINM = 7 * MiB;
constexpr size_t WS_WS = 8 * MiB;
constexpr size_t WS_RWT = 8 * MiB + 512 * 1024;
constexpr size_t WS_SSV = 1 * MiB + 640 * 1024;
static_assert(WS_SSV + (size_t)TA * 2 * 4 <= 2 * MiB && WS_RWT + (size_t)DEPTH * 2 * 32 * 1024 * 2 <= 9 * MiB, "ws map small regions");
constexpr size_t WS_WUQ = 9 * MiB;
constexpr size_t WS_WUKV = 10 * MiB;
constexpr size_t WS_WBR = 11 * MiB;
constexpr size_t WS_WOUT = 17 * MiB;
constexpr size_t WS_WIN = 21 * MiB;
constexpr size_t WS_W1 = 42 * MiB;
constexpr size_t WS_W2 = 298 * MiB;
constexpr size_t WS_XC = 426 * MiB;
constexpr size_t WS_RTE = 428 * MiB;
constexpr size_t WS_RTS = 429 * MiB;
constexpr size_t WS_LTOK = 430 * MiB;
constexpr size_t WS_LW = 435 * MiB;
constexpr size_t WS_XN = 441 * MiB;
constexpr size_t WS_QG = 506 * MiB;
constexpr size_t WS_KG = 539 * MiB;
constexpr size_t WS_VG = 548 * MiB;
constexpr size_t WS_CQN = 557 * MiB;
constexpr size_t WS_CKVN = 574 * MiB;
constexpr size_t WS_QM = 583 * MiB;
constexpr size_t WS_KM = 632 * MiB;
constexpr size_t WS_VM = 681 * MiB;
constexpr size_t WS_OG = 714 * MiB;
constexpr size_t WS_OM = 747 * MiB;
constexpr size_t WS_GM = 780 * MiB;
constexpr size_t WS_UACT = 813 * MiB;
constexpr size_t WS_VN = 846 * MiB;
constexpr size_t WS_MERGE = 879 * MiB;
constexpr size_t WS_MERGEB = 1009 * MiB;
constexpr size_t WS_Y = 1074 * MiB;
constexpr size_t WS_H = 1139 * MiB;
constexpr size_t WS_BIG = 1415 * MiB;
constexpr size_t WS_END = 1757 * MiB;
static_assert(WS_BIG + (size_t)TA * ZW * 2 <= WS_END && WS_BIG + (size_t)MOE_ROWS * 1024 * 2 <= WS_END && WS_H + (size_t)MOE_ROWS * 1024 * 2 <= WS_BIG, "ws map");
static_assert(WS_W1 + (size_t)DEPTH * 32 * 2048 * 1024 * 2 <= WS_W2 && WS_W2 + (size_t)DEPTH * 32 * 1024 * 1024 * 2 <= WS_XC, "ws map weights");
static_assert(WS_MERGE + (size_t)TA * 1024 * 4 <= WS_MERGEB && WS_XN + (size_t)TA * 1024 * 2 <= WS_QG && WS_QM + (size_t)TA * 768 * 2 <= WS_KM, "ws map acts");
constexpr int CW_BAR = 4096;
constexpr int CW_CNT = 16384;

constexpr int RING_OFF = 0, RING_BYTES = 131072;
constexpr int LDS_X = RING_BYTES + 4096;
constexpr int LDS_SVEC = LDS_X;
constexpr int LDS_ROWTOK = LDS_X;
constexpr int MISC_OFF = 159744;
constexpr int LDS_TAB = 160000;
constexpr int LDS_BYTES = 163840;
static_assert(LDS_SVEC + 3 * 1024 * 4 <= MISC_OFF && LDS_ROWTOK + 20 * 1024 <= MISC_OFF && LDS_TAB + 704 * 4 <= LDS_BYTES, "LDS map");

#define GAS __attribute__((address_space(1)))
#define LAS __attribute__((address_space(3)))
typedef unsigned v4u __attribute__((ext_vector_type(4)));
typedef float f32x4 __attribute__((ext_vector_type(4)));
typedef GAS unsigned gu32;
#define RLX_AGENT __ATOMIC_RELAXED, __HIP_MEMORY_SCOPE_AGENT
#define LDS_WAIT() asm volatile("s_waitcnt lgkmcnt(0)" ::: "memory")
#define VM_WAIT() asm volatile("s_waitcnt vmcnt(0)" ::: "memory")

__device__ __forceinline__ unsigned cvt_pk(float lo, float hi) { unsigned r; asm volatile("v_cvt_pk_bf16_f32 %0, %1, %2" : "=v"(r) : "v"(lo), "v"(hi)); return r; }
__device__ __forceinline__ float bf_lo(unsigned u) { return __uint_as_float(u << 16); }
__device__ __forceinline__ float bf_hi(unsigned u) { return __uint_as_float(u & 0xffff0000u); }
__device__ __forceinline__ void unpack8(v4u r, float (&f)[8]) { f[0] = bf_lo(r.x); f[1] = bf_hi(r.x); f[2] = bf_lo(r.y); f[3] = bf_hi(r.y); f[4] = bf_lo(r.z); f[5] = bf_hi(r.z); f[6] = bf_lo(r.w); f[7] = bf_hi(r.w); }
__device__ __forceinline__ v4u pack8(const float (&f)[8]) { v4u o; o.x = cvt_pk(f[0], f[1]); o.y = cvt_pk(f[2], f[3]); o.z = cvt_pk(f[4], f[5]); o.w = cvt_pk(f[6], f[7]); return o; }
__device__ __forceinline__ float sigmoidf_(float x) { return __builtin_amdgcn_rcpf(1.f + __builtin_amdgcn_exp2f(-LOG2E * x)); }
__device__ __forceinline__ float wave_sum(float v) {
#pragma unroll
    for (int o = 1; o < 64; o <<= 1) v += __shfl_xor(v, o);
    return v;
}
__device__ __forceinline__ float gelu_tanh(float x) { const float u = 1.5957691216057308f * (x + 0.044715f * x * x * x); return x * __builtin_amdgcn_rcpf(1.f + __builtin_amdgcn_exp2f(-LOG2E * u)); }
constexpr int NTILE = KPB / 64;
__device__ __forceinline__ void bpos_of(int r, int& b, int& pos) { if (r < TL) { b = r >> 14; pos = r & (SEQ - 1); } else { b = (r - TL) >> 8; pos = SEQ + ((r - TL) & (CTX - 1)); } }
__device__ __forceinline__ size_t ktile_off(int strm, int pos, int chunk, int nch) { return (((size_t)strm * NTILE + (pos >> 6)) * nch + chunk) * 512 + (size_t)(pos & 63) * 8; }
__device__ __forceinline__ size_t vtile_off(int strm, int pos, int d) { const int piece = (d >> 5) * 4 + ((pos & 63) >> 4), ln = (pos & 15) * 4 + ((d >> 3) & 3); return (((size_t)strm * NTILE + (pos >> 6)) * 8 + piece) * 512 + (size_t)ln * 8; }
__device__ __forceinline__ int krow_of(int r) { return r < TL ? (r >> 14) * KPB + (r & (SEQ - 1)) : ((r - TL) >> 8) * KPB + SEQ + ((r - TL) & (CTX - 1)); }

__device__ const float INVF16[16] = {1.0f, 0.5623413324356079f, 0.3162277638912201f, 0.17782793939113617f, 0.10000000149011612f, 0.05623413249850273f, 0.03162277489900589f, 0.017782794311642647f,
                                     0.009999999776482582f, 0.005623413249850273f, 0.003162277629598975f, 0.0017782794311642647f, 0.0010000000474974513f, 0.000562341301701963f, 0.0003162277571391314f, 0.00017782794020604342f};
namespace pg8 {
#define PG8_LAS __attribute__((address_space(3)))
typedef unsigned short bf16_t;
typedef short bf16x8 __attribute__((ext_vector_type(8)));
typedef float f32x4 __attribute__((ext_vector_type(4)));
typedef unsigned u32x4 __attribute__((ext_vector_type(4)));
constexpr int BM = 256, BK = 64, HALF = 128, HTB = HALF * BK * 2  , STAGE_BYTES = 8 * HTB, NXCD = 8, WGM = 8;

__host__ __device__ __forceinline__ int lds_byte(int r, int c) { const int st = (r >> 4) * 2 + (c >> 5), rr = r & 15, cc = c & 31, ob = rr * 64 + cc * 2; return st * 1024 + (ob ^ (((ob >> 9) & 1) << 5)); }
__host__ __device__ __forceinline__ void stage_rc(int b, int& R, int& C) { const int st = b / 1024, sb = b % 1024, swz = sb ^ (((sb >> 9) & 1) << 5); R = (st >> 1) * 16 + swz / 64; C = (st & 1) * 32 + (swz % 64) / 2; }
__host__ __device__ __forceinline__ int perm32(int rho) { const int n = rho >> 4, i = rho & 15; return 8 * (i >> 2) + 4 * n + (i & 3); }

struct Unit { int pm, pn; };
struct Gemm { const bf16_t* A; const bf16_t* Bt; int M, N, K; };

struct StaticOrder {
    int nM, nN, nwg, G, c;
    __device__ void init(int M, int N, int G_, int c_) { asm volatile("" : "+s"(M), "+s"(N));
        nM = M / BM; nN = N / BM; nwg = nM * nN; G = G_; c = c_; }
    __host__ __device__ bool next(int i, Unit& u) const {
        const long L = (long)i * G + c; if (L >= nwg) return false;
        int wgid = (int)L; { const int q = nwg / NXCD, r = nwg % NXCD, xcd = wgid % NXCD, off = wgid / NXCD; wgid = (xcd < r ? xcd * (q + 1) : r * (q + 1) + (xcd - r) * q) + off; }
        const int nig = WGM * nN, gid = wgid / nig, fm = gid * WGM, gsz = (nM - fm) < WGM ? (nM - fm) : WGM;
        u.pm = fm + ((wgid % nig) % gsz); u.pn = (wgid % nig) / gsz; return true;
    }
    __device__ __forceinline__ void a_ready(const Unit&) const {}
    __device__ __forceinline__ void done(const Unit&) const {}
};

template <class Epi, class Sched, bool ALIGN_EPI = false, bool SP2 = false, bool GATHER = false>
__device__ __forceinline__ void gemm_phase(PG8_LAS unsigned char* lds, const Gemm g, const Sched& S, const Epi& E) {
    static_assert(!GATHER || SP2, "GATHER is implemented for the SP2 loop only");
    int tid_ = threadIdx.x; asm volatile("" : "+v"(tid_));
    const int tid = tid_, wid = __builtin_amdgcn_readfirstlane(tid >> 6), lane = tid & 63, wr = wid >> 2, wc = wid & 3, fr = lane & 15, fq = lane >> 4;
    int K_ = g.K; asm volatile("" : "+s"(K_));
    const int K = K_, nt = K / BK;
    unsigned voffA[2], voffB[2];
#pragma unroll
    for (int i = 0; i < 2; ++i) { int R, C; stage_rc(tid * 16 + i * 8192, R, C); const int Rb = Epi::PERM ? ((R & ~31) + perm32(R & 31)) : R;
        voffA[i] = (unsigned)(R * K + C) * 2u; voffB[i] = (unsigned)(Rb * K + C) * 2u; }
    unsigned vAc0[2] = {0u, 0u}, vAc1[2] = {0u, 0u}, vAn0[2] = {0u, 0u}, vAn1[2] = {0u, 0u}, vsel0[2] = {0u, 0u}, vsel1[2] = {0u, 0u};
#define PG8_GOFF(dst0, dst1, uidx) do { _Pragma("unroll") for (int i_ = 0; i_ < 2; ++i_) { int R_, C_; stage_rc(tid * 16 + i_ * 8192, R_, C_); \
        dst0[i_] = ((unsigned)S.tok((uidx), R_) * (unsigned)K + (unsigned)C_) * 2u; dst1[i_] = ((unsigned)S.tok((uidx), HALF + R_) * (unsigned)K + (unsigned)C_) * 2u; } } while (0)
#define PG8_STG_A(bufoff, base, H, SEL) do { if constexpr (GATHER) { if (SEL) { PG8_STAGE(bufoff, base, vsel##H); } else { PG8_STAGE(bufoff, base, vAc##H); } } else { PG8_STAGE(bufoff, (base) + (H) * hstep, voffA); } } while (0)
    const size_t kstep = (size_t)(BK * 2);
    const size_t hstep = (size_t)HALF * K * 2;
    const size_t tstep = 2 * hstep;
    const unsigned ldsw = (unsigned)wid * 1024u;
    const int aoff = lds_byte(wr * 64 + fr, fq * 8), boff = lds_byte(wc * 32 + fr, fq * 8);
#define PG8_SA(b, h) (((b) * 2 + (h)) * HTB)
#define PG8_SB(b, h) ((4 + (b) * 2 + (h)) * HTB)
#define PG8_STAGE(bufoff, gbase, voff) do { _Pragma("unroll") for (int _i = 0; _i < 2; ++_i) \
        __builtin_amdgcn_global_load_lds((const unsigned*)((const char*)(gbase) + (voff)[_i]), (PG8_LAS unsigned*)(lds + (bufoff) + ldsw + _i * 8192), 16, 0, 0); } while (0)
#define PG8_LDA(dst, b, h) do { _Pragma("unroll") for (int m = 0; m < 4; ++m) _Pragma("unroll") for (int k = 0; k < 2; ++k) dst[m][k] = *(const PG8_LAS bf16x8*)(lds + PG8_SA(b, h) + aoff + m * 2048 + k * 1024); } while (0)
#define PG8_LDB(dst, b, h) do { _Pragma("unroll") for (int n = 0; n < 2; ++n) _Pragma("unroll") for (int k = 0; k < 2; ++k) dst[n][k] = *(const PG8_LAS bf16x8*)(lds + PG8_SB(b, h) + boff + n * 2048 + k * 1024); } while (0)
#define PG8_MMA(ai, bj, At, Bt) do { __builtin_amdgcn_s_setprio(1); _Pragma("unroll") for (int m = 0; m < 4; ++m) _Pragma("unroll") for (int n = 0; n < 2; ++n) _Pragma("unroll") for (int k = 0; k < 2; ++k) \
        acc[ai][bj][m][n] = __builtin_amdgcn_mfma_f32_16x16x32_bf16(Bt[n][k], At[m][k], acc[ai][bj][m][n], 0, 0, 0); __builtin_amdgcn_s_setprio(0); } while (0)
#define PG8_WAIT_V(n) asm volatile("s_waitcnt vmcnt(" #n ")" ::: "memory")
#define PG8_WAIT_L(n) asm volatile("s_waitcnt lgkmcnt(" #n ")" ::: "memory")
#define PG8_BAR __builtin_amdgcn_s_barrier()
#define PG8_SCHED __builtin_amdgcn_sched_barrier(0)
    Unit cur, nxt; int ui = 0;
    if (!S.next(0, cur)) return;
    f32x4 acc[2][2][4][2];
#pragma unroll
    for (int a = 0; a < 2; ++a)
#pragma unroll
        for (int b = 0; b < 2; ++b)
#pragma unroll
            for (int m = 0; m < 4; ++m)
#pragma unroll
                for (int n = 0; n < 2; ++n) acc[a][b][m][n] = (f32x4){0.f, 0.f, 0.f, 0.f};
    bf16x8 At[4][2], B0[2][2], B1[2][2];
    const char* cA = GATHER ? (const char*)g.A : (const char*)g.A + (size_t)cur.pm * tstep; const char* cB = (const char*)g.Bt + (size_t)cur.pn * tstep;
    if constexpr (GATHER) { PG8_GOFF(vAc0, vAc1, 0); }
    S.a_ready(cur);
    if constexpr (SP2) {
        PG8_STAGE(PG8_SB(0, 0), cB, voffB); PG8_STAGE(PG8_SB(0, 1), cB + hstep, voffB); PG8_STG_A(PG8_SA(0, 0), cA, 0, false); PG8_STG_A(PG8_SA(0, 1), cA, 1, false);
        if (wr == 1) PG8_BAR;
        PG8_WAIT_V(2); PG8_BAR;
        PG8_STAGE(PG8_SB(1, 0), cB + kstep, voffB); PG8_STG_A(PG8_SA(1, 0), cA + kstep, 0, false); PG8_STAGE(PG8_SB(1, 1), cB + hstep + kstep, voffB);
        PG8_WAIT_V(6); PG8_BAR;
    } else {
        PG8_STAGE(PG8_SB(0, 0), cB, voffB); PG8_STAGE(PG8_SA(0, 0), cA, voffA); PG8_STAGE(PG8_SB(0, 1), cB + hstep, voffB); PG8_STAGE(PG8_SA(0, 1), cA + hstep, voffA);
        if (wr == 1) PG8_BAR;
        PG8_WAIT_V(4); PG8_BAR;
        PG8_STAGE(PG8_SB(1, 0), cB + kstep, voffB); PG8_STAGE(PG8_SA(1, 0), cA + kstep, voffA); PG8_STAGE(PG8_SB(1, 1), cB + hstep + kstep, voffB);
        PG8_WAIT_V(6); PG8_BAR;
    }
    for (;;) {
        const bool has_next = S.next(ui + 1, nxt);
        const char* nA = GATHER ? (const char*)g.A : (has_next ? (const char*)g.A + (size_t)nxt.pm * tstep : cA);
        if constexpr (GATHER) { if (has_next) { PG8_GOFF(vAn0, vAn1, ui + 1); } else { vAn0[0] = vAc0[0]; vAn0[1] = vAc0[1]; vAn1[0] = vAc1[0]; vAn1[1] = vAc1[1]; } } const char* nB = has_next ? (const char*)g.Bt + (size_t)nxt.pn * tstep : cB;
        for (int t = 0; t < nt; t += 2) {
            const bool last = (t == nt - 2);
            const char* a1 = cA + (size_t)(t + 1) * kstep;
            const char* a2 = last ? nA : cA + (size_t)(t + 2) * kstep; const char* b2 = last ? nB : cB + (size_t)(t + 2) * kstep;
            const char* a3 = a2 + kstep; const char* b3 = b2 + kstep;
            if (last && has_next) S.a_ready(nxt);
            if constexpr (GATHER) { vsel0[0] = last ? vAn0[0] : vAc0[0]; vsel0[1] = last ? vAn0[1] : vAc0[1]; vsel1[0] = last ? vAn1[0] : vAc1[0]; vsel1[1] = last ? vAn1[1] : vAc1[1]; }
            if constexpr (SP2) {
            PG8_LDB(B0, 0, 0); PG8_LDB(B1, 0, 1); PG8_SCHED; PG8_LDA(At, 0, 0); PG8_STG_A(PG8_SA(1, 1), a1, 1, false);
            PG8_WAIT_V(8); PG8_WAIT_L(0); PG8_BAR; PG8_MMA(0, 0, At, B0); PG8_MMA(0, 1, At, B1); PG8_BAR; PG8_SCHED;
            PG8_LDA(At, 0, 1); PG8_STAGE(PG8_SB(0, 0), b2, voffB); PG8_STAGE(PG8_SB(0, 1), b2 + hstep, voffB); PG8_STG_A(PG8_SA(0, 0), a2, 0, true);
            PG8_WAIT_V(8); PG8_WAIT_L(0); PG8_BAR; PG8_MMA(1, 0, At, B0); PG8_MMA(1, 1, At, B1); PG8_BAR; PG8_SCHED;
            PG8_LDB(B0, 1, 0); PG8_LDB(B1, 1, 1); PG8_SCHED; PG8_LDA(At, 1, 0); PG8_STG_A(PG8_SA(0, 1), a2, 1, true);
            PG8_WAIT_V(8); PG8_WAIT_L(0); PG8_BAR; PG8_MMA(0, 0, At, B0); PG8_MMA(0, 1, At, B1); PG8_BAR; PG8_SCHED;
            PG8_LDA(At, 1, 1); PG8_STAGE(PG8_SB(1, 0), b3, voffB); PG8_STAGE(PG8_SB(1, 1), b3 + hstep, voffB); PG8_STG_A(PG8_SA(1, 0), a3, 0, true);
            PG8_WAIT_V(8); PG8_WAIT_L(0); PG8_BAR; PG8_MMA(1, 0, At, B0); PG8_MMA(1, 1, At, B1); PG8_BAR; PG8_SCHED;
            } else {
            PG8_LDB(B0, 0, 0); PG8_SCHED; PG8_LDA(At, 0, 0); PG8_STAGE(PG8_SA(1, 1), a1 + hstep, voffA);
            PG8_WAIT_L(8); PG8_BAR; PG8_WAIT_L(0); PG8_MMA(0, 0, At, B0); PG8_BAR; PG8_SCHED;
            PG8_LDB(B1, 0, 1); PG8_STAGE(PG8_SB(0, 0), b2, voffB);
            PG8_BAR; PG8_WAIT_L(0); PG8_MMA(0, 1, At, B1); PG8_BAR;
            PG8_LDA(At, 0, 1); PG8_STAGE(PG8_SA(0, 0), a2, voffA);
            PG8_BAR; PG8_WAIT_L(0); PG8_MMA(1, 0, At, B0); PG8_BAR; PG8_SCHED;
            PG8_STAGE(PG8_SB(0, 1), b2 + hstep, voffB);
            PG8_WAIT_V(6); PG8_BAR; PG8_MMA(1, 1, At, B1); PG8_BAR;
            PG8_LDB(B0, 1, 0); PG8_SCHED; PG8_LDA(At, 1, 0); PG8_STAGE(PG8_SA(0, 1), a2 + hstep, voffA);
            PG8_WAIT_L(8); PG8_BAR; PG8_WAIT_L(0); PG8_MMA(0, 0, At, B0); PG8_BAR; PG8_SCHED;
            PG8_LDB(B1, 1, 1); PG8_STAGE(PG8_SB(1, 0), b3, voffB);
            PG8_BAR; PG8_WAIT_L(0); PG8_MMA(0, 1, At, B1); PG8_BAR;
            PG8_LDA(At, 1, 1); PG8_STAGE(PG8_SA(1, 0), a3, voffA);
            PG8_BAR; PG8_WAIT_L(0); PG8_MMA(1, 0, At, B0); PG8_BAR; PG8_SCHED;
            PG8_STAGE(PG8_SB(1, 1), b3 + hstep, voffB);
            PG8_WAIT_V(6); PG8_BAR; PG8_MMA(1, 1, At, B1); PG8_BAR;
            }
        }
        if constexpr (ALIGN_EPI) { if (wr == 0) PG8_BAR; }
        if constexpr (!Epi::AFTER_DRAIN) { E(acc, cur, wr, wc, fr, fq); S.done(cur); }
        if (!has_next) break;
#pragma unroll
        for (int a = 0; a < 2; ++a)
#pragma unroll
            for (int b = 0; b < 2; ++b)
#pragma unroll
                for (int m = 0; m < 4; ++m)
#pragma unroll
                    for (int n = 0; n < 2; ++n) acc[a][b][m][n] = (f32x4){0.f, 0.f, 0.f, 0.f};
        cur = nxt; cA = nA; cB = nB; ++ui;
        if constexpr (GATHER) { vAc0[0] = vAn0[0]; vAc0[1] = vAn0[1]; vAc1[0] = vAn1[0]; vAc1[1] = vAn1[1]; }
        if constexpr (ALIGN_EPI) { if (wr == 1) PG8_BAR; }
    }
    PG8_WAIT_V(0);
    if constexpr (!ALIGN_EPI) { if (wr == 0) PG8_BAR; }
    PG8_BAR;
    if constexpr (Epi::AFTER_DRAIN) { E.fused(acc, cur, wr, wc, fr, fq, lds, wid, lane); S.done(cur); }
#undef PG8_SA
#undef PG8_SB
#undef PG8_STAGE
#undef PG8_LDA
#undef PG8_LDB
#undef PG8_MMA
#undef PG8_WAIT_V
#undef PG8_WAIT_L
#undef PG8_BAR
#undef PG8_SCHED
#undef PG8_GOFF
#undef PG8_STG_A
}
}
namespace pg8 {
#define EPI_ROWS(u, wr, fr) const int row00 = (u).pm * BM + (wr) * 64 + (fr)
#define EPI_GET8(v, ai, bj, m) float v[8] = {acc[ai][bj][m][0][0], acc[ai][bj][m][0][1], acc[ai][bj][m][0][2], acc[ai][bj][m][0][3], acc[ai][bj][m][1][0], acc[ai][bj][m][1][1], acc[ai][bj][m][1][2], acc[ai][bj][m][1][3]}

struct EpiPlain {
    static constexpr bool PERM = true, AFTER_DRAIN = false;
    bf16_t* O; int ldc;
    __device__ __forceinline__ void operator()(const f32x4 (&acc)[2][2][4][2], const Unit& u, int wr, int wc, int fr, int fq) const {
        asm volatile("" : "+v"(fr), "+v"(fq));
        EPI_ROWS(u, wr, fr); const int col0 = u.pn * BM + wc * 32 + 8 * fq;
#pragma unroll
        for (int ai = 0; ai < 2; ++ai)
#pragma unroll
            for (int m = 0; m < 4; ++m) { bf16_t* rowp = O + (size_t)(row00 + ai * HALF + m * 16) * ldc + col0;
#pragma unroll
                for (int bj = 0; bj < 2; ++bj) { EPI_GET8(v, ai, bj, m); *(u32x4*)(rowp + bj * HALF) = pack8(v); } }
    }
};

struct EpiInproj {
    static constexpr bool PERM = true, AFTER_DRAIN = false;
    unsigned char* ws; const float *qkn, *mqn, *mkvn; PG8_LAS float* xs;
    __device__ __forceinline__ void operator()(const f32x4 (&acc)[2][2][4][2], const Unit& u, int wr, int wc, int fr, int fq) const {
        asm volatile("" : "+v"(fr), "+v"(fq));
        EPI_ROWS(u, wr, fr); const int pn = u.pn; const bool lat = (u.pm * BM) < TL;
        if (pn >= 9) {
            const int col0 = (pn - 9) * BM + wc * 32 + 8 * fq;
#pragma unroll
            for (int ai = 0; ai < 2; ++ai)
#pragma unroll
                for (int m = 0; m < 4; ++m) { bf16_t* rowp = (bf16_t*)(ws + WS_BIG) + (size_t)(row00 + ai * HALF + m * 16) * 3072 + col0;
#pragma unroll
                    for (int bj = 0; bj < 2; ++bj) { EPI_GET8(v, ai, bj, m); *(u32x4*)(rowp + bj * HALF) = pack8(v); } }
        } else if (pn <= 2) {
            if (pn == 2 && wc >= 2) {
#pragma unroll
                for (int ai = 0; ai < 2; ++ai)
#pragma unroll
                    for (int m = 0; m < 4; ++m) { const int row = row00 + ai * HALF + m * 16; int b_, pos_; bpos_of(row, b_, pos_); bf16_t* vb = (bf16_t*)(ws + WS_VG); const int st = b_ * 2 + (wc - 2);
                        EPI_GET8(x1, ai, 0, m); EPI_GET8(x2, ai, 1, m); *(u32x4*)(vb + vtile_off(st, pos_, 8 * fq)) = pack8(x1); *(u32x4*)(vb + vtile_off(st, pos_, 32 + 8 * fq)) = pack8(x2); }
            } else {
                const bool isq = pn < 2; const float* gn = qkn + (isq ? 0 : 64) + 8 * fq;
                const f32x4 ga0 = *(const f32x4*)gn, ga1 = *(const f32x4*)(gn + 4), gb0 = *(const f32x4*)(gn + 32), gb1 = *(const f32x4*)(gn + 36);
                const float g1[8] = {ga0[0], ga0[1], ga0[2], ga0[3], ga1[0], ga1[1], ga1[2], ga1[3]}, g2[8] = {gb0[0], gb0[1], gb0[2], gb0[3], gb1[0], gb1[1], gb1[2], gb1[3]};
                const float sc = isq ? C2G : 1.f;
#pragma unroll
                for (int am = 0; am < 4; ++am) { const int ai = am >> 1, m0 = 2 * (am & 1);
                    f32x4 tc[2][2], ts[2][2];
#pragma unroll
                    for (int mm = 0; mm < 2; ++mm) { const int pos = lat ? ((row00 + ai * HALF + (m0 + mm) * 16) & (SEQ - 1)) : 0; const f32x4* cp = (const f32x4*)((const float*)(ws + WS_COSG) + (size_t)pos * 32 + 8 * fq); const f32x4* sp = (const f32x4*)((const float*)(ws + WS_SING) + (size_t)pos * 32 + 8 * fq);
                        tc[mm][0] = cp[0]; tc[mm][1] = cp[1]; ts[mm][0] = sp[0]; ts[mm][1] = sp[1]; }
#pragma unroll
                    for (int mm = 0; mm < 2; ++mm) { const int m = m0 + mm; const int row = row00 + ai * HALF + m * 16; const f32x4 c0 = tc[mm][0], c1 = tc[mm][1], s0 = ts[mm][0], s1 = ts[mm][1];
                        EPI_GET8(x1, ai, 0, m); EPI_GET8(x2, ai, 1, m); float ss = 0.f;
#pragma unroll
                        for (int i = 0; i < 8; ++i) ss += x1[i] * x1[i] + x2[i] * x2[i];
                        ss += __shfl_xor(ss, 16); ss += __shfl_xor(ss, 32);
                        const float rstd = __builtin_amdgcn_rsqf(ss * (1.f / 64.f) + RMS_EPS); float o1[8], o2[8];
#pragma unroll
                        for (int i = 0; i < 8; ++i) { const float y1 = x1[i] * rstd * g1[i], y2 = x2[i] * rstd * g2[i]; const float c = lat ? (i < 4 ? c0[i & 3] : c1[i & 3]) : 1.f, s = lat ? (i < 4 ? s0[i & 3] : s1[i & 3]) : 0.f;
                            o1[i] = (y1 * c - y2 * s) * sc; o2[i] = (y2 * c + y1 * s) * sc; }
                        if (isq) { bf16_t* p = (bf16_t*)(ws + WS_QG) + (size_t)row * 512 + (4 * pn + wc) * 64 + 8 * fq; *(u32x4*)p = pack8(o1); *(u32x4*)(p + 32) = pack8(o2); }
                        else { int b_, pos_; bpos_of(row, b_, pos_); bf16_t* kb = (bf16_t*)(ws + WS_KG); const int st = b_ * 2 + wc; *(u32x4*)(kb + ktile_off(st, pos_, fq, 8)) = pack8(o1); *(u32x4*)(kb + ktile_off(st, pos_, 4 + fq, 8)) = pack8(o2); } }
                    asm volatile("" ::: "memory"); }
            }
        } else if (pn == 3 || pn == 4 || pn == 7 || pn == 8) {
            const bool vg = pn >= 7; const bool part = (pn == 4) ? (wc < 2) : true;
            float ssr[2][4];
#pragma unroll
            for (int ai = 0; ai < 2; ++ai)
#pragma unroll
                for (int m = 0; m < 4; ++m) { float ss = 0.f;
#pragma unroll
                    for (int bj = 0; bj < 2; ++bj) { EPI_GET8(v, ai, bj, m);
#pragma unroll
                        for (int i = 0; i < 8; ++i) { const float t = vg ? gelu_tanh(v[i]) : v[i]; ss += t * t; } }
                    ss += __shfl_xor(ss, 16); ss += __shfl_xor(ss, 32); ssr[ai][m] = part ? ss : 0.f;
                    if (fq == 0) xs[(ai * HALF + wr * 64 + m * 16 + fr) * 4 + wc] = ssr[ai][m]; }
            asm volatile("s_waitcnt lgkmcnt(0)\n\ts_barrier" ::: "memory");
#pragma unroll
            for (int ai = 0; ai < 2; ++ai)
#pragma unroll
                for (int m = 0; m < 4; ++m) { const f32x4 t = *(const PG8_LAS f32x4*)(xs + (ai * HALF + wr * 64 + m * 16 + fr) * 4); ssr[ai][m] = (t[0] + t[1]) + (t[2] + t[3]); }
            asm volatile("s_waitcnt lgkmcnt(0)\n\ts_barrier" ::: "memory");
            if (pn == 3) {
                const int col0 = wc * 32 + 8 * fq;
#pragma unroll
                for (int ai = 0; ai < 2; ++ai)
#pragma unroll
                    for (int m = 0; m < 4; ++m) { const int row = row00 + ai * HALF + m * 16; const float rstd = __builtin_amdgcn_rsqf(ssr[ai][m] * (1.f / 256.f) + RMS_EPS);
#pragma unroll
                        for (int bj = 0; bj < 2; ++bj) { EPI_GET8(v, ai, bj, m); const int col = col0 + bj * HALF; const f32x4 ga = *(const f32x4*)(mqn + col), gb = *(const f32x4*)(mqn + col + 4);
#pragma unroll
                            for (int i = 0; i < 8; ++i) v[i] *= rstd * (i < 4 ? ga[i] : gb[i - 4]);
                            *(u32x4*)((bf16_t*)(ws + WS_CQN) + (size_t)row * 256 + col) = pack8(v); } }
            } else if (pn == 4) {
                if (wc < 2) {
#pragma unroll
                    for (int ai = 0; ai < 2; ++ai)
#pragma unroll
                        for (int m = 0; m < 4; ++m) { const int row = row00 + ai * HALF + m * 16; const float rstd = __builtin_amdgcn_rsqf(ssr[ai][m] * (1.f / 128.f) + RMS_EPS);
#pragma unroll
                            for (int bj = 0; bj < 2; ++bj) { EPI_GET8(v, ai, bj, m); const int col = wc * 64 + bj * 32 + 8 * fq; const f32x4 ga = *(const f32x4*)(mkvn + col), gb = *(const f32x4*)(mkvn + col + 4);
#pragma unroll
                                for (int i = 0; i < 8; ++i) v[i] *= rstd * (i < 4 ? ga[i] : gb[i - 4]);
                                *(u32x4*)((bf16_t*)(ws + WS_CKVN) + (size_t)row * 128 + col) = pack8(v); } }
                } else if (wc == 2 && fq < 2) {
#pragma unroll
                    for (int ai = 0; ai < 2; ++ai)
#pragma unroll
                        for (int m = 0; m < 4; ++m) { const int row = row00 + ai * HALF + m * 16; const int pos = row & (SEQ - 1);
                            EPI_GET8(x1, ai, 0, m); EPI_GET8(x2, ai, 1, m); float o1[8], o2[8];
                            if (lat) { const f32x4* cp = (const f32x4*)((const float*)(ws + WS_COSM) + (size_t)pos * 16 + 8 * fq); const f32x4* sp = (const f32x4*)((const float*)(ws + WS_SINM) + (size_t)pos * 16 + 8 * fq); const f32x4 c0 = cp[0], c1 = cp[1], s0 = sp[0], s1 = sp[1];
#pragma unroll
                                for (int i = 0; i < 8; ++i) { const float c = i < 4 ? c0[i] : c1[i - 4], s = i < 4 ? s0[i] : s1[i - 4]; o1[i] = x1[i] * c - x2[i] * s; o2[i] = x2[i] * c + x1[i] * s; } }
                            else {
#pragma unroll
                                for (int i = 0; i < 8; ++i) { o1[i] = x1[i]; o2[i] = x2[i]; } }
                            const u32x4 p1 = pack8(o1), p2 = pack8(o2); int b_, pos_; bpos_of(row, b_, pos_); bf16_t* kb = (bf16_t*)(ws + WS_KM);
#pragma unroll
                            for (int h = 0; h < 8; ++h) { *(u32x4*)(kb + ktile_off(b_ * 8 + h, pos_, 8 + fq, 12)) = p1; *(u32x4*)(kb + ktile_off(b_ * 8 + h, pos_, 10 + fq, 12)) = p2; } }
                }
            } else {
                const int half = pn - 7, col0 = half * BM + wc * 32 + 8 * fq;
#pragma unroll
                for (int ai = 0; ai < 2; ++ai)
#pragma unroll
                    for (int m = 0; m < 4; ++m) { const int row = row00 + ai * HALF + m * 16;
#pragma unroll
                        for (int bj = 0; bj < 2; ++bj) { EPI_GET8(v, ai, bj, m);
#pragma unroll
                            for (int i = 0; i < 8; ++i) v[i] = gelu_tanh(v[i]);
                            *(u32x4*)((bf16_t*)(ws + WS_VN) + (size_t)row * 512 + col0 + bj * HALF) = pack8(v); }
                        if (wc == 0 && fq == 0) ((float*)(ws + WS_SSV))[(size_t)row * 2 + half] = ssr[ai][m]; }
            }
        } else {
            const int col0 = (pn - 5) * BM + wc * 32 + 8 * fq;
#pragma unroll
            for (int ai = 0; ai < 2; ++ai)
#pragma unroll
                for (int m = 0; m < 4; ++m) { const int row = row00 + ai * HALF + m * 16;
#pragma unroll
                    for (int bj = 0; bj < 2; ++bj) { EPI_GET8(v, ai, bj, m);
#pragma unroll
                        for (int i = 0; i < 8; ++i) v[i] = gelu_tanh(v[i]);
                        *(u32x4*)((bf16_t*)(ws + WS_UACT) + (size_t)row * 512 + col0 + bj * HALF) = pack8(v); } }
        }
    }
};

struct EpiUq {
    static constexpr bool PERM = true, AFTER_DRAIN = false;
    bf16_t* Qm; const float* cosM; const float* sinM;
    __device__ __forceinline__ void operator()(const f32x4 (&acc)[2][2][4][2], const Unit& u, int wr, int wc, int fr, int fq) const {
        asm volatile("" : "+v"(fr), "+v"(fq));
        EPI_ROWS(u, wr, fr);
        if (u.pn < 2) {
#pragma unroll
            for (int ai = 0; ai < 2; ++ai)
#pragma unroll
                for (int m = 0; m < 4; ++m) { const int row = row00 + ai * HALF + m * 16;
#pragma unroll
                    for (int bj = 0; bj < 2; ++bj) { const int col = u.pn * BM + bj * HALF + wc * 32 + 8 * fq; const int head = col >> 6, d = col & 63;
                        EPI_GET8(v, ai, bj, m);
#pragma unroll
                        for (int i = 0; i < 8; ++i) v[i] *= C2M;
                        *(u32x4*)(Qm + (size_t)row * 768 + head * 96 + d) = pack8(v); } asm volatile("" ::: "memory"); }
        } else {
            const int cc = wc * 32 + 8 * fq, hh = cc >> 4, j0 = cc & 15;
            const bool lat = (u.pm * BM) < TL;
#pragma unroll
            for (int ai = 0; ai < 2; ++ai) {
                f32x4 tc[4][2], ts[4][2];
#pragma unroll
                for (int m = 0; m < 4; ++m) { const int pos = lat ? ((row00 + ai * HALF + m * 16) & (SEQ - 1)) : 0; const f32x4* cp = (const f32x4*)(cosM + (size_t)pos * 16 + j0); const f32x4* sp = (const f32x4*)(sinM + (size_t)pos * 16 + j0);
                    tc[m][0] = cp[0]; tc[m][1] = cp[1]; ts[m][0] = sp[0]; ts[m][1] = sp[1]; }
#pragma unroll
                for (int m = 0; m < 4; ++m) { const int row = row00 + ai * HALF + m * 16;
                    EPI_GET8(x1, ai, 0, m); EPI_GET8(x2, ai, 1, m);
                    float cs[8], sn[8];
#pragma unroll
                    for (int i = 0; i < 8; ++i) { cs[i] = lat ? tc[m][i >> 2][i & 3] : 1.f; sn[i] = lat ? ts[m][i >> 2][i & 3] : 0.f; }
                    float o1[8], o2[8];
#pragma unroll
                    for (int i = 0; i < 8; ++i) { o1[i] = (x1[i] * cs[i] - x2[i] * sn[i]) * C2M; o2[i] = (x2[i] * cs[i] + x1[i] * sn[i]) * C2M; }
                    bf16_t* qp = Qm + (size_t)row * 768 + hh * 96 + 64 + j0;
                    *(u32x4*)(qp) = pack8(o1); *(u32x4*)(qp + 16) = pack8(o2); }
                asm volatile("" ::: "memory"); }
        }
    }
};

struct EpiUkv {
    static constexpr bool PERM = true, AFTER_DRAIN = false;
    bf16_t* Km; bf16_t* Vm;
    __device__ __forceinline__ void operator()(const f32x4 (&acc)[2][2][4][2], const Unit& u, int wr, int wc, int fr, int fq) const {
        asm volatile("" : "+v"(fr), "+v"(fq));
        EPI_ROWS(u, wr, fr); const int within = wc * 32 + 8 * fq;
#pragma unroll
        for (int ai = 0; ai < 2; ++ai)
#pragma unroll
            for (int m = 0; m < 4; ++m) { const int row = row00 + ai * HALF + m * 16; int b_, pos_; bpos_of(row, b_, pos_);
#pragma unroll
                for (int bj = 0; bj < 2; ++bj) { const int head = u.pn * 2 + bj; EPI_GET8(v, ai, bj, m);
                    bf16_t* p = (within < 64) ? (Km + ktile_off(b_ * 8 + head, pos_, within >> 3, 12)) : (Vm + vtile_off(b_ * 8 + head, pos_, within - 64));
                    *(u32x4*)p = pack8(v); } asm volatile("" ::: "memory"); }
    }
};

template <int IDX> struct EpiBranch {
    static constexpr bool PERM = true, AFTER_DRAIN = false;
    const bf16_t* Z; bf16_t* MERGEB;
    __device__ __forceinline__ void operator()(const f32x4 (&acc)[2][2][4][2], const Unit& u, int wr, int wc, int fr, int fq) const {
        asm volatile("" : "+v"(fr), "+v"(fq));
        EPI_ROWS(u, wr, fr); const int col0 = u.pn * BM + wc * 32 + 8 * fq;
#pragma unroll
        for (int ai = 0; ai < 2; ++ai) {
            u32x4 gr[4][2], mr[4][2];
#pragma unroll
            for (int m = 0; m < 4; ++m) { const int row = row00 + ai * HALF + m * 16;
#pragma unroll
                for (int bj = 0; bj < 2; ++bj) { const int col = col0 + bj * HALF; gr[m][bj] = *(const u32x4*)(Z + (size_t)row * 3072 + IDX * 1024 + col);
                    if (IDX != 0) mr[m][bj] = *(const u32x4*)(MERGEB + (size_t)row * 1024 + col); } }
#pragma unroll
            for (int m = 0; m < 4; ++m) { const int row = row00 + ai * HALF + m * 16;
#pragma unroll
                for (int bj = 0; bj < 2; ++bj) { const int col = col0 + bj * HALF; EPI_GET8(v, ai, bj, m); float g[8], a[8], r[8]; unpack8(gr[m][bj], g);
                    if (IDX != 0) unpack8(mr[m][bj], a);
#pragma unroll
                    for (int i = 0; i < 8; ++i) r[i] = (IDX != 0 ? a[i] : 0.f) + sigmoidf_(g[i]) * v[i];
                    *(u32x4*)(MERGEB + (size_t)row * 1024 + col) = pack8(r); } }
            asm volatile("" ::: "memory"); }
    }
};

struct EpiMoe1 {
    static constexpr bool PERM = true, AFTER_DRAIN = false;
    bf16_t* H; const float* b1;
    __device__ __forceinline__ void operator()(const f32x4 (&acc)[2][2][4][2], const Unit& u, int wr, int wc, int fr, int fq) const {
        asm volatile("" : "+v"(fr), "+v"(fq));
        EPI_ROWS(u, wr, fr); const int e = u.pn >> 3, pnl = u.pn & 7, cc = pnl * 128 + wc * 32 + 8 * fq;
        const float* bp = b1 + (size_t)e * 2048 + cc;
        const f32x4 bg0 = *(const f32x4*)bp, bg1 = *(const f32x4*)(bp + 4), bl0 = *(const f32x4*)(bp + 1024), bl1 = *(const f32x4*)(bp + 1028);
        float lim = 7.0f; asm volatile("" : "+v"(lim));
#pragma unroll
        for (int ai = 0; ai < 2; ++ai)
#pragma unroll
            for (int m = 0; m < 4; ++m) { const int row = row00 + ai * HALF + m * 16;
                EPI_GET8(g, ai, 0, m); EPI_GET8(l, ai, 1, m); float r[8];
#pragma unroll
                for (int i = 0; i < 8; ++i) { float glu = g[i] + (i < 4 ? bg0[i] : bg1[i - 4]); float lin = l[i] + (i < 4 ? bl0[i] : bl1[i - 4]);
                    glu = fminf(glu, lim); lin = fminf(fmaxf(lin, -lim), lim);
                    r[i] = glu * sigmoidf_(1.702f * glu) * (lin + 1.0f); }
                *(u32x4*)(H + (size_t)row * 1024 + cc) = pack8(r); }
    }
};

struct EpiMoe2 {
    static constexpr bool PERM = true, AFTER_DRAIN = false;
    bf16_t* Yp; const float* b2; const float* lw; const PG8_LAS int* tab;
    __device__ __forceinline__ void operator()(const f32x4 (&acc)[2][2][4][2], const Unit& u, int wr, int wc, int fr, int fq) const {
        asm volatile("" : "+v"(fr), "+v"(fq));
        EPI_ROWS(u, wr, fr); const int e = u.pn >> 2, pnl = u.pn & 3, col0 = pnl * BM + wc * 32 + 8 * fq;
        f32x4 bv[2][2];
#pragma unroll
        for (int bj = 0; bj < 2; ++bj) { bv[bj][0] = *(const f32x4*)(b2 + (size_t)e * 1024 + col0 + bj * HALF); bv[bj][1] = *(const f32x4*)(b2 + (size_t)e * 1024 + col0 + bj * HALF + 4); }
        float wrow[2][4]; { const int ps_ = tab[600 + e], cn_ = tab[640 + e];
#pragma unroll
            for (int ai = 0; ai < 2; ++ai)
#pragma unroll
                for (int m = 0; m < 4; ++m) { const int slot = row00 + ai * HALF + m * 16 - ps_; wrow[ai][m] = lw[(size_t)e * TA + (slot < cn_ ? slot : 0)]; if (slot >= cn_) wrow[ai][m] = 0.f; } }
#pragma unroll
        for (int ai = 0; ai < 2; ++ai)
#pragma unroll
            for (int m = 0; m < 4; ++m) { const int row = row00 + ai * HALF + m * 16; const float w = wrow[ai][m];
#pragma unroll
                for (int bj = 0; bj < 2; ++bj) { EPI_GET8(v, ai, bj, m); float r[8];
#pragma unroll
                    for (int i = 0; i < 8; ++i) r[i] = (v[i] + (i < 4 ? bv[bj][0][i] : bv[bj][1][i - 4])) * w;
                    *(u32x4*)(Yp + (size_t)row * 1024 + col0 + bj * HALF) = pack8(r); } }
    }
};

template <int NPN> struct MoeOrder {
    int nunits, G, v; const PG8_LAS int* tab; const PG8_LAS int* rowtok;
    __device__ __forceinline__ int tok(int i, int r) const { return rowtok[i * 256 + r]; }
    __device__ __forceinline__ bool next(int i, Unit& u) const {
        const long L = (long)i * G + v; if (L >= nunits) return false;
        const int blk = (int)L / NPN, pnl = (int)L % NPN; const int e = __builtin_amdgcn_readfirstlane(tab[blk]);
        u.pm = blk; u.pn = e * NPN + pnl; return true;
    }
    __device__ __forceinline__ void a_ready(const Unit&) const {}
    __device__ __forceinline__ void done(const Unit&) const {}
};
}
namespace attn_body {
using bf16x8=__attribute__((ext_vector_type(8)))short;
using s16x4=__attribute__((ext_vector_type(4)))short;
using f32x16=__attribute__((ext_vector_type(16)))float;
using u32x4=__attribute__((ext_vector_type(4)))unsigned;
constexpr int NW=8,QBLK=32,QB=QBLK*NW,KVBLK=64;
__device__ __forceinline__ int crow(int r,int hi){return (r&3)+8*(r>>2)+4*hi;}
#define SBAR() __builtin_amdgcn_sched_barrier(0)
constexpr int NSLOT=3, SLOTB=8192;
__device__ __forceinline__ void glds16(const void*gsrc,unsigned lds_dst){unsigned keep;
  asm volatile("s_mov_b32 %0, m0\n\ts_mov_b32 m0, %2\n\ts_nop 0\n\tglobal_load_lds_dwordx4 %1, off\n\ts_mov_b32 m0, %0":"=&s"(keep):"v"(gsrc),"s"(lds_dst):"memory");}
__device__ __forceinline__ float max3f(float a,float b,float c){float r;asm("v_max3_f32 %0, %1, %2, %3":"=v"(r):"v"(a),"v"(b),"v"(c));return r;}
__device__ __forceinline__ float max2f(float a,float b){float r;asm("v_max_f32_e32 %0, %1, %2":"=v"(r):"v"(a),"v"(b));return r;}
__device__ __forceinline__ float fadd_s(float a,float b){float r;asm("v_add_f32_e32 %0, %1, %2":"=v"(r):"v"(a),"v"(b));return r;}
__device__ __forceinline__ float fsub_s(float a,float b){float r;asm("v_sub_f32_e32 %0, %1, %2":"=v"(r):"v"(a),"v"(b));return r;}
typedef float f32x2_t __attribute__((ext_vector_type(2))); typedef __bf16 bf16x2_t __attribute__((ext_vector_type(2)));
__device__ __forceinline__ unsigned cvtpk_s(float lo,float hi){f32x2_t v={lo,hi};bf16x2_t b=__builtin_convertvector(v,bf16x2_t);return __builtin_bit_cast(unsigned,b);}
#define WAIT_BAR(N) asm volatile("s_waitcnt vmcnt(" #N ") lgkmcnt(0)\n\ts_barrier":::"memory")
typedef __attribute__((address_space(3))) const char* lds_cptr;
typedef short v4i16_t __attribute__((ext_vector_type(4)));
__device__ __forceinline__ void kload2(bf16x8*kf,lds_cptr kp,int j){ kf[2*j]=*(const __attribute__((address_space(3))) bf16x8*)(kp+j*2048); kf[2*j+1]=*(const __attribute__((address_space(3))) bf16x8*)(kp+j*2048+512); }
__device__ __forceinline__ s16x4 vtr(lds_cptr p){ return __builtin_bit_cast(s16x4,__builtin_amdgcn_ds_read_tr16_b64_v4i16((__attribute__((address_space(3))) v4i16_t*)p)); }
__device__ __forceinline__ float rowmax(const f32x16&p0,const f32x16&p1){
  float a=max3f(p0[0],p0[1],p1[0]),b=max3f(p0[2],p0[3],p1[1]);a=max3f(a,p1[2],p1[3]);
  #pragma unroll
  for(int r=4;r<16;r+=4){a=max3f(a,p0[r],p0[r+1]);b=max3f(b,p0[r+2],p0[r+3]);a=max3f(a,p1[r],p1[r+1]);b=max3f(b,p1[r+2],p1[r+3]);}
  const float m=max2f(a,b);
  auto rr=__builtin_amdgcn_permlane32_swap(__float_as_uint(m),__float_as_uint(m),false,false);
  return max2f(__uint_as_float(rr[0]),__uint_as_float(rr[1]));
}
__device__ __forceinline__ void pv(f32x16*o,int vb,bf16x8 pa0,bf16x8 pa1,bf16x8 pa2,bf16x8 pa3){
  #pragma unroll
  for(int d0=0;d0<2;++d0){s16x4 lo[4],hi[4];
    #pragma unroll
    for(int ks=0;ks<4;++ks){
      asm volatile("ds_read_b64_tr_b16 %0,%1 offset:%c2":"=&v"(lo[ks]):"v"(vb),"i"(d0*4096+ks*1024):"memory");
      asm volatile("ds_read_b64_tr_b16 %0,%1 offset:%c2":"=&v"(hi[ks]):"v"(vb),"i"(d0*4096+ks*1024+512):"memory");}
    asm volatile("s_waitcnt lgkmcnt(0)":::"memory");SBAR();
    #define PK(k) (bf16x8){lo[k][0],lo[k][1],lo[k][2],lo[k][3],hi[k][0],hi[k][1],hi[k][2],hi[k][3]}
    o[d0]=__builtin_amdgcn_mfma_f32_32x32x16_bf16(pa0,PK(0),o[d0],0,0,0);
    o[d0]=__builtin_amdgcn_mfma_f32_32x32x16_bf16(pa1,PK(1),o[d0],0,0,0);
    o[d0]=__builtin_amdgcn_mfma_f32_32x32x16_bf16(pa2,PK(2),o[d0],0,0,0);
    o[d0]=__builtin_amdgcn_mfma_f32_32x32x16_bf16(pa3,PK(3),o[d0],0,0,0);
    #undef PK
  }
}
template<int NKS> struct AttnLds {
  static constexpr int SLOTK=NKS*2048;
  static constexpr int LDS_K=0, LDS_V=NSLOT*SLOTK, LDS_WS=LDS_V+NSLOT*SLOTB, LDS_OST=LDS_WS+NW*64*4, LDS_BYTES=LDS_OST+NW*4096;
};
template<int NKS,int QP,int KP,int VP,int OP,int THRL,bool LS,bool SK>
__device__ __forceinline__ void attn_unit(const bf16*Qu,const bf16*__restrict__ Ku,const bf16*__restrict__ Vu,bf16*Ou,const int NT,char*shm){
  using L=AttnLds<NKS>;
  constexpr int SLOTK=L::SLOTK, LDS_K=L::LDS_K, LDS_V=L::LDS_V, LDS_WS=L::LDS_WS, LDS_OST=L::LDS_OST;
  int tid_=threadIdx.x; asm volatile("":"+v"(tid_));
  const int tid=tid_,lane=tid&63,r32=lane&31,hi=lane>>5; const int wid=__builtin_amdgcn_readfirstlane(tid>>6);
  const bf16*Qw=Qu+(long)(wid*QBLK)*QP;
  const unsigned lds0=(unsigned)(uintptr_t)shm;
  float*wsf=(float*)(shm+LDS_WS)+wid*64;
  const bf16*ksrc=Ku+wid*512+lane*8;
  const bf16*ksrc2=Ku+(8+(wid&3))*512+lane*8;
  const bf16*vsrc=Vu+wid*512+lane*8;
  const unsigned kdst=lds0+LDS_K+wid*1024, kdst2=lds0+LDS_K+(8+(wid&3))*1024, vdst=lds0+LDS_V+wid*1024;
  #define DMA_K(t,slot) do{ glds16(ksrc+(long)(t)*(NKS*1024),(unsigned)__builtin_amdgcn_readfirstlane(kdst+(slot))); \
      if constexpr(NKS==6){ glds16(ksrc2+(long)(t)*(NKS*1024),(unsigned)__builtin_amdgcn_readfirstlane(kdst2+(slot))); } }while(0)
  #define DMA_V(t,slot) glds16(vsrc+(long)(t)*4096,(unsigned)__builtin_amdgcn_readfirstlane(vdst+(slot)))
  #define WAIT_C()  do{ if constexpr(NKS==6){WAIT_BAR(3);}else{WAIT_BAR(2);} }while(0)
  #define WAIT_P()  do{ if constexpr(NKS==6){WAIT_BAR(5);}else{WAIT_BAR(3);} }while(0)
  #define WAITA_K() do{ if constexpr(NKS==6){WAIT_BAR(2);}else{WAIT_BAR(1);} }while(0)
  #define BARONLY() asm volatile("s_barrier":::"memory")
  const int vb0=(int)(lds0+LDS_V)+((lane>>4)&1)*32+(lane&3)*8+(4*hi+((lane&15)>>2))*64;
  const char*Kbase=shm+LDS_K; bf16x8 kf[2*NKS];
  const lds_cptr shm3=(lds_cptr)shm; const lds_cptr kp0=shm3+LDS_K+hi*1024+r32*16; const lds_cptr vp0=shm3+LDS_V+((lane>>4)&1)*32+(lane&3)*8+(4*hi+((lane&15)>>2))*64;
  DMA_K(0,0);DMA_V(0,0);DMA_K(1,SLOTK);
  bf16x8 qr[NKS];
  #pragma unroll
  for(int d0=0;d0<NKS;++d0)qr[d0]=*reinterpret_cast<const bf16x8*>(&Qw[(long)r32*QP+d0*16+hi*8]);
  float mhat=0.f,l_reg=0.f;f32x16 o[2];o[0]=f32x16{};o[1]=f32x16{};f32x16 negm=f32x16{};asm volatile("":"+v"(negm));
  f32x16 o2=f32x16{}; const bf16x8 ONES=(bf16x8){(short)0x3F80,(short)0x3F80,(short)0x3F80,(short)0x3F80,(short)0x3F80,(short)0x3F80,(short)0x3F80,(short)0x3F80};
  bool resc=false;
  #define START(P0,P1) do{ const float rm=rowmax(P0,P1); resc=false; \
    { const float dl=rm; mhat=fadd_s(mhat,dl); \
      _Pragma("unroll") for(int r=0;r<16;++r){P0[r]=fsub_s(P0[r],dl);P1[r]=fsub_s(P1[r],dl);} \
      _Pragma("unroll") for(int r=0;r<16;++r)negm[r]=-mhat; asm volatile("":"+v"(negm)); } \
    _Pragma("unroll") for(int r=0;r<16;++r)P0[r]=__builtin_amdgcn_exp2f(P0[r]); }while(0)
  #define RESC() do{ if(resc){ asm volatile("s_waitcnt lgkmcnt(0)":::"memory"); \
      _Pragma("unroll") for(int d_=0;d_<2;++d_) _Pragma("unroll") for(int r=0;r<16;++r)o[d_][r]*=wsf[crow(r,hi)]; \
      if constexpr(LS){ _Pragma("unroll") for(int r=0;r<16;++r)o2[r]*=wsf[crow(r,hi)]; } } }while(0)
  f32x16 pA0,pA1,pB0,pB1;
  int kl_cur=0,kl_next=SLOTK;
  int sl_prev=0,sl_cur=0,sl_next=SLOTB;
  #define ROT() do{sl_prev=sl_cur;sl_cur=sl_next;sl_next=(sl_next==(NSLOT-1)*SLOTB)?0:sl_next+SLOTB; kl_cur=kl_next;kl_next=(kl_next==(NSLOT-1)*SLOTK)?0:kl_next+SLOTK;}while(0)
  DMA_K(2,2*SLOTK);
  WAIT_P();
  { const char*kb=Kbase+hi*1024+r32*16;
    #pragma unroll
    for(int d0=0;d0<NKS;++d0){
      const bf16x8 b0=*reinterpret_cast<const bf16x8*>(kb+d0*2048);
      const bf16x8 b1=*reinterpret_cast<const bf16x8*>(kb+d0*2048+512);
      if(d0==0){pA0=__builtin_amdgcn_mfma_f32_32x32x16_bf16(b0,qr[0],negm,0,0,0);pA1=__builtin_amdgcn_mfma_f32_32x32x16_bf16(b1,qr[0],negm,0,0,0);}
      else{pA0=__builtin_amdgcn_mfma_f32_32x32x16_bf16(b0,qr[d0],pA0,0,0,0);pA1=__builtin_amdgcn_mfma_f32_32x32x16_bf16(b1,qr[d0],pA1,0,0,0);}} }
  asm volatile("s_nop 15\n\ts_nop 7":"+v"(pA0),"+v"(pA1));
  START(pA0,pA1);
  _Pragma("unroll") for(int r=0;r<16;++r)pA1[r]=__builtin_amdgcn_exp2f(pA1[r]);
  WAIT_BAR(0);
  if constexpr(SK){ DMA_V(1,SLOTB);DMA_K(3,0); } else { DMA_K(3,0);DMA_V(1,SLOTB); }
  ROT();
  _Pragma("unroll") for(int j=0;j<NKS;++j)kload2(kf,kp0+kl_cur,j);
  WAIT_C();
  if constexpr(SK){ if(wid>=4){ BARONLY(); } }
  s16x4 vlo[8],vhi[8]; u32x4 pw0,pw1,pw2,pw3;
  #define PKW(P,B) cvtpk_s(P[B],P[B+1])
  #define PAF(k) __builtin_bit_cast(bf16x8,pw##k)
  #define VFR(i) (bf16x8){vlo[i][0],vlo[i][1],vlo[i][2],vlo[i][3],vhi[i][0],vhi[i][1],vhi[i][2],vhi[i][3]}
  #define PIN(x) asm volatile("":"+v"(x))
  #define MX3(a,b,c) __builtin_fmaxf(__builtin_fmaxf((a),(b)),(c))
  #define GAPA(MF,A0,A1,A2,A3,W0,W1,PW) do{ MF; if constexpr(!LS){ sacc+=A0; sacc+=A1; sacc+=A2; sacc+=A3; PIN(sacc); } W0; W1; PIN(PW); SBAR(); }while(0)
  #define LSM(k) do{ if constexpr(LS){ o2=MF32(PAF(k),ONES,o2); SBAR(); } }while(0)
  #define EX(v) __builtin_amdgcn_exp2f(v)
  #define GAPB(MF,X,B) do{ MF; X[B]=EX(X[B]); X[B+1]=EX(X[B+1]); X[B+2]=EX(X[B+2]); X[B+3]=EX(X[B+3]); PIN(X); SBAR(); }while(0)
  #define VRD(i) do{ vlo[i]=vtr(vp_+(((i)>>2)*4096+((i)&3)*1024)); vhi[i]=vtr(vp_+(((i)>>2)*4096+((i)&3)*1024+512)); }while(0)
  #define KRD(G,j) do{ if(G){ kload2(kf,kp0+kl_next,j); SBAR(); } }while(0)
  #define MF32(a,b,c) __builtin_amdgcn_mfma_f32_32x32x16_bf16(a,b,c,0,0,0)
  #define STEP(C0,C1,P0,P1,t,GK,GV,GL,CK,MW) do{ SBAR(); \
    const lds_cptr vp_=vp0+sl_prev; \
    VRD(0); SBAR(); float sacc=LS?0.f:(P0[0]+P0[1]); \
    GAPA(C0=MF32(kf[0],qr[0],negm), P0[2],P0[3],P0[4],P0[5],     pw0[0]=PKW(P0,0), pw0[1]=PKW(P0,2), pw0); \
    VRD(4); SBAR(); GAPA(C1=MF32(kf[1],qr[0],negm), P0[6],P0[7],P0[8],P0[9],     pw0[2]=PKW(P0,4), pw0[3]=PKW(P0,6), pw0); \
    VRD(1); SBAR(); GAPA(C0=MF32(kf[2],qr[1],C0),   P0[10],P0[11],P0[12],P0[13], pw1[0]=PKW(P0,8), pw1[1]=PKW(P0,10), pw1); \
    VRD(5); SBAR(); GAPA(C1=MF32(kf[3],qr[1],C1),   P0[14],P0[15],P1[0],P1[1],   pw1[2]=PKW(P0,12),pw1[3]=PKW(P0,14), pw1); \
    VRD(2); SBAR(); GAPA(C0=MF32(kf[4],qr[2],C0),   P1[2],P1[3],P1[4],P1[5],     pw2[0]=PKW(P1,0), pw2[1]=PKW(P1,2), pw2); \
    VRD(6); SBAR(); GAPA(C1=MF32(kf[5],qr[2],C1),   P1[6],P1[7],P1[8],P1[9],     pw2[2]=PKW(P1,4), pw2[3]=PKW(P1,6), pw2); \
    VRD(3); SBAR(); GAPA(C0=MF32(kf[6],qr[3],C0),   P1[10],P1[11],P1[12],P1[13], pw3[0]=PKW(P1,8), pw3[1]=PKW(P1,10), pw3); \
    VRD(7); SBAR(); GAPA(C1=MF32(kf[7],qr[3],C1),   P1[14],P1[15],0.f,0.f,       pw3[2]=PKW(P1,12),pw3[3]=PKW(P1,14), pw3); \
    if constexpr(NKS==6){ C0=MF32(kf[8],qr[4],C0); SBAR(); C1=MF32(kf[9],qr[4],C1); SBAR(); C0=MF32(kf[10],qr[5],C0); SBAR(); C1=MF32(kf[11],qr[5],C1); SBAR(); } \
    if constexpr(!LS){ l_reg+=sacc; } \
    if constexpr(SK){ MW; if(GV){DMA_V((t)+1,sl_next);} if(GK){DMA_K((t)+3,kl_cur);} } else { if(GK){DMA_K((t)+3,kl_cur);} if(GV){DMA_V((t)+1,sl_next);} } \
    if(CK){ float a=MX3(C0[0],C0[1],C1[0]),b=MX3(C0[2],C0[3],C1[1]); a=MX3(a,C1[2],C1[3]); \
      _Pragma("unroll") for(int r=4;r<16;r+=4){a=MX3(a,C0[r],C0[r+1]);b=MX3(b,C0[r+2],C0[r+3]);a=MX3(a,C1[r],C1[r+1]);b=MX3(b,C1[r+2],C1[r+3]);} \
      float rm=__builtin_fmaxf(a,b); { auto rr=__builtin_amdgcn_permlane32_swap(__float_as_uint(rm),__float_as_uint(rm),false,false); rm=__builtin_fmaxf(__uint_as_float(rr[0]),__uint_as_float(rr[1])); } \
      resc=false; \
      if(__builtin_expect(__any(rm>(float)THRL),0)){ const float dl=__builtin_fmaxf(rm,0.f); mhat+=dl; \
        _Pragma("unroll") for(int r=0;r<16;++r){C0[r]-=dl;C1[r]-=dl;} \
        _Pragma("unroll") for(int r=0;r<16;++r)negm[r]=-mhat; asm volatile("":"+v"(negm)); \
        const float f=__builtin_amdgcn_exp2f(-dl); l_reg*=f; if(hi==0)wsf[r32]=f; resc=true; } } else { resc=false; } \
    SBAR(); \
    GAPB(o[0]=MF32(PAF(0),VFR(0),o[0]), C0,0); \
    GAPB(o[1]=MF32(PAF(0),VFR(4),o[1]), C0,4); LSM(0); \
    KRD(GL,0); GAPB(o[0]=MF32(PAF(1),VFR(1),o[0]), C0,8); \
    KRD(GL,1); GAPB(o[1]=MF32(PAF(1),VFR(5),o[1]), C0,12); LSM(1); \
    KRD(GL,2); GAPB(o[0]=MF32(PAF(2),VFR(2),o[0]), C1,0); \
    KRD(GL,3); GAPB(o[1]=MF32(PAF(2),VFR(6),o[1]), C1,4); LSM(2); \
    if constexpr(NKS==6){ KRD(GL,4); } GAPB(o[0]=MF32(PAF(3),VFR(3),o[0]), C1,8); \
    if constexpr(NKS==6){ KRD(GL,5); } GAPB(o[1]=MF32(PAF(3),VFR(7),o[1]), C1,12); LSM(3); \
    }while(0)
  int t=1;
  for(;t+11<NT;t+=8){
    STEP(pB0,pB1,pA0,pA1,t,true,true,true,true,WAITA_K());      WAIT_C(); RESC(); ROT();
    STEP(pA0,pA1,pB0,pB1,t+1,true,true,true,false,WAITA_K());   WAIT_C(); ROT();
    STEP(pB0,pB1,pA0,pA1,t+2,true,true,true,false,WAITA_K());   WAIT_C(); ROT();
    STEP(pA0,pA1,pB0,pB1,t+3,true,true,true,false,WAITA_K());   WAIT_C(); ROT();
    STEP(pB0,pB1,pA0,pA1,t+4,true,true,true,false,WAITA_K());   WAIT_C(); ROT();
    STEP(pA0,pA1,pB0,pB1,t+5,true,true,true,false,WAITA_K());   WAIT_C(); ROT();
    STEP(pB0,pB1,pA0,pA1,t+6,true,true,true,false,WAITA_K());   WAIT_C(); ROT();
    STEP(pA0,pA1,pB0,pB1,t+7,true,true,true,false,WAITA_K());   WAIT_C(); ROT();
  }
  for(;t+5<NT;t+=2){
    STEP(pB0,pB1,pA0,pA1,t,true,true,true,true,WAITA_K());     WAIT_C(); RESC(); ROT();
    STEP(pA0,pA1,pB0,pB1,t+1,true,true,true,true,WAITA_K());   WAIT_C(); RESC(); ROT();
  }
  #define ENDW(tt) do{ if constexpr(SK){ if((tt)+3<NT){WAIT_C();} else if((tt)+1<NT){WAIT_BAR(1);} else {WAIT_BAR(0);} } \
                       else { if((tt)+3<NT){WAIT_C();} else if((tt)+2<NT){WAIT_BAR(1);} else {WAIT_BAR(0);} } }while(0)
  #define ENDA(tt) do{ if((tt)+2<NT){WAITA_K();} else {WAIT_BAR(0);} }while(0)
  for(;t+1<NT;t+=2){
    STEP(pB0,pB1,pA0,pA1,t,(t+3<NT),(t+1<NT),(t+1<NT),true,ENDA(t));         ENDW(t);   RESC(); ROT();
    STEP(pA0,pA1,pB0,pB1,t+1,(t+4<NT),(t+2<NT),(t+2<NT),true,ENDA(t+1));     ENDW(t+1); RESC(); ROT();
  }
  STEP(pB0,pB1,pA0,pA1,NT-1,false,false,false,true,WAIT_BAR(0)); if constexpr(SK){ WAIT_BAR(0); } RESC();
  { if constexpr(!LS){ float sacc=pB0[0]+pB0[1]; _Pragma("unroll") for(int r=2;r<16;++r)sacc+=pB0[r]; _Pragma("unroll") for(int r=0;r<16;++r)sacc+=pB1[r]; l_reg+=sacc; }
    pw0=(u32x4){PKW(pB0,0),PKW(pB0,2),PKW(pB0,4),PKW(pB0,6)};pw1=(u32x4){PKW(pB0,8),PKW(pB0,10),PKW(pB0,12),PKW(pB0,14)};pw2=(u32x4){PKW(pB1,0),PKW(pB1,2),PKW(pB1,4),PKW(pB1,6)};pw3=(u32x4){PKW(pB1,8),PKW(pB1,10),PKW(pB1,12),PKW(pB1,14)};
    SBAR(); pv(o,vb0+sl_cur,PAF(0),PAF(1),PAF(2),PAF(3)); LSM(0); LSM(1); LSM(2); LSM(3); }
  if constexpr(SK){ if(wid<4){ BARONLY(); } }
  #undef PKW
  #undef PAF
  #undef VFR
  #undef PIN
  #undef MX3
  #undef GAPA
  #undef GAPB
  #undef EX
  #undef VRD
  #undef KRD
  #undef LSM
  #undef MF32
  #undef STEP
  #undef ENDW
  #undef ENDA
  float rli[16];
  if constexpr(LS){
    #pragma unroll
    for(int r=0;r<16;++r)rli[r]=__builtin_amdgcn_rcpf(o2[r]);
  } else {
    {auto rr=__builtin_amdgcn_permlane32_swap(__float_as_uint(l_reg),__float_as_uint(l_reg),false,false);l_reg=__uint_as_float(rr[0])+__uint_as_float(rr[1]);}
    if(hi==0)wsf[32+r32]=l_reg;asm volatile("s_waitcnt lgkmcnt(0)":::"memory");
    #pragma unroll
    for(int r=0;r<16;++r)rli[r]=__builtin_amdgcn_rcpf(wsf[32+crow(r,hi)]);
  }
  bf16*Ow=Ou+(long)(wid*QBLK)*OP;
  { bf16*stg=(bf16*)(shm+LDS_OST)+wid*2048;
    #pragma unroll
    for(int r=0;r<16;++r){const int orow=crow(r,hi);
      #pragma unroll
      for(int d0=0;d0<2;++d0)stg[orow*64+d0*32+r32]=(bf16)(cvtpk_s(o[d0][r]*rli[r],0.f)&0xffffu);}
    asm volatile("s_waitcnt lgkmcnt(0)":::"memory");
    #pragma unroll
    for(int i=0;i<4;++i){const int row=i*8+(lane>>3),ch=lane&7; const u32x4 v=*(const u32x4*)(stg+row*64+ch*8); *(u32x4*)(Ow+(long)row*OP+ch*8)=v;} }
  asm volatile("s_waitcnt lgkmcnt(0)\n\ts_barrier":::"memory");
  #undef DMA_K
  #undef DMA_V
  #undef WAIT_C
  #undef WAIT_P
  #undef WAITA_K
  #undef BARONLY
  #undef START
  #undef RESC
  #undef ROT
}
#undef SBAR
#undef WAIT_BAR
}
#define XB_TMO      128
#define XB_XCNT(j)  (256  + 64 * (j))
#define XB_XSUB(j)  (1280 + 64 * (j))
#define XB_XGEN(j)  (2304 + 64 * (j))
#define XB_TOP      3328
#define XB_TOPGEN   3392
#define XCD_BAR_WORDS 3456
#define XB_SPIN_CAP (1u << 20)

__device__ __forceinline__ unsigned xb_ld(unsigned* p)              { return __hip_atomic_load(p, __ATOMIC_RELAXED, __HIP_MEMORY_SCOPE_AGENT); }
__device__ __forceinline__ unsigned xb_add(unsigned* p, unsigned v) { return __hip_atomic_fetch_add(p, v, __ATOMIC_RELAXED, __HIP_MEMORY_SCOPE_AGENT); }
__device__ __forceinline__ unsigned xb_xcc_id() { return (unsigned)__builtin_amdgcn_s_getreg((3 << 11) | 20) & 0xFu; }
#define XB_SPIN(cond, bar) do { unsigned _sp = 0; while (cond) { __builtin_amdgcn_s_sleep(1); \
    if ((++_sp & 255u) == 0u) { if (xb_ld(&(bar)[XB_TMO])) break; if (_sp > XB_SPIN_CAP) { atomicAdd(&(bar)[XB_TMO], 1u); break; } } } } while (0)

struct XcdBarrier {
    unsigned* bar; unsigned x;
    volatile LAS unsigned* st;
};
__device__ __forceinline__ XcdBarrier xcd_barrier_post(unsigned* bar, volatile LAS unsigned* st) {
    XcdBarrier b; b.bar = bar; b.x = xb_xcc_id(); b.st = st;
    if (threadIdx.x == 0) (void)xb_add(&bar[XB_XCNT(b.x)], 1u);
    return b;
}
__device__ __forceinline__ void xcd_barrier_complete(unsigned* bar, unsigned x, unsigned& nloc, unsigned& nx) {
    const unsigned G = gridDim.x * gridDim.y * gridDim.z;
    unsigned sum, cnt, mine, sp = 0u;
    for (;;) {
        sum = 0u; cnt = 0u; mine = 0u;
        unsigned cj[16];
#pragma unroll
        for (unsigned j = 0; j < 16; ++j) cj[j] = xb_ld(&bar[XB_XCNT(j)]);
#pragma unroll
        for (unsigned j = 0; j < 16; ++j) { const unsigned c = cj[j]; sum += c; cnt += (c > 0u) ? 1u : 0u; mine = (j == x) ? c : mine; }
        if (sum == G) break;
        __builtin_amdgcn_s_sleep(1);
        if ((++sp & 255u) == 0u) { if (xb_ld(&bar[XB_TMO])) break; if (sp > XB_SPIN_CAP) { atomicAdd(&bar[XB_TMO], 1u); break; } }
    }
    nloc = mine > 0u ? mine : 1u; nx = cnt > 0u ? cnt : 1u;
}
__device__ __forceinline__ void xcd_barrier(const XcdBarrier& b) {
    asm volatile("s_waitcnt vmcnt(0)" ::: "memory");
    __syncthreads();
    if (threadIdx.x == 0) {
        unsigned* bar = b.bar;
        __builtin_amdgcn_s_waitcnt(0);
        unsigned nloc = b.st[0], nx = b.st[1];
        if (nloc == 0u) { xcd_barrier_complete(bar, b.x, nloc, nx); b.st[0] = nloc; b.st[1] = nx; }
        const unsigned old = xb_add(&bar[XB_XSUB(b.x)], 1u);
        const unsigned gen = old / nloc;
        if (old + 1u == (gen + 1u) * nloc) {
            __builtin_amdgcn_fence(__ATOMIC_RELEASE, "agent");
            asm volatile("s_waitcnt vmcnt(0)" ::: "memory");
            const unsigned og = xb_add(&bar[XB_TOP], 1u);
            const unsigned tg = og / nx;
            if (og + 1u == (tg + 1u) * nx) xb_add(&bar[XB_TOPGEN], 1u);
            else XB_SPIN(xb_ld(&bar[XB_TOPGEN]) == tg, bar);
            __builtin_amdgcn_fence(__ATOMIC_ACQUIRE, "agent");
            xb_add(&bar[XB_XGEN(b.x)], 1u);
            asm volatile("s_waitcnt vmcnt(0)" ::: "memory");
        } else {
            XB_SPIN(xb_ld(&bar[XB_XGEN(b.x)]) == gen, bar);
            __builtin_amdgcn_fence(__ATOMIC_ACQUIRE, "agent");
            asm volatile("s_waitcnt vmcnt(0)" ::: "memory");
        }
    }
    __syncthreads();
}

struct Args { const float* in[24]; float* out; unsigned char* ws; };
enum { I_X = 0, I_C, I_CTX, I_CCTX, I_WMOD, I_BMOD, I_NORMS, I_WIN, I_QKN, I_MQN, I_MKVN, I_WUQ, I_WUKV, I_GVN, I_GWS, I_GBS, I_WBR, I_WOUT, I_RW, I_RB, I_EW1, I_EB1, I_EW2, I_EB2 };

struct Frame {
    LAS unsigned char* lds;
    volatile LAS unsigned* MISC;
    gu32* ctl;
    int tid, lane, wave, G, bx;
    unsigned char* ws;
    __device__ __forceinline__ const float* in(int i) const { const unsigned long long v = __hip_atomic_load((const unsigned long long*)(ws + WS_PTAB) + i, __ATOMIC_RELAXED, __HIP_MEMORY_SCOPE_AGENT);
        const unsigned lo = __builtin_amdgcn_readfirstlane((unsigned)v), hi = __builtin_amdgcn_readfirstlane((unsigned)(v >> 32));
        return (const float*)(const GAS float*)(((unsigned long long)hi << 32) | lo); }
    __device__ __forceinline__ float* out() const { return (float*)in(24); }
};

__device__ __forceinline__ int map_col(int kind, int n) {
    if (kind == 1) { const int pn = n >> 8, c = n & 255, bj = (c >> 7) & 1, wc = (c >> 5) & 3, j = c & 31;
        if (pn < 2) return (4 * pn + wc) * 64 + 32 * bj + j;
        if (pn == 2) return 512 + wc * 64 + 32 * bj + j;
        if (pn == 3) return 768 + c;
        if (pn == 4) { if (wc < 2) return 1024 + wc * 64 + 32 * bj + j; if (wc == 2 && j < 16) return 1152 + 16 * bj + j; return -1; }
        if (pn < 9) return 1184 + (pn - 5) * 256 + c;
        return 2208 + (pn - 9) * 256 + c; }
    if (kind == 2) { if (n < 512) return (n >> 6) * 96 + (n & 63); const int t = n - 512; return ((t & 127) >> 4) * 96 + 64 + 16 * (t >> 7) + (t & 15); }
    if (kind == 3) { return ((n >> 7) & 1) * 1024 + (n >> 8) * 128 + (n & 127); }
    return n;
}
__device__ __forceinline__ void transpose_item(const float* W, int K, int Nsrc, bf16* WT, int nblk, int kind, LAS float* scr, int item, int lane) {
    const int kb = item / nblk, nb = item % nblk, k0 = 64 * kb, n0 = 64 * nb;
    const int src = map_col(kind, n0 + 4 * (lane & 15));
    f32x4 v[16];
#pragma unroll
    for (int i = 0; i < 16; ++i) { const int kk = 4 * i + (lane >> 4); v[i] = (src >= 0) ? *(const f32x4*)(W + (size_t)(k0 + kk) * Nsrc + src) : (f32x4){0.f, 0.f, 0.f, 0.f}; }
#pragma unroll
    for (int i = 0; i < 16; ++i) { const int kk = 4 * i + (lane >> 4); LAS float* d = scr + kk * 65 + 4 * (lane & 15); d[0] = v[i][0]; d[1] = v[i][1]; d[2] = v[i][2]; d[3] = v[i][3]; }
    LDS_WAIT(); asm volatile("" ::: "memory");
    const int c = lane & 7;
#pragma unroll
    for (int j = 0; j < 8; ++j) { const int n = (lane >> 3) + 8 * j; const LAS float* s = scr + (8 * c) * 65 + n;
        v4u o; o.x = cvt_pk(s[0 * 65], s[1 * 65]); o.y = cvt_pk(s[2 * 65], s[3 * 65]); o.z = cvt_pk(s[4 * 65], s[5 * 65]); o.w = cvt_pk(s[6 * 65], s[7 * 65]);
        *(GAS v4u*)(WT + (size_t)(n0 + n) * K + k0 + 8 * c) = o; }
    LDS_WAIT(); asm volatile("" ::: "memory");
}
__device__ __forceinline__ void sincos_acc(float ang, float& c, float& s) {
    const double x = (double)ang; const double n = __builtin_rint(x * 0.6366197723675814);
    double r = __builtin_fma(-n, 1.5707963267948966, x); r = __builtin_fma(-n, 6.123233995736766e-17, r);
    const double r2 = r * r;
    double sp = -2.5052108385441720e-08; sp = sp * r2 + 2.7557319223985893e-06; sp = sp * r2 - 1.9841269841269841e-04; sp = sp * r2 + 8.3333333333333332e-03; sp = sp * r2 - 1.6666666666666666e-01; sp = sp * r2 * r + r;
    double cp = 2.0876756987868099e-09; cp = cp * r2 - 2.7557319223985888e-07; cp = cp * r2 + 2.4801587301587302e-05; cp = cp * r2 - 1.3888888888888889e-03; cp = cp * r2 + 4.1666666666666664e-02; cp = cp * r2 - 0.5; cp = cp * r2 + 1.0;
    const int q = ((int)n) & 3;
    const double sv = (q == 0) ? sp : (q == 1) ? cp : (q == 2) ? -sp : -cp;
    const double cv = (q == 0) ? cp : (q == 1) ? -sp : (q == 2) ? -cp : sp;
    c = (float)cv; s = (float)sv;
}

__device__ __forceinline__ void p_prologue(Frame& F, const Args& A) {
    const int gw = F.bx * 8 + F.wave, NGW = F.G * 8, lane = F.lane;
    if (F.bx == 0 && F.tid < 25) { ((unsigned long long*)(F.ws + WS_PTAB))[F.tid] = (F.tid < 24) ? (unsigned long long)(uintptr_t)A.in[F.tid] : (unsigned long long)(uintptr_t)A.out; }
    { LAS float* sv = (LAS float*)(F.lds + LDS_SVEC);
      for (int i = F.tid; i < 3 * 1024; i += 512) { const float v = (i < 2048) ? A.in[I_C][i] : A.in[I_CCTX][i - 2048]; sv[i] = v * sigmoidf_(v); }
      __syncthreads(); }
    { const LAS float* sv = (const LAS float*)(F.lds + LDS_SVEC); float* mod = (float*)(F.ws + WS_MOD);
      for (int it = gw; it < 3 * DEPTH * 384; it += NGW) { if (it % 3) continue; const int itm = it / 3; const int l = itm / 384, col = (itm % 384) * 16 + (lane & 15), kq = lane >> 4;
          const float* W = A.in[I_WMOD] + (size_t)l * 1024 * 6144 + col; float a0 = 0.f, a1 = 0.f, a2 = 0.f;
#pragma unroll 16
          for (int k = kq * 256; k < kq * 256 + 256; ++k) { const float w = W[(size_t)k * 6144]; a0 += sv[k] * w; a1 += sv[1024 + k] * w; a2 += sv[2048 + k] * w; }
          a0 += __shfl_xor(a0, 16); a1 += __shfl_xor(a1, 16); a2 += __shfl_xor(a2, 16); a0 += __shfl_xor(a0, 32); a1 += __shfl_xor(a1, 32); a2 += __shfl_xor(a2, 32);
          if (lane < 16) { const float b = A.in[I_BMOD][l * 6144 + col]; float* mp = mod + (size_t)l * 3 * 6144 + col; mp[0] = a0 + b; mp[6144] = a1 + b; mp[2 * 6144] = a2 + b; } } }
    { float* cg = (float*)(F.ws + WS_COSG); float* sg = (float*)(F.ws + WS_SING); float* cm = (float*)(F.ws + WS_COSM); float* sm = (float*)(F.ws + WS_SINM);
      const int gt = F.bx * 512 + F.tid, NT_ = F.G * 512;
      for (int i = gt; i < SEQ * 48; i += NT_) { const int pos = i / 48, j = i % 48; const float rowf = (float)(pos >> 6), colf = (float)(pos & 63); float c, s;
          if (j < 32) { const float ang = (j < 16) ? rowf * INVF16[j] : colf * INVF16[j - 16]; sincos_acc(ang, c, s); cg[pos * 32 + j] = c; sg[pos * 32 + j] = s; }
          else { const int jj = j - 32; const float ang = (jj < 8) ? rowf * INVF16[2 * jj] : colf * INVF16[2 * (jj - 8)]; sincos_acc(ang, c, s); cm[pos * 16 + jj] = c; sm[pos * 16 + jj] = s; } } }
    { bf16* wsb = (bf16*)(F.ws + WS_WS); const float* src = A.in[I_GWS]; const int gt = F.bx * 512 + F.tid, NT_ = F.G * 512;
      for (int i = gt; i < DEPTH * 8 * 128 * 128 / 2; i += NT_) { ((unsigned*)wsb)[i] = cvt_pk(src[2 * i], src[2 * i + 1]); } }
    { bf16* rwt = (bf16*)(F.ws + WS_RWT); const float* src = A.in[I_RW]; const int gt = F.bx * 512 + F.tid, NT_ = F.G * 512;
      for (int i = gt; i < DEPTH * 32 * 1024; i += NT_) { const int l = i >> 15, e = (i >> 10) & 31, d = i & 1023; const float w = src[(size_t)l * 32768 + d * 32 + e];
          const unsigned h16 = cvt_pk(w, 0.f) & 0xffffu; const float back = __uint_as_float(h16 << 16);
          rwt[(size_t)l * 65536 + e * 1024 + d] = (bf16)h16; rwt[(size_t)l * 65536 + 32768 + e * 1024 + d] = (bf16)(cvt_pk(w - back, 0.f) & 0xffffu); } }
    { LAS float* scr = (LAS float*)(F.lds + RING_OFF + F.wave * 16640);
      constexpr int I_IN = 16 * 84, I_UQ = 4 * 12, I_UKV = 2 * 16, I_BR = 8 * 16, I_OUT = 16 * 16, I_W1 = 16 * 32, I_W2 = 16 * 16;
      constexpr int PER_LAYER = I_IN + I_UQ + I_UKV + 3 * I_BR + I_OUT + 32 * I_W1 + 32 * I_W2;
      for (int it = gw; it < DEPTH * PER_LAYER; it += NGW) { const int l = it / PER_LAYER; int r = it % PER_LAYER;
          if (r < I_IN) { transpose_item(A.in[I_WIN] + (size_t)l * 1024 * 5280, 1024, 5280, (bf16*)(F.ws + WS_WIN) + (size_t)l * ZW * 1024, 84, 1, scr, r, lane); continue; } r -= I_IN;
          if (r < I_UQ) { transpose_item(A.in[I_WUQ] + (size_t)l * 256 * 768, 256, 768, (bf16*)(F.ws + WS_WUQ) + (size_t)l * 768 * 256, 12, 2, scr, r, lane); continue; } r -= I_UQ;
          if (r < I_UKV) { transpose_item(A.in[I_WUKV] + (size_t)l * 128 * 1024, 128, 1024, (bf16*)(F.ws + WS_WUKV) + (size_t)l * 1024 * 128, 16, 0, scr, r, lane); continue; } r -= I_UKV;
          if (r < 3 * I_BR) { const int i = r / I_BR; transpose_item(A.in[I_WBR] + (size_t)(l * 3 + i) * 512 * 1024, 512, 1024, (bf16*)(F.ws + WS_WBR) + (size_t)(l * 3 + i) * 1024 * 512, 16, 0, scr, r % I_BR, lane); continue; } r -= 3 * I_BR;
          if (r < I_OUT) { transpose_item(A.in[I_WOUT] + (size_t)l * 1024 * 1024, 1024, 1024, (bf16*)(F.ws + WS_WOUT) + (size_t)l * 1024 * 1024, 16, 0, scr, r, lane); continue; } r -= I_OUT;
          if (r < 32 * I_W1) { const int e = r / I_W1; transpose_item(A.in[I_EW1] + (size_t)(l * 32 + e) * 1024 * 2048, 1024, 2048, (bf16*)(F.ws + WS_W1) + (size_t)(l * 32 + e) * 2048 * 1024, 32, 3, scr, r % I_W1, lane); continue; } r -= 32 * I_W1;
          { const int e = r / I_W2; transpose_item(A.in[I_EW2] + (size_t)(l * 32 + e) * 1024 * 1024, 1024, 1024, (bf16*)(F.ws + WS_W2) + (size_t)(l * 32 + e) * 1024 * 1024, 16, 0, scr, r % I_W2, lane); } } }
}

__device__ __forceinline__ void mod_row_to_bf16(const float* xrow, const float* gain, const float* sc, const float* sh, bf16* orow, int lane) {
    const f32x4* xr = (const f32x4*)xrow + lane; f32x4 v[4], g[4], s[4], h[4]; float ss = 0.f;
#pragma unroll
    for (int j = 0; j < 4; ++j) { v[j] = xr[64 * j]; g[j] = ((const f32x4*)gain)[64 * j + lane]; s[j] = ((const f32x4*)sc)[64 * j + lane]; h[j] = ((const f32x4*)sh)[64 * j + lane]; }
#pragma unroll
    for (int j = 0; j < 4; ++j) ss += (v[j].x * v[j].x + v[j].y * v[j].y) + (v[j].z * v[j].z + v[j].w * v[j].w);
    const float rstd = __builtin_amdgcn_rsqf(wave_sum(ss) * (1.f / DM) + RMS_EPS);
    unsigned long long* o8 = (unsigned long long*)orow + lane;
#pragma unroll
    for (int j = 0; j < 4; ++j) { const float y0 = v[j].x * rstd * g[j].x * (1.f + s[j].x) + h[j].x, y1 = v[j].y * rstd * g[j].y * (1.f + s[j].y) + h[j].y, y2 = v[j].z * rstd * g[j].z * (1.f + s[j].z) + h[j].z, y3 = v[j].w * rstd * g[j].w * (1.f + s[j].w) + h[j].w;
        o8[64 * j] = (unsigned long long)cvt_pk(y0, y1) | ((unsigned long long)cvt_pk(y2, y3) << 32); }
}

typedef short bf16x8_t __attribute__((ext_vector_type(8)));
typedef float f32x16_t __attribute__((ext_vector_type(16)));
__device__ __forceinline__ void gmlp_unit(Frame& F, const float* gbs, const float* gvn, int l, int chunk, int nt) {
    const int lane = F.lane, g = F.wave, r32 = lane & 31, hi = lane >> 5;
    const bf16* vn = (const bf16*)(F.ws + WS_VN) + (size_t)chunk * 128 * 512 + g * 64; const float* ssv = (const float*)(F.ws + WS_SSV);
    const bf16* ua = (const bf16*)(F.ws + WS_UACT) + (size_t)chunk * 128 * 512 + g * 64;
    bf16* go = (bf16*)(F.ws + WS_GM) + (size_t)chunk * 128 * 512 + g * 64;
    const bf16* wsb = (const bf16*)(F.ws + WS_WS) + (size_t)(l * 8 + g) * 128 * 128;
    const float* bs = gbs + (size_t)(l * 8 + g) * 128;
    LAS bf16* vt = (LAS bf16*)(F.lds + RING_OFF + g * 19456); LAS bf16* ut = vt + 32 * 136; LAS float* bl = (LAS float*)(ut + 128 * 32);
    { const int dd = (lane & 3) * 8; const f32x4 ga = *(const f32x4*)(gvn + l * 512 + g * 64 + nt * 32 + dd), gb = *(const f32x4*)(gvn + l * 512 + g * 64 + nt * 32 + dd + 4);
      v4u raw[8], uraw[8]; float s0[8], s1[8];
#pragma unroll
      for (int ps = 0; ps < 8; ++ps) { const int q = ps * 16 + (lane >> 2); raw[ps] = *(const v4u*)(vn + (size_t)q * 512 + nt * 32 + dd); uraw[ps] = *(const v4u*)(ua + (size_t)q * 512 + nt * 32 + dd);
          const float* sp = ssv + ((size_t)chunk * 128 + q) * 2; s0[ps] = sp[0]; s1[ps] = sp[1]; }
      const float b0 = bs[lane], b1 = bs[64 + lane];
#pragma unroll
      for (int ps = 0; ps < 8; ++ps) { const int q = ps * 16 + (lane >> 2); float fv[8]; unpack8(raw[ps], fv);
          const float rstd = __builtin_amdgcn_rsqf((s0[ps] + s1[ps]) * (1.f / 512.f) + RMS_EPS);
#pragma unroll
          for (int i = 0; i < 8; ++i) vt[(dd + i) * 136 + q] = (bf16)(cvt_pk(fv[i] * rstd * (i < 4 ? ga[i] : gb[i - 4]), 0.f) & 0xffffu);
          *(LAS v4u*)(ut + q * 32 + dd) = uraw[ps]; }
      bl[lane] = b0; bl[64 + lane] = b1; }
    LDS_WAIT(); asm volatile("" ::: "memory");
#pragma unroll 1
    for (int mh = 0; mh < 2; ++mh) {
        f32x16_t acc[2]; acc[0] = (f32x16_t){}; acc[1] = (f32x16_t){};
        size_t zo = (size_t)mh * 64 * 128; asm volatile("" : "+v"(zo));
        const bf16* wsl = wsb + zo; bf16x8_t afr[8][2];
#pragma unroll
        for (int ks = 0; ks < 8; ++ks)
#pragma unroll
            for (int mt = 0; mt < 2; ++mt) afr[ks][mt] = *(const bf16x8_t*)(wsl + (size_t)(mt * 32 + r32) * 128 + ks * 16 + hi * 8);
#pragma unroll
        for (int ks = 0; ks < 8; ++ks) { const bf16x8_t bfr = *(const LAS bf16x8_t*)(vt + r32 * 136 + ks * 16 + hi * 8);
#pragma unroll
            for (int mt = 0; mt < 2; ++mt) acc[mt] = __builtin_amdgcn_mfma_f32_32x32x16_bf16(afr[ks][mt], bfr, acc[mt], 0, 0, 0); }
#pragma unroll
        for (int mt = 0; mt < 2; ++mt)
#pragma unroll
            for (int rg = 0; rg < 16; ++rg) { const int p = mh * 64 + mt * 32 + (rg & 3) + 8 * (rg >> 2) + 4 * hi;
                const float u = __uint_as_float((unsigned)ut[p * 32 + r32] << 16);
                go[(size_t)p * 512 + nt * 32 + r32] = (bf16)(cvt_pk(u * (acc[mt][rg] + bl[p]), 0.f) & 0xffffu); } }
    LDS_WAIT(); asm volatile("" ::: "memory");
}
constexpr int T3_REC_E = 0, T3_REC_W = 8192, T3_REC_S = 16384, T3_HIST = 24576, T3_BASE = T3_HIST + 128;
__device__ __forceinline__ void t3_phase(Frame& F, int l, int T_l, const float* xin_lat, const float* xin_ctx, int cofs, bool dry) {
    float* const outp = F.out();
    const int lane = F.lane, tid = F.tid;
    LAS int* rec_e = (LAS int*)(F.lds + RING_OFF + T3_REC_E); LAS float* rec_w = (LAS float*)(F.lds + RING_OFF + T3_REC_W); LAS int* rec_s = (LAS int*)(F.lds + RING_OFF + T3_REC_S);
    LAS int* hist = (LAS int*)(F.lds + RING_OFF + T3_HIST); LAS int* base = (LAS int*)(F.lds + RING_OFF + T3_BASE);
    if (tid < 32) hist[tid] = 0;
    const int per = (T_l + F.G - 1) / F.G; const int r0 = F.bx * per; int ntok = T_l - r0; ntok = ntok < 0 ? 0 : (ntok > per ? per : ntok);
    const float* norms = F.in(I_NORMS) + (size_t)l * 4 * 1024; const float* modl = (const float*)(F.ws + WS_MOD) + (size_t)l * 3 * 6144;
    const bf16* Y = (const bf16*)(F.ws + WS_Y); bf16* XN = (bf16*)(F.ws + (dry ? WS_H : WS_XN)); bf16* XNL = (bf16*)(F.ws + WS_MERGEB);
    for (int j = F.wave; j < ntok; j += 8) {
        const int r = r0 + j; const bool lat = r < TL; const int who = lat ? (r >> 14) : 2;
        const float* xrow = lat ? xin_lat + (size_t)r * 1024 : xin_ctx + (size_t)(r - TL) * 1024;
        float* orow = dry ? (float*)(F.ws + WS_MERGE) + (size_t)r * 1024 : (lat ? outp + (size_t)r * 1024 : (float*)(F.ws + WS_XC) + (size_t)(r - TL) * 1024);
        const float* mo = modl + (size_t)who * 6144;
        float yv[16], xv[16]; v4u yr[2]; f32x4 xr4[4], g1v[4], gn1[4], gn2[4], scv[4], shv[4];
        { const v4u* yp = (const v4u*)(Y + (size_t)r * 1024); yr[0] = yp[lane]; yr[1] = yp[64 + lane]; }
#pragma unroll
        for (int hq = 0; hq < 4; ++hq) { const int d0 = (hq >> 1) * 512 + 8 * lane + 4 * (hq & 1);
            xr4[hq] = *(const f32x4*)(xrow + d0); g1v[hq] = *(const f32x4*)(mo + 2 * 1024 + d0); gn1[hq] = *(const f32x4*)(norms + 1024 + d0);
            gn2[hq] = *(const f32x4*)(norms + 2048 + d0); scv[hq] = *(const f32x4*)(mo + 4 * 1024 + d0); shv[hq] = *(const f32x4*)(mo + 3 * 1024 + d0); }
        { float a[8], b[8]; unpack8(yr[0], a); unpack8(yr[1], b);
#pragma unroll
          for (int i = 0; i < 8; ++i) { yv[i] = a[i]; yv[8 + i] = b[i]; } }
#pragma unroll
        for (int hq = 0; hq < 4; ++hq)
#pragma unroll
            for (int i = 0; i < 4; ++i) xv[hq * 4 + i] = xr4[hq][i];
        float ss = 0.f;
#pragma unroll
        for (int i = 0; i < 16; ++i) ss += yv[i] * yv[i];
        const float rstd = __builtin_amdgcn_rsqf(wave_sum(ss) * (1.f / DM) + RMS_EPS);
        float ss2 = 0.f;
#pragma unroll
        for (int hq = 0; hq < 4; ++hq) { const int d0 = (hq >> 1) * 512 + 8 * lane + 4 * (hq & 1); f32x4 o;
#pragma unroll
            for (int i = 0; i < 4; ++i) { const int k = hq * 4 + i; const float xn = xv[k] + g1v[hq][i] * (yv[k] * rstd * gn1[hq][i]); xv[k] = xn; o[i] = xn; ss2 += xn * xn; }
            *(f32x4*)(orow + d0) = o; }
        const float rstd2 = __builtin_amdgcn_rsqf(wave_sum(ss2) * (1.f / DM) + RMS_EPS);
#pragma unroll
        for (int h = 0; h < 2; ++h) { float hi8[8], lo8[8];
#pragma unroll
            for (int q = 0; q < 2; ++q) { const int hq = h * 2 + q;
#pragma unroll
                for (int i = 0; i < 4; ++i) hi8[q * 4 + i] = xv[hq * 4 + i] * rstd2 * gn2[hq][i] * (1.f + scv[hq][i]) + shv[hq][i]; }
            const v4u ph = pack8(hi8); float back[8]; unpack8(ph, back);
#pragma unroll
            for (int i = 0; i < 8; ++i) lo8[i] = hi8[i] - back[i];
            *(v4u*)(XN + (size_t)r * 1024 + h * 512 + 8 * lane) = ph; *(v4u*)(XNL + (size_t)r * 1024 + h * 512 + 8 * lane) = pack8(lo8); }
    }
    asm volatile("s_waitcnt vmcnt(0)" ::: "memory");
    __syncthreads();
    { const int r32 = lane & 31, hi = lane >> 5, w = F.wave; const int ntiles = (ntok + 31) >> 5;
      if (w < ntiles) {
        const int tloc = 32 * w + r32; const int rr = r0 + (tloc < ntok ? tloc : ntok - 1);
        const bf16* whi = (const bf16*)(F.ws + WS_RWT) + (size_t)l * 2 * 32 * 1024 + (size_t)r32 * 1024 + hi * 8; const bf16* wlo = whi + 32 * 1024;
        const bf16* thi = XN + (size_t)rr * 1024 + hi * 8; const bf16* tlo = XNL + (size_t)rr * 1024 + hi * 8;
        f32x16_t acc = (f32x16_t){};
#pragma unroll 8
        for (int ks = 0; ks < 64; ++ks) { const bf16x8_t ah = *(const bf16x8_t*)(whi + ks * 16), al = *(const bf16x8_t*)(wlo + ks * 16), bh = *(const bf16x8_t*)(thi + ks * 16), bl = *(const bf16x8_t*)(tlo + ks * 16);
            acc = __builtin_amdgcn_mfma_f32_32x32x16_bf16(ah, bh, acc, 0, 0, 0); acc = __builtin_amdgcn_mfma_f32_32x32x16_bf16(ah, bl, acc, 0, 0, 0); acc = __builtin_amdgcn_mfma_f32_32x32x16_bf16(al, bh, acc, 0, 0, 0); }
        const float* rb = F.in(I_RB) + l * 32; float v[16]; float ninf = -INFINITY; asm volatile("" : "+v"(ninf));
#pragma unroll
        for (int i = 0; i < 16; ++i) v[i] = acc[i] + rb[(i & 3) + 8 * (i >> 2) + 4 * hi];
        float cm[8]; int cid[8];
#pragma unroll
        for (int k = 0; k < 4; ++k) { float m = v[0];
#pragma unroll
            for (int i = 1; i < 16; ++i) m = fmaxf(m, v[i]);
            int sel = 15;
#pragma unroll
            for (int i = 14; i >= 0; --i) sel = (v[i] == m) ? i : sel;
            sel = (v[15] == m && sel == 15) ? 15 : sel;
            cm[k] = m; cid[k] = (sel & 3) + 8 * (sel >> 2) + 4 * hi;
#pragma unroll
            for (int i = 0; i < 16; ++i) v[i] = (i == sel) ? ninf : v[i]; }
#pragma unroll
        for (int k = 0; k < 4; ++k) { cm[4 + k] = __shfl_xor(cm[k], 32); cid[4 + k] = __shfl_xor(cid[k], 32); }
        float tl[4]; int te[4];
#pragma unroll
        for (int k = 0; k < 4; ++k) { float best = cm[0]; int bid = cid[0]; int bc = 0;
#pragma unroll
            for (int c = 1; c < 8; ++c) { const bool better = (cm[c] > best) || (cm[c] == best && cid[c] < bid); best = better ? cm[c] : best; bid = better ? cid[c] : bid; bc = better ? c : bc; }
            tl[k] = best; te[k] = bid;
#pragma unroll
            for (int c = 0; c < 8; ++c) cm[c] = (c == bc) ? ninf : cm[c]; }
        const float e1 = __expf(tl[1] - tl[0]), e2 = __expf(tl[2] - tl[0]), e3 = __expf(tl[3] - tl[0]); const float inv = 1.f / (1.f + e1 + e2 + e3);
        if (hi == 0 && tloc < ntok) { const float wv[4] = {inv, e1 * inv, e2 * inv, e3 * inv};
#pragma unroll
            for (int k = 0; k < 4; ++k) { const int ls = __hip_atomic_fetch_add(&hist[te[k]], 1, __ATOMIC_RELAXED, __HIP_MEMORY_SCOPE_WORKGROUP);
                rec_e[tloc * 4 + k] = te[k]; rec_w[tloc * 4 + k] = wv[k]; rec_s[tloc * 4 + k] = ls; } }
      } }
    __syncthreads();
    if (tid < 32) { const int n = hist[tid]; base[tid] = n ? (int)__hip_atomic_fetch_add((unsigned*)(F.ctl + CW_CNT + cofs + l * 32 + tid), (unsigned)n, RLX_AGENT) : 0; }
    __syncthreads();
    { int* rte = (int*)(F.ws + WS_RTE); int* rts = (int*)(F.ws + WS_RTS); int* ltok = (int*)(F.ws + WS_LTOK); float* lw = (float*)(F.ws + WS_LW);
      for (int i = tid; i < ntok * 4; i += 512) { const int e = rec_e[i], slot = base[e] + rec_s[i]; const int r = r0 + (i >> 2);
          rte[(size_t)r * 4 + (i & 3)] = e; rts[(size_t)r * 4 + (i & 3)] = slot; ltok[(size_t)e * TA + slot] = r; lw[(size_t)e * TA + slot] = rec_w[i]; } }
}

__device__ __forceinline__ void moe_tables(Frame& F, int l, int cofs) {
    LAS int* tab = (LAS int*)(F.lds + LDS_TAB);
    if (F.tid == 0) { int nb = 0;
#pragma unroll 1
        for (int e = 0; e < 32; ++e) { const int c = (int)__hip_atomic_load((unsigned*)(F.ctl + CW_CNT + cofs + l * 32 + e), RLX_AGENT); const int n = (c + 255) >> 8; tab[600 + e] = nb * 256; tab[640 + e] = c;
            for (int b = 0; b < n; ++b) tab[nb + b] = e; nb += n; }
        tab[632] = nb; }
    __syncthreads();
}
__device__ __forceinline__ void t4_phase(Frame& F, int l, int T_l, bool dummy) {
    float* const outp = F.out();
    const bool nextmod = (l + 1 < DEPTH);
    const float* ngain = F.in(I_NORMS) + (size_t)(l + 1 < DEPTH ? l + 1 : l) * 4 * 1024; const float* nmod = (const float*)(F.ws + WS_MOD) + (size_t)(l + 1 < DEPTH ? l + 1 : l) * 3 * 6144; bf16* XN = (bf16*)(F.ws + WS_XN);
    const LAS int* tab = (const LAS int*)(F.lds + LDS_TAB); const int gw = F.bx * 8 + F.wave, NGW = F.G * 8, lane = F.lane;
    const int* rte = (const int*)(F.ws + WS_RTE); const int* rts = (const int*)(F.ws + WS_RTS); const bf16* Yp = (const bf16*)(F.ws + WS_BIG);
    const float* gain = F.in(I_NORMS) + (size_t)l * 4 * 1024 + 3 * 1024; const float* modl = (const float*)(F.ws + WS_MOD) + (size_t)l * 3 * 6144;
    for (int r = gw; r < T_l; r += NGW) { const bool lat = r < TL; const int who = lat ? (r >> 14) : 2; const float* g2 = modl + (size_t)who * 6144 + 5 * 1024;
        float* xrow = lat ? outp + (size_t)r * 1024 : (float*)(F.ws + WS_XC) + (size_t)(r - TL) * 1024;
        float f[16]; int re[4], rs[4];
#pragma unroll
        for (int k = 0; k < 4; ++k) { re[k] = rte[(size_t)r * 4 + k]; rs[k] = rts[(size_t)r * 4 + k]; }
        v4u yr[4][2]; f32x4 xr4[4], gv4[4], mv4[4];
#pragma unroll
        for (int k = 0; k < 4; ++k) { const size_t dst = (size_t)(tab[600 + re[k]] + rs[k]); const v4u* yp = (const v4u*)(Yp + dst * 1024); yr[k][0] = yp[lane]; yr[k][1] = yp[64 + lane]; }
#pragma unroll
        for (int hq = 0; hq < 4; ++hq) { const int d0 = (hq >> 1) * 512 + 8 * lane + 4 * (hq & 1); xr4[hq] = *(const f32x4*)(xrow + d0); gv4[hq] = *(const f32x4*)(gain + d0); mv4[hq] = *(const f32x4*)(g2 + d0); }
        f32x4 ng4[4], ns4[4], nh4[4]; const float* mo = nmod + (size_t)who * 6144;
        if (nextmod) {
#pragma unroll
            for (int hq = 0; hq < 4; ++hq) { const int d0 = (hq >> 1) * 512 + 8 * lane + 4 * (hq & 1); ng4[hq] = *(const f32x4*)(ngain + d0); ns4[hq] = *(const f32x4*)(mo + 1024 + d0); nh4[hq] = *(const f32x4*)(mo + d0); } }
#pragma unroll
        for (int i = 0; i < 16; ++i) f[i] = 0.f;
#pragma unroll
        for (int k = 0; k < 4; ++k) { float a[8], b[8]; unpack8(yr[k][0], a); unpack8(yr[k][1], b);
#pragma unroll
            for (int i = 0; i < 8; ++i) { f[i] += a[i]; f[8 + i] += b[i]; } }
        float ss = 0.f;
#pragma unroll
        for (int i = 0; i < 16; ++i) ss += f[i] * f[i];
        const float rstd = __builtin_amdgcn_rsqf(wave_sum(ss) * (1.f / DM) + RMS_EPS);
        float ssn = 0.f;
#pragma unroll
        for (int hq = 0; hq < 4; ++hq) { const int d0 = (hq >> 1) * 512 + 8 * lane + 4 * (hq & 1); f32x4 xv = xr4[hq];
#pragma unroll
            for (int i = 0; i < 4; ++i) { xv[i] += mv4[hq][i] * (f[hq * 4 + i] * rstd * gv4[hq][i]); f[hq * 4 + i] = xv[i]; ssn += xv[i] * xv[i]; }
            *(f32x4*)((dummy ? (float*)(F.ws + WS_MERGE) + (size_t)r * 1024 : xrow) + d0) = xv; }
        if (nextmod) { const float rstdn = __builtin_amdgcn_rsqf(wave_sum(ssn) * (1.f / DM) + RMS_EPS);
#pragma unroll
            for (int h = 0; h < 2; ++h) { float y[8];
#pragma unroll
                for (int q = 0; q < 2; ++q) { const int hq = h * 2 + q;
#pragma unroll
                    for (int i = 0; i < 4; ++i) y[q * 4 + i] = f[hq * 4 + i] * rstdn * ng4[hq][i] * (1.f + ns4[hq][i]) + nh4[hq][i]; }
                *(v4u*)(XN + (size_t)r * 1024 + h * 512 + 8 * lane) = pack8(y); } } }
}

#ifndef PH_MASK
#define PH_MASK 0xFFFFFFFFu
#endif
#define PH(k) ((PH_MASK >> (k)) & 1u)
#ifndef PH_TWICE
#define PH_TWICE 0u
#endif
#define REP(k) _Pragma("unroll") for (int rep_ = 0; rep_ < (((PH_TWICE >> (k)) & 1u) ? 2 : 1); ++rep_)
__global__ void __launch_bounds__(512, 2) fwd_kernel(Args A) {
    extern __shared__ __attribute__((aligned(16))) unsigned char lds[];
    Frame F;
    F.lds = (LAS unsigned char*)lds; F.MISC = (volatile LAS unsigned*)(F.lds + MISC_OFF);
    F.tid = threadIdx.x; F.lane = F.tid & 63; F.wave = __builtin_amdgcn_readfirstlane(F.tid >> 6);
    F.G = gridDim.x; F.bx = blockIdx.x; F.ws = (unsigned char*)(GAS unsigned char*)(unsigned long long)(uintptr_t)A.ws; F.ctl = (gu32*)(A.ws + WS_CTL);
    int vcu = (F.G % 8 == 0) ? (F.bx % 8) * (F.G / 8) + F.bx / 8 : F.bx;
    if (F.tid < 64) F.MISC[F.tid] = 0u;
    __syncthreads();
    XcdBarrier bar = xcd_barrier_post((unsigned*)(F.ctl + CW_BAR), F.MISC + 8);
#define GRID_BAR() do { { unsigned* bp_ = (unsigned*)(F.ctl + CW_BAR); unsigned x_ = bar.x; asm volatile("" : "+s"(bp_), "+s"(x_)); bar.bar = bp_; bar.x = x_; } xcd_barrier(bar); \
        { int t_ = threadIdx.x; asm volatile("" : "+v"(t_)); F.tid = t_; F.lane = t_ & 63; unsigned long long w_ = (unsigned long long)(uintptr_t)A.ws; int g_ = gridDim.x, b_ = blockIdx.x; asm volatile("" : "+s"(w_), "+s"(g_), "+s"(b_)); \
          F.ws = (unsigned char*)(GAS unsigned char*)w_; ws = F.ws; F.ctl = (gu32*)(w_ + WS_CTL * 1ull); F.G = g_; F.bx = b_; vcu = (g_ % 8 == 0) ? (b_ % 8) * (g_ / 8) + b_ / 8 : b_; gw = b_ * 8 + F.wave; NGW = g_ * 8; } } while (0)
    int gw = F.bx * 8 + F.wave, NGW = F.G * 8;
    unsigned char* ws = F.ws;

    if (PH(0)) REP(0) p_prologue(F, A);
    GRID_BAR();

#pragma unroll
    for (int l = 0; l < DEPTH; ++l) {
        const int T_l = (l == 0) ? TA : TL;

        if (PH(1) && l == 0) REP(1) { const float* xin_lat = (l == 0) ? F.in(I_X) : F.out(); const float* xin_ctx = (l == 0) ? F.in(I_CTX) : (const float*)(ws + WS_XC);
          const float* norms = F.in(I_NORMS) + (size_t)l * 4 * 1024; const float* modl = (const float*)(ws + WS_MOD) + (size_t)l * 3 * 6144;
          for (int r = gw; r < TA; r += NGW) { const bool lat = r < TL; const int who = lat ? (r >> 14) : 2; const float* mo = modl + (size_t)who * 6144;
            mod_row_to_bf16(lat ? xin_lat + (size_t)r * 1024 : xin_ctx + (size_t)(r - TL) * 1024, norms, mo + 1024, mo, (bf16*)(ws + WS_XN) + (size_t)r * 1024, F.lane); } }
        if (l == 0) GRID_BAR();

        if (PH(2)) REP(2) { pg8::Gemm g{(const bf16*)(ws + WS_XN), (const bf16*)(ws + WS_WIN) + (size_t)l * ZW * 1024, TA, ZW, 1024}; pg8::StaticOrder S; S.init(TA, ZW, F.G, F.bx);
          pg8::EpiInproj E{ws, F.in(I_QKN) + (size_t)l * 128, F.in(I_MQN) + (size_t)l * 256, F.in(I_MKVN) + (size_t)l * 128, (LAS float*)(F.lds + LDS_X)};
          pg8::gemm_phase<pg8::EpiInproj, pg8::StaticOrder, true, true>(F.lds + RING_OFF, g, S, E); }
        GRID_BAR();

        if (PH(4)) REP(4) { pg8::Gemm g{(const bf16*)(ws + WS_CQN), (const bf16*)(ws + WS_WUQ) + (size_t)l * 768 * 256, T_l, 768, 256}; pg8::StaticOrder S; S.init(T_l, 768, F.G, F.bx);
          pg8::EpiUq E{(bf16*)(ws + WS_QM), (const float*)(ws + WS_COSM), (const float*)(ws + WS_SINM)};
          pg8::gemm_phase<pg8::EpiUq, pg8::StaticOrder, true, true>(F.lds + RING_OFF, g, S, E); }
        if (PH(5)) REP(5) { pg8::Gemm g{(const bf16*)(ws + WS_CKVN), (const bf16*)(ws + WS_WUKV) + (size_t)l * 1024 * 128, TA, 1024, 128}; pg8::StaticOrder S; S.init(TA, 1024, F.G, (F.bx + F.G / 2) % F.G);
          pg8::EpiUkv E{(bf16*)(ws + WS_KM), (bf16*)(ws + WS_VM)};
          pg8::gemm_phase<pg8::EpiUkv, pg8::StaticOrder, true, true>(F.lds + RING_OFF, g, S, E); }
        if (PH(6)) REP(6) { const float* gbs = F.in(I_GBS); const float* gvn = F.in(I_GVN); for (int hu = (F.bx + F.G / 4) % F.G; hu < 2 * (T_l / 128); hu += F.G) gmlp_unit(F, gbs, gvn, l, hu >> 1, hu & 1); }
        GRID_BAR();

        { const int per = (1024 + F.G - 1) / F.G; char* shm = (char*)lds + RING_OFF;
          if (PH(7)) REP(7) for (int i = 0; i <= per; ++i) { size_t row0; int b, h, nt, t0;
              if (i < per) { const int L = vcu * per + i; if (L >= 1024) continue; const int bh = L >> 6, qb = L & 63; b = bh >> 3; h = bh & 7; row0 = (size_t)b * SEQ + (size_t)qb * 256; t0 = 0; nt = NTILE; }
              else { if (l != 0 || F.bx >= 16) continue; const int bh = F.bx; b = bh >> 3; h = bh & 7; row0 = (size_t)TL + (size_t)b * CTX; t0 = SEQ / 64; nt = CTX / 64; }
              attn_body::attn_unit<4, 512, 128, 128, 512, 8, false, false>((const bf16*)(ws + WS_QG) + row0 * 512 + h * 64, (const bf16*)(ws + WS_KG) + ((size_t)(b * 2 + (h >> 2)) * NTILE + t0) * 4096, (const bf16*)(ws + WS_VG) + ((size_t)(b * 2 + (h >> 2)) * NTILE + t0) * 4096,
                                                             (bf16*)(ws + WS_OG) + row0 * 512 + h * 64, nt, shm); }
          if (PH(8)) REP(8) for (int i = 0; i <= per; ++i) { size_t row0; int b, h, nt, t0;
              if (i < per) { const int L = vcu * per + i; if (L >= 1024) continue; const int bh = L >> 6, qb = L & 63; b = bh >> 3; h = bh & 7; row0 = (size_t)b * SEQ + (size_t)qb * 256; t0 = 0; nt = NTILE; }
              else { if (l != 0 || F.bx < 16 || F.bx >= 32) continue; const int bh = F.bx - 16; b = bh >> 3; h = bh & 7; row0 = (size_t)TL + (size_t)b * CTX; t0 = SEQ / 64; nt = CTX / 64; }
              attn_body::attn_unit<6, 768, 768, 512, 512, 8, false, false>((const bf16*)(ws + WS_QM) + row0 * 768 + h * 96, (const bf16*)(ws + WS_KM) + ((size_t)(b * 8 + h) * NTILE + t0) * 6144, (const bf16*)(ws + WS_VM) + ((size_t)(b * 8 + h) * NTILE + t0) * 4096,
                                                             (bf16*)(ws + WS_OM) + row0 * 512 + h * 64, nt, shm); } }
        GRID_BAR();

        if (PH(10)) REP(10) { pg8::StaticOrder S; S.init(T_l, 1024, F.G, F.bx); const bf16* wbr = (const bf16*)(ws + WS_WBR) + (size_t)l * 3 * 1024 * 512;
          { pg8::Gemm g{(const bf16*)(ws + WS_OG), wbr, T_l, 1024, 512}; pg8::EpiBranch<0> E{(const bf16*)(ws + WS_BIG), (bf16*)(ws + WS_MERGEB)};
            pg8::gemm_phase<pg8::EpiBranch<0>, pg8::StaticOrder, true, true>(F.lds + RING_OFF, g, S, E); }
          { pg8::Gemm g{(const bf16*)(ws + WS_OM), wbr + (size_t)1024 * 512, T_l, 1024, 512}; pg8::EpiBranch<1> E{(const bf16*)(ws + WS_BIG), (bf16*)(ws + WS_MERGEB)};
            pg8::gemm_phase<pg8::EpiBranch<1>, pg8::StaticOrder, true, true>(F.lds + RING_OFF, g, S, E); }
          { pg8::Gemm g{(const bf16*)(ws + WS_GM), wbr + (size_t)2 * 1024 * 512, T_l, 1024, 512}; pg8::EpiBranch<2> E{(const bf16*)(ws + WS_BIG), (bf16*)(ws + WS_MERGEB)};
            pg8::gemm_phase<pg8::EpiBranch<2>, pg8::StaticOrder, true, true>(F.lds + RING_OFF, g, S, E); } }
        GRID_BAR();

        if (PH(11)) REP(11) { pg8::Gemm g{(const bf16*)(ws + WS_MERGEB), (const bf16*)(ws + WS_WOUT) + (size_t)l * 1024 * 1024, T_l, 1024, 1024}; pg8::StaticOrder S; S.init(T_l, 1024, F.G, F.bx);
          pg8::EpiPlain E{(bf16*)(ws + WS_Y), 1024};
          pg8::gemm_phase<pg8::EpiPlain, pg8::StaticOrder, true, true>(F.lds + RING_OFF, g, S, E); }
        GRID_BAR();

        if (PH(12)) REP(12) { const float* xin_lat = (l == 0) ? F.in(I_X) : F.out(); const float* xin_ctx = (l == 0) ? F.in(I_CTX) : (const float*)(ws + WS_XC); t3_phase(F, l, T_l, xin_lat, xin_ctx, (((PH_TWICE >> 12) & 1u) && rep_ == 0) ? 64 : 0, ((PH_TWICE >> 12) & 1u) && rep_ == 0); }
        GRID_BAR();

        moe_tables(F, l, 0);

        if (PH(14)) REP(14) { const LAS int* tab = (const LAS int*)(F.lds + LDS_TAB); const int nblk = __builtin_amdgcn_readfirstlane(tab[632]);
          LAS int* rowtok = (LAS int*)(F.lds + LDS_ROWTOK);
          { const int* ltok = (const int*)(ws + WS_LTOK); const int nun = nblk * 8;
            int tk[10];
#pragma unroll
            for (int jj = 0; jj < 10; ++jj) { const int idx = F.tid + 512 * jj; const int i = idx >> 8, r = idx & 255; const long L = (long)i * F.G + vcu; tk[jj] = -1;
                if (L < nun) { const int blk = (int)(L >> 3), e = tab[blk], slot = blk * 256 + r - tab[600 + e]; if (slot < tab[640 + e]) tk[jj] = ltok[(size_t)e * TA + slot]; } }
#pragma unroll
            for (int jj = 0; jj < 10; ++jj) rowtok[F.tid + 512 * jj] = tk[jj] < 0 ? 0 : tk[jj];
            __syncthreads(); }
          pg8::Gemm g{(const bf16*)(ws + WS_XN), (const bf16*)(ws + WS_W1) + (size_t)l * 32 * 2048 * 1024, TA, 32 * 2048, 1024};
          pg8::MoeOrder<8> S{nblk * 8, F.G, vcu, tab, rowtok}; pg8::EpiMoe1 E{(bf16*)(ws + WS_H), F.in(I_EB1) + (size_t)l * 32 * 2048};
          pg8::gemm_phase<pg8::EpiMoe1, pg8::MoeOrder<8>, true, true, true>(F.lds + RING_OFF, g, S, E); }
        GRID_BAR();

        if (PH(15)) REP(15) { const LAS int* tab = (const LAS int*)(F.lds + LDS_TAB); const int nblk = __builtin_amdgcn_readfirstlane(tab[632]);
          pg8::Gemm g{(const bf16*)(ws + WS_H), (const bf16*)(ws + WS_W2) + (size_t)l * 32 * 1024 * 1024, MOE_ROWS, 32 * 1024, 1024};
          pg8::MoeOrder<4> S{nblk * 4, F.G, vcu, tab, tab}; pg8::EpiMoe2 E{(bf16*)(ws + WS_BIG), F.in(I_EB2) + (size_t)l * 32 * 1024, (const float*)(ws + WS_LW), tab};
          pg8::gemm_phase<pg8::EpiMoe2, pg8::MoeOrder<4>, true, true>(F.lds + RING_OFF, g, S, E); }
        GRID_BAR();

        if (PH(16)) REP(16) t4_phase(F, l, T_l, ((PH_TWICE >> 16) & 1u) && rep_ == 0);
        GRID_BAR();
    }
#undef GRID_BAR
}

extern "C" void kernel_launch(void* const* d_in, const int* in_sizes, int n_in, void* d_out, int out_size, void* d_ws, size_t ws_size, hipStream_t stream) {
    static int grid = 0;
    if (grid == 0) {
        if (n_in != 24 || out_size != TL * DM || ws_size < WS_END) { fprintf(stderr, "kernel_launch: unexpected problem: n_in %d out %d ws %zu (need %zu)\n", n_in, out_size, ws_size, (size_t)WS_END); grid = -1; return; }
        int dev = 0, cus = 0;
        if (hipGetDevice(&dev) != hipSuccess || hipDeviceGetAttribute(&cus, hipDeviceAttributeMultiprocessorCount, dev) != hipSuccess) { grid = -1; return; }
        if (hipFuncSetAttribute((const void*)fwd_kernel, hipFuncAttributeMaxDynamicSharedMemorySize, LDS_BYTES) != hipSuccess) { fprintf(stderr, "kernel_launch: hipFuncSetAttribute failed\n"); grid = -1; return; }
        int per_cu = 0;
        if (hipOccupancyMaxActiveBlocksPerMultiprocessor(&per_cu, (const void*)fwd_kernel, 512, LDS_BYTES) != hipSuccess || per_cu < 1) fprintf(stderr, "kernel_launch: occupancy query reports %d\n", per_cu);
        (void)hipGetLastError();
        grid = cus > 256 ? 256 : cus;
    }
    if (grid < 0) return;
    if (hipMemsetAsync((char*)d_ws + WS_CTL, 0, CTL_ZERO_BYTES, stream) != hipSuccess) return;
    Args a{};
    for (int i = 0; i < 24; ++i) a.in[i] = (const float*)d_in[i];
    a.out = (float*)d_out; a.ws = (unsigned char*)d_ws;
    hipLaunchKernelGGL(fwd_kernel, dim3(grid), dim3(512), LDS_BYTES, stream, a);
}
```

```cpp
#include <hip/hip_runtime.h>
#include <cstdio>
#include <cstdint>

typedef unsigned short bf16;

constexpr int DM = 1024, NBATCH = 2, SEQ = 16384, CTX = 256, DEPTH = 2;
constexpr int TL = NBATCH * SEQ;
constexpr int TC = NBATCH * CTX;
constexpr int TA = TL + TC;
constexpr int KPB = SEQ + CTX;
constexpr int KR = NBATCH * KPB;
constexpr int ZW = 5376;
constexpr int Z_Q = 0, Z_K = 512, Z_V = 640, Z_CQ = 768, Z_CKV = 1024, Z_KR = 1152, Z_U = 1280, Z_VG = 1792, Z_GATE = 2304;
constexpr int NEXP = 32, TOPK = 4, DEXP = 1024, MOE_ROWS = 552 * 256;
constexpr float RMS_EPS = 1e-6f;
constexpr float LOG2E = 1.4426950408889634f;
constexpr float C2G = 0.125f * LOG2E;
constexpr float C2M = 0.10206207261596577f * LOG2E;

constexpr size_t MiB = 1u << 20;
constexpr size_t WS_CTL = 0, CTL_ZERO_BYTES = 128 * 1024;
constexpr size_t WS_MOD = 1 * MiB;
constexpr size_t WS_PTAB = 1 * MiB + 512 * 1024;
constexpr size_t WS_COSG = 2 * MiB, WS_SING = 4 * MiB, WS_COSM = 6 * MiB, WS_SINM = 7 * MiB;
constexpr size_t WS_WS = 8 * MiB;
constexpr size_t WS_RWT = 8 * MiB + 512 * 1024;
constexpr size_t WS_SSV = 1 * MiB + 640 * 1024;
static_assert(WS_SSV + (size_t)TA * 2 * 4 <= 2 * MiB && WS_RWT + (size_t)DEPTH * 2 * 32 * 1024 * 2 <= 9 * MiB, "ws map small regions");
constexpr size_t WS_WUQ = 9 * MiB;
constexpr size_t WS_WUKV = 10 * MiB;
constexpr size_t WS_WBR = 11 * MiB;
constexpr size_t WS_WOUT = 17 * MiB;
constexpr size_t WS_WIN = 21 * MiB;
constexpr size_t WS_W1 = 42 * MiB;
constexpr size_t WS_W2 = 298 * MiB;
constexpr size_t WS_XC = 426 * MiB;
constexpr size_t WS_RTE = 428 * MiB;
constexpr size_t WS_RTS = 429 * MiB;
constexpr size_t WS_LTOK = 430 * MiB;
constexpr size_t WS_LW = 435 * MiB;
constexpr size_t WS_XN = 441 * MiB;
constexpr size_t WS_QG = 506 * MiB;
constexpr size_t WS_KG = 539 * MiB;
constexpr size_t WS_VG = 548 * MiB;
constexpr size_t WS_CQN = 557 * MiB;
constexpr size_t WS_CKVN = 574 * MiB;
constexpr size_t WS_QM = 583 * MiB;
constexpr size_t WS_KM = 632 * MiB;
constexpr size_t WS_VM = 681 * MiB;
constexpr size_t WS_OG = 714 * MiB;
constexpr size_t WS_OM = 747 * MiB;
constexpr size_t WS_GM = 780 * MiB;
constexpr size_t WS_UACT = 813 * MiB;
constexpr size_t WS_VN = 846 * MiB;
constexpr size_t WS_MERGE = 879 * MiB;
constexpr size_t WS_MERGEB = 1009 * MiB;
constexpr size_t WS_Y = 1074 * MiB;
constexpr size_t WS_H = 1139 * MiB;
constexpr size_t WS_BIG = 1415 * MiB;
constexpr size_t WS_END = 1757 * MiB;
static_assert(WS_BIG + (size_t)TA * ZW * 2 <= WS_END && WS_BIG + (size_t)MOE_ROWS * 1024 * 2 <= WS_END && WS_H + (size_t)MOE_ROWS * 1024 * 2 <= WS_BIG, "ws map");
static_assert(WS_W1 + (size_t)DEPTH * 32 * 2048 * 1024 * 2 <= WS_W2 && WS_W2 + (size_t)DEPTH * 32 * 1024 * 1024 * 2 <= WS_XC, "ws map weights");
static_assert(WS_MERGE + (size_t)TA * 1024 * 4 <= WS_MERGEB && WS_XN + (size_t)TA * 1024 * 2 <= WS_QG && WS_QM + (size_t)TA * 768 * 2 <= WS_KM, "ws map acts");
constexpr int CW_BAR = 4096;
constexpr int CW_CNT = 16384;
static_assert((CW_CNT + 256) * 4 <= (int)CTL_ZERO_BYTES && (CW_BAR + 3456) * 4 <= (int)CTL_ZERO_BYTES, "control words inside the per-call memset");

constexpr int RING_OFF = 0, RING_BYTES = 131072;
constexpr int LDS_X = RING_BYTES + 4096;
constexpr int LDS_SVEC = LDS_X;
constexpr int LDS_ROWTOK = LDS_X;
constexpr int MISC_OFF = 159744;
constexpr int LDS_TAB = 160000;
constexpr int LDS_BYTES = 163840;
static_assert(LDS_SVEC + 3 * 1024 * 4 <= MISC_OFF && LDS_ROWTOK + 20 * 1024 <= MISC_OFF && LDS_TAB + 704 * 4 <= LDS_BYTES, "LDS map");

#define GAS __attribute__((address_space(1)))
#define LAS __attribute__((address_space(3)))
typedef unsigned v4u __attribute__((ext_vector_type(4)));
typedef float f32x4 __attribute__((ext_vector_type(4)));
typedef GAS unsigned gu32;
#define RLX_AGENT __ATOMIC_RELAXED, __HIP_MEMORY_SCOPE_AGENT
#define LDS_WAIT() asm volatile("s_waitcnt lgkmcnt(0)" ::: "memory")
#define VM_WAIT() asm volatile("s_waitcnt vmcnt(0)" ::: "memory")

__device__ __forceinline__ unsigned cvt_pk(float lo, float hi) { unsigned r; asm volatile("v_cvt_pk_bf16_f32 %0, %1, %2" : "=v"(r) : "v"(lo), "v"(hi)); return r; }
__device__ __forceinline__ float bf_lo(unsigned u) { return __uint_as_float(u << 16); }
__device__ __forceinline__ float bf_hi(unsigned u) { return __uint_as_float(u & 0xffff0000u); }
__device__ __forceinline__ void unpack8(v4u r, float (&f)[8]) { f[0] = bf_lo(r.x); f[1] = bf_hi(r.x); f[2] = bf_lo(r.y); f[3] = bf_hi(r.y); f[4] = bf_lo(r.z); f[5] = bf_hi(r.z); f[6] = bf_lo(r.w); f[7] = bf_hi(r.w); }
__device__ __forceinline__ v4u pack8(const float (&f)[8]) { v4u o; o.x = cvt_pk(f[0], f[1]); o.y = cvt_pk(f[2], f[3]); o.z = cvt_pk(f[4], f[5]); o.w = cvt_pk(f[6], f[7]); return o; }
__device__ __forceinline__ float sigmoidf_(float x) { return __builtin_amdgcn_rcpf(1.f + __builtin_amdgcn_exp2f(-LOG2E * x)); }
__device__ __forceinline__ float wave_sum(float v) {
#pragma unroll
    for (int o = 1; o < 64; o <<= 1) v += __shfl_xor(v, o);
    return v;
}
__device__ __forceinline__ float gelu_tanh(float x) { const float u = 1.5957691216057308f * (x + 0.044715f * x * x * x); return x * __builtin_amdgcn_rcpf(1.f + __builtin_amdgcn_exp2f(-LOG2E * u)); }
constexpr int NTILE = KPB / 64;
__device__ __forceinline__ void bpos_of(int r, int& b, int& pos) { if (r < TL) { b = r >> 14; pos = r & (SEQ - 1); } else { b = (r - TL) >> 8; pos = SEQ + ((r - TL) & (CTX - 1)); } }
__device__ __forceinline__ size_t ktile_off(int strm, int pos, int chunk, int nch) { return (((size_t)strm * NTILE + (pos >> 6)) * nch + chunk) * 512 + (size_t)(pos & 63) * 8; }
__device__ __forceinline__ size_t vtile_off(int strm, int pos, int d) { const int piece = (d >> 5) * 4 + ((pos & 63) >> 4), ln = (pos & 15) * 4 + ((d >> 3) & 3); return (((size_t)strm * NTILE + (pos >> 6)) * 8 + piece) * 512 + (size_t)ln * 8; }
__device__ __forceinline__ int krow_of(int r) { return r < TL ? (r >> 14) * KPB + (r & (SEQ - 1)) : ((r - TL) >> 8) * KPB + SEQ + ((r - TL) & (CTX - 1)); }

__device__ const float INVF16[16] = {1.0f, 0.5623413324356079f, 0.3162277638912201f, 0.17782793939113617f, 0.10000000149011612f, 0.05623413249850273f, 0.03162277489900589f, 0.017782794311642647f,
                                     0.009999999776482582f, 0.005623413249850273f, 0.003162277629598975f, 0.0017782794311642647f, 0.0010000000474974513f, 0.000562341301701963f, 0.0003162277571391314f, 0.00017782794020604342f};
namespace pg8 {
#define PG8_LAS __attribute__((address_space(3)))
typedef unsigned short bf16_t;
typedef short bf16x8 __attribute__((ext_vector_type(8)));
typedef float f32x4 __attribute__((ext_vector_type(4)));
typedef unsigned u32x4 __attribute__((ext_vector_type(4)));
constexpr int BM = 256, BK = 64, HALF = 128, HTB = HALF * BK * 2  , STAGE_BYTES = 8 * HTB, NXCD = 8, WGM = 8;

__host__ __device__ __forceinline__ int lds_byte(int r, int c) { const int st = (r >> 4) * 2 + (c >> 5), rr = r & 15, cc = c & 31, ob = rr * 64 + cc * 2; return st * 1024 + (ob ^ (((ob >> 9) & 1) << 5)); }
__host__ __device__ __forceinline__ void stage_rc(int b, int& R, int& C) { const int st = b / 1024, sb = b % 1024, swz = sb ^ (((sb >> 9) & 1) << 5); R = (st >> 1) * 16 + swz / 64; C = (st & 1) * 32 + (swz % 64) / 2; }
__host__ __device__ __forceinline__ int perm32(int rho) { const int n = rho >> 4, i = rho & 15; return 8 * (i >> 2) + 4 * n + (i & 3); }

struct Unit { int pm, pn; };
struct Gemm { const bf16_t* A; const bf16_t* Bt; int M, N, K; };

struct StaticOrder {
    int nM, nN, nwg, G, c;
    __device__ void init(int M, int N, int G_, int c_) { asm volatile("" : "+s"(M), "+s"(N));
        nM = M / BM; nN = N / BM; nwg = nM * nN; G = G_; c = c_; }
    __host__ __device__ bool next(int i, Unit& u) const {
        const long L = (long)i * G + c; if (L >= nwg) return false;
        int wgid = (int)L; { const int q = nwg / NXCD, r = nwg % NXCD, xcd = wgid % NXCD, off = wgid / NXCD; wgid = (xcd < r ? xcd * (q + 1) : r * (q + 1) + (xcd - r) * q) + off; }
        const int nig = WGM * nN, gid = wgid / nig, fm = gid * WGM, gsz = (nM - fm) < WGM ? (nM - fm) : WGM;
        u.pm = fm + ((wgid % nig) % gsz); u.pn = (wgid % nig) / gsz; return true;
    }
    __device__ __forceinline__ void a_ready(const Unit&) const {}
    __device__ __forceinline__ void done(const Unit&) const {}
};

template <class Epi, class Sched, bool ALIGN_EPI = false, bool SP2 = false, bool GATHER = false>
__device__ __forceinline__ void gemm_phase(PG8_LAS unsigned char* lds, const Gemm g, const Sched& S, const Epi& E) {
    static_assert(!GATHER || SP2, "GATHER is implemented for the SP2 loop only");
    int tid_ = threadIdx.x; asm volatile("" : "+v"(tid_));
    const int tid = tid_, wid = __builtin_amdgcn_readfirstlane(tid >> 6), lane = tid & 63, wr = wid >> 2, wc = wid & 3, fr = lane & 15, fq = lane >> 4;
    int K_ = g.K; asm volatile("" : "+s"(K_));
    const int K = K_, nt = K / BK;
    unsigned voffA[2], voffB[2];
#pragma unroll
    for (int i = 0; i < 2; ++i) { int R, C; stage_rc(tid * 16 + i * 8192, R, C); const int Rb = Epi::PERM ? ((R & ~31) + perm32(R & 31)) : R;
        voffA[i] = (unsigned)(R * K + C) * 2u; voffB[i] = (unsigned)(Rb * K + C) * 2u; }
    unsigned vAc0[2] = {0u, 0u}, vAc1[2] = {0u, 0u}, vAn0[2] = {0u, 0u}, vAn1[2] = {0u, 0u}, vsel0[2] = {0u, 0u}, vsel1[2] = {0u, 0u};
#define PG8_GOFF(dst0, dst1, uidx) do { _Pragma("unroll") for (int i_ = 0; i_ < 2; ++i_) { int R_, C_; stage_rc(tid * 16 + i_ * 8192, R_, C_); \
        dst0[i_] = ((unsigned)S.tok((uidx), R_) * (unsigned)K + (unsigned)C_) * 2u; dst1[i_] = ((unsigned)S.tok((uidx), HALF + R_) * (unsigned)K + (unsigned)C_) * 2u; } } while (0)
#define PG8_STG_A(bufoff, base, H, SEL) do { if constexpr (GATHER) { if (SEL) { PG8_STAGE(bufoff, base, vsel##H); } else { PG8_STAGE(bufoff, base, vAc##H); } } else { PG8_STAGE(bufoff, (base) + (H) * hstep, voffA); } } while (0)
    const size_t kstep = (size_t)(BK * 2);
    const size_t hstep = (size_t)HALF * K * 2;
    const size_t tstep = 2 * hstep;
    const unsigned ldsw = (unsigned)wid * 1024u;
    const int aoff = lds_byte(wr * 64 + fr, fq * 8), boff = lds_byte(wc * 32 + fr, fq * 8);
#define PG8_SA(b, h) (((b) * 2 + (h)) * HTB)
#define PG8_SB(b, h) ((4 + (b) * 2 + (h)) * HTB)
#define PG8_STAGE(bufoff, gbase, voff) do { _Pragma("unroll") for (int _i = 0; _i < 2; ++_i) \
        __builtin_amdgcn_global_load_lds((const unsigned*)((const char*)(gbase) + (voff)[_i]), (PG8_LAS unsigned*)(lds + (bufoff) + ldsw + _i * 8192), 16, 0, 0); } while (0)
#define PG8_LDA(dst, b, h) do { _Pragma("unroll") for (int m = 0; m < 4; ++m) _Pragma("unroll") for (int k = 0; k < 2; ++k) dst[m][k] = *(const PG8_LAS bf16x8*)(lds + PG8_SA(b, h) + aoff + m * 2048 + k * 1024); } while (0)
#define PG8_LDB(dst, b, h) do { _Pragma("unroll") for (int n = 0; n < 2; ++n) _Pragma("unroll") for (int k = 0; k < 2; ++k) dst[n][k] = *(const PG8_LAS bf16x8*)(lds + PG8_SB(b, h) + boff + n * 2048 + k * 1024); } while (0)
#define PG8_MMA(ai, bj, At, Bt) do { __builtin_amdgcn_s_setprio(1); _Pragma("unroll") for (int m = 0; m < 4; ++m) _Pragma("unroll") for (int n = 0; n < 2; ++n) _Pragma("unroll") for (int k = 0; k < 2; ++k) \
        acc[ai][bj][m][n] = __builtin_amdgcn_mfma_f32_16x16x32_bf16(Bt[n][k], At[m][k], acc[ai][bj][m][n], 0, 0, 0); __builtin_amdgcn_s_setprio(0); } while (0)
#define PG8_WAIT_V(n) asm volatile("s_waitcnt vmcnt(" #n ")" ::: "memory")
#define PG8_WAIT_L(n) asm volatile("s_waitcnt lgkmcnt(" #n ")" ::: "memory")
#define PG8_BAR __builtin_amdgcn_s_barrier()
#define PG8_SCHED __builtin_amdgcn_sched_barrier(0)
    Unit cur, nxt; int ui = 0;
    if (!S.next(0, cur)) return;
    f32x4 acc[2][2][4][2];
#pragma unroll
    for (int a = 0; a < 2; ++a)
#pragma unroll
        for (int b = 0; b < 2; ++b)
#pragma unroll
            for (int m = 0; m < 4; ++m)
#pragma unroll
                for (int n = 0; n < 2; ++n) acc[a][b][m][n] = (f32x4){0.f, 0.f, 0.f, 0.f};
    bf16x8 At[4][2], B0[2][2], B1[2][2];
    const char* cA = GATHER ? (const char*)g.A : (const char*)g.A + (size_t)cur.pm * tstep; const char* cB = (const char*)g.Bt + (size_t)cur.pn * tstep;
    if constexpr (GATHER) { PG8_GOFF(vAc0, vAc1, 0); }
    S.a_ready(cur);
    if constexpr (SP2) {
        PG8_STAGE(PG8_SB(0, 0), cB, voffB); PG8_STAGE(PG8_SB(0, 1), cB + hstep, voffB); PG8_STG_A(PG8_SA(0, 0), cA, 0, false); PG8_STG_A(PG8_SA(0, 1), cA, 1, false);
        if (wr == 1) PG8_BAR;
        PG8_WAIT_V(2); PG8_BAR;
        PG8_STAGE(PG8_SB(1, 0), cB + kstep, voffB); PG8_STG_A(PG8_SA(1, 0), cA + kstep, 0, false); PG8_STAGE(PG8_SB(1, 1), cB + hstep + kstep, voffB);
        PG8_WAIT_V(6); PG8_BAR;
    } else {
        PG8_STAGE(PG8_SB(0, 0), cB, voffB); PG8_STAGE(PG8_SA(0, 0), cA, voffA); PG8_STAGE(PG8_SB(0, 1), cB + hstep, voffB); PG8_STAGE(PG8_SA(0, 1), cA + hstep, voffA);
        if (wr == 1) PG8_BAR;
        PG8_WAIT_V(4); PG8_BAR;
        PG8_STAGE(PG8_SB(1, 0), cB + kstep, voffB); PG8_STAGE(PG8_SA(1, 0), cA + kstep, voffA); PG8_STAGE(PG8_SB(1, 1), cB + hstep + kstep, voffB);
        PG8_WAIT_V(6); PG8_BAR;
    }
    for (;;) {
        const bool has_next = S.next(ui + 1, nxt);
        const char* nA = GATHER ? (const char*)g.A : (has_next ? (const char*)g.A + (size_t)nxt.pm * tstep : cA);
        if constexpr (GATHER) { if (has_next) { PG8_GOFF(vAn0, vAn1, ui + 1); } else { vAn0[0] = vAc0[0]; vAn0[1] = vAc0[1]; vAn1[0] = vAc1[0]; vAn1[1] = vAc1[1]; } } const char* nB = has_next ? (const char*)g.Bt + (size_t)nxt.pn * tstep : cB;
        for (int t = 0; t < nt; t += 2) {
            const bool last = (t == nt - 2);
            const char* a1 = cA + (size_t)(t + 1) * kstep;
            const char* a2 = last ? nA : cA + (size_t)(t + 2) * kstep; const char* b2 = last ? nB : cB + (size_t)(t + 2) * kstep;
            const char* a3 = a2 + kstep; const char* b3 = b2 + kstep;
            if (last && has_next) S.a_ready(nxt);
            if constexpr (GATHER) { vsel0[0] = last ? vAn0[0] : vAc0[0]; vsel0[1] = last ? vAn0[1] : vAc0[1]; vsel1[0] = last ? vAn1[0] : vAc1[0]; vsel1[1] = last ? vAn1[1] : vAc1[1]; }
            if constexpr (SP2) {
            PG8_LDB(B0, 0, 0); PG8_LDB(B1, 0, 1); PG8_SCHED; PG8_LDA(At, 0, 0); PG8_STG_A(PG8_SA(1, 1), a1, 1, false);
            PG8_WAIT_V(8); PG8_WAIT_L(0); PG8_BAR; PG8_MMA(0, 0, At, B0); PG8_MMA(0, 1, At, B1); PG8_BAR; PG8_SCHED;
            PG8_LDA(At, 0, 1); PG8_STAGE(PG8_SB(0, 0), b2, voffB); PG8_STAGE(PG8_SB(0, 1), b2 + hstep, voffB); PG8_STG_A(PG8_SA(0, 0), a2, 0, true);
            PG8_WAIT_V(8); PG8_WAIT_L(0); PG8_BAR; PG8_MMA(1, 0, At, B0); PG8_MMA(1, 1, At, B1); PG8_BAR; PG8_SCHED;
            PG8_LDB(B0, 1, 0); PG8_LDB(B1, 1, 1); PG8_SCHED; PG8_LDA(At, 1, 0); PG8_STG_A(PG8_SA(0, 1), a2, 1, true);
            PG8_WAIT_V(8); PG8_WAIT_L(0); PG8_BAR; PG8_MMA(0, 0, At, B0); PG8_MMA(0, 1, At, B1); PG8_BAR; PG8_SCHED;
            PG8_LDA(At, 1, 1); PG8_STAGE(PG8_SB(1, 0), b3, voffB); PG8_STAGE(PG8_SB(1, 1), b3 + hstep, voffB); PG8_STG_A(PG8_SA(1, 0), a3, 0, true);
            PG8_WAIT_V(8); PG8_WAIT_L(0); PG8_BAR; PG8_MMA(1, 0, At, B0); PG8_MMA(1, 1, At, B1); PG8_BAR; PG8_SCHED;
            } else {
            PG8_LDB(B0, 0, 0); PG8_SCHED; PG8_LDA(At, 0, 0); PG8_STAGE(PG8_SA(1, 1), a1 + hstep, voffA);
            PG8_WAIT_L(8); PG8_BAR; PG8_WAIT_L(0); PG8_MMA(0, 0, At, B0); PG8_BAR; PG8_SCHED;
            PG8_LDB(B1, 0, 1); PG8_STAGE(PG8_SB(0, 0), b2, voffB);
            PG8_BAR; PG8_WAIT_L(0); PG8_MMA(0, 1, At, B1); PG8_BAR;
            PG8_LDA(At, 0, 1); PG8_STAGE(PG8_SA(0, 0), a2, voffA);
            PG8_BAR; PG8_WAIT_L(0); PG8_MMA(1, 0, At, B0); PG8_BAR; PG8_SCHED;
            PG8_STAGE(PG8_SB(0, 1), b2 + hstep, voffB);
            PG8_WAIT_V(6); PG8_BAR; PG8_MMA(1, 1, At, B1); PG8_BAR;
            PG8_LDB(B0, 1, 0); PG8_SCHED; PG8_LDA(At, 1, 0); PG8_STAGE(PG8_SA(0, 1), a2 + hstep, voffA);
            PG8_WAIT_L(8); PG8_BAR; PG8_WAIT_L(0); PG8_MMA(0, 0, At, B0); PG8_BAR; PG8_SCHED;
            PG8_LDB(B1, 1, 1); PG8_STAGE(PG8_SB(1, 0), b3, voffB);
            PG8_BAR; PG8_WAIT_L(0); PG8_MMA(0, 1, At, B1); PG8_BAR;
            PG8_LDA(At, 1, 1); PG8_STAGE(PG8_SA(1, 0), a3, voffA);
            PG8_BAR; PG8_WAIT_L(0); PG8_MMA(1, 0, At, B0); PG8_BAR; PG8_SCHED;
            PG8_STAGE(PG8_SB(1, 1), b3 + hstep, voffB);
            PG8_WAIT_V(6); PG8_BAR; PG8_MMA(1, 1, At, B1); PG8_BAR;
            }
        }
        if constexpr (ALIGN_EPI) { if (wr == 0) PG8_BAR; }
        if constexpr (!Epi::AFTER_DRAIN) { E(acc, cur, wr, wc, fr, fq); S.done(cur); }
        if (!has_next) break;
#pragma unroll
        for (int a = 0; a < 2; ++a)
#pragma unroll
            for (int b = 0; b < 2; ++b)
#pragma unroll
                for (int m = 0; m < 4; ++m)
#pragma unroll
                    for (int n = 0; n < 2; ++n) acc[a][b][m][n] = (f32x4){0.f, 0.f, 0.f, 0.f};
        cur = nxt; cA = nA; cB = nB; ++ui;
        if constexpr (GATHER) { vAc0[0] = vAn0[0]; vAc0[1] = vAn0[1]; vAc1[0] = vAn1[0]; vAc1[1] = vAn1[1]; }
        if constexpr (ALIGN_EPI) { if (wr == 1) PG8_BAR; }
    }
    PG8_WAIT_V(0);
    if constexpr (!ALIGN_EPI) { if (wr == 0) PG8_BAR; }
    PG8_BAR;
    if constexpr (Epi::AFTER_DRAIN) { E.fused(acc, cur, wr, wc, fr, fq, lds, wid, lane); S.done(cur); }
#undef PG8_SA
#undef PG8_SB
#undef PG8_STAGE
#undef PG8_LDA
#undef PG8_LDB
#undef PG8_MMA
#undef PG8_WAIT_V
#undef PG8_WAIT_L
#undef PG8_BAR
#undef PG8_SCHED
#undef PG8_GOFF
#undef PG8_STG_A
}
}
namespace pg8 {
#define EPI_ROWS(u, wr, fr) const int row00 = (u).pm * BM + (wr) * 64 + (fr)
#define EPI_GET8(v, ai, bj, m) float v[8] = {acc[ai][bj][m][0][0], acc[ai][bj][m][0][1], acc[ai][bj][m][0][2], acc[ai][bj][m][0][3], acc[ai][bj][m][1][0], acc[ai][bj][m][1][1], acc[ai][bj][m][1][2], acc[ai][bj][m][1][3]}

struct EpiPlain {
    static constexpr bool PERM = true, AFTER_DRAIN = false;
    bf16_t* O; int ldc;
    __device__ __forceinline__ void operator()(const f32x4 (&acc)[2][2][4][2], const Unit& u, int wr, int wc, int fr, int fq) const {
        asm volatile("" : "+v"(fr), "+v"(fq));
        EPI_ROWS(u, wr, fr); const int col0 = u.pn * BM + wc * 32 + 8 * fq;
#pragma unroll
        for (int ai = 0; ai < 2; ++ai)
#pragma unroll
            for (int m = 0; m < 4; ++m) { bf16_t* rowp = O + (size_t)(row00 + ai * HALF + m * 16) * ldc + col0;
#pragma unroll
                for (int bj = 0; bj < 2; ++bj) { EPI_GET8(v, ai, bj, m); *(u32x4*)(rowp + bj * HALF) = pack8(v); } }
    }
};

struct EpiInproj {
    static constexpr bool PERM = true, AFTER_DRAIN = false;
    unsigned char* ws; const float *qkn, *mqn, *mkvn; PG8_LAS float* xs;
    __device__ __forceinline__ void operator()(const f32x4 (&acc)[2][2][4][2], const Unit& u, int wr, int wc, int fr, int fq) const {
        asm volatile("" : "+v"(fr), "+v"(fq));
        EPI_ROWS(u, wr, fr); const int pn = u.pn; const bool lat = (u.pm * BM) < TL;
        if (pn >= 9) {
            const int col0 = (pn - 9) * BM + wc * 32 + 8 * fq;
#pragma unroll
            for (int ai = 0; ai < 2; ++ai)
#pragma unroll
                for (int m = 0; m < 4; ++m) { bf16_t* rowp = (bf16_t*)(ws + WS_BIG) + (size_t)(row00 + ai * HALF + m * 16) * 3072 + col0;
#pragma unroll
                    for (int bj = 0; bj < 2; ++bj) { EPI_GET8(v, ai, bj, m); *(u32x4*)(rowp + bj * HALF) = pack8(v); } }
        } else if (pn <= 2) {
            if (pn == 2 && wc >= 2) {
#pragma unroll
                for (int ai = 0; ai < 2; ++ai)
#pragma unroll
                    for (int m = 0; m < 4; ++m) { const int row = row00 + ai * HALF + m * 16; int b_, pos_; bpos_of(row, b_, pos_); bf16_t* vb = (bf16_t*)(ws + WS_VG); const int st = b_ * 2 + (wc - 2);
                        EPI_GET8(x1, ai, 0, m); EPI_GET8(x2, ai, 1, m); *(u32x4*)(vb + vtile_off(st, pos_, 8 * fq)) = pack8(x1); *(u32x4*)(vb + vtile_off(st, pos_, 32 + 8 * fq)) = pack8(x2); }
            } else {
                const bool isq = pn < 2; const float* gn = qkn + (isq ? 0 : 64) + 8 * fq;
                const f32x4 ga0 = *(const f32x4*)gn, ga1 = *(const f32x4*)(gn + 4), gb0 = *(const f32x4*)(gn + 32), gb1 = *(const f32x4*)(gn + 36);
                const float g1[8] = {ga0[0], ga0[1], ga0[2], ga0[3], ga1[0], ga1[1], ga1[2], ga1[3]}, g2[8] = {gb0[0], gb0[1], gb0[2], gb0[3], gb1[0], gb1[1], gb1[2], gb1[3]};
                const float sc = isq ? C2G : 1.f;
#pragma unroll
                for (int am = 0; am < 4; ++am) { const int ai = am >> 1, m0 = 2 * (am & 1);
                    f32x4 tc[2][2], ts[2][2];
#pragma unroll
                    for (int mm = 0; mm < 2; ++mm) { const int pos = lat ? ((row00 + ai * HALF + (m0 + mm) * 16) & (SEQ - 1)) : 0; const f32x4* cp = (const f32x4*)((const float*)(ws + WS_COSG) + (size_t)pos * 32 + 8 * fq); const f32x4* sp = (const f32x4*)((const float*)(ws + WS_SING) + (size_t)pos * 32 + 8 * fq);
                        tc[mm][0] = cp[0]; tc[mm][1] = cp[1]; ts[mm][0] = sp[0]; ts[mm][1] = sp[1]; }
#pragma unroll
                    for (int mm = 0; mm < 2; ++mm) { const int m = m0 + mm; const int row = row00 + ai * HALF + m * 16; const f32x4 c0 = tc[mm][0], c1 = tc[mm][1], s0 = ts[mm][0], s1 = ts[mm][1];
                        EPI_GET8(x1, ai, 0, m); EPI_GET8(x2, ai, 1, m); float ss = 0.f;
#pragma unroll
                        for (int i = 0; i < 8; ++i) ss += x1[i] * x1[i] + x2[i] * x2[i];
                        ss += __shfl_xor(ss, 16); ss += __shfl_xor(ss, 32);
                        const float rstd = __builtin_amdgcn_rsqf(ss * (1.f / 64.f) + RMS_EPS); float o1[8], o2[8];
#pragma unroll
                        for (int i = 0; i < 8; ++i) { const float y1 = x1[i] * rstd * g1[i], y2 = x2[i] * rstd * g2[i]; const float c = lat ? (i < 4 ? c0[i & 3] : c1[i & 3]) : 1.f, s = lat ? (i < 4 ? s0[i & 3] : s1[i & 3]) : 0.f;
                            o1[i] = (y1 * c - y2 * s) * sc; o2[i] = (y2 * c + y1 * s) * sc; }
                        if (isq) { bf16_t* p = (bf16_t*)(ws + WS_QG) + (size_t)row * 512 + (4 * pn + wc) * 64 + 8 * fq; *(u32x4*)p = pack8(o1); *(u32x4*)(p + 32) = pack8(o2); }
                        else { int b_, pos_; bpos_of(row, b_, pos_); bf16_t* kb = (bf16_t*)(ws + WS_KG); const int st = b_ * 2 + wc; *(u32x4*)(kb + ktile_off(st, pos_, fq, 8)) = pack8(o1); *(u32x4*)(kb + ktile_off(st, pos_, 4 + fq, 8)) = pack8(o2); } }
                    asm volatile("" ::: "memory"); }
            }
        } else if (pn == 3 || pn == 4 || pn == 7 || pn == 8) {
            const bool vg = pn >= 7; const bool part = (pn == 4) ? (wc < 2) : true;
            float ssr[2][4];
#pragma unroll
            for (int ai = 0; ai < 2; ++ai)
#pragma unroll
                for (int m = 0; m < 4; ++m) { float ss = 0.f;
#pragma unroll
                    for (int bj = 0; bj < 2; ++bj) { EPI_GET8(v, ai, bj, m);
#pragma unroll
                        for (int i = 0; i < 8; ++i) { const float t = vg ? gelu_tanh(v[i]) : v[i]; ss += t * t; } }
                    ss += __shfl_xor(ss, 16); ss += __shfl_xor(ss, 32); ssr[ai][m] = part ? ss : 0.f;
                    if (fq == 0) xs[(ai * HALF + wr * 64 + m * 16 + fr) * 4 + wc] = ssr[ai][m]; }
            asm volatile("s_waitcnt lgkmcnt(0)\n\ts_barrier" ::: "memory");
#pragma unroll
            for (int ai = 0; ai < 2; ++ai)
#pragma unroll
                for (int m = 0; m < 4; ++m) { const f32x4 t = *(const PG8_LAS f32x4*)(xs + (ai * HALF + wr * 64 + m * 16 + fr) * 4); ssr[ai][m] = (t[0] + t[1]) + (t[2] + t[3]); }
            asm volatile("s_waitcnt lgkmcnt(0)\n\ts_barrier" ::: "memory");
            if (pn == 3) {
                const int col0 = wc * 32 + 8 * fq;
#pragma unroll
                for (int ai = 0; ai < 2; ++ai)
#pragma unroll
                    for (int m = 0; m < 4; ++m) { const int row = row00 + ai * HALF + m * 16; const float rstd = __builtin_amdgcn_rsqf(ssr[ai][m] * (1.f / 256.f) + RMS_EPS);
#pragma unroll
                        for (int bj = 0; bj < 2; ++bj) { EPI_GET8(v, ai, bj, m); const int col = col0 + bj * HALF; const f32x4 ga = *(const f32x4*)(mqn + col), gb = *(const f32x4*)(mqn + col + 4);
#pragma unroll
                            for (int i = 0; i < 8; ++i) v[i] *= rstd * (i < 4 ? ga[i] : gb[i - 4]);
                            *(u32x4*)((bf16_t*)(ws + WS_CQN) + (size_t)row * 256 + col) = pack8(v); } }
            } else if (pn == 4) {
                if (wc < 2) {
#pragma unroll
                    for (int ai = 0; ai < 2; ++ai)
#pragma unroll
                        for (int m = 0; m < 4; ++m) { const int row = row00 + ai * HALF + m * 16; const float rstd = __builtin_amdgcn_rsqf(ssr[ai][m] * (1.f / 128.f) + RMS_EPS);
#pragma unroll
                            for (int bj = 0; bj < 2; ++bj) { EPI_GET8(v, ai, bj, m); const int col = wc * 64 + bj * 32 + 8 * fq; const f32x4 ga = *(const f32x4*)(mkvn + col), gb = *(const f32x4*)(mkvn + col + 4);
#pragma unroll
                                for (int i = 0; i < 8; ++i) v[i] *= rstd * (i < 4 ? ga[i] : gb[i - 4]);
                                *(u32x4*)((bf16_t*)(ws + WS_CKVN) + (size_t)row * 128 + col) = pack8(v); } }
                } else if (wc == 2 && fq < 2) {
#pragma unroll
                    for (int ai = 0; ai < 2; ++ai)
#pragma unroll
                        for (int m = 0; m < 4; ++m) { const int row = row00 + ai * HALF + m * 16; const int pos = row & (SEQ - 1);
                            EPI_GET8(x1, ai, 0, m); EPI_GET8(x2, ai, 1, m); float o1[8], o2[8];
                            if (lat) { const f32x4* cp = (const f32x4*)((const float*)(ws + WS_COSM) + (size_t)pos * 16 + 8 * fq); const f32x4* sp = (const f32x4*)((const float*)(ws + WS_SINM) + (size_t)pos * 16 + 8 * fq); const f32x4 c0 = cp[0], c1 = cp[1], s0 = sp[0], s1 = sp[1];
#pragma unroll
                                for (int i = 0; i < 8; ++i) { const float c = i < 4 ? c0[i] : c1[i - 4], s = i < 4 ? s0[i] : s1[i - 4]; o1[i] = x1[i] * c - x2[i] * s; o2[i] = x2[i] * c + x1[i] * s; } }
                            else {
#pragma unroll
                                for (int i = 0; i < 8; ++i) { o1[i] = x1[i]; o2[i] = x2[i]; } }
                            const u32x4 p1 = pack8(o1), p2 = pack8(o2); int b_, pos_; bpos_of(row, b_, pos_); bf16_t* kb = (bf16_t*)(ws + WS_KM);
#pragma unroll
                            for (int h = 0; h < 8; ++h) { *(u32x4*)(kb + ktile_off(b_ * 8 + h, pos_, 8 + fq, 12)) = p1; *(u32x4*)(kb + ktile_off(b_ * 8 + h, pos_, 10 + fq, 12)) = p2; } }
                }
            } else {
                const int half = pn - 7, col0 = half * BM + wc * 32 + 8 * fq;
#pragma unroll
                for (int ai = 0; ai < 2; ++ai)
#pragma unroll
                    for (int m = 0; m < 4; ++m) { const int row = row00 + ai * HALF + m * 16;
#pragma unroll
                        for (int bj = 0; bj < 2; ++bj) { EPI_GET8(v, ai, bj, m);
#pragma unroll
                            for (int i = 0; i < 8; ++i) v[i] = gelu_tanh(v[i]);
                            *(u32x4*)((bf16_t*)(ws + WS_VN) + (size_t)row * 512 + col0 + bj * HALF) = pack8(v); }
                        if (wc == 0 && fq == 0) ((float*)(ws + WS_SSV))[(size_t)row * 2 + half] = ssr[ai][m]; }
            }
        } else {
            const int col0 = (pn - 5) * BM + wc * 32 + 8 * fq;
#pragma unroll
            for (int ai = 0; ai < 2; ++ai)
#pragma unroll
                for (int m = 0; m < 4; ++m) { const int row = row00 + ai * HALF + m * 16;
#pragma unroll
                    for (int bj = 0; bj < 2; ++bj) { EPI_GET8(v, ai, bj, m);
#pragma unroll
                        for (int i = 0; i < 8; ++i) v[i] = gelu_tanh(v[i]);
                        *(u32x4*)((bf16_t*)(ws + WS_UACT) + (size_t)row * 512 + col0 + bj * HALF) = pack8(v); } }
        }
    }
};

struct EpiUq {
    static constexpr bool PERM = true, AFTER_DRAIN = false;
    bf16_t* Qm; const float* cosM; const float* sinM;
    __device__ __forceinline__ void operator()(const f32x4 (&acc)[2][2][4][2], const Unit& u, int wr, int wc, int fr, int fq) const {
        asm volatile("" : "+v"(fr), "+v"(fq));
        EPI_ROWS(u, wr, fr);
        if (u.pn < 2) {
#pragma unroll
            for (int ai = 0; ai < 2; ++ai)
#pragma unroll
                for (int m = 0; m < 4; ++m) { const int row = row00 + ai * HALF + m * 16;
#pragma unroll
                    for (int bj = 0; bj < 2; ++bj) { const int col = u.pn * BM + bj * HALF + wc * 32 + 8 * fq; const int head = col >> 6, d = col & 63;
                        EPI_GET8(v, ai, bj, m);
#pragma unroll
                        for (int i = 0; i < 8; ++i) v[i] *= C2M;
                        *(u32x4*)(Qm + (size_t)row * 768 + head * 96 + d) = pack8(v); } asm volatile("" ::: "memory"); }
        } else {
            const int cc = wc * 32 + 8 * fq, hh = cc >> 4, j0 = cc & 15;
            const bool lat = (u.pm * BM) < TL;
#pragma unroll
            for (int ai = 0; ai < 2; ++ai) {
                f32x4 tc[4][2], ts[4][2];
#pragma unroll
                for (int m = 0; m < 4; ++m) { const int pos = lat ? ((row00 + ai * HALF + m * 16) & (SEQ - 1)) : 0; const f32x4* cp = (const f32x4*)(cosM + (size_t)pos * 16 + j0); const f32x4* sp = (const f32x4*)(sinM + (size_t)pos * 16 + j0);
                    tc[m][0] = cp[0]; tc[m][1] = cp[1]; ts[m][0] = sp[0]; ts[m][1] = sp[1]; }
#pragma unroll
                for (int m = 0; m < 4; ++m) { const int row = row00 + ai * HALF + m * 16;
                    EPI_GET8(x1, ai, 0, m); EPI_GET8(x2, ai, 1, m);
                    float cs[8], sn[8];
#pragma unroll
                    for (int i = 0; i < 8; ++i) { cs[i] = lat ? tc[m][i >> 2][i & 3] : 1.f; sn[i] = lat ? ts[m][i >> 2][i & 3] : 0.f; }
                    float o1[8], o2[8];
#pragma unroll
                    for (int i = 0; i < 8; ++i) { o1[i] = (x1[i] * cs[i] - x2[i] * sn[i]) * C2M; o2[i] = (x2[i] * cs[i] + x1[i] * sn[i]) * C2M; }
                    bf16_t* qp = Qm + (size_t)row * 768 + hh * 96 + 64 + j0;
                    *(u32x4*)(qp) = pack8(o1); *(u32x4*)(qp + 16) = pack8(o2); }
                asm volatile("" ::: "memory"); }
        }
    }
};

struct EpiUkv {
    static constexpr bool PERM = true, AFTER_DRAIN = false;
    bf16_t* Km; bf16_t* Vm;
    __device__ __forceinline__ void operator()(const f32x4 (&acc)[2][2][4][2], const Unit& u, int wr, int wc, int fr, int fq) const {
        asm volatile("" : "+v"(fr), "+v"(fq));
        EPI_ROWS(u, wr, fr); const int within = wc * 32 + 8 * fq;
#pragma unroll
        for (int ai = 0; ai < 2; ++ai)
#pragma unroll
            for (int m = 0; m < 4; ++m) { const int row = row00 + ai * HALF + m * 16; int b_, pos_; bpos_of(row, b_, pos_);
#pragma unroll
                for (int bj = 0; bj < 2; ++bj) { const int head = u.pn * 2 + bj; EPI_GET8(v, ai, bj, m);
                    bf16_t* p = (within < 64) ? (Km + ktile_off(b_ * 8 + head, pos_, within >> 3, 12)) : (Vm + vtile_off(b_ * 8 + head, pos_, within - 64));
                    *(u32x4*)p = pack8(v); } asm volatile("" ::: "memory"); }
    }
};

template <int IDX> struct EpiBranch {
    static constexpr bool PERM = true, AFTER_DRAIN = false;
    const bf16_t* Z; bf16_t* MERGEB;
    __device__ __forceinline__ void operator()(const f32x4 (&acc)[2][2][4][2], const Unit& u, int wr, int wc, int fr, int fq) const {
        asm volatile("" : "+v"(fr), "+v"(fq));
        EPI_ROWS(u, wr, fr); const int col0 = u.pn * BM + wc * 32 + 8 * fq;
#pragma unroll
        for (int ai = 0; ai < 2; ++ai) {
            u32x4 gr[4][2], mr[4][2];
#pragma unroll
            for (int m = 0; m < 4; ++m) { const int row = row00 + ai * HALF + m * 16;
#pragma unroll
                for (int bj = 0; bj < 2; ++bj) { const int col = col0 + bj * HALF; gr[m][bj] = *(const u32x4*)(Z + (size_t)row * 3072 + IDX * 1024 + col);
                    if (IDX != 0) mr[m][bj] = *(const u32x4*)(MERGEB + (size_t)row * 1024 + col); } }
#pragma unroll
            for (int m = 0; m < 4; ++m) { const int row = row00 + ai * HALF + m * 16;
#pragma unroll
                for (int bj = 0; bj < 2; ++bj) { const int col = col0 + bj * HALF; EPI_GET8(v, ai, bj, m); float g[8], a[8], r[8]; unpack8(gr[m][bj], g);
                    if (IDX != 0) unpack8(mr[m][bj], a);
#pragma unroll
                    for (int i = 0; i < 8; ++i) r[i] = (IDX != 0 ? a[i] : 0.f) + sigmoidf_(g[i]) * v[i];
                    *(u32x4*)(MERGEB + (size_t)row * 1024 + col) = pack8(r); } }
            asm volatile("" ::: "memory"); }
    }
};

struct EpiMoe1 {
    static constexpr bool PERM = true, AFTER_DRAIN = false;
    bf16_t* H; const float* b1;
    __device__ __forceinline__ void operator()(const f32x4 (&acc)[2][2][4][2], const Unit& u, int wr, int wc, int fr, int fq) const {
        asm volatile("" : "+v"(fr), "+v"(fq));
        EPI_ROWS(u, wr, fr); const int e = u.pn >> 3, pnl = u.pn & 7, cc = pnl * 128 + wc * 32 + 8 * fq;
        const float* bp = b1 + (size_t)e * 2048 + cc;
        const f32x4 bg0 = *(const f32x4*)bp, bg1 = *(const f32x4*)(bp + 4), bl0 = *(const f32x4*)(bp + 1024), bl1 = *(const f32x4*)(bp + 1028);
        float lim = 7.0f; asm volatile("" : "+v"(lim));
#pragma unroll
        for (int ai = 0; ai < 2; ++ai)
#pragma unroll
            for (int m = 0; m < 4; ++m) { const int row = row00 + ai * HALF + m * 16;
                EPI_GET8(g, ai, 0, m); EPI_GET8(l, ai, 1, m); float r[8];
#pragma unroll
                for (int i = 0; i < 8; ++i) { float glu = g[i] + (i < 4 ? bg0[i] : bg1[i - 4]); float lin = l[i] + (i < 4 ? bl0[i] : bl1[i - 4]);
                    glu = fminf(glu, lim); lin = fminf(fmaxf(lin, -lim), lim);
                    r[i] = glu * sigmoidf_(1.702f * glu) * (lin + 1.0f); }
                *(u32x4*)(H + (size_t)row * 1024 + cc) = pack8(r); }
    }
};

struct EpiMoe2 {
    static constexpr bool PERM = true, AFTER_DRAIN = false;
    bf16_t* Yp; const float* b2; const float* lw; const PG8_LAS int* tab;
    __device__ __forceinline__ void operator()(const f32x4 (&acc)[2][2][4][2], const Unit& u, int wr, int wc, int fr, int fq) const {
        asm volatile("" : "+v"(fr), "+v"(fq));
        EPI_ROWS(u, wr, fr); const int e = u.pn >> 2, pnl = u.pn & 3, col0 = pnl * BM + wc * 32 + 8 * fq;
        f32x4 bv[2][2];
#pragma unroll
        for (int bj = 0; bj < 2; ++bj) { bv[bj][0] = *(const f32x4*)(b2 + (size_t)e * 1024 + col0 + bj * HALF); bv[bj][1] = *(const f32x4*)(b2 + (size_t)e * 1024 + col0 + bj * HALF + 4); }
        float wrow[2][4]; { const int ps_ = tab[600 + e], cn_ = tab[640 + e];
#pragma unroll
            for (int ai = 0; ai < 2; ++ai)
#pragma unroll
                for (int m = 0; m < 4; ++m) { const int slot = row00 + ai * HALF + m * 16 - ps_; wrow[ai][m] = lw[(size_t)e * TA + (slot < cn_ ? slot : 0)]; if (slot >= cn_) wrow[ai][m] = 0.f; } }
#pragma unroll
        for (int ai = 0; ai < 2; ++ai)
#pragma unroll
            for (int m = 0; m < 4; ++m) { const int row = row00 + ai * HALF + m * 16; const float w = wrow[ai][m];
#pragma unroll
                for (int bj = 0; bj < 2; ++bj) { EPI_GET8(v, ai, bj, m); float r[8];
#pragma unroll
                    for (int i = 0; i < 8; ++i) r[i] = (v[i] + (i < 4 ? bv[bj][0][i] : bv[bj][1][i - 4])) * w;
                    *(u32x4*)(Yp + (size_t)row * 1024 + col0 + bj * HALF) = pack8(r); } }
    }
};

template <int NPN> struct MoeOrder {
    int nunits, G, v; const PG8_LAS int* tab; const PG8_LAS int* rowtok;
    __device__ __forceinline__ int tok(int i, int r) const { return rowtok[i * 256 + r]; }
    __device__ __forceinline__ bool next(int i, Unit& u) const {
        const long L = (long)i * G + v; if (L >= nunits) return false;
        const int blk = (int)L / NPN, pnl = (int)L % NPN; const int e = __builtin_amdgcn_readfirstlane(tab[blk]);
        u.pm = blk; u.pn = e * NPN + pnl; return true;
    }
    __device__ __forceinline__ void a_ready(const Unit&) const {}
    __device__ __forceinline__ void done(const Unit&) const {}
};
}
namespace attn_body {
using bf16x8=__attribute__((ext_vector_type(8)))short;
using s16x4=__attribute__((ext_vector_type(4)))short;
using f32x16=__attribute__((ext_vector_type(16)))float;
using u32x4=__attribute__((ext_vector_type(4)))unsigned;
constexpr int NW=8,QBLK=32,QB=QBLK*NW,KVBLK=64;
__device__ __forceinline__ int crow(int r,int hi){return (r&3)+8*(r>>2)+4*hi;}
#define SBAR() __builtin_amdgcn_sched_barrier(0)
constexpr int NSLOT=3, SLOTB=8192;
__device__ __forceinline__ void glds16(const void*gsrc,unsigned lds_dst){unsigned keep;
  asm volatile("s_mov_b32 %0, m0\n\ts_mov_b32 m0, %2\n\ts_nop 0\n\tglobal_load_lds_dwordx4 %1, off\n\ts_mov_b32 m0, %0":"=&s"(keep):"v"(gsrc),"s"(lds_dst):"memory");}
__device__ __forceinline__ float max3f(float a,float b,float c){float r;asm("v_max3_f32 %0, %1, %2, %3":"=v"(r):"v"(a),"v"(b),"v"(c));return r;}
__device__ __forceinline__ float max2f(float a,float b){float r;asm("v_max_f32_e32 %0, %1, %2":"=v"(r):"v"(a),"v"(b));return r;}
__device__ __forceinline__ float fadd_s(float a,float b){float r;asm("v_add_f32_e32 %0, %1, %2":"=v"(r):"v"(a),"v"(b));return r;}
__device__ __forceinline__ float fsub_s(float a,float b){float r;asm("v_sub_f32_e32 %0, %1, %2":"=v"(r):"v"(a),"v"(b));return r;}
typedef float f32x2_t __attribute__((ext_vector_type(2))); typedef __bf16 bf16x2_t __attribute__((ext_vector_type(2)));
__device__ __forceinline__ unsigned cvtpk_s(float lo,float hi){f32x2_t v={lo,hi};bf16x2_t b=__builtin_convertvector(v,bf16x2_t);return __builtin_bit_cast(unsigned,b);}
#define WAIT_BAR(N) asm volatile("s_waitcnt vmcnt(" #N ") lgkmcnt(0)\n\ts_barrier":::"memory")
typedef __attribute__((address_space(3))) const char* lds_cptr;
typedef short v4i16_t __attribute__((ext_vector_type(4)));
__device__ __forceinline__ void kload2(bf16x8*kf,lds_cptr kp,int j){ kf[2*j]=*(const __attribute__((address_space(3))) bf16x8*)(kp+j*2048); kf[2*j+1]=*(const __attribute__((address_space(3))) bf16x8*)(kp+j*2048+512); }
__device__ __forceinline__ s16x4 vtr(lds_cptr p){ return __builtin_bit_cast(s16x4,__builtin_amdgcn_ds_read_tr16_b64_v4i16((__attribute__((address_space(3))) v4i16_t*)p)); }
__device__ __forceinline__ float rowmax(const f32x16&p0,const f32x16&p1){
  float a=max3f(p0[0],p0[1],p1[0]),b=max3f(p0[2],p0[3],p1[1]);a=max3f(a,p1[2],p1[3]);
  #pragma unroll
  for(int r=4;r<16;r+=4){a=max3f(a,p0[r],p0[r+1]);b=max3f(b,p0[r+2],p0[r+3]);a=max3f(a,p1[r],p1[r+1]);b=max3f(b,p1[r+2],p1[r+3]);}
  const float m=max2f(a,b);
  auto rr=__builtin_amdgcn_permlane32_swap(__float_as_uint(m),__float_as_uint(m),false,false);
  return max2f(__uint_as_float(rr[0]),__uint_as_float(rr[1]));
}
__device__ __forceinline__ void pv(f32x16*o,int vb,bf16x8 pa0,bf16x8 pa1,bf16x8 pa2,bf16x8 pa3){
  #pragma unroll
  for(int d0=0;d0<2;++d0){s16x4 lo[4],hi[4];
    #pragma unroll
    for(int ks=0;ks<4;++ks){
      asm volatile("ds_read_b64_tr_b16 %0,%1 offset:%c2":"=&v"(lo[ks]):"v"(vb),"i"(d0*4096+ks*1024):"memory");
      asm volatile("ds_read_b64_tr_b16 %0,%1 offset:%c2":"=&v"(hi[ks]):"v"(vb),"i"(d0*4096+ks*1024+512):"memory");}
    asm volatile("s_waitcnt lgkmcnt(0)":::"memory");SBAR();
    #define PK(k) (bf16x8){lo[k][0],lo[k][1],lo[k][2],lo[k][3],hi[k][0],hi[k][1],hi[k][2],hi[k][3]}
    o[d0]=__builtin_amdgcn_mfma_f32_32x32x16_bf16(pa0,PK(0),o[d0],0,0,0);
    o[d0]=__builtin_amdgcn_mfma_f32_32x32x16_bf16(pa1,PK(1),o[d0],0,0,0);
    o[d0]=__builtin_amdgcn_mfma_f32_32x32x16_bf16(pa2,PK(2),o[d0],0,0,0);
    o[d0]=__builtin_amdgcn_mfma_f32_32x32x16_bf16(pa3,PK(3),o[d0],0,0,0);
    #undef PK
  }
}
template<int NKS> struct AttnLds {
  static constexpr int SLOTK=NKS*2048;
  static constexpr int LDS_K=0, LDS_V=NSLOT*SLOTK, LDS_WS=LDS_V+NSLOT*SLOTB, LDS_OST=LDS_WS+NW*64*4, LDS_BYTES=LDS_OST+NW*4096;
};
template<int NKS,int QP,int KP,int VP,int OP,int THRL,bool LS,bool SK>
__device__ __forceinline__ void attn_unit(const bf16*Qu,const bf16*__restrict__ Ku,const bf16*__restrict__ Vu,bf16*Ou,const int NT,char*shm){
  using L=AttnLds<NKS>;
  constexpr int SLOTK=L::SLOTK, LDS_K=L::LDS_K, LDS_V=L::LDS_V, LDS_WS=L::LDS_WS, LDS_OST=L::LDS_OST;
  int tid_=threadIdx.x; asm volatile("":"+v"(tid_));
  const int tid=tid_,lane=tid&63,r32=lane&31,hi=lane>>5; const int wid=__builtin_amdgcn_readfirstlane(tid>>6);
  const bf16*Qw=Qu+(long)(wid*QBLK)*QP;
  const unsigned lds0=(unsigned)(uintptr_t)shm;
  float*wsf=(float*)(shm+LDS_WS)+wid*64;
  const bf16*ksrc=Ku+wid*512+lane*8;
  const bf16*ksrc2=Ku+(8+(wid&3))*512+lane*8;
  const bf16*vsrc=Vu+wid*512+lane*8;
  const unsigned kdst=lds0+LDS_K+wid*1024, kdst2=lds0+LDS_K+(8+(wid&3))*1024, vdst=lds0+LDS_V+wid*1024;
  #define DMA_K(t,slot) do{ glds16(ksrc+(long)(t)*(NKS*1024),(unsigned)__builtin_amdgcn_readfirstlane(kdst+(slot))); \
      if constexpr(NKS==6){ glds16(ksrc2+(long)(t)*(NKS*1024),(unsigned)__builtin_amdgcn_readfirstlane(kdst2+(slot))); } }while(0)
  #define DMA_V(t,slot) glds16(vsrc+(long)(t)*4096,(unsigned)__builtin_amdgcn_readfirstlane(vdst+(slot)))
  #define WAIT_C()  do{ if constexpr(NKS==6){WAIT_BAR(3);}else{WAIT_BAR(2);} }while(0)
  #define WAIT_P()  do{ if constexpr(NKS==6){WAIT_BAR(5);}else{WAIT_BAR(3);} }while(0)
  #define WAITA_K() do{ if constexpr(NKS==6){WAIT_BAR(2);}else{WAIT_BAR(1);} }while(0)
  #define BARONLY() asm volatile("s_barrier":::"memory")
  const int vb0=(int)(lds0+LDS_V)+((lane>>4)&1)*32+(lane&3)*8+(4*hi+((lane&15)>>2))*64;
  const char*Kbase=shm+LDS_K; bf16x8 kf[2*NKS];
  const lds_cptr shm3=(lds_cptr)shm; const lds_cptr kp0=shm3+LDS_K+hi*1024+r32*16; const lds_cptr vp0=shm3+LDS_V+((lane>>4)&1)*32+(lane&3)*8+(4*hi+((lane&15)>>2))*64;
  DMA_K(0,0);DMA_V(0,0);DMA_K(1,SLOTK);
  bf16x8 qr[NKS];
  #pragma unroll
  for(int d0=0;d0<NKS;++d0)qr[d0]=*reinterpret_cast<const bf16x8*>(&Qw[(long)r32*QP+d0*16+hi*8]);
  float mhat=0.f,l_reg=0.f;f32x16 o[2];o[0]=f32x16{};o[1]=f32x16{};f32x16 negm=f32x16{};asm volatile("":"+v"(negm));
  f32x16 o2=f32x16{}; const bf16x8 ONES=(bf16x8){(short)0x3F80,(short)0x3F80,(short)0x3F80,(short)0x3F80,(short)0x3F80,(short)0x3F80,(short)0x3F80,(short)0x3F80};
  bool resc=false;
  #define START(P0,P1) do{ const float rm=rowmax(P0,P1); resc=false; \
    { const float dl=rm; mhat=fadd_s(mhat,dl); \
      _Pragma("unroll") for(int r=0;r<16;++r){P0[r]=fsub_s(P0[r],dl);P1[r]=fsub_s(P1[r],dl);} \
      _Pragma("unroll") for(int r=0;r<16;++r)negm[r]=-mhat; asm volatile("":"+v"(negm)); } \
    _Pragma("unroll") for(int r=0;r<16;++r)P0[r]=__builtin_amdgcn_exp2f(P0[r]); }while(0)
  #define RESC() do{ if(resc){ asm volatile("s_waitcnt lgkmcnt(0)":::"memory"); \
      _Pragma("unroll") for(int d_=0;d_<2;++d_) _Pragma("unroll") for(int r=0;r<16;++r)o[d_][r]*=wsf[crow(r,hi)]; \
      if constexpr(LS){ _Pragma("unroll") for(int r=0;r<16;++r)o2[r]*=wsf[crow(r,hi)]; } } }while(0)
  f32x16 pA0,pA1,pB0,pB1;
  int kl_cur=0,kl_next=SLOTK;
  int sl_prev=0,sl_cur=0,sl_next=SLOTB;
  #define ROT() do{sl_prev=sl_cur;sl_cur=sl_next;sl_next=(sl_next==(NSLOT-1)*SLOTB)?0:sl_next+SLOTB; kl_cur=kl_next;kl_next=(kl_next==(NSLOT-1)*SLOTK)?0:kl_next+SLOTK;}while(0)
  DMA_K(2,2*SLOTK);
  WAIT_P();
  { const char*kb=Kbase+hi*1024+r32*16;
    #pragma unroll
    for(int d0=0;d0<NKS;++d0){
      const bf16x8 b0=*reinterpret_cast<const bf16x8*>(kb+d0*2048);
      const bf16x8 b1=*reinterpret_cast<const bf16x8*>(kb+d0*2048+512);
      if(d0==0){pA0=__builtin_amdgcn_mfma_f32_32x32x16_bf16(b0,qr[0],negm,0,0,0);pA1=__builtin_amdgcn_mfma_f32_32x32x16_bf16(b1,qr[0],negm,0,0,0);}
      else{pA0=__builtin_amdgcn_mfma_f32_32x32x16_bf16(b0,qr[d0],pA0,0,0,0);pA1=__builtin_amdgcn_mfma_f32_32x32x16_bf16(b1,qr[d0],pA1,0,0,0);}} }
  asm volatile("s_nop 15\n\ts_nop 7":"+v"(pA0),"+v"(pA1));
  START(pA0,pA1);
  _Pragma("unroll") for(int r=0;r<16;++r)pA1[r]=__builtin_amdgcn_exp2f(pA1[r]);
  WAIT_BAR(0);
  if constexpr(SK){ DMA_V(1,SLOTB);DMA_K(3,0); } else { DMA_K(3,0);DMA_V(1,SLOTB); }
  ROT();
  _Pragma("unroll") for(int j=0;j<NKS;++j)kload2(kf,kp0+kl_cur,j);
  WAIT_C();
  if constexpr(SK){ if(wid>=4){ BARONLY(); } }
  s16x4 vlo[8],vhi[8]; u32x4 pw0,pw1,pw2,pw3;
  #define PKW(P,B) cvtpk_s(P[B],P[B+1])
  #define PAF(k) __builtin_bit_cast(bf16x8,pw##k)
  #define VFR(i) (bf16x8){vlo[i][0],vlo[i][1],vlo[i][2],vlo[i][3],vhi[i][0],vhi[i][1],vhi[i][2],vhi[i][3]}
  #define PIN(x) asm volatile("":"+v"(x))
  #define MX3(a,b,c) __builtin_fmaxf(__builtin_fmaxf((a),(b)),(c))
  #define GAPA(MF,A0,A1,A2,A3,W0,W1,PW) do{ MF; if constexpr(!LS){ sacc+=A0; sacc+=A1; sacc+=A2; sacc+=A3; PIN(sacc); } W0; W1; PIN(PW); SBAR(); }while(0)
  #define LSM(k) do{ if constexpr(LS){ o2=MF32(PAF(k),ONES,o2); SBAR(); } }while(0)
  #define EX(v) __builtin_amdgcn_exp2f(v)
  #define GAPB(MF,X,B) do{ MF; X[B]=EX(X[B]); X[B+1]=EX(X[B+1]); X[B+2]=EX(X[B+2]); X[B+3]=EX(X[B+3]); PIN(X); SBAR(); }while(0)
  #define VRD(i) do{ vlo[i]=vtr(vp_+(((i)>>2)*4096+((i)&3)*1024)); vhi[i]=vtr(vp_+(((i)>>2)*4096+((i)&3)*1024+512)); }while(0)
  #define KRD(G,j) do{ if(G){ kload2(kf,kp0+kl_next,j); SBAR(); } }while(0)
  #define MF32(a,b,c) __builtin_amdgcn_mfma_f32_32x32x16_bf16(a,b,c,0,0,0)
  #define STEP(C0,C1,P0,P1,t,GK,GV,GL,CK,MW) do{ SBAR(); \
    const lds_cptr vp_=vp0+sl_prev; \
    VRD(0); SBAR(); float sacc=LS?0.f:(P0[0]+P0[1]); \
    GAPA(C0=MF32(kf[0],qr[0],negm), P0[2],P0[3],P0[4],P0[5],     pw0[0]=PKW(P0,0), pw0[1]=PKW(P0,2), pw0); \
    VRD(4); SBAR(); GAPA(C1=MF32(kf[1],qr[0],negm), P0[6],P0[7],P0[8],P0[9],     pw0[2]=PKW(P0,4), pw0[3]=PKW(P0,6), pw0); \
    VRD(1); SBAR(); GAPA(C0=MF32(kf[2],qr[1],C0),   P0[10],P0[11],P0[12],P0[13], pw1[0]=PKW(P0,8), pw1[1]=PKW(P0,10), pw1); \
    VRD(5); SBAR(); GAPA(C1=MF32(kf[3],qr[1],C1),   P0[14],P0[15],P1[0],P1[1],   pw1[2]=PKW(P0,12),pw1[3]=PKW(P0,14), pw1); \
    VRD(2); SBAR(); GAPA(C0=MF32(kf[4],qr[2],C0),   P1[2],P1[3],P1[4],P1[5],     pw2[0]=PKW(P1,0), pw2[1]=PKW(P1,2), pw2); \
    VRD(6); SBAR(); GAPA(C1=MF32(kf[5],qr[2],C1),   P1[6],P1[7],P1[8],P1[9],     pw2[2]=PKW(P1,4), pw2[3]=PKW(P1,6), pw2); \
    VRD(3); SBAR(); GAPA(C0=MF32(kf[6],qr[3],C0),   P1[10],P1[11],P1[12],P1[13], pw3[0]=PKW(P1,8), pw3[1]=PKW(P1,10), pw3); \
    VRD(7); SBAR(); GAPA(C1=MF32(kf[7],qr[3],C1),   P1[14],P1[15],0.f,0.f,       pw3[2]=PKW(P1,12),pw3[3]=PKW(P1,14), pw3); \
    if constexpr(NKS==6){ C0=MF32(kf[8],qr[4],C0); SBAR(); C1=MF32(kf[9],qr[4],C1); SBAR(); C0=MF32(kf[10],qr[5],C0); SBAR(); C1=MF32(kf[11],qr[5],C1); SBAR(); } \
    if constexpr(!LS){ l_reg+=sacc; } \
    if constexpr(SK){ MW; if(GV){DMA_V((t)+1,sl_next);} if(GK){DMA_K((t)+3,kl_cur);} } else { if(GK){DMA_K((t)+3,kl_cur);} if(GV){DMA_V((t)+1,sl_next);} } \
    if(CK){ float a=MX3(C0[0],C0[1],C1[0]),b=MX3(C0[2],C0[3],C1[1]); a=MX3(a,C1[2],C1[3]); \
      _Pragma("unroll") for(int r=4;r<16;r+=4){a=MX3(a,C0[r],C0[r+1]);b=MX3(b,C0[r+2],C0[r+3]);a=MX3(a,C1[r],C1[r+1]);b=MX3(b,C1[r+2],C1[r+3]);} \
      float rm=__builtin_fmaxf(a,b); { auto rr=__builtin_amdgcn_permlane32_swap(__float_as_uint(rm),__float_as_uint(rm),false,false); rm=__builtin_fmaxf(__uint_as_float(rr[0]),__uint_as_float(rr[1])); } \
      resc=false; \
      if(__builtin_expect(__any(rm>(float)THRL),0)){ const float dl=__builtin_fmaxf(rm,0.f); mhat+=dl; \
        _Pragma("unroll") for(int r=0;r<16;++r){C0[r]-=dl;C1[r]-=dl;} \
        _Pragma("unroll") for(int r=0;r<16;++r)negm[r]=-mhat; asm volatile("":"+v"(negm)); \
        const float f=__builtin_amdgcn_exp2f(-dl); l_reg*=f; if(hi==0)wsf[r32]=f; resc=true; } } else { resc=false; } \
    SBAR(); \
    GAPB(o[0]=MF32(PAF(0),VFR(0),o[0]), C0,0); \
    GAPB(o[1]=MF32(PAF(0),VFR(4),o[1]), C0,4); LSM(0); \
    KRD(GL,0); GAPB(o[0]=MF32(PAF(1),VFR(1),o[0]), C0,8); \
    KRD(GL,1); GAPB(o[1]=MF32(PAF(1),VFR(5),o[1]), C0,12); LSM(1); \
    KRD(GL,2); GAPB(o[0]=MF32(PAF(2),VFR(2),o[0]), C1,0); \
    KRD(GL,3); GAPB(o[1]=MF32(PAF(2),VFR(6),o[1]), C1,4); LSM(2); \
    if constexpr(NKS==6){ KRD(GL,4); } GAPB(o[0]=MF32(PAF(3),VFR(3),o[0]), C1,8); \
    if constexpr(NKS==6){ KRD(GL,5); } GAPB(o[1]=MF32(PAF(3),VFR(7),o[1]), C1,12); LSM(3); \
    }while(0)
  int t=1;
  for(;t+11<NT;t+=8){
    STEP(pB0,pB1,pA0,pA1,t,true,true,true,true,WAITA_K());      WAIT_C(); RESC(); ROT();
    STEP(pA0,pA1,pB0,pB1,t+1,true,true,true,false,WAITA_K());   WAIT_C(); ROT();
    STEP(pB0,pB1,pA0,pA1,t+2,true,true,true,false,WAITA_K());   WAIT_C(); ROT();
    STEP(pA0,pA1,pB0,pB1,t+3,true,true,true,false,WAITA_K());   WAIT_C(); ROT();
    STEP(pB0,pB1,pA0,pA1,t+4,true,true,true,false,WAITA_K());   WAIT_C(); ROT();
    STEP(pA0,pA1,pB0,pB1,t+5,true,true,true,false,WAITA_K());   WAIT_C(); ROT();
    STEP(pB0,pB1,pA0,pA1,t+6,true,true,true,false,WAITA_K());   WAIT_C(); ROT();
    STEP(pA0,pA1,pB0,pB1,t+7,true,true,true,false,WAITA_K());   WAIT_C(); ROT();
  }
  for(;t+5<NT;t+=2){
    STEP(pB0,pB1,pA0,pA1,t,true,true,true,true,WAITA_K());     WAIT_C(); RESC(); ROT();
    STEP(pA0,pA1,pB0,pB1,t+1,true,true,true,true,WAITA_K());   WAIT_C(); RESC(); ROT();
  }
  #define ENDW(tt) do{ if constexpr(SK){ if((tt)+3<NT){WAIT_C();} else if((tt)+1<NT){WAIT_BAR(1);} else {WAIT_BAR(0);} } \
                       else { if((tt)+3<NT){WAIT_C();} else if((tt)+2<NT){WAIT_BAR(1);} else {WAIT_BAR(0);} } }while(0)
  #define ENDA(tt) do{ if((tt)+2<NT){WAITA_K();} else {WAIT_BAR(0);} }while(0)
  for(;t+1<NT;t+=2){
    STEP(pB0,pB1,pA0,pA1,t,(t+3<NT),(t+1<NT),(t+1<NT),true,ENDA(t));         ENDW(t);   RESC(); ROT();
    STEP(pA0,pA1,pB0,pB1,t+1,(t+4<NT),(t+2<NT),(t+2<NT),true,ENDA(t+1));     ENDW(t+1); RESC(); ROT();
  }
  STEP(pB0,pB1,pA0,pA1,NT-1,false,false,false,true,WAIT_BAR(0)); if constexpr(SK){ WAIT_BAR(0); } RESC();
  { if constexpr(!LS){ float sacc=pB0[0]+pB0[1]; _Pragma("unroll") for(int r=2;r<16;++r)sacc+=pB0[r]; _Pragma("unroll") for(int r=0;r<16;++r)sacc+=pB1[r]; l_reg+=sacc; }
    pw0=(u32x4){PKW(pB0,0),PKW(pB0,2),PKW(pB0,4),PKW(pB0,6)};pw1=(u32x4){PKW(pB0,8),PKW(pB0,10),PKW(pB0,12),PKW(pB0,14)};pw2=(u32x4){PKW(pB1,0),PKW(pB1,2),PKW(pB1,4),PKW(pB1,6)};pw3=(u32x4){PKW(pB1,8),PKW(pB1,10),PKW(pB1,12),PKW(pB1,14)};
    SBAR(); pv(o,vb0+sl_cur,PAF(0),PAF(1),PAF(2),PAF(3)); LSM(0); LSM(1); LSM(2); LSM(3); }
  if constexpr(SK){ if(wid<4){ BARONLY(); } }
  #undef PKW
  #undef PAF
  #undef VFR
  #undef PIN
  #undef MX3
  #undef GAPA
  #undef GAPB
  #undef EX
  #undef VRD
  #undef KRD
  #undef LSM
  #undef MF32
  #undef STEP
  #undef ENDW
  #undef ENDA
  float rli[16];
  if constexpr(LS){
    #pragma unroll
    for(int r=0;r<16;++r)rli[r]=__builtin_amdgcn_rcpf(o2[r]);
  } else {
    {auto rr=__builtin_amdgcn_permlane32_swap(__float_as_uint(l_reg),__float_as_uint(l_reg),false,false);l_reg=__uint_as_float(rr[0])+__uint_as_float(rr[1]);}
    if(hi==0)wsf[32+r32]=l_reg;asm volatile("s_waitcnt lgkmcnt(0)":::"memory");
    #pragma unroll
    for(int r=0;r<16;++r)rli[r]=__builtin_amdgcn_rcpf(wsf[32+crow(r,hi)]);
  }
  bf16*Ow=Ou+(long)(wid*QBLK)*OP;
  { bf16*stg=(bf16*)(shm+LDS_OST)+wid*2048;
    #pragma unroll
    for(int r=0;r<16;++r){const int orow=crow(r,hi);
      #pragma unroll
      for(int d0=0;d0<2;++d0)stg[orow*64+d0*32+r32]=(bf16)(cvtpk_s(o[d0][r]*rli[r],0.f)&0xffffu);}
    asm volatile("s_waitcnt lgkmcnt(0)":::"memory");
    #pragma unroll
    for(int i=0;i<4;++i){const int row=i*8+(lane>>3),ch=lane&7; const u32x4 v=*(const u32x4*)(stg+row*64+ch*8); *(u32x4*)(Ow+(long)row*OP+ch*8)=v;} }
  asm volatile("s_waitcnt lgkmcnt(0)\n\ts_barrier":::"memory");
  #undef DMA_K
  #undef DMA_V
  #undef WAIT_C
  #undef WAIT_P
  #undef WAITA_K
  #undef BARONLY
  #undef START
  #undef RESC
  #undef ROT
}
#undef SBAR
#undef WAIT_BAR
}
#define XB_TMO      128
#define XB_XCNT(j)  (256  + 64 * (j))
#define XB_XSUB(j)  (1280 + 64 * (j))
#define XB_XGEN(j)  (2304 + 64 * (j))
#define XB_TOP      3328
#define XB_TOPGEN   3392
#define XCD_BAR_WORDS 3456
#define XB_SPIN_CAP (1u << 20)

__device__ __forceinline__ unsigned xb_ld(unsigned* p)              { return __hip_atomic_load(p, __ATOMIC_RELAXED, __HIP_MEMORY_SCOPE_AGENT); }
__device__ __forceinline__ unsigned xb_add(unsigned* p, unsigned v) { return __hip_atomic_fetch_add(p, v, __ATOMIC_RELAXED, __HIP_MEMORY_SCOPE_AGENT); }
__device__ __forceinline__ unsigned xb_xcc_id() { return (unsigned)__builtin_amdgcn_s_getreg((3 << 11) | 20) & 0xFu; }
#define XB_SPIN(cond, bar) do { unsigned _sp = 0; while (cond) { __builtin_amdgcn_s_sleep(1); \
    if ((++_sp & 255u) == 0u) { if (xb_ld(&(bar)[XB_TMO])) break; if (_sp > XB_SPIN_CAP) { atomicAdd(&(bar)[XB_TMO], 1u); break; } } } } while (0)

struct XcdBarrier {
    unsigned* bar; unsigned x;
    volatile LAS unsigned* st;
};
__device__ __forceinline__ XcdBarrier xcd_barrier_post(unsigned* bar, volatile LAS unsigned* st) {
    XcdBarrier b; b.bar = bar; b.x = xb_xcc_id(); b.st = st;
    if (threadIdx.x == 0) (void)xb_add(&bar[XB_XCNT(b.x)], 1u);
    return b;
}
__device__ __forceinline__ void xcd_barrier_complete(unsigned* bar, unsigned x, unsigned& nloc, unsigned& nx) {
    const unsigned G = gridDim.x * gridDim.y * gridDim.z;
    unsigned sum, cnt, mine, sp = 0u;
    for (;;) {
        sum = 0u; cnt = 0u; mine = 0u;
        unsigned cj[16];
#pragma unroll
        for (unsigned j = 0; j < 16; ++j) cj[j] = xb_ld(&bar[XB_XCNT(j)]);
#pragma unroll
        for (unsigned j = 0; j < 16; ++j) { const unsigned c = cj[j]; sum += c; cnt += (c > 0u) ? 1u : 0u; mine = (j == x) ? c : mine; }
        if (sum == G) break;
        __builtin_amdgcn_s_sleep(1);
        if ((++sp & 255u) == 0u) { if (xb_ld(&bar[XB_TMO])) break; if (sp > XB_SPIN_CAP) { atomicAdd(&bar[XB_TMO], 1u); break; } }
    }
    nloc = mine > 0u ? mine : 1u; nx = cnt > 0u ? cnt : 1u;
}
__device__ __forceinline__ void xcd_barrier(const XcdBarrier& b) {
    asm volatile("s_waitcnt vmcnt(0)" ::: "memory");
    __syncthreads();
    if (threadIdx.x == 0) {
        unsigned* bar = b.bar;
        __builtin_amdgcn_s_waitcnt(0);
        unsigned nloc = b.st[0], nx = b.st[1];
        if (nloc == 0u) { xcd_barrier_complete(bar, b.x, nloc, nx); b.st[0] = nloc; b.st[1] = nx; }
        const unsigned old = xb_add(&bar[XB_XSUB(b.x)], 1u);
        const unsigned gen = old / nloc;
        if (old + 1u == (gen + 1u) * nloc) {
            __builtin_amdgcn_fence(__ATOMIC_RELEASE, "agent");
            asm volatile("s_waitcnt vmcnt(0)" ::: "memory");
            const unsigned og = xb_add(&bar[XB_TOP], 1u);
            const unsigned tg = og / nx;
            if (og + 1u == (tg + 1u) * nx) xb_add(&bar[XB_TOPGEN], 1u);
            else XB_SPIN(xb_ld(&bar[XB_TOPGEN]) == tg, bar);
            __builtin_amdgcn_fence(__ATOMIC_ACQUIRE, "agent");
            xb_add(&bar[XB_XGEN(b.x)], 1u);
            asm volatile("s_waitcnt vmcnt(0)" ::: "memory");
        } else {
            XB_SPIN(xb_ld(&bar[XB_XGEN(b.x)]) == gen, bar);
            __builtin_amdgcn_fence(__ATOMIC_ACQUIRE, "agent");
            asm volatile("s_waitcnt vmcnt(0)" ::: "memory");
        }
    }
    __syncthreads();
}

struct Args { const float* in[24]; float* out; unsigned char* ws; };
enum { I_X = 0, I_C, I_CTX, I_CCTX, I_WMOD, I_BMOD, I_NORMS, I_WIN, I_QKN, I_MQN, I_MKVN, I_WUQ, I_WUKV, I_GVN, I_GWS, I_GBS, I_WBR, I_WOUT, I_RW, I_RB, I_EW1, I_EB1, I_EW2, I_EB2 };

struct Frame {
    LAS unsigned char* lds;
    volatile LAS unsigned* MISC;
    gu32* ctl;
    int tid, lane, wave, G, bx;
    unsigned char* ws;
    __device__ __forceinline__ const float* in(int i) const { const unsigned long long v = __hip_atomic_load((const unsigned long long*)(ws + WS_PTAB) + i, __ATOMIC_RELAXED, __HIP_MEMORY_SCOPE_AGENT);
        const unsigned lo = __builtin_amdgcn_readfirstlane((unsigned)v), hi = __builtin_amdgcn_readfirstlane((unsigned)(v >> 32));
        return (const float*)(const GAS float*)(((unsigned long long)hi << 32) | lo); }
    __device__ __forceinline__ float* out() const { return (float*)in(24); }
};

__device__ __forceinline__ int map_col(int kind, int n) {
    if (kind == 1) { const int pn = n >> 8, c = n & 255, bj = (c >> 7) & 1, wc = (c >> 5) & 3, j = c & 31;
        if (pn < 2) return (4 * pn + wc) * 64 + 32 * bj + j;
        if (pn == 2) return 512 + wc * 64 + 32 * bj + j;
        if (pn == 3) return 768 + c;
        if (pn == 4) { if (wc < 2) return 1024 + wc * 64 + 32 * bj + j; if (wc == 2 && j < 16) return 1152 + 16 * bj + j; return -1; }
        if (pn < 9) return 1184 + (pn - 5) * 256 + c;
        return 2208 + (pn - 9) * 256 + c; }
    if (kind == 2) { if (n < 512) return (n >> 6) * 96 + (n & 63); const int t = n - 512; return ((t & 127) >> 4) * 96 + 64 + 16 * (t >> 7) + (t & 15); }
    if (kind == 3) { return ((n >> 7) & 1) * 1024 + (n >> 8) * 128 + (n & 127); }
    return n;
}
__device__ __forceinline__ void transpose_item(const float* W, int K, int Nsrc, bf16* WT, int nblk, int kind, LAS float* scr, int item, int lane) {
    const int kb = item / nblk, nb = item % nblk, k0 = 64 * kb, n0 = 64 * nb;
    const int src = map_col(kind, n0 + 4 * (lane & 15));
    f32x4 v[16];
#pragma unroll
    for (int i = 0; i < 16; ++i) { const int kk = 4 * i + (lane >> 4); v[i] = (src >= 0) ? *(const f32x4*)(W + (size_t)(k0 + kk) * Nsrc + src) : (f32x4){0.f, 0.f, 0.f, 0.f}; }
#pragma unroll
    for (int i = 0; i < 16; ++i) { const int kk = 4 * i + (lane >> 4); LAS float* d = scr + kk * 65 + 4 * (lane & 15); d[0] = v[i][0]; d[1] = v[i][1]; d[2] = v[i][2]; d[3] = v[i][3]; }
    LDS_WAIT(); asm volatile("" ::: "memory");
    const int c = lane & 7;
#pragma unroll
    for (int j = 0; j < 8; ++j) { const int n = (lane >> 3) + 8 * j; const LAS float* s = scr + (8 * c) * 65 + n;
        v4u o; o.x = cvt_pk(s[0 * 65], s[1 * 65]); o.y = cvt_pk(s[2 * 65], s[3 * 65]); o.z = cvt_pk(s[4 * 65], s[5 * 65]); o.w = cvt_pk(s[6 * 65], s[7 * 65]);
        *(GAS v4u*)(WT + (size_t)(n0 + n) * K + k0 + 8 * c) = o; }
    LDS_WAIT(); asm volatile("" ::: "memory");
}
__device__ __forceinline__ void sincos_acc(float ang, float& c, float& s) {
    const double x = (double)ang; const double n = __builtin_rint(x * 0.6366197723675814);
    double r = __builtin_fma(-n, 1.5707963267948966, x); r = __builtin_fma(-n, 6.123233995736766e-17, r);
    const double r2 = r * r;
    double sp = -2.5052108385441720e-08; sp = sp * r2 + 2.7557319223985893e-06; sp = sp * r2 - 1.9841269841269841e-04; sp = sp * r2 + 8.3333333333333332e-03; sp = sp * r2 - 1.6666666666666666e-01; sp = sp * r2 * r + r;
    double cp = 2.0876756987868099e-09; cp = cp * r2 - 2.7557319223985888e-07; cp = cp * r2 + 2.4801587301587302e-05; cp = cp * r2 - 1.3888888888888889e-03; cp = cp * r2 + 4.1666666666666664e-02; cp = cp * r2 - 0.5; cp = cp * r2 + 1.0;
    const int q = ((int)n) & 3;
    const double sv = (q == 0) ? sp : (q == 1) ? cp : (q == 2) ? -sp : -cp;
    const double cv = (q == 0) ? cp : (q == 1) ? -sp : (q == 2) ? -cp : sp;
    c = (float)cv; s = (float)sv;
}

__device__ __forceinline__ void p_prologue(Frame& F, const Args& A) {
    const int gw = F.bx * 8 + F.wave, NGW = F.G * 8, lane = F.lane;
    if (F.bx == 0 && F.tid < 25) { ((unsigned long long*)(F.ws + WS_PTAB))[F.tid] = (F.tid < 24) ? (unsigned long long)(uintptr_t)A.in[F.tid] : (unsigned long long)(uintptr_t)A.out; }
    { LAS float* sv = (LAS float*)(F.lds + LDS_SVEC);
      for (int i = F.tid; i < 3 * 1024; i += 512) { const float v = (i < 2048) ? A.in[I_C][i] : A.in[I_CCTX][i - 2048]; sv[i] = v * sigmoidf_(v); }
      __syncthreads(); }
    { const LAS float* sv = (const LAS float*)(F.lds + LDS_SVEC); float* mod = (float*)(F.ws + WS_MOD);
      for (int it = gw; it < 3 * DEPTH * 384; it += NGW) { if (it % 3) continue; const int itm = it / 3; const int l = itm / 384, col = (itm % 384) * 16 + (lane & 15), kq = lane >> 4;
          const float* W = A.in[I_WMOD] + (size_t)l * 1024 * 6144 + col; float a0 = 0.f, a1 = 0.f, a2 = 0.f;
#pragma unroll 16
          for (int k = kq * 256; k < kq * 256 + 256; ++k) { const float w = W[(size_t)k * 6144]; a0 += sv[k] * w; a1 += sv[1024 + k] * w; a2 += sv[2048 + k] * w; }
          a0 += __shfl_xor(a0, 16); a1 += __shfl_xor(a1, 16); a2 += __shfl_xor(a2, 16); a0 += __shfl_xor(a0, 32); a1 += __shfl_xor(a1, 32); a2 += __shfl_xor(a2, 32);
          if (lane < 16) { const float b = A.in[I_BMOD][l * 6144 + col]; float* mp = mod + (size_t)l * 3 * 6144 + col; mp[0] = a0 + b; mp[6144] = a1 + b; mp[2 * 6144] = a2 + b; } } }
    { float* cg = (float*)(F.ws + WS_COSG); float* sg = (float*)(F.ws + WS_SING); float* cm = (float*)(F.ws + WS_COSM); float* sm = (float*)(F.ws + WS_SINM);
      const int gt = F.bx * 512 + F.tid, NT_ = F.G * 512;
      for (int i = gt; i < SEQ * 48; i += NT_) { const int pos = i / 48, j = i % 48; const float rowf = (float)(pos >> 6), colf = (float)(pos & 63); float c, s;
          if (j < 32) { const float ang = (j < 16) ? rowf * INVF16[j] : colf * INVF16[j - 16]; sincos_acc(ang, c, s); cg[pos * 32 + j] = c; sg[pos * 32 + j] = s; }
          else { const int jj = j - 32; const float ang = (jj < 8) ? rowf * INVF16[2 * jj] : colf * INVF16[2 * (jj - 8)]; sincos_acc(ang, c, s); cm[pos * 16 + jj] = c; sm[pos * 16 + jj] = s; } } }
    { bf16* wsb = (bf16*)(F.ws + WS_WS); const float* src = A.in[I_GWS]; const int gt = F.bx * 512 + F.tid, NT_ = F.G * 512;
      for (int i = gt; i < DEPTH * 8 * 128 * 128 / 2; i += NT_) { ((unsigned*)wsb)[i] = cvt_pk(src[2 * i], src[2 * i + 1]); } }
    { bf16* rwt = (bf16*)(F.ws + WS_RWT); const float* src = A.in[I_RW]; const int gt = F.bx * 512 + F.tid, NT_ = F.G * 512;
      for (int i = gt; i < DEPTH * 32 * 1024; i += NT_) { const int l = i >> 15, e = (i >> 10) & 31, d = i & 1023; const float w = src[(size_t)l * 32768 + d * 32 + e];
          const unsigned h16 = cvt_pk(w, 0.f) & 0xffffu; const float back = __uint_as_float(h16 << 16);
          rwt[(size_t)l * 65536 + e * 1024 + d] = (bf16)h16; rwt[(size_t)l * 65536 + 32768 + e * 1024 + d] = (bf16)(cvt_pk(w - back, 0.f) & 0xffffu); } }
    { LAS float* scr = (LAS float*)(F.lds + RING_OFF + F.wave * 16640);
      constexpr int I_IN = 16 * 84, I_UQ = 4 * 12, I_UKV = 2 * 16, I_BR = 8 * 16, I_OUT = 16 * 16, I_W1 = 16 * 32, I_W2 = 16 * 16;
      constexpr int PER_LAYER = I_IN + I_UQ + I_UKV + 3 * I_BR + I_OUT + 32 * I_W1 + 32 * I_W2;
      for (int it = gw; it < DEPTH * PER_LAYER; it += NGW) { const int l = it / PER_LAYER; int r = it % PER_LAYER;
          if (r < I_IN) { transpose_item(A.in[I_WIN] + (size_t)l * 1024 * 5280, 1024, 5280, (bf16*)(F.ws + WS_WIN) + (size_t)l * ZW * 1024, 84, 1, scr, r, lane); continue; } r -= I_IN;
          if (r < I_UQ) { transpose_item(A.in[I_WUQ] + (size_t)l * 256 * 768, 256, 768, (bf16*)(F.ws + WS_WUQ) + (size_t)l * 768 * 256, 12, 2, scr, r, lane); continue; } r -= I_UQ;
          if (r < I_UKV) { transpose_item(A.in[I_WUKV] + (size_t)l * 128 * 1024, 128, 1024, (bf16*)(F.ws + WS_WUKV) + (size_t)l * 1024 * 128, 16, 0, scr, r, lane); continue; } r -= I_UKV;
          if (r < 3 * I_BR) { const int i = r / I_BR; transpose_item(A.in[I_WBR] + (size_t)(l * 3 + i) * 512 * 1024, 512, 1024, (bf16*)(F.ws + WS_WBR) + (size_t)(l * 3 + i) * 1024 * 512, 16, 0, scr, r % I_BR, lane); continue; } r -= 3 * I_BR;
          if (r < I_OUT) { transpose_item(A.in[I_WOUT] + (size_t)l * 1024 * 1024, 1024, 1024, (bf16*)(F.ws + WS_WOUT) + (size_t)l * 1024 * 1024, 16, 0, scr, r, lane); continue; } r -= I_OUT;
          if (r < 32 * I_W1) { const int e = r / I_W1; transpose_item(A.in[I_EW1] + (size_t)(l * 32 + e) * 1024 * 2048, 1024, 2048, (bf16*)(F.ws + WS_W1) + (size_t)(l * 32 + e) * 2048 * 1024, 32, 3, scr, r % I_W1, lane); continue; } r -= 32 * I_W1;
          { const int e = r / I_W2; transpose_item(A.in[I_EW2] + (size_t)(l * 32 + e) * 1024 * 1024, 1024, 1024, (bf16*)(F.ws + WS_W2) + (size_t)(l * 32 + e) * 1024 * 1024, 16, 0, scr, r % I_W2, lane); } } }
}

__device__ __forceinline__ void mod_row_to_bf16(const float* xrow, const float* gain, const float* sc, const float* sh, bf16* orow, int lane) {
    const f32x4* xr = (const f32x4*)xrow + lane; f32x4 v[4], g[4], s[4], h[4]; float ss = 0.f;
#pragma unroll
    for (int j = 0; j < 4; ++j) { v[j] = xr[64 * j]; g[j] = ((const f32x4*)gain)[64 * j + lane]; s[j] = ((const f32x4*)sc)[64 * j + lane]; h[j] = ((const f32x4*)sh)[64 * j + lane]; }
#pragma unroll
    for (int j = 0; j < 4; ++j) ss += (v[j].x * v[j].x + v[j].y * v[j].y) + (v[j].z * v[j].z + v[j].w * v[j].w);
    const float rstd = __builtin_amdgcn_rsqf(wave_sum(ss) * (1.f / DM) + RMS_EPS);
    unsigned long long* o8 = (unsigned long long*)orow + lane;
#pragma unroll
    for (int j = 0; j < 4; ++j) { const float y0 = v[j].x * rstd * g[j].x * (1.f + s[j].x) + h[j].x, y1 = v[j].y * rstd * g[j].y * (1.f + s[j].y) + h[j].y, y2 = v[j].z * rstd * g[j].z * (1.f + s[j].z) + h[j].z, y3 = v[j].w * rstd * g[j].w * (1.f + s[j].w) + h[j].w;
        o8[64 * j] = (unsigned long long)cvt_pk(y0, y1) | ((unsigned long long)cvt_pk(y2, y3) << 32); }
}

typedef short bf16x8_t __attribute__((ext_vector_type(8)));
typedef float f32x16_t __attribute__((ext_vector_type(16)));
__device__ __forceinline__ void gmlp_unit(Frame& F, const float* gbs, const float* gvn, int l, int chunk, int nt) {
    const int lane = F.lane, g = F.wave, r32 = lane & 31, hi = lane >> 5;
    const bf16* vn = (const bf16*)(F.ws + WS_VN) + (size_t)chunk * 128 * 512 + g * 64; const float* ssv = (const float*)(F.ws + WS_SSV);
    const bf16* ua = (const bf16*)(F.ws + WS_UACT) + (size_t)chunk * 128 * 512 + g * 64;
    bf16* go = (bf16*)(F.ws + WS_GM) + (size_t)chunk * 128 * 512 + g * 64;
    const bf16* wsb = (const bf16*)(F.ws + WS_WS) + (size_t)(l * 8 + g) * 128 * 128;
    const float* bs = gbs + (size_t)(l * 8 + g) * 128;
    LAS bf16* vt = (LAS bf16*)(F.lds + RING_OFF + g * 19456); LAS bf16* ut = vt + 32 * 136; LAS float* bl = (LAS float*)(ut + 128 * 32);
    { const int dd = (lane & 3) * 8; const f32x4 ga = *(const f32x4*)(gvn + l * 512 + g * 64 + nt * 32 + dd), gb = *(const f32x4*)(gvn + l * 512 + g * 64 + nt * 32 + dd + 4);
      v4u raw[8], uraw[8]; float s0[8], s1[8];
#pragma unroll
      for (int ps = 0; ps < 8; ++ps) { const int q = ps * 16 + (lane >> 2); raw[ps] = *(const v4u*)(vn + (size_t)q * 512 + nt * 32 + dd); uraw[ps] = *(const v4u*)(ua + (size_t)q * 512 + nt * 32 + dd);
          const float* sp = ssv + ((size_t)chunk * 128 + q) * 2; s0[ps] = sp[0]; s1[ps] = sp[1]; }
      const float b0 = bs[lane], b1 = bs[64 + lane];
#pragma unroll
      for (int ps = 0; ps < 8; ++ps) { const int q = ps * 16 + (lane >> 2); float fv[8]; unpack8(raw[ps], fv);
          const float rstd = __builtin_amdgcn_rsqf((s0[ps] + s1[ps]) * (1.f / 512.f) + RMS_EPS);
#pragma unroll
          for (int i = 0; i < 8; ++i) vt[(dd + i) * 136 + q] = (bf16)(cvt_pk(fv[i] * rstd * (i < 4 ? ga[i] : gb[i - 4]), 0.f) & 0xffffu);
          *(LAS v4u*)(ut + q * 32 + dd) = uraw[ps]; }
      bl[lane] = b0; bl[64 + lane] = b1; }
    LDS_WAIT(); asm volatile("" ::: "memory");
#pragma unroll 1
    for (int mh = 0; mh < 2; ++mh) {
        f32x16_t acc[2]; acc[0] = (f32x16_t){}; acc[1] = (f32x16_t){};
        size_t zo = (size_t)mh * 64 * 128; asm volatile("" : "+v"(zo));
        const bf16* wsl = wsb + zo; bf16x8_t afr[8][2];
#pragma unroll
        for (int ks = 0; ks < 8; ++ks)
#pragma unroll
            for (int mt = 0; mt < 2; ++mt) afr[ks][mt] = *(const bf16x8_t*)(wsl + (size_t)(mt * 32 + r32) * 128 + ks * 16 + hi * 8);
#pragma unroll
        for (int ks = 0; ks < 8; ++ks) { const bf16x8_t bfr = *(const LAS bf16x8_t*)(vt + r32 * 136 + ks * 16 + hi * 8);
#pragma unroll
            for (int mt = 0; mt < 2; ++mt) acc[mt] = __builtin_amdgcn_mfma_f32_32x32x16_bf16(afr[ks][mt], bfr, acc[mt], 0, 0, 0); }
#pragma unroll
        for (int mt = 0; mt < 2; ++mt)
#pragma unroll
            for (int rg = 0; rg < 16; ++rg) { const int p = mh * 64 + mt * 32 + (rg & 3) + 8 * (rg >> 2) + 4 * hi;
                const float u = __uint_as_float((unsigned)ut[p * 32 + r32] << 16);
                go[(size_t)p * 512 + nt * 32 + r32] = (bf16)(cvt_pk(u * (acc[mt][rg] + bl[p]), 0.f) & 0xffffu); } }
    LDS_WAIT(); asm volatile("" ::: "memory");
}
constexpr int T3_REC_E = 0, T3_REC_W = 8192, T3_REC_S = 16384, T3_HIST = 24576, T3_BASE = T3_HIST + 128;
__device__ __forceinline__ void t3_phase(Frame& F, int l, int T_l, const float* xin_lat, const float* xin_ctx, int cofs, bool dry) {
    float* const outp = F.out();
    const int lane = F.lane, tid = F.tid;
    LAS int* rec_e = (LAS int*)(F.lds + RING_OFF + T3_REC_E); LAS float* rec_w = (LAS float*)(F.lds + RING_OFF + T3_REC_W); LAS int* rec_s = (LAS int*)(F.lds + RING_OFF + T3_REC_S);
    LAS int* hist = (LAS int*)(F.lds + RING_OFF + T3_HIST); LAS int* base = (LAS int*)(F.lds + RING_OFF + T3_BASE);
    if (tid < 32) hist[tid] = 0;
    const int per = (T_l + F.G - 1) / F.G; const int r0 = F.bx * per; int ntok = T_l - r0; ntok = ntok < 0 ? 0 : (ntok > per ? per : ntok);
    const float* norms = F.in(I_NORMS) + (size_t)l * 4 * 1024; const float* modl = (const float*)(F.ws + WS_MOD) + (size_t)l * 3 * 6144;
    const bf16* Y = (const bf16*)(F.ws + WS_Y); bf16* XN = (bf16*)(F.ws + (dry ? WS_H : WS_XN)); bf16* XNL = (bf16*)(F.ws + WS_MERGEB);
    for (int j = F.wave; j < ntok; j += 8) {
        const int r = r0 + j; const bool lat = r < TL; const int who = lat ? (r >> 14) : 2;
        const float* xrow = lat ? xin_lat + (size_t)r * 1024 : xin_ctx + (size_t)(r - TL) * 1024;
        float* orow = dry ? (float*)(F.ws + WS_MERGE) + (size_t)r * 1024 : (lat ? outp + (size_t)r * 1024 : (float*)(F.ws + WS_XC) + (size_t)(r - TL) * 1024);
        const float* mo = modl + (size_t)who * 6144;
        float yv[16], xv[16]; v4u yr[2]; f32x4 xr4[4], g1v[4], gn1[4], gn2[4], scv[4], shv[4];
        { const v4u* yp = (const v4u*)(Y + (size_t)r * 1024); yr[0] = yp[lane]; yr[1] = yp[64 + lane]; }
#pragma unroll
        for (int hq = 0; hq < 4; ++hq) { const int d0 = (hq >> 1) * 512 + 8 * lane + 4 * (hq & 1);
            xr4[hq] = *(const f32x4*)(xrow + d0); g1v[hq] = *(const f32x4*)(mo + 2 * 1024 + d0); gn1[hq] = *(const f32x4*)(norms + 1024 + d0);
            gn2[hq] = *(const f32x4*)(norms + 2048 + d0); scv[hq] = *(const f32x4*)(mo + 4 * 1024 + d0); shv[hq] = *(const f32x4*)(mo + 3 * 1024 + d0); }
        { float a[8], b[8]; unpack8(yr[0], a); unpack8(yr[1], b);
#pragma unroll
          for (int i = 0; i < 8; ++i) { yv[i] = a[i]; yv[8 + i] = b[i]; } }
#pragma unroll
        for (int hq = 0; hq < 4; ++hq)
#pragma unroll
            for (int i = 0; i < 4; ++i) xv[hq * 4 + i] = xr4[hq][i];
        float ss = 0.f;
#pragma unroll
        for (int i = 0; i < 16; ++i) ss += yv[i] * yv[i];
        const float rstd = __builtin_amdgcn_rsqf(wave_sum(ss) * (1.f / DM) + RMS_EPS);
        float ss2 = 0.f;
#pragma unroll
        for (int hq = 0; hq < 4; ++hq) { const int d0 = (hq >> 1) * 512 + 8 * lane + 4 * (hq & 1); f32x4 o;
#pragma unroll
            for (int i = 0; i < 4; ++i) { const int k = hq * 4 + i; const float xn = xv[k] + g1v[hq][i] * (yv[k] * rstd * gn1[hq][i]); xv[k] = xn; o[i] = xn; ss2 += xn * xn; }
            *(f32x4*)(orow + d0) = o; }
        const float rstd2 = __builtin_amdgcn_rsqf(wave_sum(ss2) * (1.f / DM) + RMS_EPS);
#pragma unroll
        for (int h = 0; h < 2; ++h) { float hi8[8], lo8[8];
#pragma unroll
            for (int q = 0; q < 2; ++q) { const int hq = h * 2 + q;
#pragma unroll
                for (int i = 0; i < 4; ++i) hi8[q * 4 + i] = xv[hq * 4 + i] * rstd2 * gn2[hq][i] * (1.f + scv[hq][i]) + shv[hq][i]; }
            const v4u ph = pack8(hi8); float back[8]; unpack8(ph, back);
#pragma unroll
            for (int i = 0; i < 8; ++i) lo8[i] = hi8[i] - back[i];
            *(v4u*)(XN + (size_t)r * 1024 + h * 512 + 8 * lane) = ph; *(v4u*)(XNL + (size_t)r * 1024 + h * 512 + 8 * lane) = pack8(lo8); }
    }
    asm volatile("s_waitcnt vmcnt(0)" ::: "memory");
    __syncthreads();
    { const int r32 = lane & 31, hi = lane >> 5, w = F.wave; const int ntiles = (ntok + 31) >> 5;
      if (w < ntiles) {
        const int tloc = 32 * w + r32; const int rr = r0 + (tloc < ntok ? tloc : ntok - 1);
        const bf16* whi = (const bf16*)(F.ws + WS_RWT) + (size_t)l * 2 * 32 * 1024 + (size_t)r32 * 1024 + hi * 8; const bf16* wlo = whi + 32 * 1024;
        const bf16* thi = XN + (size_t)rr * 1024 + hi * 8; const bf16* tlo = XNL + (size_t)rr * 1024 + hi * 8;
        f32x16_t acc = (f32x16_t){};
#pragma unroll 1
        for (int k0 = 0; k0 < 64; k0 += 8) {
            bf16x8_t ah[8], al[8], bh[8], bl[8];
#pragma unroll
            for (int u = 0; u < 8; ++u) { ah[u] = *(const bf16x8_t*)(whi + (k0 + u) * 16); al[u] = *(const bf16x8_t*)(wlo + (k0 + u) * 16); bh[u] = *(const bf16x8_t*)(thi + (k0 + u) * 16); bl[u] = *(const bf16x8_t*)(tlo + (k0 + u) * 16); }
#pragma unroll
            for (int u = 0; u < 8; ++u) { acc = __builtin_amdgcn_mfma_f32_32x32x16_bf16(ah[u], bh[u], acc, 0, 0, 0); acc = __builtin_amdgcn_mfma_f32_32x32x16_bf16(ah[u], bl[u], acc, 0, 0, 0); acc = __builtin_amdgcn_mfma_f32_32x32x16_bf16(al[u], bh[u], acc, 0, 0, 0); } }
        const float* rb = F.in(I_RB) + l * 32; float v[16]; float ninf = -INFINITY; asm volatile("" : "+v"(ninf));
#pragma unroll
        for (int i = 0; i < 16; ++i) v[i] = acc[i] + rb[(i & 3) + 8 * (i >> 2) + 4 * hi];
        float cm[8]; int cid[8];
#pragma unroll
        for (int k = 0; k < 4; ++k) { float m = v[0];
#pragma unroll
            for (int i = 1; i < 16; ++i) m = fmaxf(m, v[i]);
            int sel = 15;
#pragma unroll
            for (int i = 14; i >= 0; --i) sel = (v[i] == m) ? i : sel;
            sel = (v[15] == m && sel == 15) ? 15 : sel;
            cm[k] = m; cid[k] = (sel & 3) + 8 * (sel >> 2) + 4 * hi;
#pragma unroll
            for (int i = 0; i < 16; ++i) v[i] = (i == sel) ? ninf : v[i]; }
#pragma unroll
        for (int k = 0; k < 4; ++k) { cm[4 + k] = __shfl_xor(cm[k], 32); cid[4 + k] = __shfl_xor(cid[k], 32); }
        float tl[4]; int te[4];
#pragma unroll
        for (int k = 0; k < 4; ++k) { float best = cm[0]; int bid = cid[0]; int bc = 0;
#pragma unroll
            for (int c = 1; c < 8; ++c) { const bool better = (cm[c] > best) || (cm[c] == best && cid[c] < bid); best = better ? cm[c] : best; bid = better ? cid[c] : bid; bc = better ? c : bc; }
            tl[k] = best; te[k] = bid;
#pragma unroll
            for (int c = 0; c < 8; ++c) cm[c] = (c == bc) ? ninf : cm[c]; }
        const float e1 = __expf(tl[1] - tl[0]), e2 = __expf(tl[2] - tl[0]), e3 = __expf(tl[3] - tl[0]); const float inv = 1.f / (1.f + e1 + e2 + e3);
        if (hi == 0 && tloc < ntok) { const float wv[4] = {inv, e1 * inv, e2 * inv, e3 * inv};
#pragma unroll
            for (int k = 0; k < 4; ++k) { const int ls = __hip_atomic_fetch_add(&hist[te[k]], 1, __ATOMIC_RELAXED, __HIP_MEMORY_SCOPE_WORKGROUP);
                rec_e[tloc * 4 + k] = te[k]; rec_w[tloc * 4 + k] = wv[k]; rec_s[tloc * 4 + k] = ls; } }
      } }
    __syncthreads();
    if (tid < 32) { const int n = hist[tid]; base[tid] = n ? (int)__hip_atomic_fetch_add((unsigned*)(F.ctl + CW_CNT + cofs + l * 32 + tid), (unsigned)n, RLX_AGENT) : 0; }
    __syncthreads();
    { int* rte = (int*)(F.ws + WS_RTE); int* rts = (int*)(F.ws + WS_RTS); int* ltok = (int*)(F.ws + WS_LTOK); float* lw = (float*)(F.ws + WS_LW);
      for (int i = tid; i < ntok * 4; i += 512) { const int e = rec_e[i], slot = base[e] + rec_s[i]; const int r = r0 + (i >> 2);
          rte[(size_t)r * 4 + (i & 3)] = e; rts[(size_t)r * 4 + (i & 3)] = slot; ltok[(size_t)e * TA + slot] = r; lw[(size_t)e * TA + slot] = rec_w[i]; } }
}

__device__ __forceinline__ void moe_tables(Frame& F, int l, int cofs) {
    LAS int* tab = (LAS int*)(F.lds + LDS_TAB);
    if (F.tid == 0) { int nb = 0;
#pragma unroll 1
        for (int e = 0; e < 32; ++e) { const int c = (int)__hip_atomic_load((unsigned*)(F.ctl + CW_CNT + cofs + l * 32 + e), RLX_AGENT); const int n = (c + 255) >> 8; tab[600 + e] = nb * 256; tab[640 + e] = c;
            for (int b = 0; b < n; ++b) tab[nb + b] = e; nb += n; }
        tab[632] = nb; }
    __syncthreads();
}
__device__ __forceinline__ void t4_phase(Frame& F, int l, int T_l, bool dummy) {
    float* const outp = F.out();
    const bool nextmod = (l + 1 < DEPTH);
    const float* ngain = F.in(I_NORMS) + (size_t)(l + 1 < DEPTH ? l + 1 : l) * 4 * 1024; const float* nmod = (const float*)(F.ws + WS_MOD) + (size_t)(l + 1 < DEPTH ? l + 1 : l) * 3 * 6144; bf16* XN = (bf16*)(F.ws + WS_XN);
    const LAS int* tab = (const LAS int*)(F.lds + LDS_TAB); const int gw = F.bx * 8 + F.wave, NGW = F.G * 8, lane = F.lane;
    const int* rte = (const int*)(F.ws + WS_RTE); const int* rts = (const int*)(F.ws + WS_RTS); const bf16* Yp = (const bf16*)(F.ws + WS_BIG);
    const float* gain = F.in(I_NORMS) + (size_t)l * 4 * 1024 + 3 * 1024; const float* modl = (const float*)(F.ws + WS_MOD) + (size_t)l * 3 * 6144;
    for (int r = gw; r < T_l; r += NGW) { const bool lat = r < TL; const int who = lat ? (r >> 14) : 2; const float* g2 = modl + (size_t)who * 6144 + 5 * 1024;
        float* xrow = lat ? outp + (size_t)r * 1024 : (float*)(F.ws + WS_XC) + (size_t)(r - TL) * 1024;
        float f[16]; int re[4], rs[4];
#pragma unroll
        for (int k = 0; k < 4; ++k) { re[k] = rte[(size_t)r * 4 + k]; rs[k] = rts[(size_t)r * 4 + k]; }
        v4u yr[4][2]; f32x4 xr4[4], gv4[4], mv4[4];
#pragma unroll
        for (int k = 0; k < 4; ++k) { const size_t dst = (size_t)(tab[600 + re[k]] + rs[k]); const v4u* yp = (const v4u*)(Yp + dst * 1024); yr[k][0] = yp[lane]; yr[k][1] = yp[64 + lane]; }
#pragma unroll
        for (int hq = 0; hq < 4; ++hq) { const int d0 = (hq >> 1) * 512 + 8 * lane + 4 * (hq & 1); xr4[hq] = *(const f32x4*)(xrow + d0); gv4[hq] = *(const f32x4*)(gain + d0); mv4[hq] = *(const f32x4*)(g2 + d0); }
        f32x4 ng4[4], ns4[4], nh4[4]; const float* mo = nmod + (size_t)who * 6144;
        if (nextmod) {
#pragma unroll
            for (int hq = 0; hq < 4; ++hq) { const int d0 = (hq >> 1) * 512 + 8 * lane + 4 * (hq & 1); ng4[hq] = *(const f32x4*)(ngain + d0); ns4[hq] = *(const f32x4*)(mo + 1024 + d0); nh4[hq] = *(const f32x4*)(mo + d0); } }
#pragma unroll
        for (int i = 0; i < 16; ++i) f[i] = 0.f;
#pragma unroll
        for (int k = 0; k < 4; ++k) { float a[8], b[8]; unpack8(yr[k][0], a); unpack8(yr[k][1], b);
#pragma unroll
            for (int i = 0; i < 8; ++i) { f[i] += a[i]; f[8 + i] += b[i]; } }
        float ss = 0.f;
#pragma unroll
        for (int i = 0; i < 16; ++i) ss += f[i] * f[i];
        const float rstd = __builtin_amdgcn_rsqf(wave_sum(ss) * (1.f / DM) + RMS_EPS);
        float ssn = 0.f;
#pragma unroll
        for (int hq = 0; hq < 4; ++hq) { const int d0 = (hq >> 1) * 512 + 8 * lane + 4 * (hq & 1); f32x4 xv = xr4[hq];
#pragma unroll
            for (int i = 0; i < 4; ++i) { xv[i] += mv4[hq][i] * (f[hq * 4 + i] * rstd * gv4[hq][i]); f[hq * 4 + i] = xv[i]; ssn += xv[i] * xv[i]; }
            *(f32x4*)((dummy ? (float*)(F.ws + WS_MERGE) + (size_t)r * 1024 : xrow) + d0) = xv; }
        if (nextmod) { const float rstdn = __builtin_amdgcn_rsqf(wave_sum(ssn) * (1.f / DM) + RMS_EPS);
#pragma unroll
            for (int h = 0; h < 2; ++h) { float y[8];
#pragma unroll
                for (int q = 0; q < 2; ++q) { const int hq = h * 2 + q;
#pragma unroll
                    for (int i = 0; i < 4; ++i) y[q * 4 + i] = f[hq * 4 + i] * rstdn * ng4[hq][i] * (1.f + ns4[hq][i]) + nh4[hq][i]; }
                *(v4u*)(XN + (size_t)r * 1024 + h * 512 + 8 * lane) = pack8(y); } } }
}

#ifndef PH_MASK
#define PH_MASK 0xFFFFFFFFu
#endif
#define PH(k) ((PH_MASK >> (k)) & 1u)
#ifndef PH_TWICE
#define PH_TWICE 0u
#endif
#define REP(k) _Pragma("unroll") for (int rep_ = 0; rep_ < (((PH_TWICE >> (k)) & 1u) ? 2 : 1); ++rep_)
__global__ void __launch_bounds__(512, 2) fwd_kernel(Args A) {
    extern __shared__ __attribute__((aligned(16))) unsigned char lds[];
    Frame F;
    F.lds = (LAS unsigned char*)lds; F.MISC = (volatile LAS unsigned*)(F.lds + MISC_OFF);
    F.tid = threadIdx.x; F.lane = F.tid & 63; F.wave = __builtin_amdgcn_readfirstlane(F.tid >> 6);
    F.G = gridDim.x; F.bx = blockIdx.x; F.ws = (unsigned char*)(GAS unsigned char*)(unsigned long long)(uintptr_t)A.ws; F.ctl = (gu32*)(A.ws + WS_CTL);
    int vcu = (F.G % 8 == 0) ? (F.bx % 8) * (F.G / 8) + F.bx / 8 : F.bx;
    if (F.tid < 64) F.MISC[F.tid] = 0u;
    __syncthreads();
    XcdBarrier bar = xcd_barrier_post((unsigned*)(F.ctl + CW_BAR), F.MISC + 8);
#define GRID_BAR() do { { unsigned* bp_ = (unsigned*)(F.ctl + CW_BAR); unsigned x_ = bar.x; asm volatile("" : "+s"(bp_), "+s"(x_)); bar.bar = bp_; bar.x = x_; } xcd_barrier(bar); \
        { int t_ = threadIdx.x; asm volatile("" : "+v"(t_)); F.tid = t_; F.lane = t_ & 63; unsigned long long w_ = (unsigned long long)(uintptr_t)A.ws; int g_ = gridDim.x, b_ = blockIdx.x; asm volatile("" : "+s"(w_), "+s"(g_), "+s"(b_)); \
          F.ws = (unsigned char*)(GAS unsigned char*)w_; ws = F.ws; F.ctl = (gu32*)(w_ + WS_CTL * 1ull); F.G = g_; F.bx = b_; vcu = (g_ % 8 == 0) ? (b_ % 8) * (g_ / 8) + b_ / 8 : b_; gw = b_ * 8 + F.wave; NGW = g_ * 8; } } while (0)
    int gw = F.bx * 8 + F.wave, NGW = F.G * 8;
    unsigned char* ws = F.ws;

    if (PH(0)) REP(0) p_prologue(F, A);
    GRID_BAR();

#pragma unroll
    for (int l = 0; l < DEPTH; ++l) {
        const int T_l = (l == 0) ? TA : TL;

        if (PH(1) && l == 0) REP(1) { const float* xin_lat = (l == 0) ? F.in(I_X) : F.out(); const float* xin_ctx = (l == 0) ? F.in(I_CTX) : (const float*)(ws + WS_XC);
          const float* norms = F.in(I_NORMS) + (size_t)l * 4 * 1024; const float* modl = (const float*)(ws + WS_MOD) + (size_t)l * 3 * 6144;
          for (int r = gw; r < TA; r += NGW) { const bool lat = r < TL; const int who = lat ? (r >> 14) : 2; const float* mo = modl + (size_t)who * 6144;
            mod_row_to_bf16(lat ? xin_lat + (size_t)r * 1024 : xin_ctx + (size_t)(r - TL) * 1024, norms, mo + 1024, mo, (bf16*)(ws + WS_XN) + (size_t)r * 1024, F.lane); } }
        if (l == 0) GRID_BAR();

        if (PH(2)) REP(2) { pg8::Gemm g{(const bf16*)(ws + WS_XN), (const bf16*)(ws + WS_WIN) + (size_t)l * ZW * 1024, TA, ZW, 1024}; pg8::StaticOrder S; S.init(TA, ZW, F.G, F.bx);
          pg8::EpiInproj E{ws, F.in(I_QKN) + (size_t)l * 128, F.in(I_MQN) + (size_t)l * 256, F.in(I_MKVN) + (size_t)l * 128, (LAS float*)(F.lds + LDS_X)};
          pg8::gemm_phase<pg8::EpiInproj, pg8::StaticOrder, true, true>(F.lds + RING_OFF, g, S, E); }
        GRID_BAR();

        if (PH(4)) REP(4) { pg8::Gemm g{(const bf16*)(ws + WS_CQN), (const bf16*)(ws + WS_WUQ) + (size_t)l * 768 * 256, T_l, 768, 256}; pg8::StaticOrder S; S.init(T_l, 768, F.G, F.bx);
          pg8::EpiUq E{(bf16*)(ws + WS_QM), (const float*)(ws + WS_COSM), (const float*)(ws + WS_SINM)};
          pg8::gemm_phase<pg8::EpiUq, pg8::StaticOrder, true, true>(F.lds + RING_OFF, g, S, E); }
        if (PH(5)) REP(5) { pg8::Gemm g{(const bf16*)(ws + WS_CKVN), (const bf16*)(ws + WS_WUKV) + (size_t)l * 1024 * 128, TA, 1024, 128}; pg8::StaticOrder S; S.init(TA, 1024, F.G, (F.bx + F.G / 2) % F.G);
          pg8::EpiUkv E{(bf16*)(ws + WS_KM), (bf16*)(ws + WS_VM)};
          pg8::gemm_phase<pg8::EpiUkv, pg8::StaticOrder, true, true>(F.lds + RING_OFF, g, S, E); }
        if (PH(6)) REP(6) { const float* gbs = F.in(I_GBS); const float* gvn = F.in(I_GVN); for (int hu = (F.bx + F.G / 4) % F.G; hu < 2 * (T_l / 128); hu += F.G) gmlp_unit(F, gbs, gvn, l, hu >> 1, hu & 1); }
        GRID_BAR();

        { const int per = (1024 + F.G - 1) / F.G; char* shm = (char*)lds + RING_OFF;
          if (PH(7)) REP(7) for (int i = 0; i <= per; ++i) { size_t row0; int b, h, nt, t0;
              if (i < per) { const int L = vcu * per + i; if (L >= 1024) continue; const int bh = L >> 6, qb = L & 63; b = bh >> 3; h = bh & 7; row0 = (size_t)b * SEQ + (size_t)qb * 256; t0 = 0; nt = NTILE; }
              else { if (l != 0 || F.bx >= 16) continue; const int bh = F.bx; b = bh >> 3; h = bh & 7; row0 = (size_t)TL + (size_t)b * CTX; t0 = SEQ / 64; nt = CTX / 64; }
              attn_body::attn_unit<4, 512, 128, 128, 512, 8, false, false>((const bf16*)(ws + WS_QG) + row0 * 512 + h * 64, (const bf16*)(ws + WS_KG) + ((size_t)(b * 2 + (h >> 2)) * NTILE + t0) * 4096, (const bf16*)(ws + WS_VG) + ((size_t)(b * 2 + (h >> 2)) * NTILE + t0) * 4096,
                                                             (bf16*)(ws + WS_OG) + row0 * 512 + h * 64, nt, shm); }
          if (PH(8)) REP(8) for (int i = 0; i <= per; ++i) { size_t row0; int b, h, nt, t0;
              if (i < per) { const int L = vcu * per + i; if (L >= 1024) continue; const int bh = L >> 6, qb = L & 63; b = bh >> 3; h = bh & 7; row0 = (size_t)b * SEQ + (size_t)qb * 256; t0 = 0; nt = NTILE; }
              else { if (l != 0 || F.bx < 16 || F.bx >= 32) continue; const int bh = F.bx - 16; b = bh >> 3; h = bh & 7; row0 = (size_t)TL + (size_t)b * CTX; t0 = SEQ / 64; nt = CTX / 64; }
              attn_body::attn_unit<6, 768, 768, 512, 512, 8, false, false>((const bf16*)(ws + WS_QM) + row0 * 768 + h * 96, (const bf16*)(ws + WS_KM) + ((size_t)(b * 8 + h) * NTILE + t0) * 6144, (const bf16*)(ws + WS_VM) + ((size_t)(b * 8 + h) * NTILE + t0) * 4096,
                                                             (bf16*)(ws + WS_OM) + row0 * 512 + h * 64, nt, shm); } }
        GRID_BAR();

        if (PH(10)) REP(10) { pg8::StaticOrder S; S.init(T_l, 1024, F.G, F.bx); const bf16* wbr = (const bf16*)(ws + WS_WBR) + (size_t)l * 3 * 1024 * 512;
          { pg8::Gemm g{(const bf16*)(ws + WS_OG), wbr, T_l, 1024, 512}; pg8::EpiBranch<0> E{(const bf16*)(ws + WS_BIG), (bf16*)(ws + WS_MERGEB)};
            pg8::gemm_phase<pg8::EpiBranch<0>, pg8::StaticOrder, true, true>(F.lds + RING_OFF, g, S, E); }
          { pg8::Gemm g{(const bf16*)(ws + WS_OM), wbr + (size_t)1024 * 512, T_l, 1024, 512}; pg8::EpiBranch<1> E{(const bf16*)(ws + WS_BIG), (bf16*)(ws + WS_MERGEB)};
            pg8::gemm_phase<pg8::EpiBranch<1>, pg8::StaticOrder, true, true>(F.lds + RING_OFF, g, S, E); }
          { pg8::Gemm g{(const bf16*)(ws + WS_GM), wbr + (size_t)2 * 1024 * 512, T_l, 1024, 512}; pg8::EpiBranch<2> E{(const bf16*)(ws + WS_BIG), (bf16*)(ws + WS_MERGEB)};
            pg8::gemm_phase<pg8::EpiBranch<2>, pg8::StaticOrder, true, true>(F.lds + RING_OFF, g, S, E); } }
        GRID_BAR();

        if (PH(11)) REP(11) { pg8::Gemm g{(const bf16*)(ws + WS_MERGEB), (const bf16*)(ws + WS_WOUT) + (size_t)l * 1024 * 1024, T_l, 1024, 1024}; pg8::StaticOrder S; S.init(T_l, 1024, F.G, F.bx);
          pg8::EpiPlain E{(bf16*)(ws + WS_Y), 1024};
          pg8::gemm_phase<pg8::EpiPlain, pg8::StaticOrder, true, true>(F.lds + RING_OFF, g, S, E); }
        GRID_BAR();

        if (PH(12)) REP(12) { const float* xin_lat = (l == 0) ? F.in(I_X) : F.out(); const float* xin_ctx = (l == 0) ? F.in(I_CTX) : (const float*)(ws + WS_XC); t3_phase(F, l, T_l, xin_lat, xin_ctx, (((PH_TWICE >> 12) & 1u) && rep_ == 0) ? 64 : 0, ((PH_TWICE >> 12) & 1u) && rep_ == 0); }
        GRID_BAR();

        moe_tables(F, l, 0);

        if (PH(14)) REP(14) { const LAS int* tab = (const LAS int*)(F.lds + LDS_TAB); const int nblk = __builtin_amdgcn_readfirstlane(tab[632]);
          LAS int* rowtok = (LAS int*)(F.lds + LDS_ROWTOK);
          { const int* ltok = (const int*)(ws + WS_LTOK); const int nun = nblk * 8;
            int tk[10];
#pragma unroll
            for (int jj = 0; jj < 10; ++jj) { const int idx = F.tid + 512 * jj; const int i = idx >> 8, r = idx & 255; const long L = (long)i * F.G + vcu; tk[jj] = -1;
                if (L < nun) { const int blk = (int)(L >> 3), e = tab[blk], slot = blk * 256 + r - tab[600 + e]; if (slot < tab[640 + e]) tk[jj] = ltok[(size_t)e * TA + slot]; } }
#pragma unroll
            for (int jj = 0; jj < 10; ++jj) rowtok[F.tid + 512 * jj] = tk[jj] < 0 ? 0 : tk[jj];
            __syncthreads(); }
          pg8::Gemm g{(const bf16*)(ws + WS_XN), (const bf16*)(ws + WS_W1) + (size_t)l * 32 * 2048 * 1024, TA, 32 * 2048, 1024};
          pg8::MoeOrder<8> S{nblk * 8, F.G, vcu, tab, rowtok}; pg8::EpiMoe1 E{(bf16*)(ws + WS_H), F.in(I_EB1) + (size_t)l * 32 * 2048};
          pg8::gemm_phase<pg8::EpiMoe1, pg8::MoeOrder<8>, true, true, true>(F.lds + RING_OFF, g, S, E); }
        GRID_BAR();

        if (PH(15)) REP(15) { const LAS int* tab = (const LAS int*)(F.lds + LDS_TAB); const int nblk = __builtin_amdgcn_readfirstlane(tab[632]);
          pg8::Gemm g{(const bf16*)(ws + WS_H), (const bf16*)(ws + WS_W2) + (size_t)l * 32 * 1024 * 1024, MOE_ROWS, 32 * 1024, 1024};
          pg8::MoeOrder<4> S{nblk * 4, F.G, vcu, tab, tab}; pg8::EpiMoe2 E{(bf16*)(ws + WS_BIG), F.in(I_EB2) + (size_t)l * 32 * 1024, (const float*)(ws + WS_LW), tab};
          pg8::gemm_phase<pg8::EpiMoe2, pg8::MoeOrder<4>, true, true>(F.lds + RING_OFF, g, S, E); }
        GRID_BAR();

        if (PH(16)) REP(16) t4_phase(F, l, T_l, ((PH_TWICE >> 16) & 1u) && rep_ == 0);
        GRID_BAR();
    }
#undef GRID_BAR
}

extern "C" void kernel_launch(void* const* d_in, const int* in_sizes, int n_in, void* d_out, int out_size, void* d_ws, size_t ws_size, hipStream_t stream) {
    static int grid = 0;
    if (grid == 0) {
        if (n_in != 24 || out_size != TL * DM || ws_size < WS_END) { fprintf(stderr, "kernel_launch: unexpected problem: n_in %d out %d ws %zu (need %zu)\n", n_in, out_size, ws_size, (size_t)WS_END); grid = -1; return; }
        int dev = 0, cus = 0;
        if (hipGetDevice(&dev) != hipSuccess || hipDeviceGetAttribute(&cus, hipDeviceAttributeMultiprocessorCount, dev) != hipSuccess) { grid = -1; return; }
        if (hipFuncSetAttribute((const void*)fwd_kernel, hipFuncAttributeMaxDynamicSharedMemorySize, LDS_BYTES) != hipSuccess) { fprintf(stderr, "kernel_launch: hipFuncSetAttribute failed\n"); grid = -1; return; }
        int per_cu = 0;
        if (hipOccupancyMaxActiveBlocksPerMultiprocessor(&per_cu, (const void*)fwd_kernel, 512, LDS_BYTES) != hipSuccess || per_cu < 1) fprintf(stderr, "kernel_launch: occupancy query reports %d\n", per_cu);
        (void)hipGetLastError();
        grid = cus > 256 ? 256 : cus;
    }
    if (grid < 0) return;
    if (hipMemsetAsync((char*)d_ws + WS_CTL, 0, CTL_ZERO_BYTES, stream) != hipSuccess) return;
    Args a{};
    for (int i = 0; i < 24; ++i) a.in[i] = (const float*)d_in[i];
    a.out = (float*)d_out; a.ws = (unsigned char*)d_ws;
    hipLaunchKernelGGL(fwd_kernel, dim3(grid), dim3(512), LDS_BYTES, stream, a);
}
```

```cpp
#include <hip/hip_runtime.h>
#include <cstdio>
#include <cstdint>

typedef unsigned short bf16;

constexpr int DM = 1024, NBATCH = 2, SEQ = 16384, CTX = 256, DEPTH = 2;
constexpr int TL = NBATCH * SEQ;
constexpr int TC = NBATCH * CTX;
constexpr int TA = TL + TC;
constexpr int KPB = SEQ + CTX;
constexpr int KR = NBATCH * KPB;
constexpr int ZW = 5376;
constexpr int Z_Q = 0, Z_K = 512, Z_V = 640, Z_CQ = 768, Z_CKV = 1024, Z_KR = 1152, Z_U = 1280, Z_VG = 1792, Z_GATE = 2304;
constexpr int NEXP = 32, TOPK = 4, DEXP = 1024, MOE_ROWS = 552 * 256;
constexpr float RMS_EPS = 1e-6f;
constexpr float LOG2E = 1.4426950408889634f;
constexpr float C2G = 0.125f * LOG2E;
constexpr float C2M = 0.10206207261596577f * LOG2E;

constexpr size_t MiB = 1u << 20;
constexpr size_t WS_CTL = 0, CTL_ZERO_BYTES = 128 * 1024;
constexpr size_t WS_MOD = 1 * MiB;
constexpr size_t WS_PTAB = 1 * MiB + 512 * 1024;
constexpr size_t WS_COSG = 2 * MiB, WS_SING = 4 * MiB, WS_COSM = 6 * MiB, WS_SINM = 7 * MiB;
constexpr size_t WS_WS = 8 * MiB;
constexpr size_t WS_RWT = 8 * MiB + 512 * 1024;
constexpr size_t WS_SSV = 1 * MiB + 640 * 1024;
static_assert(WS_SSV + (size_t)TA * 2 * 4 <= 2 * MiB && WS_RWT + (size_t)DEPTH * 2 * 32 * 1024 * 2 <= 9 * MiB, "ws map small regions");
constexpr size_t WS_WUQ = 9 * MiB;
constexpr size_t WS_WUKV = 10 * MiB;
constexpr size_t WS_WBR = 11 * MiB;
constexpr size_t WS_WOUT = 17 * MiB;
constexpr size_t WS_WIN = 21 * MiB;
constexpr size_t WS_W1 = 42 * MiB;
constexpr size_t WS_W2 = 298 * MiB;
constexpr size_t WS_XC = 426 * MiB;
constexpr size_t WS_RTE = 428 * MiB;
constexpr size_t WS_RTS = 429 * MiB;
constexpr size_t WS_LTOK = 430 * MiB;
constexpr size_t WS_LW = 435 * MiB;
constexpr size_t WS_XN = 441 * MiB;
constexpr size_t WS_QG = 506 * MiB;
constexpr size_t WS_KG = 539 * MiB;
constexpr size_t WS_VG = 548 * MiB;
constexpr size_t WS_CQN = 557 * MiB;
constexpr size_t WS_CKVN = 574 * MiB;
constexpr size_t WS_QM = 583 * MiB;
constexpr size_t WS_KM = 632 * MiB;
constexpr size_t WS_VM = 681 * MiB;
constexpr size_t WS_OG = 714 * MiB;
constexpr size_t WS_OM = 747 * MiB;
constexpr size_t WS_GM = 780 * MiB;
constexpr size_t WS_UACT = 813 * MiB;
constexpr size_t WS_VN = 846 * MiB;
constexpr size_t WS_MERGE = 879 * MiB;
constexpr size_t WS_MERGEB = 1009 * MiB;
constexpr size_t WS_Y = 1074 * MiB;
constexpr size_t WS_H = 1139 * MiB;
constexpr size_t WS_BIG = 1415 * MiB;
constexpr size_t WS_END = 1757 * MiB;
static_assert(WS_BIG + (size_t)TA * ZW * 2 <= WS_END && WS_BIG + (size_t)MOE_ROWS * 1024 * 2 <= WS_END && WS_H + (size_t)MOE_ROWS * 1024 * 2 <= WS_BIG, "ws map");
static_assert(WS_W1 + (size_t)DEPTH * 32 * 2048 * 1024 * 2 <= WS_W2 && WS_W2 + (size_t)DEPTH * 32 * 1024 * 1024 * 2 <= WS_XC, "ws map weights");
static_assert(WS_MERGE + (size_t)TA * 1024 * 4 <= WS_MERGEB && WS_XN + (size_t)TA * 1024 * 2 <= WS_QG && WS_QM + (size_t)TA * 768 * 2 <= WS_KM, "ws map acts");
constexpr int CW_BAR = 4096;
constexpr int CW_CNT = 16384;
constexpr int CW_BGQ = 16384 + 512;
static_assert((CW_BGQ + 1) * 4 <= (int)CTL_ZERO_BYTES && (CW_BAR + 3456) * 4 <= (int)CTL_ZERO_BYTES, "control words inside the per-call memset");

constexpr int RING_OFF = 0, RING_BYTES = 131072;
constexpr int LDS_X = RING_BYTES + 4096;
constexpr int LDS_SVEC = LDS_X;
constexpr int LDS_ROWTOK = LDS_X;
constexpr int MISC_OFF = 159744;
constexpr int LDS_TAB = 160000;
constexpr int LDS_BYTES = 163840;
static_assert(LDS_SVEC + 3 * 1024 * 4 <= MISC_OFF && LDS_ROWTOK + 20 * 1024 <= MISC_OFF && LDS_TAB + 704 * 4 <= LDS_BYTES, "LDS map");

#define GAS __attribute__((address_space(1)))
#define LAS __attribute__((address_space(3)))
typedef unsigned v4u __attribute__((ext_vector_type(4)));
typedef float f32x4 __attribute__((ext_vector_type(4)));
typedef GAS unsigned gu32;
#define RLX_AGENT __ATOMIC_RELAXED, __HIP_MEMORY_SCOPE_AGENT
#define LDS_WAIT() asm volatile("s_waitcnt lgkmcnt(0)" ::: "memory")
#define VM_WAIT() asm volatile("s_waitcnt vmcnt(0)" ::: "memory")

__device__ __forceinline__ unsigned cvt_pk(float lo, float hi) { unsigned r; asm volatile("v_cvt_pk_bf16_f32 %0, %1, %2" : "=v"(r) : "v"(lo), "v"(hi)); return r; }
__device__ __forceinline__ float bf_lo(unsigned u) { return __uint_as_float(u << 16); }
__device__ __forceinline__ float bf_hi(unsigned u) { return __uint_as_float(u & 0xffff0000u); }
__device__ __forceinline__ void unpack8(v4u r, float (&f)[8]) { f[0] = bf_lo(r.x); f[1] = bf_hi(r.x); f[2] = bf_lo(r.y); f[3] = bf_hi(r.y); f[4] = bf_lo(r.z); f[5] = bf_hi(r.z); f[6] = bf_lo(r.w); f[7] = bf_hi(r.w); }
__device__ __forceinline__ v4u pack8(const float (&f)[8]) { v4u o; o.x = cvt_pk(f[0], f[1]); o.y = cvt_pk(f[2], f[3]); o.z = cvt_pk(f[4], f[5]); o.w = cvt_pk(f[6], f[7]); return o; }
__device__ __forceinline__ float sigmoidf_(float x) { return __builtin_amdgcn_rcpf(1.f + __builtin_amdgcn_exp2f(-LOG2E * x)); }
__device__ __forceinline__ float wave_sum(float v) {
#pragma unroll
    for (int o = 1; o < 64; o <<= 1) v += __shfl_xor(v, o);
    return v;
}
__device__ __forceinline__ float gelu_tanh(float x) { const float u = 1.5957691216057308f * (x + 0.044715f * x * x * x); return x * __builtin_amdgcn_rcpf(1.f + __builtin_amdgcn_exp2f(-LOG2E * u)); }
constexpr int NTILE = KPB / 64;
__device__ __forceinline__ void bpos_of(int r, int& b, int& pos) { if (r < TL) { b = r >> 14; pos = r & (SEQ - 1); } else { b = (r - TL) >> 8; pos = SEQ + ((r - TL) & (CTX - 1)); } }
__device__ __forceinline__ size_t ktile_off(int strm, int pos, int chunk, int nch) { return (((size_t)strm * NTILE + (pos >> 6)) * nch + chunk) * 512 + (size_t)(pos & 63) * 8; }
__device__ __forceinline__ size_t vtile_off(int strm, int pos, int d) { const int piece = (d >> 5) * 4 + ((pos & 63) >> 4), ln = (pos & 15) * 4 + ((d >> 3) & 3); return (((size_t)strm * NTILE + (pos >> 6)) * 8 + piece) * 512 + (size_t)ln * 8; }
__device__ __forceinline__ int krow_of(int r) { return r < TL ? (r >> 14) * KPB + (r & (SEQ - 1)) : ((r - TL) >> 8) * KPB + SEQ + ((r - TL) & (CTX - 1)); }

__device__ const float INVF16[16] = {1.0f, 0.5623413324356079f, 0.3162277638912201f, 0.17782793939113617f, 0.10000000149011612f, 0.05623413249850273f, 0.03162277489900589f, 0.017782794311642647f,
                                     0.009999999776482582f, 0.005623413249850273f, 0.003162277629598975f, 0.0017782794311642647f, 0.0010000000474974513f, 0.000562341301701963f, 0.0003162277571391314f, 0.00017782794020604342f};
namespace pg8 {
#define PG8_LAS __attribute__((address_space(3)))
typedef unsigned short bf16_t;
typedef short bf16x8 __attribute__((ext_vector_type(8)));
typedef float f32x4 __attribute__((ext_vector_type(4)));
typedef unsigned u32x4 __attribute__((ext_vector_type(4)));
constexpr int BM = 256, BK = 64, HALF = 128, HTB = HALF * BK * 2  , STAGE_BYTES = 8 * HTB, NXCD = 8, WGM = 8;

__host__ __device__ __forceinline__ int lds_byte(int r, int c) { const int st = (r >> 4) * 2 + (c >> 5), rr = r & 15, cc = c & 31, ob = rr * 64 + cc * 2; return st * 1024 + (ob ^ (((ob >> 9) & 1) << 5)); }
__host__ __device__ __forceinline__ void stage_rc(int b, int& R, int& C) { const int st = b / 1024, sb = b % 1024, swz = sb ^ (((sb >> 9) & 1) << 5); R = (st >> 1) * 16 + swz / 64; C = (st & 1) * 32 + (swz % 64) / 2; }
__host__ __device__ __forceinline__ int perm32(int rho) { const int n = rho >> 4, i = rho & 15; return 8 * (i >> 2) + 4 * n + (i & 3); }

struct Unit { int pm, pn; };
struct Gemm { const bf16_t* A; const bf16_t* Bt; int M, N, K; };

struct StaticOrder {
    int nM, nN, nwg, G, c;
    __device__ void init(int M, int N, int G_, int c_) { asm volatile("" : "+s"(M), "+s"(N));
        nM = M / BM; nN = N / BM; nwg = nM * nN; G = G_; c = c_; }
    __host__ __device__ bool next(int i, Unit& u) const {
        const long L = (long)i * G + c; if (L >= nwg) return false;
        int wgid = (int)L; { const int q = nwg / NXCD, r = nwg % NXCD, xcd = wgid % NXCD, off = wgid / NXCD; wgid = (xcd < r ? xcd * (q + 1) : r * (q + 1) + (xcd - r) * q) + off; }
        const int nig = WGM * nN, gid = wgid / nig, fm = gid * WGM, gsz = (nM - fm) < WGM ? (nM - fm) : WGM;
        u.pm = fm + ((wgid % nig) % gsz); u.pn = (wgid % nig) / gsz; return true;
    }
    __device__ __forceinline__ void a_ready(const Unit&) const {}
    __device__ __forceinline__ void done(const Unit&) const {}
};

template <class Epi, class Sched, bool ALIGN_EPI = false, bool SP2 = false, bool GATHER = false>
__device__ __forceinline__ void gemm_phase(PG8_LAS unsigned char* lds, const Gemm g, const Sched& S, const Epi& E) {
    static_assert(!GATHER || SP2, "GATHER is implemented for the SP2 loop only");
    int tid_ = threadIdx.x; asm volatile("" : "+v"(tid_));
    const int tid = tid_, wid = __builtin_amdgcn_readfirstlane(tid >> 6), lane = tid & 63, wr = wid >> 2, wc = wid & 3, fr = lane & 15, fq = lane >> 4;
    int K_ = g.K; asm volatile("" : "+s"(K_));
    const int K = K_, nt = K / BK;
    unsigned voffA[2], voffB[2];
#pragma unroll
    for (int i = 0; i < 2; ++i) { int R, C; stage_rc(tid * 16 + i * 8192, R, C); const int Rb = Epi::PERM ? ((R & ~31) + perm32(R & 31)) : R;
        voffA[i] = (unsigned)(R * K + C) * 2u; voffB[i] = (unsigned)(Rb * K + C) * 2u; }
    unsigned vAc0[2] = {0u, 0u}, vAc1[2] = {0u, 0u}, vAn0[2] = {0u, 0u}, vAn1[2] = {0u, 0u}, vsel0[2] = {0u, 0u}, vsel1[2] = {0u, 0u};
#define PG8_GOFF(dst0, dst1, uidx) do { _Pragma("unroll") for (int i_ = 0; i_ < 2; ++i_) { int R_, C_; stage_rc(tid * 16 + i_ * 8192, R_, C_); \
        dst0[i_] = ((unsigned)S.tok((uidx), R_) * (unsigned)K + (unsigned)C_) * 2u; dst1[i_] = ((unsigned)S.tok((uidx), HALF + R_) * (unsigned)K + (unsigned)C_) * 2u; } } while (0)
#define PG8_STG_A(bufoff, base, H, SEL) do { if constexpr (GATHER) { if (SEL) { PG8_STAGE(bufoff, base, vsel##H); } else { PG8_STAGE(bufoff, base, vAc##H); } } else { PG8_STAGE(bufoff, (base) + (H) * hstep, voffA); } } while (0)
    const size_t kstep = (size_t)(BK * 2);
    const size_t hstep = (size_t)HALF * K * 2;
    const size_t tstep = 2 * hstep;
    const unsigned ldsw = (unsigned)wid * 1024u;
    const int aoff = lds_byte(wr * 64 + fr, fq * 8), boff = lds_byte(wc * 32 + fr, fq * 8);
#define PG8_SA(b, h) (((b) * 2 + (h)) * HTB)
#define PG8_SB(b, h) ((4 + (b) * 2 + (h)) * HTB)
#define PG8_STAGE(bufoff, gbase, voff) do { _Pragma("unroll") for (int _i = 0; _i < 2; ++_i) \
        __builtin_amdgcn_global_load_lds((const unsigned*)((const char*)(gbase) + (voff)[_i]), (PG8_LAS unsigned*)(lds + (bufoff) + ldsw + _i * 8192), 16, 0, 0); } while (0)
#define PG8_LDA(dst, b, h) do { _Pragma("unroll") for (int m = 0; m < 4; ++m) _Pragma("unroll") for (int k = 0; k < 2; ++k) dst[m][k] = *(const PG8_LAS bf16x8*)(lds + PG8_SA(b, h) + aoff + m * 2048 + k * 1024); } while (0)
#define PG8_LDB(dst, b, h) do { _Pragma("unroll") for (int n = 0; n < 2; ++n) _Pragma("unroll") for (int k = 0; k < 2; ++k) dst[n][k] = *(const PG8_LAS bf16x8*)(lds + PG8_SB(b, h) + boff + n * 2048 + k * 1024); } while (0)
#define PG8_MMA(ai, bj, At, Bt) do { __builtin_amdgcn_s_setprio(1); _Pragma("unroll") for (int m = 0; m < 4; ++m) _Pragma("unroll") for (int n = 0; n < 2; ++n) _Pragma("unroll") for (int k = 0; k < 2; ++k) \
        acc[ai][bj][m][n] = __builtin_amdgcn_mfma_f32_16x16x32_bf16(Bt[n][k], At[m][k], acc[ai][bj][m][n], 0, 0, 0); __builtin_amdgcn_s_setprio(0); } while (0)
#define PG8_WAIT_V(n) asm volatile("s_waitcnt vmcnt(" #n ")" ::: "memory")
#define PG8_WAIT_L(n) asm volatile("s_waitcnt lgkmcnt(" #n ")" ::: "memory")
#define PG8_BAR __builtin_amdgcn_s_barrier()
#define PG8_SCHED __builtin_amdgcn_sched_barrier(0)
    Unit cur, nxt; int ui = 0;
    if (!S.next(0, cur)) return;
    f32x4 acc[2][2][4][2];
#pragma unroll
    for (int a = 0; a < 2; ++a)
#pragma unroll
        for (int b = 0; b < 2; ++b)
#pragma unroll
            for (int m = 0; m < 4; ++m)
#pragma unroll
                for (int n = 0; n < 2; ++n) acc[a][b][m][n] = (f32x4){0.f, 0.f, 0.f, 0.f};
    bf16x8 At[4][2], B0[2][2], B1[2][2];
    const char* cA = GATHER ? (const char*)g.A : (const char*)g.A + (size_t)cur.pm * tstep; const char* cB = (const char*)g.Bt + (size_t)cur.pn * tstep;
    if constexpr (GATHER) { PG8_GOFF(vAc0, vAc1, 0); }
    S.a_ready(cur);
    if constexpr (SP2) {
        PG8_STAGE(PG8_SB(0, 0), cB, voffB); PG8_STAGE(PG8_SB(0, 1), cB + hstep, voffB); PG8_STG_A(PG8_SA(0, 0), cA, 0, false); PG8_STG_A(PG8_SA(0, 1), cA, 1, false);
        if (wr == 1) PG8_BAR;
        PG8_WAIT_V(2); PG8_BAR;
        PG8_STAGE(PG8_SB(1, 0), cB + kstep, voffB); PG8_STG_A(PG8_SA(1, 0), cA + kstep, 0, false); PG8_STAGE(PG8_SB(1, 1), cB + hstep + kstep, voffB);
        PG8_WAIT_V(6); PG8_BAR;
    } else {
        PG8_STAGE(PG8_SB(0, 0), cB, voffB); PG8_STAGE(PG8_SA(0, 0), cA, voffA); PG8_STAGE(PG8_SB(0, 1), cB + hstep, voffB); PG8_STAGE(PG8_SA(0, 1), cA + hstep, voffA);
        if (wr == 1) PG8_BAR;
        PG8_WAIT_V(4); PG8_BAR;
        PG8_STAGE(PG8_SB(1, 0), cB + kstep, voffB); PG8_STAGE(PG8_SA(1, 0), cA + kstep, voffA); PG8_STAGE(PG8_SB(1, 1), cB + hstep + kstep, voffB);
        PG8_WAIT_V(6); PG8_BAR;
    }
    for (;;) {
        const bool has_next = S.next(ui + 1, nxt);
        const char* nA = GATHER ? (const char*)g.A : (has_next ? (const char*)g.A + (size_t)nxt.pm * tstep : cA);
        if constexpr (GATHER) { if (has_next) { PG8_GOFF(vAn0, vAn1, ui + 1); } else { vAn0[0] = vAc0[0]; vAn0[1] = vAc0[1]; vAn1[0] = vAc1[0]; vAn1[1] = vAc1[1]; } } const char* nB = has_next ? (const char*)g.Bt + (size_t)nxt.pn * tstep : cB;
        for (int t = 0; t < nt; t += 2) {
            const bool last = (t == nt - 2);
            const char* a1 = cA + (size_t)(t + 1) * kstep;
            const char* a2 = last ? nA : cA + (size_t)(t + 2) * kstep; const char* b2 = last ? nB : cB + (size_t)(t + 2) * kstep;
            const char* a3 = a2 + kstep; const char* b3 = b2 + kstep;
            if (last && has_next) S.a_ready(nxt);
            if constexpr (GATHER) { vsel0[0] = last ? vAn0[0] : vAc0[0]; vsel0[1] = last ? vAn0[1] : vAc0[1]; vsel1[0] = last ? vAn1[0] : vAc1[0]; vsel1[1] = last ? vAn1[1] : vAc1[1]; }
            if constexpr (SP2) {
            PG8_LDB(B0, 0, 0); PG8_LDB(B1, 0, 1); PG8_SCHED; PG8_LDA(At, 0, 0); PG8_STG_A(PG8_SA(1, 1), a1, 1, false);
            PG8_WAIT_V(8); PG8_WAIT_L(0); PG8_BAR; PG8_MMA(0, 0, At, B0); PG8_MMA(0, 1, At, B1); PG8_BAR; PG8_SCHED;
            PG8_LDA(At, 0, 1); PG8_STAGE(PG8_SB(0, 0), b2, voffB); PG8_STAGE(PG8_SB(0, 1), b2 + hstep, voffB); PG8_STG_A(PG8_SA(0, 0), a2, 0, true);
            PG8_WAIT_V(8); PG8_WAIT_L(0); PG8_BAR; PG8_MMA(1, 0, At, B0); PG8_MMA(1, 1, At, B1); PG8_BAR; PG8_SCHED;
            PG8_LDB(B0, 1, 0); PG8_LDB(B1, 1, 1); PG8_SCHED; PG8_LDA(At, 1, 0); PG8_STG_A(PG8_SA(0, 1), a2, 1, true);
            PG8_WAIT_V(8); PG8_WAIT_L(0); PG8_BAR; PG8_MMA(0, 0, At, B0); PG8_MMA(0, 1, At, B1); PG8_BAR; PG8_SCHED;
            PG8_LDA(At, 1, 1); PG8_STAGE(PG8_SB(1, 0), b3, voffB); PG8_STAGE(PG8_SB(1, 1), b3 + hstep, voffB); PG8_STG_A(PG8_SA(1, 0), a3, 0, true);
            PG8_WAIT_V(8); PG8_WAIT_L(0); PG8_BAR; PG8_MMA(1, 0, At, B0); PG8_MMA(1, 1, At, B1); PG8_BAR; PG8_SCHED;
            } else {
            PG8_LDB(B0, 0, 0); PG8_SCHED; PG8_LDA(At, 0, 0); PG8_STAGE(PG8_SA(1, 1), a1 + hstep, voffA);
            PG8_WAIT_L(8); PG8_BAR; PG8_WAIT_L(0); PG8_MMA(0, 0, At, B0); PG8_BAR; PG8_SCHED;
            PG8_LDB(B1, 0, 1); PG8_STAGE(PG8_SB(0, 0), b2, voffB);
            PG8_BAR; PG8_WAIT_L(0); PG8_MMA(0, 1, At, B1); PG8_BAR;
            PG8_LDA(At, 0, 1); PG8_STAGE(PG8_SA(0, 0), a2, voffA);
            PG8_BAR; PG8_WAIT_L(0); PG8_MMA(1, 0, At, B0); PG8_BAR; PG8_SCHED;
            PG8_STAGE(PG8_SB(0, 1), b2 + hstep, voffB);
            PG8_WAIT_V(6); PG8_BAR; PG8_MMA(1, 1, At, B1); PG8_BAR;
            PG8_LDB(B0, 1, 0); PG8_SCHED; PG8_LDA(At, 1, 0); PG8_STAGE(PG8_SA(0, 1), a2 + hstep, voffA);
            PG8_WAIT_L(8); PG8_BAR; PG8_WAIT_L(0); PG8_MMA(0, 0, At, B0); PG8_BAR; PG8_SCHED;
            PG8_LDB(B1, 1, 1); PG8_STAGE(PG8_SB(1, 0), b3, voffB);
            PG8_BAR; PG8_WAIT_L(0); PG8_MMA(0, 1, At, B1); PG8_BAR;
            PG8_LDA(At, 1, 1); PG8_STAGE(PG8_SA(1, 0), a3, voffA);
            PG8_BAR; PG8_WAIT_L(0); PG8_MMA(1, 0, At, B0); PG8_BAR; PG8_SCHED;
            PG8_STAGE(PG8_SB(1, 1), b3 + hstep, voffB);
            PG8_WAIT_V(6); PG8_BAR; PG8_MMA(1, 1, At, B1); PG8_BAR;
            }
        }
        if constexpr (ALIGN_EPI) { if (wr == 0) PG8_BAR; }
        if constexpr (!Epi::AFTER_DRAIN) { E(acc, cur, wr, wc, fr, fq); S.done(cur); }
        if (!has_next) break;
#pragma unroll
        for (int a = 0; a < 2; ++a)
#pragma unroll
            for (int b = 0; b < 2; ++b)
#pragma unroll
                for (int m = 0; m < 4; ++m)
#pragma unroll
                    for (int n = 0; n < 2; ++n) acc[a][b][m][n] = (f32x4){0.f, 0.f, 0.f, 0.f};
        cur = nxt; cA = nA; cB = nB; ++ui;
        if constexpr (GATHER) { vAc0[0] = vAn0[0]; vAc0[1] = vAn0[1]; vAc1[0] = vAn1[0]; vAc1[1] = vAn1[1]; }
        if constexpr (ALIGN_EPI) { if (wr == 1) PG8_BAR; }
    }
    PG8_WAIT_V(0);
    if constexpr (!ALIGN_EPI) { if (wr == 0) PG8_BAR; }
    PG8_BAR;
    if constexpr (Epi::AFTER_DRAIN) { E.fused(acc, cur, wr, wc, fr, fq, lds, wid, lane); S.done(cur); }
#undef PG8_SA
#undef PG8_SB
#undef PG8_STAGE
#undef PG8_LDA
#undef PG8_LDB
#undef PG8_MMA
#undef PG8_WAIT_V
#undef PG8_WAIT_L
#undef PG8_BAR
#undef PG8_SCHED
#undef PG8_GOFF
#undef PG8_STG_A
}
}
namespace pg8 {
#define EPI_ROWS(u, wr, fr) const int row00 = (u).pm * BM + (wr) * 64 + (fr)
#define EPI_GET8(v, ai, bj, m) float v[8] = {acc[ai][bj][m][0][0], acc[ai][bj][m][0][1], acc[ai][bj][m][0][2], acc[ai][bj][m][0][3], acc[ai][bj][m][1][0], acc[ai][bj][m][1][1], acc[ai][bj][m][1][2], acc[ai][bj][m][1][3]}

struct EpiPlain {
    static constexpr bool PERM = true, AFTER_DRAIN = false;
    bf16_t* O; int ldc;
    __device__ __forceinline__ void operator()(const f32x4 (&acc)[2][2][4][2], const Unit& u, int wr, int wc, int fr, int fq) const {
        asm volatile("" : "+v"(fr), "+v"(fq));
        EPI_ROWS(u, wr, fr); const int col0 = u.pn * BM + wc * 32 + 8 * fq;
#pragma unroll
        for (int ai = 0; ai < 2; ++ai)
#pragma unroll
            for (int m = 0; m < 4; ++m) { bf16_t* rowp = O + (size_t)(row00 + ai * HALF + m * 16) * ldc + col0;
#pragma unroll
                for (int bj = 0; bj < 2; ++bj) { EPI_GET8(v, ai, bj, m); *(u32x4*)(rowp + bj * HALF) = pack8(v); } }
    }
};

struct EpiInproj {
    static constexpr bool PERM = true, AFTER_DRAIN = false;
    unsigned char* ws; const float *qkn, *mqn, *mkvn; PG8_LAS float* xs;
    __device__ __forceinline__ void operator()(const f32x4 (&acc)[2][2][4][2], const Unit& u, int wr, int wc, int fr, int fq) const {
        asm volatile("" : "+v"(fr), "+v"(fq));
        EPI_ROWS(u, wr, fr); const int pn = u.pn; const bool lat = (u.pm * BM) < TL;
        if (pn >= 9) {
            const int col0 = (pn - 9) * BM + wc * 32 + 8 * fq;
#pragma unroll
            for (int ai = 0; ai < 2; ++ai)
#pragma unroll
                for (int m = 0; m < 4; ++m) { bf16_t* rowp = (bf16_t*)(ws + WS_BIG) + (size_t)(row00 + ai * HALF + m * 16) * 3072 + col0;
#pragma unroll
                    for (int bj = 0; bj < 2; ++bj) { EPI_GET8(v, ai, bj, m); *(u32x4*)(rowp + bj * HALF) = pack8(v); } }
        } else if (pn <= 2) {
            if (pn == 2 && wc >= 2) {
#pragma unroll
                for (int ai = 0; ai < 2; ++ai)
#pragma unroll
                    for (int m = 0; m < 4; ++m) { const int row = row00 + ai * HALF + m * 16; int b_, pos_; bpos_of(row, b_, pos_); bf16_t* vb = (bf16_t*)(ws + WS_VG); const int st = b_ * 2 + (wc - 2);
                        EPI_GET8(x1, ai, 0, m); EPI_GET8(x2, ai, 1, m); *(u32x4*)(vb + vtile_off(st, pos_, 8 * fq)) = pack8(x1); *(u32x4*)(vb + vtile_off(st, pos_, 32 + 8 * fq)) = pack8(x2); }
            } else {
                const bool isq = pn < 2; const float* gn = qkn + (isq ? 0 : 64) + 8 * fq;
                const f32x4 ga0 = *(const f32x4*)gn, ga1 = *(const f32x4*)(gn + 4), gb0 = *(const f32x4*)(gn + 32), gb1 = *(const f32x4*)(gn + 36);
                const float g1[8] = {ga0[0], ga0[1], ga0[2], ga0[3], ga1[0], ga1[1], ga1[2], ga1[3]}, g2[8] = {gb0[0], gb0[1], gb0[2], gb0[3], gb1[0], gb1[1], gb1[2], gb1[3]};
                const float sc = isq ? C2G : 1.f;
#pragma unroll
                for (int am = 0; am < 4; ++am) { const int ai = am >> 1, m0 = 2 * (am & 1);
                    f32x4 tc[2][2], ts[2][2];
#pragma unroll
                    for (int mm = 0; mm < 2; ++mm) { const int pos = lat ? ((row00 + ai * HALF + (m0 + mm) * 16) & (SEQ - 1)) : 0; const f32x4* cp = (const f32x4*)((const float*)(ws + WS_COSG) + (size_t)pos * 32 + 8 * fq); const f32x4* sp = (const f32x4*)((const float*)(ws + WS_SING) + (size_t)pos * 32 + 8 * fq);
                        tc[mm][0] = cp[0]; tc[mm][1] = cp[1]; ts[mm][0] = sp[0]; ts[mm][1] = sp[1]; }
#pragma unroll
                    for (int mm = 0; mm < 2; ++mm) { const int m = m0 + mm; const int row = row00 + ai * HALF + m * 16; const f32x4 c0 = tc[mm][0], c1 = tc[mm][1], s0 = ts[mm][0], s1 = ts[mm][1];
                        EPI_GET8(x1, ai, 0, m); EPI_GET8(x2, ai, 1, m); float ss = 0.f;
#pragma unroll
                        for (int i = 0; i < 8; ++i) ss += x1[i] * x1[i] + x2[i] * x2[i];
                        ss += __shfl_xor(ss, 16); ss += __shfl_xor(ss, 32);
                        const float rstd = __builtin_amdgcn_rsqf(ss * (1.f / 64.f) + RMS_EPS); float o1[8], o2[8];
#pragma unroll
                        for (int i = 0; i < 8; ++i) { const float y1 = x1[i] * rstd * g1[i], y2 = x2[i] * rstd * g2[i]; const float c = lat ? (i < 4 ? c0[i & 3] : c1[i & 3]) : 1.f, s = lat ? (i < 4 ? s0[i & 3] : s1[i & 3]) : 0.f;
                            o1[i] = (y1 * c - y2 * s) * sc; o2[i] = (y2 * c + y1 * s) * sc; }
                        if (isq) { bf16_t* p = (bf16_t*)(ws + WS_QG) + (size_t)row * 512 + (4 * pn + wc) * 64 + 8 * fq; *(u32x4*)p = pack8(o1); *(u32x4*)(p + 32) = pack8(o2); }
                        else { int b_, pos_; bpos_of(row, b_, pos_); bf16_t* kb = (bf16_t*)(ws + WS_KG); const int st = b_ * 2 + wc; *(u32x4*)(kb + ktile_off(st, pos_, fq, 8)) = pack8(o1); *(u32x4*)(kb + ktile_off(st, pos_, 4 + fq, 8)) = pack8(o2); } }
                    asm volatile("" ::: "memory"); }
            }
        } else if (pn == 3 || pn == 4 || pn == 7 || pn == 8) {
            const bool vg = pn >= 7; const bool part = (pn == 4) ? (wc < 2) : true;
            float ssr[2][4];
#pragma unroll
            for (int ai = 0; ai < 2; ++ai)
#pragma unroll
                for (int m = 0; m < 4; ++m) { float ss = 0.f;
#pragma unroll
                    for (int bj = 0; bj < 2; ++bj) { EPI_GET8(v, ai, bj, m);
#pragma unroll
                        for (int i = 0; i < 8; ++i) { const float t = vg ? gelu_tanh(v[i]) : v[i]; ss += t * t; } }
                    ss += __shfl_xor(ss, 16); ss += __shfl_xor(ss, 32); ssr[ai][m] = part ? ss : 0.f;
                    if (fq == 0) xs[(ai * HALF + wr * 64 + m * 16 + fr) * 4 + wc] = ssr[ai][m]; }
            asm volatile("s_waitcnt lgkmcnt(0)\n\ts_barrier" ::: "memory");
#pragma unroll
            for (int ai = 0; ai < 2; ++ai)
#pragma unroll
                for (int m = 0; m < 4; ++m) { const f32x4 t = *(const PG8_LAS f32x4*)(xs + (ai * HALF + wr * 64 + m * 16 + fr) * 4); ssr[ai][m] = (t[0] + t[1]) + (t[2] + t[3]); }
            asm volatile("s_waitcnt lgkmcnt(0)\n\ts_barrier" ::: "memory");
            if (pn == 3) {
                const int col0 = wc * 32 + 8 * fq;
#pragma unroll
                for (int ai = 0; ai < 2; ++ai)
#pragma unroll
                    for (int m = 0; m < 4; ++m) { const int row = row00 + ai * HALF + m * 16; const float rstd = __builtin_amdgcn_rsqf(ssr[ai][m] * (1.f / 256.f) + RMS_EPS);
#pragma unroll
                        for (int bj = 0; bj < 2; ++bj) { EPI_GET8(v, ai, bj, m); const int col = col0 + bj * HALF; const f32x4 ga = *(const f32x4*)(mqn + col), gb = *(const f32x4*)(mqn + col + 4);
#pragma unroll
                            for (int i = 0; i < 8; ++i) v[i] *= rstd * (i < 4 ? ga[i] : gb[i - 4]);
                            *(u32x4*)((bf16_t*)(ws + WS_CQN) + (size_t)row * 256 + col) = pack8(v); } }
            } else if (pn == 4) {
                if (wc < 2) {
#pragma unroll
                    for (int ai = 0; ai < 2; ++ai)
#pragma unroll
                        for (int m = 0; m < 4; ++m) { const int row = row00 + ai * HALF + m * 16; const float rstd = __builtin_amdgcn_rsqf(ssr[ai][m] * (1.f / 128.f) + RMS_EPS);
#pragma unroll
                            for (int bj = 0; bj < 2; ++bj) { EPI_GET8(v, ai, bj, m); const int col = wc * 64 + bj * 32 + 8 * fq; const f32x4 ga = *(const f32x4*)(mkvn + col), gb = *(const f32x4*)(mkvn + col + 4);
#pragma unroll
                                for (int i = 0; i < 8; ++i) v[i] *= rstd * (i < 4 ? ga[i] : gb[i - 4]);
                                *(u32x4*)((bf16_t*)(ws + WS_CKVN) + (size_t)row * 128 + col) = pack8(v); } }
                } else if (wc == 2 && fq < 2) {
#pragma unroll
                    for (int ai = 0; ai < 2; ++ai)
#pragma unroll
                        for (int m = 0; m < 4; ++m) { const int row = row00 + ai * HALF + m * 16; const int pos = row & (SEQ - 1);
                            EPI_GET8(x1, ai, 0, m); EPI_GET8(x2, ai, 1, m); float o1[8], o2[8];
                            if (lat) { const f32x4* cp = (const f32x4*)((const float*)(ws + WS_COSM) + (size_t)pos * 16 + 8 * fq); const f32x4* sp = (const f32x4*)((const float*)(ws + WS_SINM) + (size_t)pos * 16 + 8 * fq); const f32x4 c0 = cp[0], c1 = cp[1], s0 = sp[0], s1 = sp[1];
#pragma unroll
                                for (int i = 0; i < 8; ++i) { const float c = i < 4 ? c0[i] : c1[i - 4], s = i < 4 ? s0[i] : s1[i - 4]; o1[i] = x1[i] * c - x2[i] * s; o2[i] = x2[i] * c + x1[i] * s; } }
                            else {
#pragma unroll
                                for (int i = 0; i < 8; ++i) { o1[i] = x1[i]; o2[i] = x2[i]; } }
                            const u32x4 p1 = pack8(o1), p2 = pack8(o2); int b_, pos_; bpos_of(row, b_, pos_); bf16_t* kb = (bf16_t*)(ws + WS_KM);
#pragma unroll
                            for (int h = 0; h < 8; ++h) { *(u32x4*)(kb + ktile_off(b_ * 8 + h, pos_, 8 + fq, 12)) = p1; *(u32x4*)(kb + ktile_off(b_ * 8 + h, pos_, 10 + fq, 12)) = p2; } }
                }
            } else {
                const int half = pn - 7, col0 = half * BM + wc * 32 + 8 * fq;
#pragma unroll
                for (int ai = 0; ai < 2; ++ai)
#pragma unroll
                    for (int m = 0; m < 4; ++m) { const int row = row00 + ai * HALF + m * 16;
#pragma unroll
                        for (int bj = 0; bj < 2; ++bj) { EPI_GET8(v, ai, bj, m);
#pragma unroll
                            for (int i = 0; i < 8; ++i) v[i] = gelu_tanh(v[i]);
                            *(u32x4*)((bf16_t*)(ws + WS_VN) + (size_t)row * 512 + col0 + bj * HALF) = pack8(v); }
                        if (wc == 0 && fq == 0) ((float*)(ws + WS_SSV))[(size_t)row * 2 + half] = ssr[ai][m]; }
            }
        } else {
            const int col0 = (pn - 5) * BM + wc * 32 + 8 * fq;
#pragma unroll
            for (int ai = 0; ai < 2; ++ai)
#pragma unroll
                for (int m = 0; m < 4; ++m) { const int row = row00 + ai * HALF + m * 16;
#pragma unroll
                    for (int bj = 0; bj < 2; ++bj) { EPI_GET8(v, ai, bj, m);
#pragma unroll
                        for (int i = 0; i < 8; ++i) v[i] = gelu_tanh(v[i]);
                        *(u32x4*)((bf16_t*)(ws + WS_UACT) + (size_t)row * 512 + col0 + bj * HALF) = pack8(v); } }
        }
    }
};

struct EpiUq {
    static constexpr bool PERM = true, AFTER_DRAIN = false;
    bf16_t* Qm; const float* cosM; const float* sinM;
    __device__ __forceinline__ void operator()(const f32x4 (&acc)[2][2][4][2], const Unit& u, int wr, int wc, int fr, int fq) const {
        asm volatile("" : "+v"(fr), "+v"(fq));
        EPI_ROWS(u, wr, fr);
        if (u.pn < 2) {
#pragma unroll
            for (int ai = 0; ai < 2; ++ai)
#pragma unroll
                for (int m = 0; m < 4; ++m) { const int row = row00 + ai * HALF + m * 16;
#pragma unroll
                    for (int bj = 0; bj < 2; ++bj) { const int col = u.pn * BM + bj * HALF + wc * 32 + 8 * fq; const int head = col >> 6, d = col & 63;
                        EPI_GET8(v, ai, bj, m);
#pragma unroll
                        for (int i = 0; i < 8; ++i) v[i] *= C2M;
                        *(u32x4*)(Qm + (size_t)row * 768 + head * 96 + d) = pack8(v); } asm volatile("" ::: "memory"); }
        } else {
            const int cc = wc * 32 + 8 * fq, hh = cc >> 4, j0 = cc & 15;
            const bool lat = (u.pm * BM) < TL;
#pragma unroll
            for (int ai = 0; ai < 2; ++ai) {
                f32x4 tc[4][2], ts[4][2];
#pragma unroll
                for (int m = 0; m < 4; ++m) { const int pos = lat ? ((row00 + ai * HALF + m * 16) & (SEQ - 1)) : 0; const f32x4* cp = (const f32x4*)(cosM + (size_t)pos * 16 + j0); const f32x4* sp = (const f32x4*)(sinM + (size_t)pos * 16 + j0);
                    tc[m][0] = cp[0]; tc[m][1] = cp[1]; ts[m][0] = sp[0]; ts[m][1] = sp[1]; }
#pragma unroll
                for (int m = 0; m < 4; ++m) { const int row = row00 + ai * HALF + m * 16;
                    EPI_GET8(x1, ai, 0, m); EPI_GET8(x2, ai, 1, m);
                    float cs[8], sn[8];
#pragma unroll
                    for (int i = 0; i < 8; ++i) { cs[i] = lat ? tc[m][i >> 2][i & 3] : 1.f; sn[i] = lat ? ts[m][i >> 2][i & 3] : 0.f; }
                    float o1[8], o2[8];
#pragma unroll
                    for (int i = 0; i < 8; ++i) { o1[i] = (x1[i] * cs[i] - x2[i] * sn[i]) * C2M; o2[i] = (x2[i] * cs[i] + x1[i] * sn[i]) * C2M; }
                    bf16_t* qp = Qm + (size_t)row * 768 + hh * 96 + 64 + j0;
                    *(u32x4*)(qp) = pack8(o1); *(u32x4*)(qp + 16) = pack8(o2); }
                asm volatile("" ::: "memory"); }
        }
    }
};

struct EpiUkv {
    static constexpr bool PERM = true, AFTER_DRAIN = false;
    bf16_t* Km; bf16_t* Vm;
    __device__ __forceinline__ void operator()(const f32x4 (&acc)[2][2][4][2], const Unit& u, int wr, int wc, int fr, int fq) const {
        asm volatile("" : "+v"(fr), "+v"(fq));
        EPI_ROWS(u, wr, fr); const int within = wc * 32 + 8 * fq;
#pragma unroll
        for (int ai = 0; ai < 2; ++ai)
#pragma unroll
            for (int m = 0; m < 4; ++m) { const int row = row00 + ai * HALF + m * 16; int b_, pos_; bpos_of(row, b_, pos_);
#pragma unroll
                for (int bj = 0; bj < 2; ++bj) { const int head = u.pn * 2 + bj; EPI_GET8(v, ai, bj, m);
                    bf16_t* p = (within < 64) ? (Km + ktile_off(b_ * 8 + head, pos_, within >> 3, 12)) : (Vm + vtile_off(b_ * 8 + head, pos_, within - 64));
                    *(u32x4*)p = pack8(v); } asm volatile("" ::: "memory"); }
    }
};

template <int IDX> struct EpiBranch {
    static constexpr bool PERM = true, AFTER_DRAIN = false;
    const bf16_t* Z; bf16_t* MERGEB;
    __device__ __forceinline__ void operator()(const f32x4 (&acc)[2][2][4][2], const Unit& u, int wr, int wc, int fr, int fq) const {
        asm volatile("" : "+v"(fr), "+v"(fq));
        EPI_ROWS(u, wr, fr); const int col0 = u.pn * BM + wc * 32 + 8 * fq;
#pragma unroll
        for (int ai = 0; ai < 2; ++ai) {
            u32x4 gr[4][2], mr[4][2];
#pragma unroll
            for (int m = 0; m < 4; ++m) { const int row = row00 + ai * HALF + m * 16;
#pragma unroll
                for (int bj = 0; bj < 2; ++bj) { const int col = col0 + bj * HALF; gr[m][bj] = *(const u32x4*)(Z + (size_t)row * 3072 + IDX * 1024 + col);
                    if (IDX != 0) mr[m][bj] = *(const u32x4*)(MERGEB + (size_t)row * 1024 + col); } }
#pragma unroll
            for (int m = 0; m < 4; ++m) { const int row = row00 + ai * HALF + m * 16;
#pragma unroll
                for (int bj = 0; bj < 2; ++bj) { const int col = col0 + bj * HALF; EPI_GET8(v, ai, bj, m); float g[8], a[8], r[8]; unpack8(gr[m][bj], g);
                    if (IDX != 0) unpack8(mr[m][bj], a);
#pragma unroll
                    for (int i = 0; i < 8; ++i) r[i] = (IDX != 0 ? a[i] : 0.f) + sigmoidf_(g[i]) * v[i];
                    *(u32x4*)(MERGEB + (size_t)row * 1024 + col) = pack8(r); } }
            asm volatile("" ::: "memory"); }
    }
};

struct EpiMoe1 {
    static constexpr bool PERM = true, AFTER_DRAIN = false;
    bf16_t* H; const float* b1;
    __device__ __forceinline__ void operator()(const f32x4 (&acc)[2][2][4][2], const Unit& u, int wr, int wc, int fr, int fq) const {
        asm volatile("" : "+v"(fr), "+v"(fq));
        EPI_ROWS(u, wr, fr); const int e = u.pn >> 3, pnl = u.pn & 7, cc = pnl * 128 + wc * 32 + 8 * fq;
        const float* bp = b1 + (size_t)e * 2048 + cc;
        const f32x4 bg0 = *(const f32x4*)bp, bg1 = *(const f32x4*)(bp + 4), bl0 = *(const f32x4*)(bp + 1024), bl1 = *(const f32x4*)(bp + 1028);
        float lim = 7.0f; asm volatile("" : "+v"(lim));
#pragma unroll
        for (int ai = 0; ai < 2; ++ai)
#pragma unroll
            for (int m = 0; m < 4; ++m) { const int row = row00 + ai * HALF + m * 16;
                EPI_GET8(g, ai, 0, m); EPI_GET8(l, ai, 1, m); float r[8];
#pragma unroll
                for (int i = 0; i < 8; ++i) { float glu = g[i] + (i < 4 ? bg0[i] : bg1[i - 4]); float lin = l[i] + (i < 4 ? bl0[i] : bl1[i - 4]);
                    glu = fminf(glu, lim); lin = fminf(fmaxf(lin, -lim), lim);
                    r[i] = glu * sigmoidf_(1.702f * glu) * (lin + 1.0f); }
                *(u32x4*)(H + (size_t)row * 1024 + cc) = pack8(r); }
    }
};

struct EpiMoe2 {
    static constexpr bool PERM = true, AFTER_DRAIN = false;
    bf16_t* Yp; const float* b2; const float* lw; const PG8_LAS int* tab;
    __device__ __forceinline__ void operator()(const f32x4 (&acc)[2][2][4][2], const Unit& u, int wr, int wc, int fr, int fq) const {
        asm volatile("" : "+v"(fr), "+v"(fq));
        EPI_ROWS(u, wr, fr); const int e = u.pn >> 2, pnl = u.pn & 3, col0 = pnl * BM + wc * 32 + 8 * fq;
        f32x4 bv[2][2];
#pragma unroll
        for (int bj = 0; bj < 2; ++bj) { bv[bj][0] = *(const f32x4*)(b2 + (size_t)e * 1024 + col0 + bj * HALF); bv[bj][1] = *(const f32x4*)(b2 + (size_t)e * 1024 + col0 + bj * HALF + 4); }
        float wrow[2][4]; { const int ps_ = tab[600 + e], cn_ = tab[640 + e];
#pragma unroll
            for (int ai = 0; ai < 2; ++ai)
#pragma unroll
                for (int m = 0; m < 4; ++m) { const int slot = row00 + ai * HALF + m * 16 - ps_; wrow[ai][m] = lw[(size_t)e * TA + (slot < cn_ ? slot : 0)]; if (slot >= cn_) wrow[ai][m] = 0.f; } }
#pragma unroll
        for (int ai = 0; ai < 2; ++ai)
#pragma unroll
            for (int m = 0; m < 4; ++m) { const int row = row00 + ai * HALF + m * 16; const float w = wrow[ai][m];
#pragma unroll
                for (int bj = 0; bj < 2; ++bj) { EPI_GET8(v, ai, bj, m); float r[8];
#pragma unroll
                    for (int i = 0; i < 8; ++i) r[i] = (v[i] + (i < 4 ? bv[bj][0][i] : bv[bj][1][i - 4])) * w;
                    *(u32x4*)(Yp + (size_t)row * 1024 + col0 + bj * HALF) = pack8(r); } }
    }
};

template <int NPN> struct MoeOrder {
    int nunits, G, v; const PG8_LAS int* tab; const PG8_LAS int* rowtok;
    __device__ __forceinline__ int tok(int i, int r) const { return rowtok[i * 256 + r]; }
    __device__ __forceinline__ bool next(int i, Unit& u) const {
        const long L = (long)i * G + v; if (L >= nunits) return false;
        const int blk = (int)L / NPN, pnl = (int)L % NPN; const int e = __builtin_amdgcn_readfirstlane(tab[blk]);
        u.pm = blk; u.pn = e * NPN + pnl; return true;
    }
    __device__ __forceinline__ void a_ready(const Unit&) const {}
    __device__ __forceinline__ void done(const Unit&) const {}
};
}
namespace attn_body {
using bf16x8=__attribute__((ext_vector_type(8)))short;
using s16x4=__attribute__((ext_vector_type(4)))short;
using f32x16=__attribute__((ext_vector_type(16)))float;
using u32x4=__attribute__((ext_vector_type(4)))unsigned;
constexpr int NW=8,QBLK=32,QB=QBLK*NW,KVBLK=64;
__device__ __forceinline__ int crow(int r,int hi){return (r&3)+8*(r>>2)+4*hi;}
#define SBAR() __builtin_amdgcn_sched_barrier(0)
constexpr int NSLOT=3, SLOTB=8192;
__device__ __forceinline__ void glds16(const void*gsrc,unsigned lds_dst){unsigned keep;
  asm volatile("s_mov_b32 %0, m0\n\ts_mov_b32 m0, %2\n\ts_nop 0\n\tglobal_load_lds_dwordx4 %1, off\n\ts_mov_b32 m0, %0":"=&s"(keep):"v"(gsrc),"s"(lds_dst):"memory");}
__device__ __forceinline__ float max3f(float a,float b,float c){float r;asm("v_max3_f32 %0, %1, %2, %3":"=v"(r):"v"(a),"v"(b),"v"(c));return r;}
__device__ __forceinline__ float max2f(float a,float b){float r;asm("v_max_f32_e32 %0, %1, %2":"=v"(r):"v"(a),"v"(b));return r;}
__device__ __forceinline__ float fadd_s(float a,float b){float r;asm("v_add_f32_e32 %0, %1, %2":"=v"(r):"v"(a),"v"(b));return r;}
__device__ __forceinline__ float fsub_s(float a,float b){float r;asm("v_sub_f32_e32 %0, %1, %2":"=v"(r):"v"(a),"v"(b));return r;}
typedef float f32x2_t __attribute__((ext_vector_type(2))); typedef __bf16 bf16x2_t __attribute__((ext_vector_type(2)));
__device__ __forceinline__ unsigned cvtpk_s(float lo,float hi){f32x2_t v={lo,hi};bf16x2_t b=__builtin_convertvector(v,bf16x2_t);return __builtin_bit_cast(unsigned,b);}
#define WAIT_BAR(N) asm volatile("s_waitcnt vmcnt(" #N ") lgkmcnt(0)\n\ts_barrier":::"memory")
typedef __attribute__((address_space(3))) const char* lds_cptr;
typedef short v4i16_t __attribute__((ext_vector_type(4)));
__device__ __forceinline__ void kload2(bf16x8*kf,lds_cptr kp,int j){ kf[2*j]=*(const __attribute__((address_space(3))) bf16x8*)(kp+j*2048); kf[2*j+1]=*(const __attribute__((address_space(3))) bf16x8*)(kp+j*2048+512); }
__device__ __forceinline__ s16x4 vtr(lds_cptr p){ return __builtin_bit_cast(s16x4,__builtin_amdgcn_ds_read_tr16_b64_v4i16((__attribute__((address_space(3))) v4i16_t*)p)); }
__device__ __forceinline__ float rowmax(const f32x16&p0,const f32x16&p1){
  float a=max3f(p0[0],p0[1],p1[0]),b=max3f(p0[2],p0[3],p1[1]);a=max3f(a,p1[2],p1[3]);
  #pragma unroll
  for(int r=4;r<16;r+=4){a=max3f(a,p0[r],p0[r+1]);b=max3f(b,p0[r+2],p0[r+3]);a=max3f(a,p1[r],p1[r+1]);b=max3f(b,p1[r+2],p1[r+3]);}
  const float m=max2f(a,b);
  auto rr=__builtin_amdgcn_permlane32_swap(__float_as_uint(m),__float_as_uint(m),false,false);
  return max2f(__uint_as_float(rr[0]),__uint_as_float(rr[1]));
}
__device__ __forceinline__ void pv(f32x16*o,int vb,bf16x8 pa0,bf16x8 pa1,bf16x8 pa2,bf16x8 pa3){
  #pragma unroll
  for(int d0=0;d0<2;++d0){s16x4 lo[4],hi[4];
    #pragma unroll
    for(int ks=0;ks<4;++ks){
      asm volatile("ds_read_b64_tr_b16 %0,%1 offset:%c2":"=&v"(lo[ks]):"v"(vb),"i"(d0*4096+ks*1024):"memory");
      asm volatile("ds_read_b64_tr_b16 %0,%1 offset:%c2":"=&v"(hi[ks]):"v"(vb),"i"(d0*4096+ks*1024+512):"memory");}
    asm volatile("s_waitcnt lgkmcnt(0)":::"memory");SBAR();
    #define PK(k) (bf16x8){lo[k][0],lo[k][1],lo[k][2],lo[k][3],hi[k][0],hi[k][1],hi[k][2],hi[k][3]}
    o[d0]=__builtin_amdgcn_mfma_f32_32x32x16_bf16(pa0,PK(0),o[d0],0,0,0);
    o[d0]=__builtin_amdgcn_mfma_f32_32x32x16_bf16(pa1,PK(1),o[d0],0,0,0);
    o[d0]=__builtin_amdgcn_mfma_f32_32x32x16_bf16(pa2,PK(2),o[d0],0,0,0);
    o[d0]=__builtin_amdgcn_mfma_f32_32x32x16_bf16(pa3,PK(3),o[d0],0,0,0);
    #undef PK
  }
}
template<int NKS> struct AttnLds {
  static constexpr int SLOTK=NKS*2048;
  static constexpr int LDS_K=0, LDS_V=NSLOT*SLOTK, LDS_WS=LDS_V+NSLOT*SLOTB, LDS_OST=LDS_WS+NW*64*4, LDS_BYTES=LDS_OST+NW*4096;
};
template<int NKS,int QP,int KP,int VP,int OP,int THRL,bool LS,bool SK>
__device__ __forceinline__ void attn_unit(const bf16*Qu,const bf16*__restrict__ Ku,const bf16*__restrict__ Vu,bf16*Ou,const int NT,char*shm){
  using L=AttnLds<NKS>;
  constexpr int SLOTK=L::SLOTK, LDS_K=L::LDS_K, LDS_V=L::LDS_V, LDS_WS=L::LDS_WS, LDS_OST=L::LDS_OST;
  int tid_=threadIdx.x; asm volatile("":"+v"(tid_));
  const int tid=tid_,lane=tid&63,r32=lane&31,hi=lane>>5; const int wid=__builtin_amdgcn_readfirstlane(tid>>6);
  const bf16*Qw=Qu+(long)(wid*QBLK)*QP;
  const unsigned lds0=(unsigned)(uintptr_t)shm;
  float*wsf=(float*)(shm+LDS_WS)+wid*64;
  const bf16*ksrc=Ku+wid*512+lane*8;
  const bf16*ksrc2=Ku+(8+(wid&3))*512+lane*8;
  const bf16*vsrc=Vu+wid*512+lane*8;
  const unsigned kdst=lds0+LDS_K+wid*1024, kdst2=lds0+LDS_K+(8+(wid&3))*1024, vdst=lds0+LDS_V+wid*1024;
  #define DMA_K(t,slot) do{ glds16(ksrc+(long)(t)*(NKS*1024),(unsigned)__builtin_amdgcn_readfirstlane(kdst+(slot))); \
      if constexpr(NKS==6){ glds16(ksrc2+(long)(t)*(NKS*1024),(unsigned)__builtin_amdgcn_readfirstlane(kdst2+(slot))); } }while(0)
  #define DMA_V(t,slot) glds16(vsrc+(long)(t)*4096,(unsigned)__builtin_amdgcn_readfirstlane(vdst+(slot)))
  #define WAIT_C()  do{ if constexpr(NKS==6){WAIT_BAR(3);}else{WAIT_BAR(2);} }while(0)
  #define WAIT_P()  do{ if constexpr(NKS==6){WAIT_BAR(5);}else{WAIT_BAR(3);} }while(0)
  #define WAITA_K() do{ if constexpr(NKS==6){WAIT_BAR(2);}else{WAIT_BAR(1);} }while(0)
  #define BARONLY() asm volatile("s_barrier":::"memory")
  const int vb0=(int)(lds0+LDS_V)+((lane>>4)&1)*32+(lane&3)*8+(4*hi+((lane&15)>>2))*64;
  const char*Kbase=shm+LDS_K; bf16x8 kf[2*NKS];
  const lds_cptr shm3=(lds_cptr)shm; const lds_cptr kp0=shm3+LDS_K+hi*1024+r32*16; const lds_cptr vp0=shm3+LDS_V+((lane>>4)&1)*32+(lane&3)*8+(4*hi+((lane&15)>>2))*64;
  DMA_K(0,0);DMA_V(0,0);DMA_K(1,SLOTK);
  bf16x8 qr[NKS];
  #pragma unroll
  for(int d0=0;d0<NKS;++d0)qr[d0]=*reinterpret_cast<const bf16x8*>(&Qw[(long)r32*QP+d0*16+hi*8]);
  float mhat=0.f,l_reg=0.f;f32x16 o[2];o[0]=f32x16{};o[1]=f32x16{};f32x16 negm=f32x16{};asm volatile("":"+v"(negm));
  f32x16 o2=f32x16{}; const bf16x8 ONES=(bf16x8){(short)0x3F80,(short)0x3F80,(short)0x3F80,(short)0x3F80,(short)0x3F80,(short)0x3F80,(short)0x3F80,(short)0x3F80};
  bool resc=false;
  #define START(P0,P1) do{ const float rm=rowmax(P0,P1); resc=false; \
    { const float dl=rm; mhat=fadd_s(mhat,dl); \
      _Pragma("unroll") for(int r=0;r<16;++r){P0[r]=fsub_s(P0[r],dl);P1[r]=fsub_s(P1[r],dl);} \
      _Pragma("unroll") for(int r=0;r<16;++r)negm[r]=-mhat; asm volatile("":"+v"(negm)); } \
    _Pragma("unroll") for(int r=0;r<16;++r)P0[r]=__builtin_amdgcn_exp2f(P0[r]); }while(0)
  #define RESC() do{ if(resc){ asm volatile("s_waitcnt lgkmcnt(0)":::"memory"); \
      _Pragma("unroll") for(int d_=0;d_<2;++d_) _Pragma("unroll") for(int r=0;r<16;++r)o[d_][r]*=wsf[crow(r,hi)]; \
      if constexpr(LS){ _Pragma("unroll") for(int r=0;r<16;++r)o2[r]*=wsf[crow(r,hi)]; } } }while(0)
  f32x16 pA0,pA1,pB0,pB1;
  int kl_cur=0,kl_next=SLOTK;
  int sl_prev=0,sl_cur=0,sl_next=SLOTB;
  #define ROT() do{sl_prev=sl_cur;sl_cur=sl_next;sl_next=(sl_next==(NSLOT-1)*SLOTB)?0:sl_next+SLOTB; kl_cur=kl_next;kl_next=(kl_next==(NSLOT-1)*SLOTK)?0:kl_next+SLOTK;}while(0)
  DMA_K(2,2*SLOTK);
  WAIT_P();
  { const char*kb=Kbase+hi*1024+r32*16;
    #pragma unroll
    for(int d0=0;d0<NKS;++d0){
      const bf16x8 b0=*reinterpret_cast<const bf16x8*>(kb+d0*2048);
      const bf16x8 b1=*reinterpret_cast<const bf16x8*>(kb+d0*2048+512);
      if(d0==0){pA0=__builtin_amdgcn_mfma_f32_32x32x16_bf16(b0,qr[0],negm,0,0,0);pA1=__builtin_amdgcn_mfma_f32_32x32x16_bf16(b1,qr[0],negm,0,0,0);}
      else{pA0=__builtin_amdgcn_mfma_f32_32x32x16_bf16(b0,qr[d0],pA0,0,0,0);pA1=__builtin_amdgcn_mfma_f32_32x32x16_bf16(b1,qr[d0],pA1,0,0,0);}} }
  asm volatile("s_nop 15\n\ts_nop 7":"+v"(pA0),"+v"(pA1));
  START(pA0,pA1);
  _Pragma("unroll") for(int r=0;r<16;++r)pA1[r]=__builtin_amdgcn_exp2f(pA1[r]);
  WAIT_BAR(0);
  if constexpr(SK){ DMA_V(1,SLOTB);DMA_K(3,0); } else { DMA_K(3,0);DMA_V(1,SLOTB); }
  ROT();
  _Pragma("unroll") for(int j=0;j<NKS;++j)kload2(kf,kp0+kl_cur,j);
  WAIT_C();
  if constexpr(SK){ if(wid>=4){ BARONLY(); } }
  s16x4 vlo[8],vhi[8]; u32x4 pw0,pw1,pw2,pw3;
  #define PKW(P,B) cvtpk_s(P[B],P[B+1])
  #define PAF(k) __builtin_bit_cast(bf16x8,pw##k)
  #define VFR(i) (bf16x8){vlo[i][0],vlo[i][1],vlo[i][2],vlo[i][3],vhi[i][0],vhi[i][1],vhi[i][2],vhi[i][3]}
  #define PIN(x) asm volatile("":"+v"(x))
  #define MX3(a,b,c) __builtin_fmaxf(__builtin_fmaxf((a),(b)),(c))
  #define GAPA(MF,A0,A1,A2,A3,W0,W1,PW) do{ MF; if constexpr(!LS){ sacc+=A0; sacc+=A1; sacc+=A2; sacc+=A3; PIN(sacc); } W0; W1; PIN(PW); SBAR(); }while(0)
  #define LSM(k) do{ if constexpr(LS){ o2=MF32(PAF(k),ONES,o2); SBAR(); } }while(0)
  #define EX(v) __builtin_amdgcn_exp2f(v)
  #define GAPB(MF,X,B) do{ MF; X[B]=EX(X[B]); X[B+1]=EX(X[B+1]); X[B+2]=EX(X[B+2]); X[B+3]=EX(X[B+3]); PIN(X); SBAR(); }while(0)
  #define VRD(i) do{ vlo[i]=vtr(vp_+(((i)>>2)*4096+((i)&3)*1024)); vhi[i]=vtr(vp_+(((i)>>2)*4096+((i)&3)*1024+512)); }while(0)
  #define KRD(G,j) do{ if(G){ kload2(kf,kp0+kl_next,j); SBAR(); } }while(0)
  #define MF32(a,b,c) __builtin_amdgcn_mfma_f32_32x32x16_bf16(a,b,c,0,0,0)
  #define STEP(C0,C1,P0,P1,t,GK,GV,GL,CK,MW) do{ SBAR(); \
    const lds_cptr vp_=vp0+sl_prev; \
    VRD(0); SBAR(); float sacc=LS?0.f:(P0[0]+P0[1]); \
    GAPA(C0=MF32(kf[0],qr[0],negm), P0[2],P0[3],P0[4],P0[5],     pw0[0]=PKW(P0,0), pw0[1]=PKW(P0,2), pw0); \
    VRD(4); SBAR(); GAPA(C1=MF32(kf[1],qr[0],negm), P0[6],P0[7],P0[8],P0[9],     pw0[2]=PKW(P0,4), pw0[3]=PKW(P0,6), pw0); \
    VRD(1); SBAR(); GAPA(C0=MF32(kf[2],qr[1],C0),   P0[10],P0[11],P0[12],P0[13], pw1[0]=PKW(P0,8), pw1[1]=PKW(P0,10), pw1); \
    VRD(5); SBAR(); GAPA(C1=MF32(kf[3],qr[1],C1),   P0[14],P0[15],P1[0],P1[1],   pw1[2]=PKW(P0,12),pw1[3]=PKW(P0,14), pw1); \
    VRD(2); SBAR(); GAPA(C0=MF32(kf[4],qr[2],C0),   P1[2],P1[3],P1[4],P1[5],     pw2[0]=PKW(P1,0), pw2[1]=PKW(P1,2), pw2); \
    VRD(6); SBAR(); GAPA(C1=MF32(kf[5],qr[2],C1),   P1[6],P1[7],P1[8],P1[9],     pw2[2]=PKW(P1,4), pw2[3]=PKW(P1,6), pw2); \
    VRD(3); SBAR(); GAPA(C0=MF32(kf[6],qr[3],C0),   P1[10],P1[11],P1[12],P1[13], pw3[0]=PKW(P1,8), pw3[1]=PKW(P1,10), pw3); \
    VRD(7); SBAR(); GAPA(C1=MF32(kf[7],qr[3],C1),   P1[14],P1[15],0.f,0.f,       pw3[2]=PKW(P1,12),pw3[3]=PKW(P1,14), pw3); \
    if constexpr(NKS==6){ C0=MF32(kf[8],qr[4],C0); SBAR(); C1=MF32(kf[9],qr[4],C1); SBAR(); C0=MF32(kf[10],qr[5],C0); SBAR(); C1=MF32(kf[11],qr[5],C1); SBAR(); } \
    if constexpr(!LS){ l_reg+=sacc; } \
    if constexpr(SK){ MW; if(GV){DMA_V((t)+1,sl_next);} if(GK){DMA_K((t)+3,kl_cur);} } else { if(GK){DMA_K((t)+3,kl_cur);} if(GV){DMA_V((t)+1,sl_next);} } \
    if(CK){ float a=MX3(C0[0],C0[1],C1[0]),b=MX3(C0[2],C0[3],C1[1]); a=MX3(a,C1[2],C1[3]); \
      _Pragma("unroll") for(int r=4;r<16;r+=4){a=MX3(a,C0[r],C0[r+1]);b=MX3(b,C0[r+2],C0[r+3]);a=MX3(a,C1[r],C1[r+1]);b=MX3(b,C1[r+2],C1[r+3]);} \
      float rm=__builtin_fmaxf(a,b); { auto rr=__builtin_amdgcn_permlane32_swap(__float_as_uint(rm),__float_as_uint(rm),false,false); rm=__builtin_fmaxf(__uint_as_float(rr[0]),__uint_as_float(rr[1])); } \
      resc=false; \
      if(__builtin_expect(__any(rm>(float)THRL),0)){ const float dl=__builtin_fmaxf(rm,0.f); mhat+=dl; \
        _Pragma("unroll") for(int r=0;r<16;++r){C0[r]-=dl;C1[r]-=dl;} \
        _Pragma("unroll") for(int r=0;r<16;++r)negm[r]=-mhat; asm volatile("":"+v"(negm)); \
        const float f=__builtin_amdgcn_exp2f(-dl); l_reg*=f; if(hi==0)wsf[r32]=f; resc=true; } } else { resc=false; } \
    SBAR(); \
    GAPB(o[0]=MF32(PAF(0),VFR(0),o[0]), C0,0); \
    GAPB(o[1]=MF32(PAF(0),VFR(4),o[1]), C0,4); LSM(0); \
    KRD(GL,0); GAPB(o[0]=MF32(PAF(1),VFR(1),o[0]), C0,8); \
    KRD(GL,1); GAPB(o[1]=MF32(PAF(1),VFR(5),o[1]), C0,12); LSM(1); \
    KRD(GL,2); GAPB(o[0]=MF32(PAF(2),VFR(2),o[0]), C1,0); \
    KRD(GL,3); GAPB(o[1]=MF32(PAF(2),VFR(6),o[1]), C1,4); LSM(2); \
    if constexpr(NKS==6){ KRD(GL,4); } GAPB(o[0]=MF32(PAF(3),VFR(3),o[0]), C1,8); \
    if constexpr(NKS==6){ KRD(GL,5); } GAPB(o[1]=MF32(PAF(3),VFR(7),o[1]), C1,12); LSM(3); \
    }while(0)
  int t=1;
  for(;t+11<NT;t+=8){
    STEP(pB0,pB1,pA0,pA1,t,true,true,true,true,WAITA_K());      WAIT_C(); RESC(); ROT();
    STEP(pA0,pA1,pB0,pB1,t+1,true,true,true,false,WAITA_K());   WAIT_C(); ROT();
    STEP(pB0,pB1,pA0,pA1,t+2,true,true,true,false,WAITA_K());   WAIT_C(); ROT();
    STEP(pA0,pA1,pB0,pB1,t+3,true,true,true,false,WAITA_K());   WAIT_C(); ROT();
    STEP(pB0,pB1,pA0,pA1,t+4,true,true,true,false,WAITA_K());   WAIT_C(); ROT();
    STEP(pA0,pA1,pB0,pB1,t+5,true,true,true,false,WAITA_K());   WAIT_C(); ROT();
    STEP(pB0,pB1,pA0,pA1,t+6,true,true,true,false,WAITA_K());   WAIT_C(); ROT();
    STEP(pA0,pA1,pB0,pB1,t+7,true,true,true,false,WAITA_K());   WAIT_C(); ROT();
  }
  for(;t+5<NT;t+=2){
    STEP(pB0,pB1,pA0,pA1,t,true,true,true,true,WAITA_K());     WAIT_C(); RESC(); ROT();
    STEP(pA0,pA1,pB0,pB1,t+1,true,true,true,true,WAITA_K());   WAIT_C(); RESC(); ROT();
  }
  #define ENDW(tt) do{ if constexpr(SK){ if((tt)+3<NT){WAIT_C();} else if((tt)+1<NT){WAIT_BAR(1);} else {WAIT_BAR(0);} } \
                       else { if((tt)+3<NT){WAIT_C();} else if((tt)+2<NT){WAIT_BAR(1);} else {WAIT_BAR(0);} } }while(0)
  #define ENDA(tt) do{ if((tt)+2<NT){WAITA_K();} else {WAIT_BAR(0);} }while(0)
  for(;t+1<NT;t+=2){
    STEP(pB0,pB1,pA0,pA1,t,(t+3<NT),(t+1<NT),(t+1<NT),true,ENDA(t));         ENDW(t);   RESC(); ROT();
    STEP(pA0,pA1,pB0,pB1,t+1,(t+4<NT),(t+2<NT),(t+2<NT),true,ENDA(t+1));     ENDW(t+1); RESC(); ROT();
  }
  STEP(pB0,pB1,pA0,pA1,NT-1,false,false,false,true,WAIT_BAR(0)); if constexpr(SK){ WAIT_BAR(0); } RESC();
  { if constexpr(!LS){ float sacc=pB0[0]+pB0[1]; _Pragma("unroll") for(int r=2;r<16;++r)sacc+=pB0[r]; _Pragma("unroll") for(int r=0;r<16;++r)sacc+=pB1[r]; l_reg+=sacc; }
    pw0=(u32x4){PKW(pB0,0),PKW(pB0,2),PKW(pB0,4),PKW(pB0,6)};pw1=(u32x4){PKW(pB0,8),PKW(pB0,10),PKW(pB0,12),PKW(pB0,14)};pw2=(u32x4){PKW(pB1,0),PKW(pB1,2),PKW(pB1,4),PKW(pB1,6)};pw3=(u32x4){PKW(pB1,8),PKW(pB1,10),PKW(pB1,12),PKW(pB1,14)};
    SBAR(); pv(o,vb0+sl_cur,PAF(0),PAF(1),PAF(2),PAF(3)); LSM(0); LSM(1); LSM(2); LSM(3); }
  if constexpr(SK){ if(wid<4){ BARONLY(); } }
  #undef PKW
  #undef PAF
  #undef VFR
  #undef PIN
  #undef MX3
  #undef GAPA
  #undef GAPB
  #undef EX
  #undef VRD
  #undef KRD
  #undef LSM
  #undef MF32
  #undef STEP
  #undef ENDW
  #undef ENDA
  float rli[16];
  if constexpr(LS){
    #pragma unroll
    for(int r=0;r<16;++r)rli[r]=__builtin_amdgcn_rcpf(o2[r]);
  } else {
    {auto rr=__builtin_amdgcn_permlane32_swap(__float_as_uint(l_reg),__float_as_uint(l_reg),false,false);l_reg=__uint_as_float(rr[0])+__uint_as_float(rr[1]);}
    if(hi==0)wsf[32+r32]=l_reg;asm volatile("s_waitcnt lgkmcnt(0)":::"memory");
    #pragma unroll
    for(int r=0;r<16;++r)rli[r]=__builtin_amdgcn_rcpf(wsf[32+crow(r,hi)]);
  }
  bf16*Ow=Ou+(long)(wid*QBLK)*OP;
  { bf16*stg=(bf16*)(shm+LDS_OST)+wid*2048;
    #pragma unroll
    for(int r=0;r<16;++r){const int orow=crow(r,hi);
      #pragma unroll
      for(int d0=0;d0<2;++d0)stg[orow*64+d0*32+r32]=(bf16)(cvtpk_s(o[d0][r]*rli[r],0.f)&0xffffu);}
    asm volatile("s_waitcnt lgkmcnt(0)":::"memory");
    #pragma unroll
    for(int i=0;i<4;++i){const int row=i*8+(lane>>3),ch=lane&7; const u32x4 v=*(const u32x4*)(stg+row*64+ch*8); *(u32x4*)(Ow+(long)row*OP+ch*8)=v;} }
  asm volatile("s_waitcnt lgkmcnt(0)\n\ts_barrier":::"memory");
  #undef DMA_K
  #undef DMA_V
  #undef WAIT_C
  #undef WAIT_P
  #undef WAITA_K
  #undef BARONLY
  #undef START
  #undef RESC
  #undef ROT
}
#undef SBAR
#undef WAIT_BAR
}
#define XB_TMO      128
#define XB_XCNT(j)  (256  + 64 * (j))
#define XB_XSUB(j)  (1280 + 64 * (j))
#define XB_XGEN(j)  (2304 + 64 * (j))
#define XB_TOP      3328
#define XB_TOPGEN   3392
#define XCD_BAR_WORDS 3456
#define XB_SPIN_CAP (1u << 20)

__device__ __forceinline__ unsigned xb_ld(unsigned* p)              { return __hip_atomic_load(p, __ATOMIC_RELAXED, __HIP_MEMORY_SCOPE_AGENT); }
__device__ __forceinline__ unsigned xb_add(unsigned* p, unsigned v) { return __hip_atomic_fetch_add(p, v, __ATOMIC_RELAXED, __HIP_MEMORY_SCOPE_AGENT); }
__device__ __forceinline__ unsigned xb_xcc_id() { return (unsigned)__builtin_amdgcn_s_getreg((3 << 11) | 20) & 0xFu; }
#define XB_SPIN(cond, bar) do { unsigned _sp = 0; while (cond) { __builtin_amdgcn_s_sleep(1); \
    if ((++_sp & 255u) == 0u) { if (xb_ld(&(bar)[XB_TMO])) break; if (_sp > XB_SPIN_CAP) { atomicAdd(&(bar)[XB_TMO], 1u); break; } } } } while (0)

struct XcdBarrier {
    unsigned* bar; unsigned x;
    volatile LAS unsigned* st;
};
__device__ __forceinline__ XcdBarrier xcd_barrier_post(unsigned* bar, volatile LAS unsigned* st) {
    XcdBarrier b; b.bar = bar; b.x = xb_xcc_id(); b.st = st;
    if (threadIdx.x == 0) (void)xb_add(&bar[XB_XCNT(b.x)], 1u);
    return b;
}
__device__ __forceinline__ void xcd_barrier_complete(unsigned* bar, unsigned x, unsigned& nloc, unsigned& nx) {
    const unsigned G = gridDim.x * gridDim.y * gridDim.z;
    unsigned sum, cnt, mine, sp = 0u;
    for (;;) {
        sum = 0u; cnt = 0u; mine = 0u;
        unsigned cj[16];
#pragma unroll
        for (unsigned j = 0; j < 16; ++j) cj[j] = xb_ld(&bar[XB_XCNT(j)]);
#pragma unroll
        for (unsigned j = 0; j < 16; ++j) { const unsigned c = cj[j]; sum += c; cnt += (c > 0u) ? 1u : 0u; mine = (j == x) ? c : mine; }
        if (sum == G) break;
        __builtin_amdgcn_s_sleep(1);
        if ((++sp & 255u) == 0u) { if (xb_ld(&bar[XB_TMO])) break; if (sp > XB_SPIN_CAP) { atomicAdd(&bar[XB_TMO], 1u); break; } }
    }
    nloc = mine > 0u ? mine : 1u; nx = cnt > 0u ? cnt : 1u;
}
__device__ __forceinline__ void xcd_barrier(const XcdBarrier& b) {
    asm volatile("s_waitcnt vmcnt(0)" ::: "memory");
    __syncthreads();
    if (threadIdx.x == 0) {
        unsigned* bar = b.bar;
        __builtin_amdgcn_s_waitcnt(0);
        unsigned nloc = b.st[0], nx = b.st[1];
        if (nloc == 0u) { xcd_barrier_complete(bar, b.x, nloc, nx); b.st[0] = nloc; b.st[1] = nx; }
        const unsigned old = xb_add(&bar[XB_XSUB(b.x)], 1u);
        const unsigned gen = old / nloc;
        if (old + 1u == (gen + 1u) * nloc) {
            __builtin_amdgcn_fence(__ATOMIC_RELEASE, "agent");
            asm volatile("s_waitcnt vmcnt(0)" ::: "memory");
            const unsigned og = xb_add(&bar[XB_TOP], 1u);
            const unsigned tg = og / nx;
            if (og + 1u == (tg + 1u) * nx) xb_add(&bar[XB_TOPGEN], 1u);
            else XB_SPIN(xb_ld(&bar[XB_TOPGEN]) == tg, bar);
            __builtin_amdgcn_fence(__ATOMIC_ACQUIRE, "agent");
            xb_add(&bar[XB_XGEN(b.x)], 1u);
            asm volatile("s_waitcnt vmcnt(0)" ::: "memory");
        } else {
            XB_SPIN(xb_ld(&bar[XB_XGEN(b.x)]) == gen, bar);
            __builtin_amdgcn_fence(__ATOMIC_ACQUIRE, "agent");
            asm volatile("s_waitcnt vmcnt(0)" ::: "memory");
        }
    }
    __syncthreads();
}

struct Args { const float* in[24]; float* out; unsigned char* ws; };
enum { I_X = 0, I_C, I_CTX, I_CCTX, I_WMOD, I_BMOD, I_NORMS, I_WIN, I_QKN, I_MQN, I_MKVN, I_WUQ, I_WUKV, I_GVN, I_GWS, I_GBS, I_WBR, I_WOUT, I_RW, I_RB, I_EW1, I_EB1, I_EW2, I_EB2 };

struct Frame {
    LAS unsigned char* lds;
    volatile LAS unsigned* MISC;
    gu32* ctl;
    int tid, lane, wave, G, bx;
    unsigned char* ws;
    __device__ __forceinline__ const float* in(int i) const { const unsigned long long v = __hip_atomic_load((const unsigned long long*)(ws + WS_PTAB) + i, __ATOMIC_RELAXED, __HIP_MEMORY_SCOPE_AGENT);
        const unsigned lo = __builtin_amdgcn_readfirstlane((unsigned)v), hi = __builtin_amdgcn_readfirstlane((unsigned)(v >> 32));
        return (const float*)(const GAS float*)(((unsigned long long)hi << 32) | lo); }
    __device__ __forceinline__ float* out() const { return (float*)in(24); }
};

__device__ __forceinline__ int map_col(int kind, int n) {
    if (kind == 1) { const int pn = n >> 8, c = n & 255, bj = (c >> 7) & 1, wc = (c >> 5) & 3, j = c & 31;
        if (pn < 2) return (4 * pn + wc) * 64 + 32 * bj + j;
        if (pn == 2) return 512 + wc * 64 + 32 * bj + j;
        if (pn == 3) return 768 + c;
        if (pn == 4) { if (wc < 2) return 1024 + wc * 64 + 32 * bj + j; if (wc == 2 && j < 16) return 1152 + 16 * bj + j; return -1; }
        if (pn < 9) return 1184 + (pn - 5) * 256 + c;
        return 2208 + (pn - 9) * 256 + c; }
    if (kind == 2) { if (n < 512) return (n >> 6) * 96 + (n & 63); const int t = n - 512; return ((t & 127) >> 4) * 96 + 64 + 16 * (t >> 7) + (t & 15); }
    if (kind == 3) { return ((n >> 7) & 1) * 1024 + (n >> 8) * 128 + (n & 127); }
    return n;
}
__device__ __forceinline__ void transpose_item(const float* W, int K, int Nsrc, bf16* WT, int nblk, int kind, LAS float* scr, int item, int lane) {
    const int kb = item / nblk, nb = item % nblk, k0 = 64 * kb, n0 = 64 * nb;
    const int src = map_col(kind, n0 + 4 * (lane & 15));
    f32x4 v[16];
#pragma unroll
    for (int i = 0; i < 16; ++i) { const int kk = 4 * i + (lane >> 4); v[i] = (src >= 0) ? *(const f32x4*)(W + (size_t)(k0 + kk) * Nsrc + src) : (f32x4){0.f, 0.f, 0.f, 0.f}; }
#pragma unroll
    for (int i = 0; i < 16; ++i) { const int kk = 4 * i + (lane >> 4); LAS float* d = scr + kk * 65 + 4 * (lane & 15); d[0] = v[i][0]; d[1] = v[i][1]; d[2] = v[i][2]; d[3] = v[i][3]; }
    LDS_WAIT(); asm volatile("" ::: "memory");
    const int c = lane & 7;
#pragma unroll
    for (int j = 0; j < 8; ++j) { const int n = (lane >> 3) + 8 * j; const LAS float* s = scr + (8 * c) * 65 + n;
        v4u o; o.x = cvt_pk(s[0 * 65], s[1 * 65]); o.y = cvt_pk(s[2 * 65], s[3 * 65]); o.z = cvt_pk(s[4 * 65], s[5 * 65]); o.w = cvt_pk(s[6 * 65], s[7 * 65]);
        *(GAS v4u*)(WT + (size_t)(n0 + n) * K + k0 + 8 * c) = o; }
    LDS_WAIT(); asm volatile("" ::: "memory");
}
__device__ __forceinline__ void sincos_acc(float ang, float& c, float& s) {
    const double x = (double)ang; const double n = __builtin_rint(x * 0.6366197723675814);
    double r = __builtin_fma(-n, 1.5707963267948966, x); r = __builtin_fma(-n, 6.123233995736766e-17, r);
    const double r2 = r * r;
    double sp = -2.5052108385441720e-08; sp = sp * r2 + 2.7557319223985893e-06; sp = sp * r2 - 1.9841269841269841e-04; sp = sp * r2 + 8.3333333333333332e-03; sp = sp * r2 - 1.6666666666666666e-01; sp = sp * r2 * r + r;
    double cp = 2.0876756987868099e-09; cp = cp * r2 - 2.7557319223985888e-07; cp = cp * r2 + 2.4801587301587302e-05; cp = cp * r2 - 1.3888888888888889e-03; cp = cp * r2 + 4.1666666666666664e-02; cp = cp * r2 - 0.5; cp = cp * r2 + 1.0;
    const int q = ((int)n) & 3;
    const double sv = (q == 0) ? sp : (q == 1) ? cp : (q == 2) ? -sp : -cp;
    const double cv = (q == 0) ? cp : (q == 1) ? -sp : (q == 2) ? -cp : sp;
    c = (float)cv; s = (float)sv;
}

__device__ __forceinline__ void p_prologue(Frame& F, const Args& A) {
    const int gw = F.bx * 8 + F.wave, NGW = F.G * 8, lane = F.lane;
    if (F.bx == 0 && F.tid < 25) { ((unsigned long long*)(F.ws + WS_PTAB))[F.tid] = (F.tid < 24) ? (unsigned long long)(uintptr_t)A.in[F.tid] : (unsigned long long)(uintptr_t)A.out; }
    { LAS float* sv = (LAS float*)(F.lds + LDS_SVEC);
      for (int i = F.tid; i < 3 * 1024; i += 512) { const float v = (i < 2048) ? A.in[I_C][i] : A.in[I_CCTX][i - 2048]; sv[i] = v * sigmoidf_(v); }
      __syncthreads(); }
    { const LAS float* sv = (const LAS float*)(F.lds + LDS_SVEC); float* mod = (float*)(F.ws + WS_MOD); LAS float* red = (LAS float*)(F.lds + RING_OFF);
      for (int item = F.bx; item < DEPTH * 96; item += F.G) { const int l = item / 96, col0 = (item % 96) * 64, c4 = (lane & 15) * 4, kr = lane >> 4;
          const float* W = A.in[I_WMOD] + (size_t)l * 1024 * 6144 + col0 + c4; f32x4 a0 = {0.f, 0.f, 0.f, 0.f}, a1 = a0, a2 = a0;
#pragma unroll
          for (int j0 = 0; j0 < 32; j0 += 16) { f32x4 w[16];
#pragma unroll
              for (int j = 0; j < 16; ++j) { const int k = 128 * F.wave + 4 * (j0 + j) + kr; w[j] = *(const f32x4*)(W + (size_t)k * 6144); }
#pragma unroll
              for (int j = 0; j < 16; ++j) { const int k = 128 * F.wave + 4 * (j0 + j) + kr; const float s0 = sv[k], s1 = sv[1024 + k], s2 = sv[2048 + k];
#pragma unroll
                  for (int c = 0; c < 4; ++c) { a0[c] += s0 * w[j][c]; a1[c] += s1 * w[j][c]; a2[c] += s2 * w[j][c]; } } }
#pragma unroll
          for (int c = 0; c < 4; ++c) { a0[c] += __shfl_xor(a0[c], 16); a1[c] += __shfl_xor(a1[c], 16); a2[c] += __shfl_xor(a2[c], 16); a0[c] += __shfl_xor(a0[c], 32); a1[c] += __shfl_xor(a1[c], 32); a2[c] += __shfl_xor(a2[c], 32); }
          if (lane < 16) {
#pragma unroll
              for (int c = 0; c < 4; ++c) { red[(F.wave * 3 + 0) * 64 + c4 + c] = a0[c]; red[(F.wave * 3 + 1) * 64 + c4 + c] = a1[c]; red[(F.wave * 3 + 2) * 64 + c4 + c] = a2[c]; } }
          __syncthreads();
          if (F.tid < 192) { const int who = F.tid >> 6, c = F.tid & 63; float sm = 0.f;
#pragma unroll
              for (int w8 = 0; w8 < 8; ++w8) sm += red[(w8 * 3 + who) * 64 + c];
              mod[(size_t)l * 3 * 6144 + (size_t)who * 6144 + col0 + c] = sm + A.in[I_BMOD][l * 6144 + col0 + c]; }
          __syncthreads(); } }
    { float* cg = (float*)(F.ws + WS_COSG); float* sg = (float*)(F.ws + WS_SING); float* cm = (float*)(F.ws + WS_COSM); float* sm = (float*)(F.ws + WS_SINM);
      const int gt = F.bx * 512 + F.tid, NT_ = F.G * 512;
      for (int i = gt; i < SEQ * 48; i += NT_) { const int pos = i / 48, j = i % 48; const float rowf = (float)(pos >> 6), colf = (float)(pos & 63); float c, s;
          if (j < 32) { const float ang = (j < 16) ? rowf * INVF16[j] : colf * INVF16[j - 16]; sincos_acc(ang, c, s); cg[pos * 32 + j] = c; sg[pos * 32 + j] = s; }
          else { const int jj = j - 32; const float ang = (jj < 8) ? rowf * INVF16[2 * jj] : colf * INVF16[2 * (jj - 8)]; sincos_acc(ang, c, s); cm[pos * 16 + jj] = c; sm[pos * 16 + jj] = s; } } }
    { bf16* wsb = (bf16*)(F.ws + WS_WS); const float* src = A.in[I_GWS]; const int gt = F.bx * 512 + F.tid, NT_ = F.G * 512;
      for (int i = gt; i < DEPTH * 8 * 128 * 128 / 2; i += NT_) { ((unsigned*)wsb)[i] = cvt_pk(src[2 * i], src[2 * i + 1]); } }
    { bf16* rwt = (bf16*)(F.ws + WS_RWT); const float* src = A.in[I_RW]; const int gt = F.bx * 512 + F.tid, NT_ = F.G * 512;
      for (int i = gt; i < DEPTH * 32 * 1024; i += NT_) { const int l = i >> 15, e = (i >> 10) & 31, d = i & 1023; const float w = src[(size_t)l * 32768 + d * 32 + e];
          const unsigned h16 = cvt_pk(w, 0.f) & 0xffffu; const float back = __uint_as_float(h16 << 16);
          rwt[(size_t)l * 65536 + e * 1024 + d] = (bf16)h16; rwt[(size_t)l * 65536 + 32768 + e * 1024 + d] = (bf16)(cvt_pk(w - back, 0.f) & 0xffffu); } }
    { LAS float* scr = (LAS float*)(F.lds + RING_OFF + F.wave * 16640);
      constexpr int I_IN = 16 * 84, I_UQ = 4 * 12, I_UKV = 2 * 16, I_BR = 8 * 16, I_OUT = 16 * 16;
      constexpr int PER_LAYER = I_IN + I_UQ + I_UKV + 3 * I_BR + I_OUT;
      for (int it = gw; it < DEPTH * PER_LAYER; it += NGW) { const int l = it / PER_LAYER; int r = it % PER_LAYER;
          if (r < I_IN) { transpose_item(A.in[I_WIN] + (size_t)l * 1024 * 5280, 1024, 5280, (bf16*)(F.ws + WS_WIN) + (size_t)l * ZW * 1024, 84, 1, scr, r, lane); continue; } r -= I_IN;
          if (r < I_UQ) { transpose_item(A.in[I_WUQ] + (size_t)l * 256 * 768, 256, 768, (bf16*)(F.ws + WS_WUQ) + (size_t)l * 768 * 256, 12, 2, scr, r, lane); continue; } r -= I_UQ;
          if (r < I_UKV) { transpose_item(A.in[I_WUKV] + (size_t)l * 128 * 1024, 128, 1024, (bf16*)(F.ws + WS_WUKV) + (size_t)l * 1024 * 128, 16, 0, scr, r, lane); continue; } r -= I_UKV;
          if (r < 3 * I_BR) { const int i = r / I_BR; transpose_item(A.in[I_WBR] + (size_t)(l * 3 + i) * 512 * 1024, 512, 1024, (bf16*)(F.ws + WS_WBR) + (size_t)(l * 3 + i) * 1024 * 512, 16, 0, scr, r % I_BR, lane); continue; } r -= 3 * I_BR;
          { transpose_item(A.in[I_WOUT] + (size_t)l * 1024 * 1024, 1024, 1024, (bf16*)(F.ws + WS_WOUT) + (size_t)l * 1024 * 1024, 16, 0, scr, r, lane); } } }
}

constexpr int BG_W1 = 16 * 32, BG_W2 = 16 * 16, BG_PER_LAYER = 32 * (BG_W1 + BG_W2);
__device__ __forceinline__ void bg_item(Frame& F, int l, int r) {
    LAS float* scr = (LAS float*)(F.lds + RING_OFF + F.wave * 16640);
    if (r < 32 * BG_W1) { const int e = r / BG_W1; transpose_item(F.in(I_EW1) + (size_t)(l * 32 + e) * 1024 * 2048, 1024, 2048, (bf16*)(F.ws + WS_W1) + (size_t)(l * 32 + e) * 2048 * 1024, 32, 3, scr, r % BG_W1, F.lane); }
    else { r -= 32 * BG_W1; const int e = r / BG_W2; transpose_item(F.in(I_EW2) + (size_t)(l * 32 + e) * 1024 * 1024, 1024, 1024, (bf16*)(F.ws + WS_W2) + (size_t)(l * 32 + e) * 1024 * 1024, 16, 0, scr, r % BG_W2, F.lane); }
}
__device__ __forceinline__ void bg_site(Frame& F, int l, int lo, int hi, int nunits, int c) {
    const int r = nunits % F.G; int widx, nw;
    if (r == 0) { widx = c * 8 + F.wave; nw = F.G * 8; } else { if (c < r) return; widx = (c - r) * 8 + F.wave; nw = (F.G - r) * 8; }
#pragma unroll 1
    for (int it = lo + widx; it < hi; it += nw) bg_item(F, l, it);
}

__device__ __forceinline__ void mod_row_to_bf16(const float* xrow, const float* gain, const float* sc, const float* sh, bf16* orow, int lane) {
    const f32x4* xr = (const f32x4*)xrow + lane; f32x4 v[4], g[4], s[4], h[4]; float ss = 0.f;
#pragma unroll
    for (int j = 0; j < 4; ++j) { v[j] = xr[64 * j]; g[j] = ((const f32x4*)gain)[64 * j + lane]; s[j] = ((const f32x4*)sc)[64 * j + lane]; h[j] = ((const f32x4*)sh)[64 * j + lane]; }
#pragma unroll
    for (int j = 0; j < 4; ++j) ss += (v[j].x * v[j].x + v[j].y * v[j].y) + (v[j].z * v[j].z + v[j].w * v[j].w);
    const float rstd = __builtin_amdgcn_rsqf(wave_sum(ss) * (1.f / DM) + RMS_EPS);
    unsigned long long* o8 = (unsigned long long*)orow + lane;
#pragma unroll
    for (int j = 0; j < 4; ++j) { const float y0 = v[j].x * rstd * g[j].x * (1.f + s[j].x) + h[j].x, y1 = v[j].y * rstd * g[j].y * (1.f + s[j].y) + h[j].y, y2 = v[j].z * rstd * g[j].z * (1.f + s[j].z) + h[j].z, y3 = v[j].w * rstd * g[j].w * (1.f + s[j].w) + h[j].w;
        o8[64 * j] = (unsigned long long)cvt_pk(y0, y1) | ((unsigned long long)cvt_pk(y2, y3) << 32); }
}

typedef short bf16x8_t __attribute__((ext_vector_type(8)));
typedef float f32x16_t __attribute__((ext_vector_type(16)));
__device__ __forceinline__ void gmlp_unit(Frame& F, const float* gbs, const float* gvn, int l, int chunk, int nt) {
    const int lane = F.lane, g = F.wave, r32 = lane & 31, hi = lane >> 5;
    const bf16* vn = (const bf16*)(F.ws + WS_VN) + (size_t)chunk * 128 * 512 + g * 64; const float* ssv = (const float*)(F.ws + WS_SSV);
    const bf16* ua = (const bf16*)(F.ws + WS_UACT) + (size_t)chunk * 128 * 512 + g * 64;
    bf16* go = (bf16*)(F.ws + WS_GM) + (size_t)chunk * 128 * 512 + g * 64;
    const bf16* wsb = (const bf16*)(F.ws + WS_WS) + (size_t)(l * 8 + g) * 128 * 128;
    const float* bs = gbs + (size_t)(l * 8 + g) * 128;
    LAS bf16* vt = (LAS bf16*)(F.lds + RING_OFF + g * 19456); LAS bf16* ut = vt + 32 * 136; LAS float* bl = (LAS float*)(ut + 128 * 32);
    { const int dd = (lane & 3) * 8; const f32x4 ga = *(const f32x4*)(gvn + l * 512 + g * 64 + nt * 32 + dd), gb = *(const f32x4*)(gvn + l * 512 + g * 64 + nt * 32 + dd + 4);
      v4u raw[8], uraw[8]; float s0[8], s1[8];
#pragma unroll
      for (int ps = 0; ps < 8; ++ps) { const int q = ps * 16 + (lane >> 2); raw[ps] = *(const v4u*)(vn + (size_t)q * 512 + nt * 32 + dd); uraw[ps] = *(const v4u*)(ua + (size_t)q * 512 + nt * 32 + dd);
          const float* sp = ssv + ((size_t)chunk * 128 + q) * 2; s0[ps] = sp[0]; s1[ps] = sp[1]; }
      const float b0 = bs[lane], b1 = bs[64 + lane];
#pragma unroll
      for (int ps = 0; ps < 8; ++ps) { const int q = ps * 16 + (lane >> 2); float fv[8]; unpack8(raw[ps], fv);
          const float rstd = __builtin_amdgcn_rsqf((s0[ps] + s1[ps]) * (1.f / 512.f) + RMS_EPS);
#pragma unroll
          for (int i = 0; i < 8; ++i) vt[(dd + i) * 136 + q] = (bf16)(cvt_pk(fv[i] * rstd * (i < 4 ? ga[i] : gb[i - 4]), 0.f) & 0xffffu);
          *(LAS v4u*)(ut + q * 32 + dd) = uraw[ps]; }
      bl[lane] = b0; bl[64 + lane] = b1; }
    LDS_WAIT(); asm volatile("" ::: "memory");
#pragma unroll 1
    for (int mh = 0; mh < 2; ++mh) {
        f32x16_t acc[2]; acc[0] = (f32x16_t){}; acc[1] = (f32x16_t){};
        size_t zo = (size_t)mh * 64 * 128; asm volatile("" : "+v"(zo));
        const bf16* wsl = wsb + zo; bf16x8_t afr[8][2];
#pragma unroll
        for (int ks = 0; ks < 8; ++ks)
#pragma unroll
            for (int mt = 0; mt < 2; ++mt) afr[ks][mt] = *(const bf16x8_t*)(wsl + (size_t)(mt * 32 + r32) * 128 + ks * 16 + hi * 8);
#pragma unroll
        for (int ks = 0; ks < 8; ++ks) { const bf16x8_t bfr = *(const LAS bf16x8_t*)(vt + r32 * 136 + ks * 16 + hi * 8);
#pragma unroll
            for (int mt = 0; mt < 2; ++mt) acc[mt] = __builtin_amdgcn_mfma_f32_32x32x16_bf16(afr[ks][mt], bfr, acc[mt], 0, 0, 0); }
#pragma unroll
        for (int mt = 0; mt < 2; ++mt)
#pragma unroll
            for (int rg = 0; rg < 16; ++rg) { const int p = mh * 64 + mt * 32 + (rg & 3) + 8 * (rg >> 2) + 4 * hi;
                const float u = __uint_as_float((unsigned)ut[p * 32 + r32] << 16);
                go[(size_t)p * 512 + nt * 32 + r32] = (bf16)(cvt_pk(u * (acc[mt][rg] + bl[p]), 0.f) & 0xffffu); } }
    LDS_WAIT(); asm volatile("" ::: "memory");
}
constexpr int T3_REC_E = 0, T3_REC_W = 8192, T3_REC_S = 16384, T3_HIST = 24576, T3_BASE = T3_HIST + 128;
__device__ __forceinline__ void t3_phase(Frame& F, int l, int T_l, const float* xin_lat, const float* xin_ctx, int cofs, bool dry) {
    float* const outp = F.out();
    const int lane = F.lane, tid = F.tid;
    LAS int* rec_e = (LAS int*)(F.lds + RING_OFF + T3_REC_E); LAS float* rec_w = (LAS float*)(F.lds + RING_OFF + T3_REC_W); LAS int* rec_s = (LAS int*)(F.lds + RING_OFF + T3_REC_S);
    LAS int* hist = (LAS int*)(F.lds + RING_OFF + T3_HIST); LAS int* base = (LAS int*)(F.lds + RING_OFF + T3_BASE);
    if (tid < 32) hist[tid] = 0;
    const int per = (T_l + F.G - 1) / F.G; const int r0 = F.bx * per; int ntok = T_l - r0; ntok = ntok < 0 ? 0 : (ntok > per ? per : ntok);
    const float* norms = F.in(I_NORMS) + (size_t)l * 4 * 1024; const float* modl = (const float*)(F.ws + WS_MOD) + (size_t)l * 3 * 6144;
    const bf16* Y = (const bf16*)(F.ws + WS_Y); bf16* XN = (bf16*)(F.ws + (dry ? WS_H : WS_XN)); bf16* XNL = (bf16*)(F.ws + WS_MERGEB);
    for (int j = F.wave; j < ntok; j += 8) {
        const int r = r0 + j; const bool lat = r < TL; const int who = lat ? (r >> 14) : 2;
        const float* xrow = lat ? xin_lat + (size_t)r * 1024 : xin_ctx + (size_t)(r - TL) * 1024;
        float* orow = dry ? (float*)(F.ws + WS_MERGE) + (size_t)r * 1024 : (lat ? outp + (size_t)r * 1024 : (float*)(F.ws + WS_XC) + (size_t)(r - TL) * 1024);
        const float* mo = modl + (size_t)who * 6144;
        float yv[16], xv[16]; v4u yr[2]; f32x4 xr4[4], g1v[4], gn1[4], gn2[4], scv[4], shv[4];
        { const v4u* yp = (const v4u*)(Y + (size_t)r * 1024); yr[0] = yp[lane]; yr[1] = yp[64 + lane]; }
#pragma unroll
        for (int hq = 0; hq < 4; ++hq) { const int d0 = (hq >> 1) * 512 + 8 * lane + 4 * (hq & 1);
            xr4[hq] = *(const f32x4*)(xrow + d0); g1v[hq] = *(const f32x4*)(mo + 2 * 1024 + d0); gn1[hq] = *(const f32x4*)(norms + 1024 + d0);
            gn2[hq] = *(const f32x4*)(norms + 2048 + d0); scv[hq] = *(const f32x4*)(mo + 4 * 1024 + d0); shv[hq] = *(const f32x4*)(mo + 3 * 1024 + d0); }
        { float a[8], b[8]; unpack8(yr[0], a); unpack8(yr[1], b);
#pragma unroll
          for (int i = 0; i < 8; ++i) { yv[i] = a[i]; yv[8 + i] = b[i]; } }
#pragma unroll
        for (int hq = 0; hq < 4; ++hq)
#pragma unroll
            for (int i = 0; i < 4; ++i) xv[hq * 4 + i] = xr4[hq][i];
        float ss = 0.f;
#pragma unroll
        for (int i = 0; i < 16; ++i) ss += yv[i] * yv[i];
        const float rstd = __builtin_amdgcn_rsqf(wave_sum(ss) * (1.f / DM) + RMS_EPS);
        float ss2 = 0.f;
#pragma unroll
        for (int hq = 0; hq < 4; ++hq) { const int d0 = (hq >> 1) * 512 + 8 * lane + 4 * (hq & 1); f32x4 o;
#pragma unroll
            for (int i = 0; i < 4; ++i) { const int k = hq * 4 + i; const float xn = xv[k] + g1v[hq][i] * (yv[k] * rstd * gn1[hq][i]); xv[k] = xn; o[i] = xn; ss2 += xn * xn; }
            *(f32x4*)(orow + d0) = o; }
        const float rstd2 = __builtin_amdgcn_rsqf(wave_sum(ss2) * (1.f / DM) + RMS_EPS);
#pragma unroll
        for (int h = 0; h < 2; ++h) { float hi8[8], lo8[8];
#pragma unroll
            for (int q = 0; q < 2; ++q) { const int hq = h * 2 + q;
#pragma unroll
                for (int i = 0; i < 4; ++i) hi8[q * 4 + i] = xv[hq * 4 + i] * rstd2 * gn2[hq][i] * (1.f + scv[hq][i]) + shv[hq][i]; }
            const v4u ph = pack8(hi8); float back[8]; unpack8(ph, back);
#pragma unroll
            for (int i = 0; i < 8; ++i) lo8[i] = hi8[i] - back[i];
            *(v4u*)(XN + (size_t)r * 1024 + h * 512 + 8 * lane) = ph; *(v4u*)(XNL + (size_t)r * 1024 + h * 512 + 8 * lane) = pack8(lo8); }
    }
    asm volatile("s_waitcnt vmcnt(0)" ::: "memory");
    __syncthreads();
    { const int r32 = lane & 31, hi = lane >> 5, w = F.wave; const int ntiles = (ntok + 31) >> 5;
      if (w < ntiles) {
        const int tloc = 32 * w + r32; const int rr = r0 + (tloc < ntok ? tloc : ntok - 1);
        const bf16* whi = (const bf16*)(F.ws + WS_RWT) + (size_t)l * 2 * 32 * 1024 + (size_t)r32 * 1024 + hi * 8; const bf16* wlo = whi + 32 * 1024;
        const bf16* thi = XN + (size_t)rr * 1024 + hi * 8; const bf16* tlo = XNL + (size_t)rr * 1024 + hi * 8;
        f32x16_t acc = (f32x16_t){};
#pragma unroll 1
        for (int k0 = 0; k0 < 64; k0 += 8) {
            bf16x8_t ah[8], al[8], bh[8], bl[8];
#pragma unroll
            for (int u = 0; u < 8; ++u) { ah[u] = *(const bf16x8_t*)(whi + (k0 + u) * 16); al[u] = *(const bf16x8_t*)(wlo + (k0 + u) * 16); bh[u] = *(const bf16x8_t*)(thi + (k0 + u) * 16); bl[u] = *(const bf16x8_t*)(tlo + (k0 + u) * 16); }
#pragma unroll
            for (int u = 0; u < 8; ++u) { acc = __builtin_amdgcn_mfma_f32_32x32x16_bf16(ah[u], bh[u], acc, 0, 0, 0); acc = __builtin_amdgcn_mfma_f32_32x32x16_bf16(ah[u], bl[u], acc, 0, 0, 0); acc = __builtin_amdgcn_mfma_f32_32x32x16_bf16(al[u], bh[u], acc, 0, 0, 0); } }
        const float* rb = F.in(I_RB) + l * 32; float v[16]; float ninf = -INFINITY; asm volatile("" : "+v"(ninf));
#pragma unroll
        for (int i = 0; i < 16; ++i) v[i] = acc[i] + rb[(i & 3) + 8 * (i >> 2) + 4 * hi];
        float cm[8]; int cid[8];
#pragma unroll
        for (int k = 0; k < 4; ++k) { float m = v[0];
#pragma unroll
            for (int i = 1; i < 16; ++i) m = fmaxf(m, v[i]);
            int sel = 15;
#pragma unroll
            for (int i = 14; i >= 0; --i) sel = (v[i] == m) ? i : sel;
            sel = (v[15] == m && sel == 15) ? 15 : sel;
            cm[k] = m; cid[k] = (sel & 3) + 8 * (sel >> 2) + 4 * hi;
#pragma unroll
            for (int i = 0; i < 16; ++i) v[i] = (i == sel) ? ninf : v[i]; }
#pragma unroll
        for (int k = 0; k < 4; ++k) { cm[4 + k] = __shfl_xor(cm[k], 32); cid[4 + k] = __shfl_xor(cid[k], 32); }
        float tl[4]; int te[4];
#pragma unroll
        for (int k = 0; k < 4; ++k) { float best = cm[0]; int bid = cid[0]; int bc = 0;
#pragma unroll
            for (int c = 1; c < 8; ++c) { const bool better = (cm[c] > best) || (cm[c] == best && cid[c] < bid); best = better ? cm[c] : best; bid = better ? cid[c] : bid; bc = better ? c : bc; }
            tl[k] = best; te[k] = bid;
#pragma unroll
            for (int c = 0; c < 8; ++c) cm[c] = (c == bc) ? ninf : cm[c]; }
        const float e1 = __expf(tl[1] - tl[0]), e2 = __expf(tl[2] - tl[0]), e3 = __expf(tl[3] - tl[0]); const float inv = 1.f / (1.f + e1 + e2 + e3);
        if (hi == 0 && tloc < ntok) { const float wv[4] = {inv, e1 * inv, e2 * inv, e3 * inv};
#pragma unroll
            for (int k = 0; k < 4; ++k) { const int ls = __hip_atomic_fetch_add(&hist[te[k]], 1, __ATOMIC_RELAXED, __HIP_MEMORY_SCOPE_WORKGROUP);
                rec_e[tloc * 4 + k] = te[k]; rec_w[tloc * 4 + k] = wv[k]; rec_s[tloc * 4 + k] = ls; } }
      } }
    __syncthreads();
    if (tid < 32) { const int n = hist[tid]; base[tid] = n ? (int)__hip_atomic_fetch_add((unsigned*)(F.ctl + CW_CNT + cofs + l * 32 + tid), (unsigned)n, RLX_AGENT) : 0; }
    __syncthreads();
    { int* rte = (int*)(F.ws + WS_RTE); int* rts = (int*)(F.ws + WS_RTS); int* ltok = (int*)(F.ws + WS_LTOK); float* lw = (float*)(F.ws + WS_LW);
      for (int i = tid; i < ntok * 4; i += 512) { const int e = rec_e[i], slot = base[e] + rec_s[i]; const int r = r0 + (i >> 2);
          rte[(size_t)r * 4 + (i & 3)] = e; rts[(size_t)r * 4 + (i & 3)] = slot; ltok[(size_t)e * TA + slot] = r; lw[(size_t)e * TA + slot] = rec_w[i]; } }
}

__device__ __forceinline__ void moe_tables(Frame& F, int l, int cofs) {
    LAS int* tab = (LAS int*)(F.lds + LDS_TAB);
    if (F.tid == 0) { int nb = 0;
#pragma unroll 1
        for (int e = 0; e < 32; ++e) { const int c = (int)__hip_atomic_load((unsigned*)(F.ctl + CW_CNT + cofs + l * 32 + e), RLX_AGENT); const int n = (c + 255) >> 8; tab[600 + e] = nb * 256; tab[640 + e] = c;
            for (int b = 0; b < n; ++b) tab[nb + b] = e; nb += n; }
        tab[632] = nb; }
    __syncthreads();
}
__device__ __forceinline__ void t4_phase(Frame& F, int l, int T_l, bool dummy) {
    float* const outp = F.out();
    const bool nextmod = (l + 1 < DEPTH);
    const float* ngain = F.in(I_NORMS) + (size_t)(l + 1 < DEPTH ? l + 1 : l) * 4 * 1024; const float* nmod = (const float*)(F.ws + WS_MOD) + (size_t)(l + 1 < DEPTH ? l + 1 : l) * 3 * 6144; bf16* XN = (bf16*)(F.ws + WS_XN);
    const LAS int* tab = (const LAS int*)(F.lds + LDS_TAB); const int gw = F.bx * 8 + F.wave, NGW = F.G * 8, lane = F.lane;
    const int* rte = (const int*)(F.ws + WS_RTE); const int* rts = (const int*)(F.ws + WS_RTS); const bf16* Yp = (const bf16*)(F.ws + WS_BIG);
    const float* gain = F.in(I_NORMS) + (size_t)l * 4 * 1024 + 3 * 1024; const float* modl = (const float*)(F.ws + WS_MOD) + (size_t)l * 3 * 6144;
    for (int r = gw; r < T_l; r += NGW) { const bool lat = r < TL; const int who = lat ? (r >> 14) : 2; const float* g2 = modl + (size_t)who * 6144 + 5 * 1024;
        float* xrow = lat ? outp + (size_t)r * 1024 : (float*)(F.ws + WS_XC) + (size_t)(r - TL) * 1024;
        float f[16]; int re[4], rs[4];
#pragma unroll
        for (int k = 0; k < 4; ++k) { re[k] = rte[(size_t)r * 4 + k]; rs[k] = rts[(size_t)r * 4 + k]; }
        v4u yr[4][2]; f32x4 xr4[4], gv4[4], mv4[4];
#pragma unroll
        for (int k = 0; k < 4; ++k) { const size_t dst = (size_t)(tab[600 + re[k]] + rs[k]); const v4u* yp = (const v4u*)(Yp + dst * 1024); yr[k][0] = yp[lane]; yr[k][1] = yp[64 + lane]; }
#pragma unroll
        for (int hq = 0; hq < 4; ++hq) { const int d0 = (hq >> 1) * 512 + 8 * lane + 4 * (hq & 1); xr4[hq] = *(const f32x4*)(xrow + d0); gv4[hq] = *(const f32x4*)(gain + d0); mv4[hq] = *(const f32x4*)(g2 + d0); }
        f32x4 ng4[4], ns4[4], nh4[4]; const float* mo = nmod + (size_t)who * 6144;
        if (nextmod) {
#pragma unroll
            for (int hq = 0; hq < 4; ++hq) { const int d0 = (hq >> 1) * 512 + 8 * lane + 4 * (hq & 1); ng4[hq] = *(const f32x4*)(ngain + d0); ns4[hq] = *(const f32x4*)(mo + 1024 + d0); nh4[hq] = *(const f32x4*)(mo + d0); } }
#pragma unroll
        for (int i = 0; i < 16; ++i) f[i] = 0.f;
#pragma unroll
        for (int k = 0; k < 4; ++k) { float a[8], b[8]; unpack8(yr[k][0], a); unpack8(yr[k][1], b);
#pragma unroll
            for (int i = 0; i < 8; ++i) { f[i] += a[i]; f[8 + i] += b[i]; } }
        float ss = 0.f;
#pragma unroll
        for (int i = 0; i < 16; ++i) ss += f[i] * f[i];
        const float rstd = __builtin_amdgcn_rsqf(wave_sum(ss) * (1.f / DM) + RMS_EPS);
        float ssn = 0.f;
#pragma unroll
        for (int hq = 0; hq < 4; ++hq) { const int d0 = (hq >> 1) * 512 + 8 * lane + 4 * (hq & 1); f32x4 xv = xr4[hq];
#pragma unroll
            for (int i = 0; i < 4; ++i) { xv[i] += mv4[hq][i] * (f[hq * 4 + i] * rstd * gv4[hq][i]); f[hq * 4 + i] = xv[i]; ssn += xv[i] * xv[i]; }
            *(f32x4*)((dummy ? (float*)(F.ws + WS_MERGE) + (size_t)r * 1024 : xrow) + d0) = xv; }
        if (nextmod) { const float rstdn = __builtin_amdgcn_rsqf(wave_sum(ssn) * (1.f / DM) + RMS_EPS);
#pragma unroll
            for (int h = 0; h < 2; ++h) { float y[8];
#pragma unroll
                for (int q = 0; q < 2; ++q) { const int hq = h * 2 + q;
#pragma unroll
                    for (int i = 0; i < 4; ++i) y[q * 4 + i] = f[hq * 4 + i] * rstdn * ng4[hq][i] * (1.f + ns4[hq][i]) + nh4[hq][i]; }
                *(v4u*)(XN + (size_t)r * 1024 + h * 512 + 8 * lane) = pack8(y); } } }
}

#ifndef PH_MASK
#define PH_MASK 0xFFFFFFFFu
#endif
#define PH(k) ((PH_MASK >> (k)) & 1u)
#ifndef PH_TWICE
#define PH_TWICE 0u
#endif
#ifndef BG_A
#define BG_A 5504
#endif
#ifndef BG_B
#define BG_B 19392
#endif
#ifndef BG_C
#define BG_C 23360
#endif
#ifndef BG_D
#define BG_D 4096
#endif
#ifndef BG_E
#define BG_E 8192
#endif
#ifndef BG_F
#define BG_F 13696
#endif
#define REP(k) _Pragma("unroll") for (int rep_ = 0; rep_ < (((PH_TWICE >> (k)) & 1u) ? 2 : 1); ++rep_)
__global__ void __launch_bounds__(512, 2) fwd_kernel(Args A) {
    extern __shared__ __attribute__((aligned(16))) unsigned char lds[];
    Frame F;
    F.lds = (LAS unsigned char*)lds; F.MISC = (volatile LAS unsigned*)(F.lds + MISC_OFF);
    F.tid = threadIdx.x; F.lane = F.tid & 63; F.wave = __builtin_amdgcn_readfirstlane(F.tid >> 6);
    F.G = gridDim.x; F.bx = blockIdx.x; F.ws = (unsigned char*)(GAS unsigned char*)(unsigned long long)(uintptr_t)A.ws; F.ctl = (gu32*)(A.ws + WS_CTL);
    int vcu = (F.G % 8 == 0) ? (F.bx % 8) * (F.G / 8) + F.bx / 8 : F.bx;
    if (F.tid < 64) F.MISC[F.tid] = 0u;
    __syncthreads();
    XcdBarrier bar = xcd_barrier_post((unsigned*)(F.ctl + CW_BAR), F.MISC + 8);
#define GRID_BAR() do { { unsigned* bp_ = (unsigned*)(F.ctl + CW_BAR); unsigned x_ = bar.x; asm volatile("" : "+s"(bp_), "+s"(x_)); bar.bar = bp_; bar.x = x_; } xcd_barrier(bar); \
        { int t_ = threadIdx.x; asm volatile("" : "+v"(t_)); F.tid = t_; F.lane = t_ & 63; unsigned long long w_ = (unsigned long long)(uintptr_t)A.ws; int g_ = gridDim.x, b_ = blockIdx.x; asm volatile("" : "+s"(w_), "+s"(g_), "+s"(b_)); \
          F.ws = (unsigned char*)(GAS unsigned char*)w_; ws = F.ws; F.ctl = (gu32*)(w_ + WS_CTL * 1ull); F.G = g_; F.bx = b_; vcu = (g_ % 8 == 0) ? (b_ % 8) * (g_ / 8) + b_ / 8 : b_; gw = b_ * 8 + F.wave; NGW = g_ * 8; } } while (0)
    int gw = F.bx * 8 + F.wave, NGW = F.G * 8;
    unsigned char* ws = F.ws;

    if (PH(0)) REP(0) p_prologue(F, A);
    GRID_BAR();

#pragma unroll
    for (int l = 0; l < DEPTH; ++l) {
        const int T_l = (l == 0) ? TA : TL;

        if (PH(1) && l == 0) REP(1) { const float* xin_lat = (l == 0) ? F.in(I_X) : F.out(); const float* xin_ctx = (l == 0) ? F.in(I_CTX) : (const float*)(ws + WS_XC);
          const float* norms = F.in(I_NORMS) + (size_t)l * 4 * 1024; const float* modl = (const float*)(ws + WS_MOD) + (size_t)l * 3 * 6144;
          for (int r = gw; r < TA; r += NGW) { const bool lat = r < TL; const int who = lat ? (r >> 14) : 2; const float* mo = modl + (size_t)who * 6144;
            mod_row_to_bf16(lat ? xin_lat + (size_t)r * 1024 : xin_ctx + (size_t)(r - TL) * 1024, norms, mo + 1024, mo, (bf16*)(ws + WS_XN) + (size_t)r * 1024, F.lane); } }
        if (l == 0) GRID_BAR();

        if (PH(2)) REP(2) { pg8::Gemm g{(const bf16*)(ws + WS_XN), (const bf16*)(ws + WS_WIN) + (size_t)l * ZW * 1024, TA, ZW, 1024}; pg8::StaticOrder S; S.init(TA, ZW, F.G, F.bx);
          pg8::EpiInproj E{ws, F.in(I_QKN) + (size_t)l * 128, F.in(I_MQN) + (size_t)l * 256, F.in(I_MKVN) + (size_t)l * 128, (LAS float*)(F.lds + LDS_X)};
          pg8::gemm_phase<pg8::EpiInproj, pg8::StaticOrder, true, true>(F.lds + RING_OFF, g, S, E); }
        __syncthreads(); bg_site(F, l, (l == 0) ? 0 : BG_E, (l == 0) ? BG_A : BG_F, (TA / 256) * (ZW / 256), F.bx);
        GRID_BAR();

        if (PH(4)) REP(4) { pg8::Gemm g{(const bf16*)(ws + WS_CQN), (const bf16*)(ws + WS_WUQ) + (size_t)l * 768 * 256, T_l, 768, 256}; pg8::StaticOrder S; S.init(T_l, 768, F.G, F.bx);
          pg8::EpiUq E{(bf16*)(ws + WS_QM), (const float*)(ws + WS_COSM), (const float*)(ws + WS_SINM)};
          pg8::gemm_phase<pg8::EpiUq, pg8::StaticOrder, true, true>(F.lds + RING_OFF, g, S, E); }
        if (PH(5)) REP(5) { pg8::Gemm g{(const bf16*)(ws + WS_CKVN), (const bf16*)(ws + WS_WUKV) + (size_t)l * 1024 * 128, TA, 1024, 128}; pg8::StaticOrder S; S.init(TA, 1024, F.G, (F.bx + F.G / 2) % F.G);
          pg8::EpiUkv E{(bf16*)(ws + WS_KM), (bf16*)(ws + WS_VM)};
          pg8::gemm_phase<pg8::EpiUkv, pg8::StaticOrder, true, true>(F.lds + RING_OFF, g, S, E); }
        if (PH(6)) REP(6) { const float* gbs = F.in(I_GBS); const float* gvn = F.in(I_GVN); for (int hu = (F.bx + F.G / 4) % F.G; hu < 2 * (T_l / 128); hu += F.G) gmlp_unit(F, gbs, gvn, l, hu >> 1, hu & 1); }
        GRID_BAR();

        { const int per = (1024 + F.G - 1) / F.G; char* shm = (char*)lds + RING_OFF;
          if (PH(7)) REP(7) for (int i = 0; i <= per; ++i) { size_t row0; int b, h, nt, t0;
              if (i < per) { const int L = vcu * per + i; if (L >= 1024) continue; const int bh = L >> 6, qb = L & 63; b = bh >> 3; h = bh & 7; row0 = (size_t)b * SEQ + (size_t)qb * 256; t0 = 0; nt = NTILE; }
              else { if (l != 0 || F.bx >= 16) continue; const int bh = F.bx; b = bh >> 3; h = bh & 7; row0 = (size_t)TL + (size_t)b * CTX; t0 = SEQ / 64; nt = CTX / 64; }
              attn_body::attn_unit<4, 512, 128, 128, 512, 8, false, false>((const bf16*)(ws + WS_QG) + row0 * 512 + h * 64, (const bf16*)(ws + WS_KG) + ((size_t)(b * 2 + (h >> 2)) * NTILE + t0) * 4096, (const bf16*)(ws + WS_VG) + ((size_t)(b * 2 + (h >> 2)) * NTILE + t0) * 4096,
                                                             (bf16*)(ws + WS_OG) + row0 * 512 + h * 64, nt, shm); }
          if (PH(8)) REP(8) for (int i = 0; i <= per; ++i) { size_t row0; int b, h, nt, t0;
              if (i < per) { const int L = vcu * per + i; if (L >= 1024) continue; const int bh = L >> 6, qb = L & 63; b = bh >> 3; h = bh & 7; row0 = (size_t)b * SEQ + (size_t)qb * 256; t0 = 0; nt = NTILE; }
              else { if (l != 0 || F.bx < 16 || F.bx >= 32) continue; const int bh = F.bx - 16; b = bh >> 3; h = bh & 7; row0 = (size_t)TL + (size_t)b * CTX; t0 = SEQ / 64; nt = CTX / 64; }
              attn_body::attn_unit<6, 768, 768, 512, 512, 8, false, false>((const bf16*)(ws + WS_QM) + row0 * 768 + h * 96, (const bf16*)(ws + WS_KM) + ((size_t)(b * 8 + h) * NTILE + t0) * 6144, (const bf16*)(ws + WS_VM) + ((size_t)(b * 8 + h) * NTILE + t0) * 4096,
                                                             (bf16*)(ws + WS_OM) + row0 * 512 + h * 64, nt, shm); } }
        GRID_BAR();

        if (PH(10)) REP(10) { pg8::StaticOrder S; S.init(T_l, 1024, F.G, F.bx); const bf16* wbr = (const bf16*)(ws + WS_WBR) + (size_t)l * 3 * 1024 * 512;
          { pg8::Gemm g{(const bf16*)(ws + WS_OG), wbr, T_l, 1024, 512}; pg8::EpiBranch<0> E{(const bf16*)(ws + WS_BIG), (bf16*)(ws + WS_MERGEB)};
            pg8::gemm_phase<pg8::EpiBranch<0>, pg8::StaticOrder, true, true>(F.lds + RING_OFF, g, S, E); }
          { pg8::Gemm g{(const bf16*)(ws + WS_OM), wbr + (size_t)1024 * 512, T_l, 1024, 512}; pg8::EpiBranch<1> E{(const bf16*)(ws + WS_BIG), (bf16*)(ws + WS_MERGEB)};
            pg8::gemm_phase<pg8::EpiBranch<1>, pg8::StaticOrder, true, true>(F.lds + RING_OFF, g, S, E); }
          { pg8::Gemm g{(const bf16*)(ws + WS_GM), wbr + (size_t)2 * 1024 * 512, T_l, 1024, 512}; pg8::EpiBranch<2> E{(const bf16*)(ws + WS_BIG), (bf16*)(ws + WS_MERGEB)};
            pg8::gemm_phase<pg8::EpiBranch<2>, pg8::StaticOrder, true, true>(F.lds + RING_OFF, g, S, E); } }
        if (l == 0) { __syncthreads(); bg_site(F, 0, BG_A, BG_B, (T_l / 256) * 4, F.bx); }
        GRID_BAR();

        if (PH(11)) REP(11) { pg8::Gemm g{(const bf16*)(ws + WS_MERGEB), (const bf16*)(ws + WS_WOUT) + (size_t)l * 1024 * 1024, T_l, 1024, 1024}; pg8::StaticOrder S; S.init(T_l, 1024, F.G, F.bx);
          pg8::EpiPlain E{(bf16*)(ws + WS_Y), 1024};
          pg8::gemm_phase<pg8::EpiPlain, pg8::StaticOrder, true, true>(F.lds + RING_OFF, g, S, E); }
        if (l == 0) { __syncthreads(); bg_site(F, 0, BG_B, BG_C, (T_l / 256) * 4, F.bx); }
        GRID_BAR();

        bg_site(F, l, (l == 0) ? BG_C : BG_F, BG_PER_LAYER, 0, F.bx); __syncthreads();
        if (PH(12)) REP(12) { const float* xin_lat = (l == 0) ? F.in(I_X) : F.out(); const float* xin_ctx = (l == 0) ? F.in(I_CTX) : (const float*)(ws + WS_XC); t3_phase(F, l, T_l, xin_lat, xin_ctx, (((PH_TWICE >> 12) & 1u) && rep_ == 0) ? 64 : 0, ((PH_TWICE >> 12) & 1u) && rep_ == 0); }
        GRID_BAR();

        moe_tables(F, l, 0);

        if (PH(14)) REP(14) { const LAS int* tab = (const LAS int*)(F.lds + LDS_TAB); const int nblk = __builtin_amdgcn_readfirstlane(tab[632]);
          LAS int* rowtok = (LAS int*)(F.lds + LDS_ROWTOK);
          { const int* ltok = (const int*)(ws + WS_LTOK); const int nun = nblk * 8;
            int tk[10];
#pragma unroll
            for (int jj = 0; jj < 10; ++jj) { const int idx = F.tid + 512 * jj; const int i = idx >> 8, r = idx & 255; const long L = (long)i * F.G + vcu; tk[jj] = -1;
                if (L < nun) { const int blk = (int)(L >> 3), e = tab[blk], slot = blk * 256 + r - tab[600 + e]; if (slot < tab[640 + e]) tk[jj] = ltok[(size_t)e * TA + slot]; } }
#pragma unroll
            for (int jj = 0; jj < 10; ++jj) rowtok[F.tid + 512 * jj] = tk[jj] < 0 ? 0 : tk[jj];
            __syncthreads(); }
          pg8::Gemm g{(const bf16*)(ws + WS_XN), (const bf16*)(ws + WS_W1) + (size_t)l * 32 * 2048 * 1024, TA, 32 * 2048, 1024};
          pg8::MoeOrder<8> S{nblk * 8, F.G, vcu, tab, rowtok}; pg8::EpiMoe1 E{(bf16*)(ws + WS_H), F.in(I_EB1) + (size_t)l * 32 * 2048};
          pg8::gemm_phase<pg8::EpiMoe1, pg8::MoeOrder<8>, true, true, true>(F.lds + RING_OFF, g, S, E);
          if (l == 0) { __syncthreads(); bg_site(F, 1, 0, BG_D, nblk * 8, vcu); } }
        GRID_BAR();

        if (PH(15)) REP(15) { const LAS int* tab = (const LAS int*)(F.lds + LDS_TAB); const int nblk = __builtin_amdgcn_readfirstlane(tab[632]);
          pg8::Gemm g{(const bf16*)(ws + WS_H), (const bf16*)(ws + WS_W2) + (size_t)l * 32 * 1024 * 1024, MOE_ROWS, 32 * 1024, 1024};
          pg8::MoeOrder<4> S{nblk * 4, F.G, vcu, tab, tab}; pg8::EpiMoe2 E{(bf16*)(ws + WS_BIG), F.in(I_EB2) + (size_t)l * 32 * 1024, (const float*)(ws + WS_LW), tab};
          pg8::gemm_phase<pg8::EpiMoe2, pg8::MoeOrder<4>, true, true>(F.lds + RING_OFF, g, S, E);
          if (l == 0) { __syncthreads(); bg_site(F, 1, BG_D, BG_E, nblk * 4, vcu); } }
        GRID_BAR();

        if (PH(16)) REP(16) t4_phase(F, l, T_l, ((PH_TWICE >> 16) & 1u) && rep_ == 0);
        GRID_BAR();
    }
#undef GRID_BAR
}

extern "C" void kernel_launch(void* const* d_in, const int* in_sizes, int n_in, void* d_out, int out_size, void* d_ws, size_t ws_size, hipStream_t stream) {
    static int grid = 0;
    if (grid == 0) {
        if (n_in != 24 || out_size != TL * DM || ws_size < WS_END) { fprintf(stderr, "kernel_launch: unexpected problem: n_in %d out %d ws %zu (need %zu)\n", n_in, out_size, ws_size, (size_t)WS_END); grid = -1; return; }
        int dev = 0, cus = 0;
        if (hipGetDevice(&dev) != hipSuccess || hipDeviceGetAttribute(&cus, hipDeviceAttributeMultiprocessorCount, dev) != hipSuccess) { grid = -1; return; }
        if (hipFuncSetAttribute((const void*)fwd_kernel, hipFuncAttributeMaxDynamicSharedMemorySize, LDS_BYTES) != hipSuccess) { fprintf(stderr, "kernel_launch: hipFuncSetAttribute failed\n"); grid = -1; return; }
        int per_cu = 0;
        if (hipOccupancyMaxActiveBlocksPerMultiprocessor(&per_cu, (const void*)fwd_kernel, 512, LDS_BYTES) != hipSuccess || per_cu < 1) fprintf(stderr, "kernel_launch: occupancy query reports %d\n", per_cu);
        (void)hipGetLastError();
        grid = cus > 256 ? 256 : cus;
    }
    if (grid < 0) return;
    if (hipMemsetAsync((char*)d_ws + WS_CTL, 0, CTL_ZERO_BYTES, stream) != hipSuccess) return;
    Args a{};
    for (int i = 0; i < 24; ++i) a.in[i] = (const float*)d_in[i];
    a.out = (float*)d_out; a.ws = (unsigned char*)d_ws;
    hipLaunchKernelGGL(fwd_kernel, dim3(grid), dim3(512), LDS_BYTES, stream, a);
}
```

```cpp
#include <hip/hip_runtime.h>
#include <cstdio>
#include <cstdint>

typedef unsigned short bf16;

constexpr int DM = 1024, NBATCH = 2, SEQ = 16384, CTX = 256, DEPTH = 2;
constexpr int TL = NBATCH * SEQ;
constexpr int TC = NBATCH * CTX;
constexpr int TA = TL + TC;
constexpr int KPB = SEQ + CTX;
constexpr int KR = NBATCH * KPB;
constexpr int ZW = 5376;
constexpr int Z_Q = 0, Z_K = 512, Z_V = 640, Z_CQ = 768, Z_CKV = 1024, Z_KR = 1152, Z_U = 1280, Z_VG = 1792, Z_GATE = 2304;
constexpr int NEXP = 32, TOPK = 4, DEXP = 1024, MOE_ROWS = 552 * 256;
constexpr float RMS_EPS = 1e-6f;
constexpr float LOG2E = 1.4426950408889634f;
constexpr float C2G = 0.125f * LOG2E;
constexpr float C2M = 0.10206207261596577f * LOG2E;

constexpr size_t MiB = 1u << 20;
constexpr size_t WS_CTL = 0, CTL_ZERO_BYTES = 128 * 1024;
constexpr size_t WS_MOD = 1 * MiB;
constexpr size_t WS_PTAB = 1 * MiB + 512 * 1024;
constexpr size_t WS_COSG = 2 * MiB, WS_SING = 4 * MiB, WS_COSM = 6 * MiB, WS_SINM = 7 * MiB;
constexpr size_t WS_WS = 8 * MiB;
constexpr size_t WS_RWT = 8 * MiB + 512 * 1024;
constexpr size_t WS_SSV = 1 * MiB + 640 * 1024;
static_assert(WS_SSV + (size_t)TA * 2 * 4 <= 2 * MiB && WS_RWT + (size_t)DEPTH * 2 * 32 * 1024 * 2 <= 9 * MiB, "ws map small regions");
constexpr size_t WS_WUQ = 9 * MiB;
constexpr size_t WS_WUKV = 10 * MiB;
constexpr size_t WS_WBR = 11 * MiB;
constexpr size_t WS_WOUT = 17 * MiB;
constexpr size_t WS_WIN = 21 * MiB;
constexpr size_t WS_W1 = 42 * MiB;
constexpr size_t WS_W2 = 298 * MiB;
constexpr size_t WS_XC = 426 * MiB;
constexpr size_t WS_RTE = 428 * MiB;
constexpr size_t WS_RTS = 429 * MiB;
constexpr size_t WS_LTOK = 430 * MiB;
constexpr size_t WS_LW = 435 * MiB;
constexpr size_t WS_XN = 441 * MiB;
constexpr size_t WS_QG = 506 * MiB;
constexpr size_t WS_KG = 539 * MiB;
constexpr size_t WS_VG = 548 * MiB;
constexpr size_t WS_CQN = 557 * MiB;
constexpr size_t WS_CKVN = 574 * MiB;
constexpr size_t WS_QM = 583 * MiB;
constexpr size_t WS_KM = 632 * MiB;
constexpr size_t WS_VM = 681 * MiB;
constexpr size_t WS_OG = 714 * MiB;
constexpr size_t WS_OM = 747 * MiB;
constexpr size_t WS_GM = 780 * MiB;
constexpr size_t WS_UACT = 813 * MiB;
constexpr size_t WS_VN = 846 * MiB;
constexpr size_t WS_MERGE = 879 * MiB;
constexpr size_t WS_MERGEB = 1009 * MiB;
constexpr size_t WS_Y = 1074 * MiB;
constexpr size_t WS_H = 1139 * MiB;
constexpr size_t WS_BIG = 1415 * MiB;
constexpr size_t WS_END = 1757 * MiB;
static_assert(WS_BIG + (size_t)TA * ZW * 2 <= WS_END && WS_BIG + (size_t)MOE_ROWS * 1024 * 2 <= WS_END && WS_H + (size_t)MOE_ROWS * 1024 * 2 <= WS_BIG, "ws map");
static_assert(WS_W1 + (size_t)DEPTH * 32 * 2048 * 1024 * 2 <= WS_W2 && WS_W2 + (size_t)DEPTH * 32 * 1024 * 1024 * 2 <= WS_XC, "ws map weights");
static_assert(WS_MERGE + (size_t)TA * 1024 * 4 <= WS_MERGEB && WS_XN + (size_t)TA * 1024 * 2 <= WS_QG && WS_QM + (size_t)TA * 768 * 2 <= WS_KM, "ws map acts");
constexpr int CW_BAR = 4096;
constexpr int CW_CNT = 16384;
constexpr int CW_BGQ = 16384 + 512;
static_assert((CW_BGQ + 1) * 4 <= (int)CTL_ZERO_BYTES && (CW_BAR + 3456) * 4 <= (int)CTL_ZERO_BYTES, "control words inside the per-call memset");

constexpr int RING_OFF = 0, RING_BYTES = 131072;
constexpr int LDS_X = RING_BYTES + 4096;
constexpr int LDS_SVEC = LDS_X;
constexpr int LDS_ROWTOK = LDS_X;
constexpr int MISC_OFF = 159744;
constexpr int LDS_TAB = 160000;
constexpr int LDS_BYTES = 163840;
static_assert(LDS_SVEC + 3 * 1024 * 4 <= MISC_OFF && LDS_ROWTOK + 20 * 1024 <= MISC_OFF && LDS_TAB + 704 * 4 <= LDS_BYTES, "LDS map");

#define GAS __attribute__((address_space(1)))
#define LAS __attribute__((address_space(3)))
typedef unsigned v4u __attribute__((ext_vector_type(4)));
typedef float f32x4 __attribute__((ext_vector_type(4)));
typedef GAS unsigned gu32;
#define RLX_AGENT __ATOMIC_RELAXED, __HIP_MEMORY_SCOPE_AGENT
#define LDS_WAIT() asm volatile("s_waitcnt lgkmcnt(0)" ::: "memory")
#define VM_WAIT() asm volatile("s_waitcnt vmcnt(0)" ::: "memory")

__device__ __forceinline__ unsigned cvt_pk(float lo, float hi) { unsigned r; asm volatile("v_cvt_pk_bf16_f32 %0, %1, %2" : "=v"(r) : "v"(lo), "v"(hi)); return r; }
__device__ __forceinline__ float bf_lo(unsigned u) { return __uint_as_float(u << 16); }
__device__ __forceinline__ float bf_hi(unsigned u) { return __uint_as_float(u & 0xffff0000u); }
__device__ __forceinline__ void unpack8(v4u r, float (&f)[8]) { f[0] = bf_lo(r.x); f[1] = bf_hi(r.x); f[2] = bf_lo(r.y); f[3] = bf_hi(r.y); f[4] = bf_lo(r.z); f[5] = bf_hi(r.z); f[6] = bf_lo(r.w); f[7] = bf_hi(r.w); }
__device__ __forceinline__ v4u pack8(const float (&f)[8]) { v4u o; o.x = cvt_pk(f[0], f[1]); o.y = cvt_pk(f[2], f[3]); o.z = cvt_pk(f[4], f[5]); o.w = cvt_pk(f[6], f[7]); return o; }
__device__ __forceinline__ float sigmoidf_(float x) { return __builtin_amdgcn_rcpf(1.f + __builtin_amdgcn_exp2f(-LOG2E * x)); }
__device__ __forceinline__ float wave_sum(float v) {
#pragma unroll
    for (int o = 1; o < 64; o <<= 1) v += __shfl_xor(v, o);
    return v;
}
__device__ __forceinline__ float gelu_tanh(float x) { const float u = 1.5957691216057308f * (x + 0.044715f * x * x * x); return x * __builtin_amdgcn_rcpf(1.f + __builtin_amdgcn_exp2f(-LOG2E * u)); }
constexpr int NTILE = KPB / 64;
__device__ __forceinline__ void bpos_of(int r, int& b, int& pos) { if (r < TL) { b = r >> 14; pos = r & (SEQ - 1); } else { b = (r - TL) >> 8; pos = SEQ + ((r - TL) & (CTX - 1)); } }
__device__ __forceinline__ size_t ktile_off(int strm, int pos, int chunk, int nch) { return (((size_t)strm * NTILE + (pos >> 6)) * nch + chunk) * 512 + (size_t)(pos & 63) * 8; }
__device__ __forceinline__ size_t vtile_off(int strm, int pos, int d) { const int piece = (d >> 5) * 4 + ((pos & 63) >> 4), ln = (pos & 15) * 4 + ((d >> 3) & 3); return (((size_t)strm * NTILE + (pos >> 6)) * 8 + piece) * 512 + (size_t)ln * 8; }
__device__ __forceinline__ int krow_of(int r) { return r < TL ? (r >> 14) * KPB + (r & (SEQ - 1)) : ((r - TL) >> 8) * KPB + SEQ + ((r - TL) & (CTX - 1)); }

__device__ const float INVF16[16] = {1.0f, 0.5623413324356079f, 0.3162277638912201f, 0.17782793939113617f, 0.10000000149011612f, 0.05623413249850273f, 0.03162277489900589f, 0.017782794311642647f,
                                     0.009999999776482582f, 0.005623413249850273f, 0.003162277629598975f, 0.0017782794311642647f, 0.0010000000474974513f, 0.000562341301701963f, 0.0003162277571391314f, 0.00017782794020604342f};
namespace pg8 {
#define PG8_LAS __attribute__((address_space(3)))
typedef unsigned short bf16_t;
typedef short bf16x8 __attribute__((ext_vector_type(8)));
typedef float f32x4 __attribute__((ext_vector_type(4)));
typedef unsigned u32x4 __attribute__((ext_vector_type(4)));
constexpr int BM = 256, BK = 64, HALF = 128, HTB = HALF * BK * 2  , STAGE_BYTES = 8 * HTB, NXCD = 8, WGM = 8;

__host__ __device__ __forceinline__ int lds_byte(int r, int c) { const int st = (r >> 4) * 2 + (c >> 5), rr = r & 15, cc = c & 31, ob = rr * 64 + cc * 2; return st * 1024 + (ob ^ (((ob >> 9) & 1) << 5)); }
__host__ __device__ __forceinline__ void stage_rc(int b, int& R, int& C) { const int st = b / 1024, sb = b % 1024, swz = sb ^ (((sb >> 9) & 1) << 5); R = (st >> 1) * 16 + swz / 64; C = (st & 1) * 32 + (swz % 64) / 2; }
__host__ __device__ __forceinline__ int perm32(int rho) { const int n = rho >> 4, i = rho & 15; return 8 * (i >> 2) + 4 * n + (i & 3); }

struct Unit { int pm, pn; };
struct Gemm { const bf16_t* A; const bf16_t* Bt; int M, N, K; };

struct StaticOrder {
    int nM, nN, nwg, G, c;
    __device__ void init(int M, int N, int G_, int c_) { asm volatile("" : "+s"(M), "+s"(N));
        nM = M / BM; nN = N / BM; nwg = nM * nN; G = G_; c = c_; }
    __host__ __device__ bool next(int i, Unit& u) const {
        const long L = (long)i * G + c; if (L >= nwg) return false;
        int wgid = (int)L; { const int q = nwg / NXCD, r = nwg % NXCD, xcd = wgid % NXCD, off = wgid / NXCD; wgid = (xcd < r ? xcd * (q + 1) : r * (q + 1) + (xcd - r) * q) + off; }
        const int nig = WGM * nN, gid = wgid / nig, fm = gid * WGM, gsz = (nM - fm) < WGM ? (nM - fm) : WGM;
        u.pm = fm + ((wgid % nig) % gsz); u.pn = (wgid % nig) / gsz; return true;
    }
    __device__ __forceinline__ void a_ready(const Unit&) const {}
    __device__ __forceinline__ void done(const Unit&) const {}
};

template <class Epi, class Sched, bool ALIGN_EPI = false, bool SP2 = false, bool GATHER = false>
__device__ __forceinline__ void gemm_phase(PG8_LAS unsigned char* lds, const Gemm g, const Sched& S, const Epi& E) {
    static_assert(!GATHER || SP2, "GATHER is implemented for the SP2 loop only");
    int tid_ = threadIdx.x; asm volatile("" : "+v"(tid_));
    const int tid = tid_, wid = __builtin_amdgcn_readfirstlane(tid >> 6), lane = tid & 63, wr = wid >> 2, wc = wid & 3, fr = lane & 15, fq = lane >> 4;
    int K_ = g.K; asm volatile("" : "+s"(K_));
    const int K = K_, nt = K / BK;
    unsigned voffA[2], voffB[2];
#pragma unroll
    for (int i = 0; i < 2; ++i) { int R, C; stage_rc(tid * 16 + i * 8192, R, C); const int Rb = Epi::PERM ? ((R & ~31) + perm32(R & 31)) : R;
        voffA[i] = (unsigned)(R * K + C) * 2u; voffB[i] = (unsigned)(Rb * K + C) * 2u; }
    unsigned vAc0[2] = {0u, 0u}, vAc1[2] = {0u, 0u}, vAn0[2] = {0u, 0u}, vAn1[2] = {0u, 0u}, vsel0[2] = {0u, 0u}, vsel1[2] = {0u, 0u};
#define PG8_GOFF(dst0, dst1, uidx) do { _Pragma("unroll") for (int i_ = 0; i_ < 2; ++i_) { int R_, C_; stage_rc(tid * 16 + i_ * 8192, R_, C_); \
        dst0[i_] = ((unsigned)S.tok((uidx), R_) * (unsigned)K + (unsigned)C_) * 2u; dst1[i_] = ((unsigned)S.tok((uidx), HALF + R_) * (unsigned)K + (unsigned)C_) * 2u; } } while (0)
#define PG8_STG_A(bufoff, base, H, SEL) do { if constexpr (GATHER) { if (SEL) { PG8_STAGE(bufoff, base, vsel##H); } else { PG8_STAGE(bufoff, base, vAc##H); } } else { PG8_STAGE(bufoff, (base) + (H) * hstep, voffA); } } while (0)
    const size_t kstep = (size_t)(BK * 2);
    const size_t hstep = (size_t)HALF * K * 2;
    const size_t tstep = 2 * hstep;
    const unsigned ldsw = (unsigned)wid * 1024u;
    const int aoff = lds_byte(wr * 64 + fr, fq * 8), boff = lds_byte(wc * 32 + fr, fq * 8);
#define PG8_SA(b, h) (((b) * 2 + (h)) * HTB)
#define PG8_SB(b, h) ((4 + (b) * 2 + (h)) * HTB)
#define PG8_STAGE(bufoff, gbase, voff) do { _Pragma("unroll") for (int _i = 0; _i < 2; ++_i) \
        __builtin_amdgcn_global_load_lds((const unsigned*)((const char*)(gbase) + (voff)[_i]), (PG8_LAS unsigned*)(lds + (bufoff) + ldsw + _i * 8192), 16, 0, 0); } while (0)
#define PG8_LDA(dst, b, h) do { _Pragma("unroll") for (int m = 0; m < 4; ++m) _Pragma("unroll") for (int k = 0; k < 2; ++k) dst[m][k] = *(const PG8_LAS bf16x8*)(lds + PG8_SA(b, h) + aoff + m * 2048 + k * 1024); } while (0)
#define PG8_LDB(dst, b, h) do { _Pragma("unroll") for (int n = 0; n < 2; ++n) _Pragma("unroll") for (int k = 0; k < 2; ++k) dst[n][k] = *(const PG8_LAS bf16x8*)(lds + PG8_SB(b, h) + boff + n * 2048 + k * 1024); } while (0)
#define PG8_MMA(ai, bj, At, Bt) do { __builtin_amdgcn_s_setprio(1); _Pragma("unroll") for (int m = 0; m < 4; ++m) _Pragma("unroll") for (int n = 0; n < 2; ++n) _Pragma("unroll") for (int k = 0; k < 2; ++k) \
        acc[ai][bj][m][n] = __builtin_amdgcn_mfma_f32_16x16x32_bf16(Bt[n][k], At[m][k], acc[ai][bj][m][n], 0, 0, 0); __builtin_amdgcn_s_setprio(0); } while (0)
#define PG8_WAIT_V(n) asm volatile("s_waitcnt vmcnt(" #n ")" ::: "memory")
#define PG8_WAIT_L(n) asm volatile("s_waitcnt lgkmcnt(" #n ")" ::: "memory")
#define PG8_BAR __builtin_amdgcn_s_barrier()
#define PG8_SCHED __builtin_amdgcn_sched_barrier(0)
    Unit cur, nxt; int ui = 0;
    if (!S.next(0, cur)) return;
    f32x4 acc[2][2][4][2];
#pragma unroll
    for (int a = 0; a < 2; ++a)
#pragma unroll
        for (int b = 0; b < 2; ++b)
#pragma unroll
            for (int m = 0; m < 4; ++m)
#pragma unroll
                for (int n = 0; n < 2; ++n) acc[a][b][m][n] = (f32x4){0.f, 0.f, 0.f, 0.f};
    bf16x8 At[4][2], B0[2][2], B1[2][2];
    const char* cA = GATHER ? (const char*)g.A : (const char*)g.A + (size_t)cur.pm * tstep; const char* cB = (const char*)g.Bt + (size_t)cur.pn * tstep;
    if constexpr (GATHER) { PG8_GOFF(vAc0, vAc1, 0); }
    S.a_ready(cur);
    if constexpr (SP2) {
        PG8_STAGE(PG8_SB(0, 0), cB, voffB); PG8_STAGE(PG8_SB(0, 1), cB + hstep, voffB); PG8_STG_A(PG8_SA(0, 0), cA, 0, false); PG8_STG_A(PG8_SA(0, 1), cA, 1, false);
        if (wr == 1) PG8_BAR;
        PG8_WAIT_V(2); PG8_BAR;
        PG8_STAGE(PG8_SB(1, 0), cB + kstep, voffB); PG8_STG_A(PG8_SA(1, 0), cA + kstep, 0, false); PG8_STAGE(PG8_SB(1, 1), cB + hstep + kstep, voffB);
        PG8_WAIT_V(6); PG8_BAR;
    } else {
        PG8_STAGE(PG8_SB(0, 0), cB, voffB); PG8_STAGE(PG8_SA(0, 0), cA, voffA); PG8_STAGE(PG8_SB(0, 1), cB + hstep, voffB); PG8_STAGE(PG8_SA(0, 1), cA + hstep, voffA);
        if (wr == 1) PG8_BAR;
        PG8_WAIT_V(4); PG8_BAR;
        PG8_STAGE(PG8_SB(1, 0), cB + kstep, voffB); PG8_STAGE(PG8_SA(1, 0), cA + kstep, voffA); PG8_STAGE(PG8_SB(1, 1), cB + hstep + kstep, voffB);
        PG8_WAIT_V(6); PG8_BAR;
    }
    for (;;) {
        const bool has_next = S.next(ui + 1, nxt);
        const char* nA = GATHER ? (const char*)g.A : (has_next ? (const char*)g.A + (size_t)nxt.pm * tstep : cA);
        if constexpr (GATHER) { if (has_next) { PG8_GOFF(vAn0, vAn1, ui + 1); } else { vAn0[0] = vAc0[0]; vAn0[1] = vAc0[1]; vAn1[0] = vAc1[0]; vAn1[1] = vAc1[1]; } } const char* nB = has_next ? (const char*)g.Bt + (size_t)nxt.pn * tstep : cB;
        for (int t = 0; t < nt; t += 2) {
            const bool last = (t == nt - 2);
            const char* a1 = cA + (size_t)(t + 1) * kstep;
            const char* a2 = last ? nA : cA + (size_t)(t + 2) * kstep; const char* b2 = last ? nB : cB + (size_t)(t + 2) * kstep;
            const char* a3 = a2 + kstep; const char* b3 = b2 + kstep;
            if (last && has_next) S.a_ready(nxt);
            if constexpr (GATHER) { vsel0[0] = last ? vAn0[0] : vAc0[0]; vsel0[1] = last ? vAn0[1] : vAc0[1]; vsel1[0] = last ? vAn1[0] : vAc1[0]; vsel1[1] = last ? vAn1[1] : vAc1[1]; }
            if constexpr (SP2) {
            PG8_LDB(B0, 0, 0); PG8_LDB(B1, 0, 1); PG8_SCHED; PG8_LDA(At, 0, 0); PG8_STG_A(PG8_SA(1, 1), a1, 1, false);
            PG8_WAIT_V(8); PG8_WAIT_L(0); PG8_BAR; PG8_MMA(0, 0, At, B0); PG8_MMA(0, 1, At, B1); PG8_BAR; PG8_SCHED;
            PG8_LDA(At, 0, 1); PG8_STAGE(PG8_SB(0, 0), b2, voffB); PG8_STAGE(PG8_SB(0, 1), b2 + hstep, voffB); PG8_STG_A(PG8_SA(0, 0), a2, 0, true);
            PG8_WAIT_V(8); PG8_WAIT_L(0); PG8_BAR; PG8_MMA(1, 0, At, B0); PG8_MMA(1, 1, At, B1); PG8_BAR; PG8_SCHED;
            PG8_LDB(B0, 1, 0); PG8_LDB(B1, 1, 1); PG8_SCHED; PG8_LDA(At, 1, 0); PG8_STG_A(PG8_SA(0, 1), a2, 1, true);
            PG8_WAIT_V(8); PG8_WAIT_L(0); PG8_BAR; PG8_MMA(0, 0, At, B0); PG8_MMA(0, 1, At, B1); PG8_BAR; PG8_SCHED;
            PG8_LDA(At, 1, 1); PG8_STAGE(PG8_SB(1, 0), b3, voffB); PG8_STAGE(PG8_SB(1, 1), b3 + hstep, voffB); PG8_STG_A(PG8_SA(1, 0), a3, 0, true);
            PG8_WAIT_V(8); PG8_WAIT_L(0); PG8_BAR; PG8_MMA(1, 0, At, B0); PG8_MMA(1, 1, At, B1); PG8_BAR; PG8_SCHED;
            } else {
            PG8_LDB(B0, 0, 0); PG8_SCHED; PG8_LDA(At, 0, 0); PG8_STAGE(PG8_SA(1, 1), a1 + hstep, voffA);
            PG8_WAIT_L(8); PG8_BAR; PG8_WAIT_L(0); PG8_MMA(0, 0, At, B0); PG8_BAR; PG8_SCHED;
            PG8_LDB(B1, 0, 1); PG8_STAGE(PG8_SB(0, 0), b2, voffB);
            PG8_BAR; PG8_WAIT_L(0); PG8_MMA(0, 1, At, B1); PG8_BAR;
            PG8_LDA(At, 0, 1); PG8_STAGE(PG8_SA(0, 0), a2, voffA);
            PG8_BAR; PG8_WAIT_L(0); PG8_MMA(1, 0, At, B0); PG8_BAR; PG8_SCHED;
            PG8_STAGE(PG8_SB(0, 1), b2 + hstep, voffB);
            PG8_WAIT_V(6); PG8_BAR; PG8_MMA(1, 1, At, B1); PG8_BAR;
            PG8_LDB(B0, 1, 0); PG8_SCHED; PG8_LDA(At, 1, 0); PG8_STAGE(PG8_SA(0, 1), a2 + hstep, voffA);
            PG8_WAIT_L(8); PG8_BAR; PG8_WAIT_L(0); PG8_MMA(0, 0, At, B0); PG8_BAR; PG8_SCHED;
            PG8_LDB(B1, 1, 1); PG8_STAGE(PG8_SB(1, 0), b3, voffB);
            PG8_BAR; PG8_WAIT_L(0); PG8_MMA(0, 1, At, B1); PG8_BAR;
            PG8_LDA(At, 1, 1); PG8_STAGE(PG8_SA(1, 0), a3, voffA);
            PG8_BAR; PG8_WAIT_L(0); PG8_MMA(1, 0, At, B0); PG8_BAR; PG8_SCHED;
            PG8_STAGE(PG8_SB(1, 1), b3 + hstep, voffB);
            PG8_WAIT_V(6); PG8_BAR; PG8_MMA(1, 1, At, B1); PG8_BAR;
            }
        }
        if constexpr (ALIGN_EPI) { if (wr == 0) PG8_BAR; }
        if constexpr (!Epi::AFTER_DRAIN) { E(acc, cur, wr, wc, fr, fq); S.done(cur); }
        if (!has_next) break;
#pragma unroll
        for (int a = 0; a < 2; ++a)
#pragma unroll
            for (int b = 0; b < 2; ++b)
#pragma unroll
                for (int m = 0; m < 4; ++m)
#pragma unroll
                    for (int n = 0; n < 2; ++n) acc[a][b][m][n] = (f32x4){0.f, 0.f, 0.f, 0.f};
        cur = nxt; cA = nA; cB = nB; ++ui;
        if constexpr (GATHER) { vAc0[0] = vAn0[0]; vAc0[1] = vAn0[1]; vAc1[0] = vAn1[0]; vAc1[1] = vAn1[1]; }
        if constexpr (ALIGN_EPI) { if (wr == 1) PG8_BAR; }
    }
    PG8_WAIT_V(0);
    if constexpr (!ALIGN_EPI) { if (wr == 0) PG8_BAR; }
    PG8_BAR;
    if constexpr (Epi::AFTER_DRAIN) { E.fused(acc, cur, wr, wc, fr, fq, lds, wid, lane); S.done(cur); }
#undef PG8_SA
#undef PG8_SB
#undef PG8_STAGE
#undef PG8_LDA
#undef PG8_LDB
#undef PG8_MMA
#undef PG8_WAIT_V
#undef PG8_WAIT_L
#undef PG8_BAR
#undef PG8_SCHED
#undef PG8_GOFF
#undef PG8_STG_A
}
}
namespace pg8 {
#define EPI_ROWS(u, wr, fr) const int row00 = (u).pm * BM + (wr) * 64 + (fr)
#define EPI_GET8(v, ai, bj, m) float v[8] = {acc[ai][bj][m][0][0], acc[ai][bj][m][0][1], acc[ai][bj][m][0][2], acc[ai][bj][m][0][3], acc[ai][bj][m][1][0], acc[ai][bj][m][1][1], acc[ai][bj][m][1][2], acc[ai][bj][m][1][3]}

struct EpiPlain {
    static constexpr bool PERM = true, AFTER_DRAIN = false;
    bf16_t* O; int ldc;
    __device__ __forceinline__ void operator()(const f32x4 (&acc)[2][2][4][2], const Unit& u, int wr, int wc, int fr, int fq) const {
        asm volatile("" : "+v"(fr), "+v"(fq));
        EPI_ROWS(u, wr, fr); const int col0 = u.pn * BM + wc * 32 + 8 * fq;
#pragma unroll
        for (int ai = 0; ai < 2; ++ai)
#pragma unroll
            for (int m = 0; m < 4; ++m) { bf16_t* rowp = O + (size_t)(row00 + ai * HALF + m * 16) * ldc + col0;
#pragma unroll
                for (int bj = 0; bj < 2; ++bj) { EPI_GET8(v, ai, bj, m); *(u32x4*)(rowp + bj * HALF) = pack8(v); } }
    }
};

struct EpiInproj {
    static constexpr bool PERM = true, AFTER_DRAIN = false;
    unsigned char* ws; const float *qkn, *mqn, *mkvn; PG8_LAS float* xs;
    __device__ __forceinline__ void operator()(const f32x4 (&acc)[2][2][4][2], const Unit& u, int wr, int wc, int fr, int fq) const {
        asm volatile("" : "+v"(fr), "+v"(fq));
        EPI_ROWS(u, wr, fr); const int pn = u.pn; const bool lat = (u.pm * BM) < TL;
        if (pn >= 9) {
            const int col0 = (pn - 9) * BM + wc * 32 + 8 * fq;
#pragma unroll
            for (int ai = 0; ai < 2; ++ai)
#pragma unroll
                for (int m = 0; m < 4; ++m) { bf16_t* rowp = (bf16_t*)(ws + WS_BIG) + (size_t)(row00 + ai * HALF + m * 16) * 3072 + col0;
#pragma unroll
                    for (int bj = 0; bj < 2; ++bj) { EPI_GET8(v, ai, bj, m); *(u32x4*)(rowp + bj * HALF) = pack8(v); } }
        } else if (pn <= 2) {
            if (pn == 2 && wc >= 2) {
#pragma unroll
                for (int ai = 0; ai < 2; ++ai)
#pragma unroll
                    for (int m = 0; m < 4; ++m) { const int row = row00 + ai * HALF + m * 16; int b_, pos_; bpos_of(row, b_, pos_); bf16_t* vb = (bf16_t*)(ws + WS_VG); const int st = b_ * 2 + (wc - 2);
                        EPI_GET8(x1, ai, 0, m); EPI_GET8(x2, ai, 1, m); *(u32x4*)(vb + vtile_off(st, pos_, 8 * fq)) = pack8(x1); *(u32x4*)(vb + vtile_off(st, pos_, 32 + 8 * fq)) = pack8(x2); }
            } else {
                const bool isq = pn < 2; const float* gn = qkn + (isq ? 0 : 64) + 8 * fq;
                const f32x4 ga0 = *(const f32x4*)gn, ga1 = *(const f32x4*)(gn + 4), gb0 = *(const f32x4*)(gn + 32), gb1 = *(const f32x4*)(gn + 36);
                const float g1[8] = {ga0[0], ga0[1], ga0[2], ga0[3], ga1[0], ga1[1], ga1[2], ga1[3]}, g2[8] = {gb0[0], gb0[1], gb0[2], gb0[3], gb1[0], gb1[1], gb1[2], gb1[3]};
                const float sc = isq ? C2G : 1.f;
#pragma unroll
                for (int am = 0; am < 4; ++am) { const int ai = am >> 1, m0 = 2 * (am & 1);
                    f32x4 tc[2][2], ts[2][2];
#pragma unroll
                    for (int mm = 0; mm < 2; ++mm) { const int pos = lat ? ((row00 + ai * HALF + (m0 + mm) * 16) & (SEQ - 1)) : 0; const f32x4* cp = (const f32x4*)((const float*)(ws + WS_COSG) + (size_t)pos * 32 + 8 * fq); const f32x4* sp = (const f32x4*)((const float*)(ws + WS_SING) + (size_t)pos * 32 + 8 * fq);
                        tc[mm][0] = cp[0]; tc[mm][1] = cp[1]; ts[mm][0] = sp[0]; ts[mm][1] = sp[1]; }
#pragma unroll
                    for (int mm = 0; mm < 2; ++mm) { const int m = m0 + mm; const int row = row00 + ai * HALF + m * 16; const f32x4 c0 = tc[mm][0], c1 = tc[mm][1], s0 = ts[mm][0], s1 = ts[mm][1];
                        EPI_GET8(x1, ai, 0, m); EPI_GET8(x2, ai, 1, m); float ss = 0.f;
#pragma unroll
                        for (int i = 0; i < 8; ++i) ss += x1[i] * x1[i] + x2[i] * x2[i];
                        ss += __shfl_xor(ss, 16); ss += __shfl_xor(ss, 32);
                        const float rstd = __builtin_amdgcn_rsqf(ss * (1.f / 64.f) + RMS_EPS); float o1[8], o2[8];
#pragma unroll
                        for (int i = 0; i < 8; ++i) { const float y1 = x1[i] * rstd * g1[i], y2 = x2[i] * rstd * g2[i]; const float c = lat ? (i < 4 ? c0[i & 3] : c1[i & 3]) : 1.f, s = lat ? (i < 4 ? s0[i & 3] : s1[i & 3]) : 0.f;
                            o1[i] = (y1 * c - y2 * s) * sc; o2[i] = (y2 * c + y1 * s) * sc; }
                        if (isq) { bf16_t* p = (bf16_t*)(ws + WS_QG) + (size_t)row * 512 + (4 * pn + wc) * 64 + 8 * fq; *(u32x4*)p = pack8(o1); *(u32x4*)(p + 32) = pack8(o2); }
                        else { int b_, pos_; bpos_of(row, b_, pos_); bf16_t* kb = (bf16_t*)(ws + WS_KG); const int st = b_ * 2 + wc; *(u32x4*)(kb + ktile_off(st, pos_, fq, 8)) = pack8(o1); *(u32x4*)(kb + ktile_off(st, pos_, 4 + fq, 8)) = pack8(o2); } }
                    asm volatile("" ::: "memory"); }
            }
        } else if (pn == 3 || pn == 4 || pn == 7 || pn == 8) {
            const bool vg = pn >= 7; const bool part = (pn == 4) ? (wc < 2) : true;
            float ssr[2][4];
#pragma unroll
            for (int ai = 0; ai < 2; ++ai)
#pragma unroll
                for (int m = 0; m < 4; ++m) { float ss = 0.f;
#pragma unroll
                    for (int bj = 0; bj < 2; ++bj) { EPI_GET8(v, ai, bj, m);
#pragma unroll
                        for (int i = 0; i < 8; ++i) { const float t = vg ? gelu_tanh(v[i]) : v[i]; ss += t * t; } }
                    ss += __shfl_xor(ss, 16); ss += __shfl_xor(ss, 32); ssr[ai][m] = part ? ss : 0.f;
                    if (fq == 0) xs[(ai * HALF + wr * 64 + m * 16 + fr) * 4 + wc] = ssr[ai][m]; }
            asm volatile("s_waitcnt lgkmcnt(0)\n\ts_barrier" ::: "memory");
#pragma unroll
            for (int ai = 0; ai < 2; ++ai)
#pragma unroll
                for (int m = 0; m < 4; ++m) { const f32x4 t = *(const PG8_LAS f32x4*)(xs + (ai * HALF + wr * 64 + m * 16 + fr) * 4); ssr[ai][m] = (t[0] + t[1]) + (t[2] + t[3]); }
            asm volatile("s_waitcnt lgkmcnt(0)\n\ts_barrier" ::: "memory");
            if (pn == 3) {
                const int col0 = wc * 32 + 8 * fq;
#pragma unroll
                for (int ai = 0; ai < 2; ++ai)
#pragma unroll
                    for (int m = 0; m < 4; ++m) { const int row = row00 + ai * HALF + m * 16; const float rstd = __builtin_amdgcn_rsqf(ssr[ai][m] * (1.f / 256.f) + RMS_EPS);
#pragma unroll
                        for (int bj = 0; bj < 2; ++bj) { EPI_GET8(v, ai, bj, m); const int col = col0 + bj * HALF; const f32x4 ga = *(const f32x4*)(mqn + col), gb = *(const f32x4*)(mqn + col + 4);
#pragma unroll
                            for (int i = 0; i < 8; ++i) v[i] *= rstd * (i < 4 ? ga[i] : gb[i - 4]);
                            *(u32x4*)((bf16_t*)(ws + WS_CQN) + (size_t)row * 256 + col) = pack8(v); } }
            } else if (pn == 4) {
                if (wc < 2) {
#pragma unroll
                    for (int ai = 0; ai < 2; ++ai)
#pragma unroll
                        for (int m = 0; m < 4; ++m) { const int row = row00 + ai * HALF + m * 16; const float rstd = __builtin_amdgcn_rsqf(ssr[ai][m] * (1.f / 128.f) + RMS_EPS);
#pragma unroll
                            for (int bj = 0; bj < 2; ++bj) { EPI_GET8(v, ai, bj, m); const int col = wc * 64 + bj * 32 + 8 * fq; const f32x4 ga = *(const f32x4*)(mkvn + col), gb = *(const f32x4*)(mkvn + col + 4);
#pragma unroll
                                for (int i = 0; i < 8; ++i) v[i] *= rstd * (i < 4 ? ga[i] : gb[i - 4]);
                                *(u32x4*)((bf16_t*)(ws + WS_CKVN) + (size_t)row * 128 + col) = pack8(v); } }
                } else if (wc == 2 && fq < 2) {
#pragma unroll
                    for (int ai = 0; ai < 2; ++ai)
#pragma unroll
                        for (int m = 0; m < 4; ++m) { const int row = row00 + ai * HALF + m * 16; const int pos = row & (SEQ - 1);
                            EPI_GET8(x1, ai, 0, m); EPI_GET8(x2, ai, 1, m); float o1[8], o2[8];
                            if (lat) { const f32x4* cp = (const f32x4*)((const float*)(ws + WS_COSM) + (size_t)pos * 16 + 8 * fq); const f32x4* sp = (const f32x4*)((const float*)(ws + WS_SINM) + (size_t)pos * 16 + 8 * fq); const f32x4 c0 = cp[0], c1 = cp[1], s0 = sp[0], s1 = sp[1];
#pragma unroll
                                for (int i = 0; i < 8; ++i) { const float c = i < 4 ? c0[i] : c1[i - 4], s = i < 4 ? s0[i] : s1[i - 4]; o1[i] = x1[i] * c - x2[i] * s; o2[i] = x2[i] * c + x1[i] * s; } }
                            else {
#pragma unroll
                                for (int i = 0; i < 8; ++i) { o1[i] = x1[i]; o2[i] = x2[i]; } }
                            const u32x4 p1 = pack8(o1), p2 = pack8(o2); int b_, pos_; bpos_of(row, b_, pos_); bf16_t* kb = (bf16_t*)(ws + WS_KM);
#pragma unroll
                            for (int h = 0; h < 8; ++h) { *(u32x4*)(kb + ktile_off(b_ * 8 + h, pos_, 8 + fq, 12)) = p1; *(u32x4*)(kb + ktile_off(b_ * 8 + h, pos_, 10 + fq, 12)) = p2; } }
                }
            } else {
                const int half = pn - 7, col0 = half * BM + wc * 32 + 8 * fq;
#pragma unroll
                for (int ai = 0; ai < 2; ++ai)
#pragma unroll
                    for (int m = 0; m < 4; ++m) { const int row = row00 + ai * HALF + m * 16;
#pragma unroll
                        for (int bj = 0; bj < 2; ++bj) { EPI_GET8(v, ai, bj, m);
#pragma unroll
                            for (int i = 0; i < 8; ++i) v[i] = gelu_tanh(v[i]);
                            *(u32x4*)((bf16_t*)(ws + WS_VN) + (size_t)row * 512 + col0 + bj * HALF) = pack8(v); }
                        if (wc == 0 && fq == 0) ((float*)(ws + WS_SSV))[(size_t)row * 2 + half] = ssr[ai][m]; }
            }
        } else {
            const int col0 = (pn - 5) * BM + wc * 32 + 8 * fq;
#pragma unroll
            for (int ai = 0; ai < 2; ++ai)
#pragma unroll
                for (int m = 0; m < 4; ++m) { const int row = row00 + ai * HALF + m * 16;
#pragma unroll
                    for (int bj = 0; bj < 2; ++bj) { EPI_GET8(v, ai, bj, m);
#pragma unroll
                        for (int i = 0; i < 8; ++i) v[i] = gelu_tanh(v[i]);
                        *(u32x4*)((bf16_t*)(ws + WS_UACT) + (size_t)row * 512 + col0 + bj * HALF) = pack8(v); } }
        }
    }
};

struct EpiUq {
    static constexpr bool PERM = true, AFTER_DRAIN = false;
    bf16_t* Qm; const float* cosM; const float* sinM;
    __device__ __forceinline__ void operator()(const f32x4 (&acc)[2][2][4][2], const Unit& u, int wr, int wc, int fr, int fq) const {
        asm volatile("" : "+v"(fr), "+v"(fq));
        EPI_ROWS(u, wr, fr);
        if (u.pn < 2) {
#pragma unroll
            for (int ai = 0; ai < 2; ++ai)
#pragma unroll
                for (int m = 0; m < 4; ++m) { const int row = row00 + ai * HALF + m * 16;
#pragma unroll
                    for (int bj = 0; bj < 2; ++bj) { const int col = u.pn * BM + bj * HALF + wc * 32 + 8 * fq; const int head = col >> 6, d = col & 63;
                        EPI_GET8(v, ai, bj, m);
#pragma unroll
                        for (int i = 0; i < 8; ++i) v[i] *= C2M;
                        *(u32x4*)(Qm + (size_t)row * 768 + head * 96 + d) = pack8(v); } asm volatile("" ::: "memory"); }
        } else {
            const int cc = wc * 32 + 8 * fq, hh = cc >> 4, j0 = cc & 15;
            const bool lat = (u.pm * BM) < TL;
#pragma unroll
            for (int ai = 0; ai < 2; ++ai) {
                f32x4 tc[4][2], ts[4][2];
#pragma unroll
                for (int m = 0; m < 4; ++m) { const int pos = lat ? ((row00 + ai * HALF + m * 16) & (SEQ - 1)) : 0; const f32x4* cp = (const f32x4*)(cosM + (size_t)pos * 16 + j0); const f32x4* sp = (const f32x4*)(sinM + (size_t)pos * 16 + j0);
                    tc[m][0] = cp[0]; tc[m][1] = cp[1]; ts[m][0] = sp[0]; ts[m][1] = sp[1]; }
#pragma unroll
                for (int m = 0; m < 4; ++m) { const int row = row00 + ai * HALF + m * 16;
                    EPI_GET8(x1, ai, 0, m); EPI_GET8(x2, ai, 1, m);
                    float cs[8], sn[8];
#pragma unroll
                    for (int i = 0; i < 8; ++i) { cs[i] = lat ? tc[m][i >> 2][i & 3] : 1.f; sn[i] = lat ? ts[m][i >> 2][i & 3] : 0.f; }
                    float o1[8], o2[8];
#pragma unroll
                    for (int i = 0; i < 8; ++i) { o1[i] = (x1[i] * cs[i] - x2[i] * sn[i]) * C2M; o2[i] = (x2[i] * cs[i] + x1[i] * sn[i]) * C2M; }
                    bf16_t* qp = Qm + (size_t)row * 768 + hh * 96 + 64 + j0;
                    *(u32x4*)(qp) = pack8(o1); *(u32x4*)(qp + 16) = pack8(o2); }
                asm volatile("" ::: "memory"); }
        }
    }
};

struct EpiUkv {
    static constexpr bool PERM = true, AFTER_DRAIN = false;
    bf16_t* Km; bf16_t* Vm;
    __device__ __forceinline__ void operator()(const f32x4 (&acc)[2][2][4][2], const Unit& u, int wr, int wc, int fr, int fq) const {
        asm volatile("" : "+v"(fr), "+v"(fq));
        EPI_ROWS(u, wr, fr); const int within = wc * 32 + 8 * fq;
#pragma unroll
        for (int ai = 0; ai < 2; ++ai)
#pragma unroll
            for (int m = 0; m < 4; ++m) { const int row = row00 + ai * HALF + m * 16; int b_, pos_; bpos_of(row, b_, pos_);
#pragma unroll
                for (int bj = 0; bj < 2; ++bj) { const int head = u.pn * 2 + bj; EPI_GET8(v, ai, bj, m);
                    bf16_t* p = (within < 64) ? (Km + ktile_off(b_ * 8 + head, pos_, within >> 3, 12)) : (Vm + vtile_off(b_ * 8 + head, pos_, within - 64));
                    *(u32x4*)p = pack8(v); } asm volatile("" ::: "memory"); }
    }
};

template <int IDX> struct EpiBranch {
    static constexpr bool PERM = true, AFTER_DRAIN = false;
    const bf16_t* Z; bf16_t* MERGEB;
    __device__ __forceinline__ void operator()(const f32x4 (&acc)[2][2][4][2], const Unit& u, int wr, int wc, int fr, int fq) const {
        asm volatile("" : "+v"(fr), "+v"(fq));
        EPI_ROWS(u, wr, fr); const int col0 = u.pn * BM + wc * 32 + 8 * fq;
#pragma unroll
        for (int ai = 0; ai < 2; ++ai) {
            u32x4 gr[4][2], mr[4][2];
#pragma unroll
            for (int m = 0; m < 4; ++m) { const int row = row00 + ai * HALF + m * 16;
#pragma unroll
                for (int bj = 0; bj < 2; ++bj) { const int col = col0 + bj * HALF; gr[m][bj] = *(const u32x4*)(Z + (size_t)row * 3072 + IDX * 1024 + col);
                    if (IDX != 0) mr[m][bj] = *(const u32x4*)(MERGEB + (size_t)row * 1024 + col); } }
#pragma unroll
            for (int m = 0; m < 4; ++m) { const int row = row00 + ai * HALF + m * 16;
#pragma unroll
                for (int bj = 0; bj < 2; ++bj) { const int col = col0 + bj * HALF; EPI_GET8(v, ai, bj, m); float g[8], a[8], r[8]; unpack8(gr[m][bj], g);
                    if (IDX != 0) unpack8(mr[m][bj], a);
#pragma unroll
                    for (int i = 0; i < 8; ++i) r[i] = (IDX != 0 ? a[i] : 0.f) + sigmoidf_(g[i]) * v[i];
                    *(u32x4*)(MERGEB + (size_t)row * 1024 + col) = pack8(r); } }
            asm volatile("" ::: "memory"); }
    }
};

struct EpiMoe1 {
    static constexpr bool PERM = true, AFTER_DRAIN = false;
    bf16_t* H; const float* b1;
    __device__ __forceinline__ void operator()(const f32x4 (&acc)[2][2][4][2], const Unit& u, int wr, int wc, int fr, int fq) const {
        asm volatile("" : "+v"(fr), "+v"(fq));
        EPI_ROWS(u, wr, fr); const int e = u.pn >> 3, pnl = u.pn & 7, cc = pnl * 128 + wc * 32 + 8 * fq;
        const float* bp = b1 + (size_t)e * 2048 + cc;
        const f32x4 bg0 = *(const f32x4*)bp, bg1 = *(const f32x4*)(bp + 4), bl0 = *(const f32x4*)(bp + 1024), bl1 = *(const f32x4*)(bp + 1028);
        float lim = 7.0f; asm volatile("" : "+v"(lim));
#pragma unroll
        for (int ai = 0; ai < 2; ++ai)
#pragma unroll
            for (int m = 0; m < 4; ++m) { const int row = row00 + ai * HALF + m * 16;
                EPI_GET8(g, ai, 0, m); EPI_GET8(l, ai, 1, m); float r[8];
#pragma unroll
                for (int i = 0; i < 8; ++i) { float glu = g[i] + (i < 4 ? bg0[i] : bg1[i - 4]); float lin = l[i] + (i < 4 ? bl0[i] : bl1[i - 4]);
                    glu = fminf(glu, lim); lin = fminf(fmaxf(lin, -lim), lim);
                    r[i] = glu * sigmoidf_(1.702f * glu) * (lin + 1.0f); }
                *(u32x4*)(H + (size_t)row * 1024 + cc) = pack8(r); }
    }
};

struct EpiMoe2 {
    static constexpr bool PERM = true, AFTER_DRAIN = false;
    bf16_t* Yp; const float* b2; const float* lw; const PG8_LAS int* tab;
    __device__ __forceinline__ void operator()(const f32x4 (&acc)[2][2][4][2], const Unit& u, int wr, int wc, int fr, int fq) const {
        asm volatile("" : "+v"(fr), "+v"(fq));
        EPI_ROWS(u, wr, fr); const int e = u.pn >> 2, pnl = u.pn & 3, col0 = pnl * BM + wc * 32 + 8 * fq;
        f32x4 bv[2][2];
#pragma unroll
        for (int bj = 0; bj < 2; ++bj) { bv[bj][0] = *(const f32x4*)(b2 + (size_t)e * 1024 + col0 + bj * HALF); bv[bj][1] = *(const f32x4*)(b2 + (size_t)e * 1024 + col0 + bj * HALF + 4); }
        float wrow[2][4]; { const int ps_ = tab[600 + e], cn_ = tab[640 + e];
#pragma unroll
            for (int ai = 0; ai < 2; ++ai)
#pragma unroll
                for (int m = 0; m < 4; ++m) { const int slot = row00 + ai * HALF + m * 16 - ps_; wrow[ai][m] = lw[(size_t)e * TA + (slot < cn_ ? slot : 0)]; if (slot >= cn_) wrow[ai][m] = 0.f; } }
#pragma unroll
        for (int ai = 0; ai < 2; ++ai)
#pragma unroll
            for (int m = 0; m < 4; ++m) { const int row = row00 + ai * HALF + m * 16; const float w = wrow[ai][m];
#pragma unroll
                for (int bj = 0; bj < 2; ++bj) { EPI_GET8(v, ai, bj, m); float r[8];
#pragma unroll
                    for (int i = 0; i < 8; ++i) r[i] = (v[i] + (i < 4 ? bv[bj][0][i] : bv[bj][1][i - 4])) * w;
                    *(u32x4*)(Yp + (size_t)row * 1024 + col0 + bj * HALF) = pack8(r); } }
    }
};

template <int NPN> struct MoeOrder {
    int nunits, G, v; const PG8_LAS int* tab; const PG8_LAS int* rowtok;
    __device__ __forceinline__ int tok(int i, int r) const { return rowtok[i * 256 + r]; }
    __device__ __forceinline__ bool next(int i, Unit& u) const {
        const long L = (long)i * G + v; if (L >= nunits) return false;
        const int blk = (int)L / NPN, pnl = (int)L % NPN; const int e = __builtin_amdgcn_readfirstlane(tab[blk]);
        u.pm = blk; u.pn = e * NPN + pnl; return true;
    }
    __device__ __forceinline__ void a_ready(const Unit&) const {}
    __device__ __forceinline__ void done(const Unit&) const {}
};
}
namespace attn_body {
using bf16x8=__attribute__((ext_vector_type(8)))short;
using s16x4=__attribute__((ext_vector_type(4)))short;
using f32x16=__attribute__((ext_vector_type(16)))float;
using u32x4=__attribute__((ext_vector_type(4)))unsigned;
constexpr int NW=8,QBLK=32,QB=QBLK*NW,KVBLK=64;
__device__ __forceinline__ int crow(int r,int hi){return (r&3)+8*(r>>2)+4*hi;}
#define SBAR() __builtin_amdgcn_sched_barrier(0)
constexpr int NSLOT=3, SLOTB=8192;
__device__ __forceinline__ void glds16(const void*gsrc,unsigned lds_dst){unsigned keep;
  asm volatile("s_mov_b32 %0, m0\n\ts_mov_b32 m0, %2\n\ts_nop 0\n\tglobal_load_lds_dwordx4 %1, off\n\ts_mov_b32 m0, %0":"=&s"(keep):"v"(gsrc),"s"(lds_dst):"memory");}
__device__ __forceinline__ float max3f(float a,float b,float c){float r;asm("v_max3_f32 %0, %1, %2, %3":"=v"(r):"v"(a),"v"(b),"v"(c));return r;}
__device__ __forceinline__ float max2f(float a,float b){float r;asm("v_max_f32_e32 %0, %1, %2":"=v"(r):"v"(a),"v"(b));return r;}
__device__ __forceinline__ float fadd_s(float a,float b){float r;asm("v_add_f32_e32 %0, %1, %2":"=v"(r):"v"(a),"v"(b));return r;}
__device__ __forceinline__ float fsub_s(float a,float b){float r;asm("v_sub_f32_e32 %0, %1, %2":"=v"(r):"v"(a),"v"(b));return r;}
typedef float f32x2_t __attribute__((ext_vector_type(2))); typedef __bf16 bf16x2_t __attribute__((ext_vector_type(2)));
__device__ __forceinline__ unsigned cvtpk_s(float lo,float hi){f32x2_t v={lo,hi};bf16x2_t b=__builtin_convertvector(v,bf16x2_t);return __builtin_bit_cast(unsigned,b);}
#define WAIT_BAR(N) asm volatile("s_waitcnt vmcnt(" #N ") lgkmcnt(0)\n\ts_barrier":::"memory")
typedef __attribute__((address_space(3))) const char* lds_cptr;
typedef short v4i16_t __attribute__((ext_vector_type(4)));
__device__ __forceinline__ void kload2(bf16x8*kf,lds_cptr kp,int j){ kf[2*j]=*(const __attribute__((address_space(3))) bf16x8*)(kp+j*2048); kf[2*j+1]=*(const __attribute__((address_space(3))) bf16x8*)(kp+j*2048+512); }
__device__ __forceinline__ s16x4 vtr(lds_cptr p){ return __builtin_bit_cast(s16x4,__builtin_amdgcn_ds_read_tr16_b64_v4i16((__attribute__((address_space(3))) v4i16_t*)p)); }
__device__ __forceinline__ float rowmax(const f32x16&p0,const f32x16&p1){
  float a=max3f(p0[0],p0[1],p1[0]),b=max3f(p0[2],p0[3],p1[1]);a=max3f(a,p1[2],p1[3]);
  #pragma unroll
  for(int r=4;r<16;r+=4){a=max3f(a,p0[r],p0[r+1]);b=max3f(b,p0[r+2],p0[r+3]);a=max3f(a,p1[r],p1[r+1]);b=max3f(b,p1[r+2],p1[r+3]);}
  const float m=max2f(a,b);
  auto rr=__builtin_amdgcn_permlane32_swap(__float_as_uint(m),__float_as_uint(m),false,false);
  return max2f(__uint_as_float(rr[0]),__uint_as_float(rr[1]));
}
__device__ __forceinline__ void pv(f32x16*o,int vb,bf16x8 pa0,bf16x8 pa1,bf16x8 pa2,bf16x8 pa3){
  #pragma unroll
  for(int d0=0;d0<2;++d0){s16x4 lo[4],hi[4];
    #pragma unroll
    for(int ks=0;ks<4;++ks){
      asm volatile("ds_read_b64_tr_b16 %0,%1 offset:%c2":"=&v"(lo[ks]):"v"(vb),"i"(d0*4096+ks*1024):"memory");
      asm volatile("ds_read_b64_tr_b16 %0,%1 offset:%c2":"=&v"(hi[ks]):"v"(vb),"i"(d0*4096+ks*1024+512):"memory");}
    asm volatile("s_waitcnt lgkmcnt(0)":::"memory");SBAR();
    #define PK(k) (bf16x8){lo[k][0],lo[k][1],lo[k][2],lo[k][3],hi[k][0],hi[k][1],hi[k][2],hi[k][3]}
    o[d0]=__builtin_amdgcn_mfma_f32_32x32x16_bf16(pa0,PK(0),o[d0],0,0,0);
    o[d0]=__builtin_amdgcn_mfma_f32_32x32x16_bf16(pa1,PK(1),o[d0],0,0,0);
    o[d0]=__builtin_amdgcn_mfma_f32_32x32x16_bf16(pa2,PK(2),o[d0],0,0,0);
    o[d0]=__builtin_amdgcn_mfma_f32_32x32x16_bf16(pa3,PK(3),o[d0],0,0,0);
    #undef PK
  }
}
template<int NKS> struct AttnLds {
  static constexpr int SLOTK=NKS*2048;
  static constexpr int LDS_K=0, LDS_V=NSLOT*SLOTK, LDS_WS=LDS_V+NSLOT*SLOTB, LDS_OST=LDS_WS+NW*64*4, LDS_BYTES=LDS_OST+NW*4096;
};
template<int NKS,int QP,int KP,int VP,int OP,int THRL,bool LS,bool SK>
__device__ __forceinline__ void attn_unit(const bf16*Qu,const bf16*__restrict__ Ku,const bf16*__restrict__ Vu,bf16*Ou,const int NT,char*shm){
  using L=AttnLds<NKS>;
  constexpr int SLOTK=L::SLOTK, LDS_K=L::LDS_K, LDS_V=L::LDS_V, LDS_WS=L::LDS_WS, LDS_OST=L::LDS_OST;
  int tid_=threadIdx.x; asm volatile("":"+v"(tid_));
  const int tid=tid_,lane=tid&63,r32=lane&31,hi=lane>>5; const int wid=__builtin_amdgcn_readfirstlane(tid>>6);
  const bf16*Qw=Qu+(long)(wid*QBLK)*QP;
  const unsigned lds0=(unsigned)(uintptr_t)shm;
  float*wsf=(float*)(shm+LDS_WS)+wid*64;
  const bf16*ksrc=Ku+wid*512+lane*8;
  const bf16*ksrc2=Ku+(8+(wid&3))*512+lane*8;
  const bf16*vsrc=Vu+wid*512+lane*8;
  const unsigned kdst=lds0+LDS_K+wid*1024, kdst2=lds0+LDS_K+(8+(wid&3))*1024, vdst=lds0+LDS_V+wid*1024;
  #define DMA_K(t,slot) do{ glds16(ksrc+(long)(t)*(NKS*1024),(unsigned)__builtin_amdgcn_readfirstlane(kdst+(slot))); \
      if constexpr(NKS==6){ glds16(ksrc2+(long)(t)*(NKS*1024),(unsigned)__builtin_amdgcn_readfirstlane(kdst2+(slot))); } }while(0)
  #define DMA_V(t,slot) glds16(vsrc+(long)(t)*4096,(unsigned)__builtin_amdgcn_readfirstlane(vdst+(slot)))
  #define WAIT_C()  do{ if constexpr(NKS==6){WAIT_BAR(3);}else{WAIT_BAR(2);} }while(0)
  #define WAIT_P()  do{ if constexpr(NKS==6){WAIT_BAR(5);}else{WAIT_BAR(3);} }while(0)
  #define WAITA_K() do{ if constexpr(NKS==6){WAIT_BAR(2);}else{WAIT_BAR(1);} }while(0)
  #define BARONLY() asm volatile("s_barrier":::"memory")
  const int vb0=(int)(lds0+LDS_V)+((lane>>4)&1)*32+(lane&3)*8+(4*hi+((lane&15)>>2))*64;
  const char*Kbase=shm+LDS_K; bf16x8 kf[2*NKS];
  const lds_cptr shm3=(lds_cptr)shm; const lds_cptr kp0=shm3+LDS_K+hi*1024+r32*16; const lds_cptr vp0=shm3+LDS_V+((lane>>4)&1)*32+(lane&3)*8+(4*hi+((lane&15)>>2))*64;
  DMA_K(0,0);DMA_V(0,0);DMA_K(1,SLOTK);
  bf16x8 qr[NKS];
  #pragma unroll
  for(int d0=0;d0<NKS;++d0)qr[d0]=*reinterpret_cast<const bf16x8*>(&Qw[(long)r32*QP+d0*16+hi*8]);
  float mhat=0.f,l_reg=0.f;f32x16 o[2];o[0]=f32x16{};o[1]=f32x16{};f32x16 negm=f32x16{};asm volatile("":"+v"(negm));
  f32x16 o2=f32x16{}; const bf16x8 ONES=(bf16x8){(short)0x3F80,(short)0x3F80,(short)0x3F80,(short)0x3F80,(short)0x3F80,(short)0x3F80,(short)0x3F80,(short)0x3F80};
  bool resc=false;
  #define START(P0,P1) do{ const float rm=rowmax(P0,P1); resc=false; \
    { const float dl=rm; mhat=fadd_s(mhat,dl); \
      _Pragma("unroll") for(int r=0;r<16;++r){P0[r]=fsub_s(P0[r],dl);P1[r]=fsub_s(P1[r],dl);} \
      _Pragma("unroll") for(int r=0;r<16;++r)negm[r]=-mhat; asm volatile("":"+v"(negm)); } \
    _Pragma("unroll") for(int r=0;r<16;++r)P0[r]=__builtin_amdgcn_exp2f(P0[r]); }while(0)
  #define RESC() do{ if(resc){ asm volatile("s_waitcnt lgkmcnt(0)":::"memory"); \
      _Pragma("unroll") for(int d_=0;d_<2;++d_) _Pragma("unroll") for(int r=0;r<16;++r)o[d_][r]*=wsf[crow(r,hi)]; \
      if constexpr(LS){ _Pragma("unroll") for(int r=0;r<16;++r)o2[r]*=wsf[crow(r,hi)]; } } }while(0)
  f32x16 pA0,pA1,pB0,pB1;
  int kl_cur=0,kl_next=SLOTK;
  int sl_prev=0,sl_cur=0,sl_next=SLOTB;
  #define ROT() do{sl_prev=sl_cur;sl_cur=sl_next;sl_next=(sl_next==(NSLOT-1)*SLOTB)?0:sl_next+SLOTB; kl_cur=kl_next;kl_next=(kl_next==(NSLOT-1)*SLOTK)?0:kl_next+SLOTK;}while(0)
  DMA_K(2,2*SLOTK);
  WAIT_P();
  { const char*kb=Kbase+hi*1024+r32*16;
    #pragma unroll
    for(int d0=0;d0<NKS;++d0){
      const bf16x8 b0=*reinterpret_cast<const bf16x8*>(kb+d0*2048);
      const bf16x8 b1=*reinterpret_cast<const bf16x8*>(kb+d0*2048+512);
      if(d0==0){pA0=__builtin_amdgcn_mfma_f32_32x32x16_bf16(b0,qr[0],negm,0,0,0);pA1=__builtin_amdgcn_mfma_f32_32x32x16_bf16(b1,qr[0],negm,0,0,0);}
      else{pA0=__builtin_amdgcn_mfma_f32_32x32x16_bf16(b0,qr[d0],pA0,0,0,0);pA1=__builtin_amdgcn_mfma_f32_32x32x16_bf16(b1,qr[d0],pA1,0,0,0);}} }
  asm volatile("s_nop 15\n\ts_nop 7":"+v"(pA0),"+v"(pA1));
  START(pA0,pA1);
  _Pragma("unroll") for(int r=0;r<16;++r)pA1[r]=__builtin_amdgcn_exp2f(pA1[r]);
  WAIT_BAR(0);
  if constexpr(SK){ DMA_V(1,SLOTB);DMA_K(3,0); } else { DMA_K(3,0);DMA_V(1,SLOTB); }
  ROT();
  _Pragma("unroll") for(int j=0;j<NKS;++j)kload2(kf,kp0+kl_cur,j);
  WAIT_C();
  if constexpr(SK){ if(wid>=4){ BARONLY(); } }
  s16x4 vlo[8],vhi[8]; u32x4 pw0,pw1,pw2,pw3;
  #define PKW(P,B) cvtpk_s(P[B],P[B+1])
  #define PAF(k) __builtin_bit_cast(bf16x8,pw##k)
  #define VFR(i) (bf16x8){vlo[i][0],vlo[i][1],vlo[i][2],vlo[i][3],vhi[i][0],vhi[i][1],vhi[i][2],vhi[i][3]}
  #define PIN(x) asm volatile("":"+v"(x))
  #define MX3(a,b,c) __builtin_fmaxf(__builtin_fmaxf((a),(b)),(c))
  #define GAPA(MF,A0,A1,A2,A3,W0,W1,PW) do{ MF; if constexpr(!LS){ sacc+=A0; sacc+=A1; sacc+=A2; sacc+=A3; PIN(sacc); } W0; W1; PIN(PW); SBAR(); }while(0)
  #define LSM(k) do{ if constexpr(LS){ o2=MF32(PAF(k),ONES,o2); SBAR(); } }while(0)
  #define EX(v) __builtin_amdgcn_exp2f(v)
  #define GAPB(MF,X,B) do{ MF; X[B]=EX(X[B]); X[B+1]=EX(X[B+1]); X[B+2]=EX(X[B+2]); X[B+3]=EX(X[B+3]); PIN(X); SBAR(); }while(0)
  #define VRD(i) do{ vlo[i]=vtr(vp_+(((i)>>2)*4096+((i)&3)*1024)); vhi[i]=vtr(vp_+(((i)>>2)*4096+((i)&3)*1024+512)); }while(0)
  #define KRD(G,j) do{ if(G){ kload2(kf,kp0+kl_next,j); SBAR(); } }while(0)
  #define MF32(a,b,c) __builtin_amdgcn_mfma_f32_32x32x16_bf16(a,b,c,0,0,0)
  #define STEP(C0,C1,P0,P1,t,GK,GV,GL,CK,MW) do{ SBAR(); \
    const lds_cptr vp_=vp0+sl_prev; \
    VRD(0); SBAR(); float sacc=LS?0.f:(P0[0]+P0[1]); \
    GAPA(C0=MF32(kf[0],qr[0],negm), P0[2],P0[3],P0[4],P0[5],     pw0[0]=PKW(P0,0), pw0[1]=PKW(P0,2), pw0); \
    VRD(4); SBAR(); GAPA(C1=MF32(kf[1],qr[0],negm), P0[6],P0[7],P0[8],P0[9],     pw0[2]=PKW(P0,4), pw0[3]=PKW(P0,6), pw0); \
    VRD(1); SBAR(); GAPA(C0=MF32(kf[2],qr[1],C0),   P0[10],P0[11],P0[12],P0[13], pw1[0]=PKW(P0,8), pw1[1]=PKW(P0,10), pw1); \
    VRD(5); SBAR(); GAPA(C1=MF32(kf[3],qr[1],C1),   P0[14],P0[15],P1[0],P1[1],   pw1[2]=PKW(P0,12),pw1[3]=PKW(P0,14), pw1); \
    VRD(2); SBAR(); GAPA(C0=MF32(kf[4],qr[2],C0),   P1[2],P1[3],P1[4],P1[5],     pw2[0]=PKW(P1,0), pw2[1]=PKW(P1,2), pw2); \
    VRD(6); SBAR(); GAPA(C1=MF32(kf[5],qr[2],C1),   P1[6],P1[7],P1[8],P1[9],     pw2[2]=PKW(P1,4), pw2[3]=PKW(P1,6), pw2); \
    VRD(3); SBAR(); GAPA(C0=MF32(kf[6],qr[3],C0),   P1[10],P1[11],P1[12],P1[13], pw3[0]=PKW(P1,8), pw3[1]=PKW(P1,10), pw3); \
    VRD(7); SBAR(); GAPA(C1=MF32(kf[7],qr[3],C1),   P1[14],P1[15],0.f,0.f,       pw3[2]=PKW(P1,12),pw3[3]=PKW(P1,14), pw3); \
    if constexpr(NKS==6){ C0=MF32(kf[8],qr[4],C0); SBAR(); C1=MF32(kf[9],qr[4],C1); SBAR(); C0=MF32(kf[10],qr[5],C0); SBAR(); C1=MF32(kf[11],qr[5],C1); SBAR(); } \
    if constexpr(!LS){ l_reg+=sacc; } \
    if constexpr(SK){ MW; if(GV){DMA_V((t)+1,sl_next);} if(GK){DMA_K((t)+3,kl_cur);} } else { if(GK){DMA_K((t)+3,kl_cur);} if(GV){DMA_V((t)+1,sl_next);} } \
    if(CK){ float a=MX3(C0[0],C0[1],C1[0]),b=MX3(C0[2],C0[3],C1[1]); a=MX3(a,C1[2],C1[3]); \
      _Pragma("unroll") for(int r=4;r<16;r+=4){a=MX3(a,C0[r],C0[r+1]);b=MX3(b,C0[r+2],C0[r+3]);a=MX3(a,C1[r],C1[r+1]);b=MX3(b,C1[r+2],C1[r+3]);} \
      float rm=__builtin_fmaxf(a,b); { auto rr=__builtin_amdgcn_permlane32_swap(__float_as_uint(rm),__float_as_uint(rm),false,false); rm=__builtin_fmaxf(__uint_as_float(rr[0]),__uint_as_float(rr[1])); } \
      resc=false; \
      if(__builtin_expect(__any(rm>(float)THRL),0)){ const float dl=__builtin_fmaxf(rm,0.f); mhat+=dl; \
        _Pragma("unroll") for(int r=0;r<16;++r){C0[r]-=dl;C1[r]-=dl;} \
        _Pragma("unroll") for(int r=0;r<16;++r)negm[r]=-mhat; asm volatile("":"+v"(negm)); \
        const float f=__builtin_amdgcn_exp2f(-dl); l_reg*=f; if(hi==0)wsf[r32]=f; resc=true; } } else { resc=false; } \
    SBAR(); \
    GAPB(o[0]=MF32(PAF(0),VFR(0),o[0]), C0,0); \
    GAPB(o[1]=MF32(PAF(0),VFR(4),o[1]), C0,4); LSM(0); \
    KRD(GL,0); GAPB(o[0]=MF32(PAF(1),VFR(1),o[0]), C0,8); \
    KRD(GL,1); GAPB(o[1]=MF32(PAF(1),VFR(5),o[1]), C0,12); LSM(1); \
    KRD(GL,2); GAPB(o[0]=MF32(PAF(2),VFR(2),o[0]), C1,0); \
    KRD(GL,3); GAPB(o[1]=MF32(PAF(2),VFR(6),o[1]), C1,4); LSM(2); \
    if constexpr(NKS==6){ KRD(GL,4); } GAPB(o[0]=MF32(PAF(3),VFR(3),o[0]), C1,8); \
    if constexpr(NKS==6){ KRD(GL,5); } GAPB(o[1]=MF32(PAF(3),VFR(7),o[1]), C1,12); LSM(3); \
    }while(0)
  int t=1;
  for(;t+11<NT;t+=8){
    STEP(pB0,pB1,pA0,pA1,t,true,true,true,true,WAITA_K());      WAIT_C(); RESC(); ROT();
    STEP(pA0,pA1,pB0,pB1,t+1,true,true,true,false,WAITA_K());   WAIT_C(); ROT();
    STEP(pB0,pB1,pA0,pA1,t+2,true,true,true,false,WAITA_K());   WAIT_C(); ROT();
    STEP(pA0,pA1,pB0,pB1,t+3,true,true,true,false,WAITA_K());   WAIT_C(); ROT();
    STEP(pB0,pB1,pA0,pA1,t+4,true,true,true,false,WAITA_K());   WAIT_C(); ROT();
    STEP(pA0,pA1,pB0,pB1,t+5,true,true,true,false,WAITA_K());   WAIT_C(); ROT();
    STEP(pB0,pB1,pA0,pA1,t+6,true,true,true,false,WAITA_K());   WAIT_C(); ROT();
    STEP(pA0,pA1,pB0,pB1,t+7,true,true,true,false,WAITA_K());   WAIT_C(); ROT();
  }
  for(;t+5<NT;t+=2){
    STEP(pB0,pB1,pA0,pA1,t,true,true,true,true,WAITA_K());     WAIT_C(); RESC(); ROT();
    STEP(pA0,pA1,pB0,pB1,t+1,true,true,true,true,WAITA_K());   WAIT_C(); RESC(); ROT();
  }
  #define ENDW(tt) do{ if constexpr(SK){ if((tt)+3<NT){WAIT_C();} else if((tt)+1<NT){WAIT_BAR(1);} else {WAIT_BAR(0);} } \
                       else { if((tt)+3<NT){WAIT_C();} else if((tt)+2<NT){WAIT_BAR(1);} else {WAIT_BAR(0);} } }while(0)
  #define ENDA(tt) do{ if((tt)+2<NT){WAITA_K();} else {WAIT_BAR(0);} }while(0)
  for(;t+1<NT;t+=2){
    STEP(pB0,pB1,pA0,pA1,t,(t+3<NT),(t+1<NT),(t+1<NT),true,ENDA(t));         ENDW(t);   RESC(); ROT();
    STEP(pA0,pA1,pB0,pB1,t+1,(t+4<NT),(t+2<NT),(t+2<NT),true,ENDA(t+1));     ENDW(t+1); RESC(); ROT();
  }
  STEP(pB0,pB1,pA0,pA1,NT-1,false,false,false,true,WAIT_BAR(0)); if constexpr(SK){ WAIT_BAR(0); } RESC();
  { if constexpr(!LS){ float sacc=pB0[0]+pB0[1]; _Pragma("unroll") for(int r=2;r<16;++r)sacc+=pB0[r]; _Pragma("unroll") for(int r=0;r<16;++r)sacc+=pB1[r]; l_reg+=sacc; }
    pw0=(u32x4){PKW(pB0,0),PKW(pB0,2),PKW(pB0,4),PKW(pB0,6)};pw1=(u32x4){PKW(pB0,8),PKW(pB0,10),PKW(pB0,12),PKW(pB0,14)};pw2=(u32x4){PKW(pB1,0),PKW(pB1,2),PKW(pB1,4),PKW(pB1,6)};pw3=(u32x4){PKW(pB1,8),PKW(pB1,10),PKW(pB1,12),PKW(pB1,14)};
    SBAR(); pv(o,vb0+sl_cur,PAF(0),PAF(1),PAF(2),PAF(3)); LSM(0); LSM(1); LSM(2); LSM(3); }
  if constexpr(SK){ if(wid<4){ BARONLY(); } }
  #undef PKW
  #undef PAF
  #undef VFR
  #undef PIN
  #undef MX3
  #undef GAPA
  #undef GAPB
  #undef EX
  #undef VRD
  #undef KRD
  #undef LSM
  #undef MF32
  #undef STEP
  #undef ENDW
  #undef ENDA
  float rli[16];
  if constexpr(LS){
    #pragma unroll
    for(int r=0;r<16;++r)rli[r]=__builtin_amdgcn_rcpf(o2[r]);
  } else {
    {auto rr=__builtin_amdgcn_permlane32_swap(__float_as_uint(l_reg),__float_as_uint(l_reg),false,false);l_reg=__uint_as_float(rr[0])+__uint_as_float(rr[1]);}
    if(hi==0)wsf[32+r32]=l_reg;asm volatile("s_waitcnt lgkmcnt(0)":::"memory");
    #pragma unroll
    for(int r=0;r<16;++r)rli[r]=__builtin_amdgcn_rcpf(wsf[32+crow(r,hi)]);
  }
  bf16*Ow=Ou+(long)(wid*QBLK)*OP;
  { bf16*stg=(bf16*)(shm+LDS_OST)+wid*2048;
    #pragma unroll
    for(int r=0;r<16;++r){const int orow=crow(r,hi);
      #pragma unroll
      for(int d0=0;d0<2;++d0)stg[orow*64+d0*32+r32]=(bf16)(cvtpk_s(o[d0][r]*rli[r],0.f)&0xffffu);}
    asm volatile("s_waitcnt lgkmcnt(0)":::"memory");
    #pragma unroll
    for(int i=0;i<4;++i){const int row=i*8+(lane>>3),ch=lane&7; const u32x4 v=*(const u32x4*)(stg+row*64+ch*8); *(u32x4*)(Ow+(long)row*OP+ch*8)=v;} }
  asm volatile("s_waitcnt lgkmcnt(0)\n\ts_barrier":::"memory");
  #undef DMA_K
  #undef DMA_V
  #undef WAIT_C
  #undef WAIT_P
  #undef WAITA_K
  #undef BARONLY
  #undef START
  #undef RESC
  #undef ROT
}
#undef SBAR
#undef WAIT_BAR
}
#define XB_TMO      128
#define XB_XCNT(j)  (256  + 64 * (j))
#define XB_XSUB(j)  (1280 + 64 * (j))
#define XB_XGEN(j)  (2304 + 64 * (j))
#define XB_TOP      3328
#define XB_TOPGEN   3392
#define XCD_BAR_WORDS 3456
#define XB_SPIN_CAP (1u << 20)

__device__ __forceinline__ unsigned xb_ld(unsigned* p)              { return __hip_atomic_load(p, __ATOMIC_RELAXED, __HIP_MEMORY_SCOPE_AGENT); }
__device__ __forceinline__ unsigned xb_add(unsigned* p, unsigned v) { return __hip_atomic_fetch_add(p, v, __ATOMIC_RELAXED, __HIP_MEMORY_SCOPE_AGENT); }
__device__ __forceinline__ unsigned xb_xcc_id() { return (unsigned)__builtin_amdgcn_s_getreg((3 << 11) | 20) & 0xFu; }
#define XB_SPIN(cond, bar) do { unsigned _sp = 0; while (cond) { __builtin_amdgcn_s_sleep(1); \
    if ((++_sp & 255u) == 0u) { if (xb_ld(&(bar)[XB_TMO])) break; if (_sp > XB_SPIN_CAP) { atomicAdd(&(bar)[XB_TMO], 1u); break; } } } } while (0)

struct XcdBarrier {
    unsigned* bar; unsigned x;
    volatile LAS unsigned* st;
};
__device__ __forceinline__ XcdBarrier xcd_barrier_post(unsigned* bar, volatile LAS unsigned* st) {
    XcdBarrier b; b.bar = bar; b.x = xb_xcc_id(); b.st = st;
    if (threadIdx.x == 0) (void)xb_add(&bar[XB_XCNT(b.x)], 1u);
    return b;
}
__device__ __forceinline__ void xcd_barrier_complete(unsigned* bar, unsigned x, unsigned& nloc, unsigned& nx) {
    const unsigned G = gridDim.x * gridDim.y * gridDim.z;
    unsigned sum, cnt, mine, sp = 0u;
    for (;;) {
        sum = 0u; cnt = 0u; mine = 0u;
        unsigned cj[16];
#pragma unroll
        for (unsigned j = 0; j < 16; ++j) cj[j] = xb_ld(&bar[XB_XCNT(j)]);
#pragma unroll
        for (unsigned j = 0; j < 16; ++j) { const unsigned c = cj[j]; sum += c; cnt += (c > 0u) ? 1u : 0u; mine = (j == x) ? c : mine; }
        if (sum == G) break;
        __builtin_amdgcn_s_sleep(1);
        if ((++sp & 255u) == 0u) { if (xb_ld(&bar[XB_TMO])) break; if (sp > XB_SPIN_CAP) { atomicAdd(&bar[XB_TMO], 1u); break; } }
    }
    nloc = mine > 0u ? mine : 1u; nx = cnt > 0u ? cnt : 1u;
}
__device__ __forceinline__ void xcd_barrier(const XcdBarrier& b) {
    asm volatile("s_waitcnt vmcnt(0)" ::: "memory");
    __syncthreads();
    if (threadIdx.x == 0) {
        unsigned* bar = b.bar;
        __builtin_amdgcn_s_waitcnt(0);
        unsigned nloc = b.st[0], nx = b.st[1];
        if (nloc == 0u) { xcd_barrier_complete(bar, b.x, nloc, nx); b.st[0] = nloc; b.st[1] = nx; }
        const unsigned old = xb_add(&bar[XB_XSUB(b.x)], 1u);
        const unsigned gen = old / nloc;
        if (old + 1u == (gen + 1u) * nloc) {
            __builtin_amdgcn_fence(__ATOMIC_RELEASE, "agent");
            asm volatile("s_waitcnt vmcnt(0)" ::: "memory");
            const unsigned og = xb_add(&bar[XB_TOP], 1u);
            const unsigned tg = og / nx;
            if (og + 1u == (tg + 1u) * nx) xb_add(&bar[XB_TOPGEN], 1u);
            else XB_SPIN(xb_ld(&bar[XB_TOPGEN]) == tg, bar);
            __builtin_amdgcn_fence(__ATOMIC_ACQUIRE, "agent");
            xb_add(&bar[XB_XGEN(b.x)], 1u);
            asm volatile("s_waitcnt vmcnt(0)" ::: "memory");
        } else {
            XB_SPIN(xb_ld(&bar[XB_XGEN(b.x)]) == gen, bar);
            __builtin_amdgcn_fence(__ATOMIC_ACQUIRE, "agent");
            asm volatile("s_waitcnt vmcnt(0)" ::: "memory");
        }
    }
    __syncthreads();
}

struct Args { const float* in[24]; float* out; unsigned char* ws; };
enum { I_X = 0, I_C, I_CTX, I_CCTX, I_WMOD, I_BMOD, I_NORMS, I_WIN, I_QKN, I_MQN, I_MKVN, I_WUQ, I_WUKV, I_GVN, I_GWS, I_GBS, I_WBR, I_WOUT, I_RW, I_RB, I_EW1, I_EB1, I_EW2, I_EB2 };

struct Frame {
    LAS unsigned char* lds;
    volatile LAS unsigned* MISC;
    gu32* ctl;
    int tid, lane, wave, G, bx;
    unsigned char* ws;
    __device__ __forceinline__ const float* in(int i) const { const unsigned long long v = __hip_atomic_load((const unsigned long long*)(ws + WS_PTAB) + i, __ATOMIC_RELAXED, __HIP_MEMORY_SCOPE_AGENT);
        const unsigned lo = __builtin_amdgcn_readfirstlane((unsigned)v), hi = __builtin_amdgcn_readfirstlane((unsigned)(v >> 32));
        return (const float*)(const GAS float*)(((unsigned long long)hi << 32) | lo); }
    __device__ __forceinline__ float* out() const { return (float*)in(24); }
};

__device__ __forceinline__ int map_col(int kind, int n) {
    if (kind == 1) { const int pn = n >> 8, c = n & 255, bj = (c >> 7) & 1, wc = (c >> 5) & 3, j = c & 31;
        if (pn < 2) return (4 * pn + wc) * 64 + 32 * bj + j;
        if (pn == 2) return 512 + wc * 64 + 32 * bj + j;
        if (pn == 3) return 768 + c;
        if (pn == 4) { if (wc < 2) return 1024 + wc * 64 + 32 * bj + j; if (wc == 2 && j < 16) return 1152 + 16 * bj + j; return -1; }
        if (pn < 9) return 1184 + (pn - 5) * 256 + c;
        return 2208 + (pn - 9) * 256 + c; }
    if (kind == 2) { if (n < 512) return (n >> 6) * 96 + (n & 63); const int t = n - 512; return ((t & 127) >> 4) * 96 + 64 + 16 * (t >> 7) + (t & 15); }
    if (kind == 3) { return ((n >> 7) & 1) * 1024 + (n >> 8) * 128 + (n & 127); }
    return n;
}
__device__ __forceinline__ void transpose_item(const float* W, int K, int Nsrc, bf16* WT, int nblk, int kind, LAS float* scr, int item, int lane) {
    const int kb = item / nblk, nb = item % nblk, k0 = 64 * kb, n0 = 64 * nb;
    const int src = map_col(kind, n0 + 4 * (lane & 15));
    f32x4 v[16];
#pragma unroll
    for (int i = 0; i < 16; ++i) { const int kk = 4 * i + (lane >> 4); v[i] = (src >= 0) ? *(const f32x4*)(W + (size_t)(k0 + kk) * Nsrc + src) : (f32x4){0.f, 0.f, 0.f, 0.f}; }
#pragma unroll
    for (int i = 0; i < 16; ++i) { const int kk = 4 * i + (lane >> 4); LAS float* d = scr + kk * 65 + 4 * (lane & 15); d[0] = v[i][0]; d[1] = v[i][1]; d[2] = v[i][2]; d[3] = v[i][3]; }
    LDS_WAIT(); asm volatile("" ::: "memory");
    const int c = lane & 7;
#pragma unroll
    for (int j = 0; j < 8; ++j) { const int n = (lane >> 3) + 8 * j; const LAS float* s = scr + (8 * c) * 65 + n;
        v4u o; o.x = cvt_pk(s[0 * 65], s[1 * 65]); o.y = cvt_pk(s[2 * 65], s[3 * 65]); o.z = cvt_pk(s[4 * 65], s[5 * 65]); o.w = cvt_pk(s[6 * 65], s[7 * 65]);
        *(GAS v4u*)(WT + (size_t)(n0 + n) * K + k0 + 8 * c) = o; }
    LDS_WAIT(); asm volatile("" ::: "memory");
}
__device__ __forceinline__ void sincos_acc(float ang, float& c, float& s) {
    const double x = (double)ang; const double n = __builtin_rint(x * 0.6366197723675814);
    double r = __builtin_fma(-n, 1.5707963267948966, x); r = __builtin_fma(-n, 6.123233995736766e-17, r);
    const double r2 = r * r;
    double sp = -2.5052108385441720e-08; sp = sp * r2 + 2.7557319223985893e-06; sp = sp * r2 - 1.9841269841269841e-04; sp = sp * r2 + 8.3333333333333332e-03; sp = sp * r2 - 1.6666666666666666e-01; sp = sp * r2 * r + r;
    double cp = 2.0876756987868099e-09; cp = cp * r2 - 2.7557319223985888e-07; cp = cp * r2 + 2.4801587301587302e-05; cp = cp * r2 - 1.3888888888888889e-03; cp = cp * r2 + 4.1666666666666664e-02; cp = cp * r2 - 0.5; cp = cp * r2 + 1.0;
    const int q = ((int)n) & 3;
    const double sv = (q == 0) ? sp : (q == 1) ? cp : (q == 2) ? -sp : -cp;
    const double cv = (q == 0) ? cp : (q == 1) ? -sp : (q == 2) ? -cp : sp;
    c = (float)cv; s = (float)sv;
}

__device__ __forceinline__ void p_prologue(Frame& F, const Args& A) {
    const int gw = F.bx * 8 + F.wave, NGW = F.G * 8, lane = F.lane;
    if (F.bx == 0 && F.tid < 25) { ((unsigned long long*)(F.ws + WS_PTAB))[F.tid] = (F.tid < 24) ? (unsigned long long)(uintptr_t)A.in[F.tid] : (unsigned long long)(uintptr_t)A.out; }
    { LAS float* sv = (LAS float*)(F.lds + LDS_SVEC);
      for (int i = F.tid; i < 3 * 1024; i += 512) { const float v = (i < 2048) ? A.in[I_C][i] : A.in[I_CCTX][i - 2048]; sv[i] = v * sigmoidf_(v); }
      __syncthreads(); }
    { const LAS float* sv = (const LAS float*)(F.lds + LDS_SVEC); float* mod = (float*)(F.ws + WS_MOD); LAS float* red = (LAS float*)(F.lds + RING_OFF);
      for (int item = F.bx; item < DEPTH * 96; item += F.G) { const int l = item / 96, col0 = (item % 96) * 64, c4 = (lane & 15) * 4, kr = lane >> 4;
          const float* W = A.in[I_WMOD] + (size_t)l * 1024 * 6144 + col0 + c4; f32x4 a0 = {0.f, 0.f, 0.f, 0.f}, a1 = a0, a2 = a0;
#pragma unroll
          for (int j0 = 0; j0 < 32; j0 += 16) { f32x4 w[16];
#pragma unroll
              for (int j = 0; j < 16; ++j) { const int k = 128 * F.wave + 4 * (j0 + j) + kr; w[j] = *(const f32x4*)(W + (size_t)k * 6144); }
#pragma unroll
              for (int j = 0; j < 16; ++j) { const int k = 128 * F.wave + 4 * (j0 + j) + kr; const float s0 = sv[k], s1 = sv[1024 + k], s2 = sv[2048 + k];
#pragma unroll
                  for (int c = 0; c < 4; ++c) { a0[c] += s0 * w[j][c]; a1[c] += s1 * w[j][c]; a2[c] += s2 * w[j][c]; } } }
#pragma unroll
          for (int c = 0; c < 4; ++c) { a0[c] += __shfl_xor(a0[c], 16); a1[c] += __shfl_xor(a1[c], 16); a2[c] += __shfl_xor(a2[c], 16); a0[c] += __shfl_xor(a0[c], 32); a1[c] += __shfl_xor(a1[c], 32); a2[c] += __shfl_xor(a2[c], 32); }
          if (lane < 16) {
#pragma unroll
              for (int c = 0; c < 4; ++c) { red[(F.wave * 3 + 0) * 64 + c4 + c] = a0[c]; red[(F.wave * 3 + 1) * 64 + c4 + c] = a1[c]; red[(F.wave * 3 + 2) * 64 + c4 + c] = a2[c]; } }
          __syncthreads();
          if (F.tid < 192) { const int who = F.tid >> 6, c = F.tid & 63; float sm = 0.f;
#pragma unroll
              for (int w8 = 0; w8 < 8; ++w8) sm += red[(w8 * 3 + who) * 64 + c];
              mod[(size_t)l * 3 * 6144 + (size_t)who * 6144 + col0 + c] = sm + A.in[I_BMOD][l * 6144 + col0 + c]; }
          __syncthreads(); } }
    { float* cg = (float*)(F.ws + WS_COSG); float* sg = (float*)(F.ws + WS_SING); float* cm = (float*)(F.ws + WS_COSM); float* sm = (float*)(F.ws + WS_SINM);
      const int gt = F.bx * 512 + F.tid, NT_ = F.G * 512;
      for (int i = gt; i < SEQ * 48; i += NT_) { const int pos = i / 48, j = i % 48; const float rowf = (float)(pos >> 6), colf = (float)(pos & 63); float c, s;
          if (j < 32) { const float ang = (j < 16) ? rowf * INVF16[j] : colf * INVF16[j - 16]; sincos_acc(ang, c, s); cg[pos * 32 + j] = c; sg[pos * 32 + j] = s; }
          else { const int jj = j - 32; const float ang = (jj < 8) ? rowf * INVF16[2 * jj] : colf * INVF16[2 * (jj - 8)]; sincos_acc(ang, c, s); cm[pos * 16 + jj] = c; sm[pos * 16 + jj] = s; } } }
    { bf16* wsb = (bf16*)(F.ws + WS_WS); const float* src = A.in[I_GWS]; const int gt = F.bx * 512 + F.tid, NT_ = F.G * 512;
      for (int i = gt; i < DEPTH * 8 * 128 * 128 / 2; i += NT_) { ((unsigned*)wsb)[i] = cvt_pk(src[2 * i], src[2 * i + 1]); } }
    { bf16* rwt = (bf16*)(F.ws + WS_RWT); const float* src = A.in[I_RW]; const int gt = F.bx * 512 + F.tid, NT_ = F.G * 512;
      for (int i = gt; i < DEPTH * 32 * 1024; i += NT_) { const int l = i >> 15, e = (i >> 10) & 31, d = i & 1023; const float w = src[(size_t)l * 32768 + d * 32 + e];
          const unsigned h16 = cvt_pk(w, 0.f) & 0xffffu; const float back = __uint_as_float(h16 << 16);
          rwt[(size_t)l * 65536 + e * 1024 + d] = (bf16)h16; rwt[(size_t)l * 65536 + 32768 + e * 1024 + d] = (bf16)(cvt_pk(w - back, 0.f) & 0xffffu); } }
    { LAS float* scr = (LAS float*)(F.lds + RING_OFF + F.wave * 16640);
      constexpr int I_IN = 16 * 84, I_UQ = 4 * 12, I_UKV = 2 * 16, I_BR = 8 * 16, I_OUT = 16 * 16;
      constexpr int PER_LAYER = I_IN + I_UQ + I_UKV + 3 * I_BR + I_OUT;
      for (int it = gw; it < DEPTH * PER_LAYER; it += NGW) { const int l = it / PER_LAYER; int r = it % PER_LAYER;
          if (r < I_IN) { transpose_item(A.in[I_WIN] + (size_t)l * 1024 * 5280, 1024, 5280, (bf16*)(F.ws + WS_WIN) + (size_t)l * ZW * 1024, 84, 1, scr, r, lane); continue; } r -= I_IN;
          if (r < I_UQ) { transpose_item(A.in[I_WUQ] + (size_t)l * 256 * 768, 256, 768, (bf16*)(F.ws + WS_WUQ) + (size_t)l * 768 * 256, 12, 2, scr, r, lane); continue; } r -= I_UQ;
          if (r < I_UKV) { transpose_item(A.in[I_WUKV] + (size_t)l * 128 * 1024, 128, 1024, (bf16*)(F.ws + WS_WUKV) + (size_t)l * 1024 * 128, 16, 0, scr, r, lane); continue; } r -= I_UKV;
          if (r < 3 * I_BR) { const int i = r / I_BR; transpose_item(A.in[I_WBR] + (size_t)(l * 3 + i) * 512 * 1024, 512, 1024, (bf16*)(F.ws + WS_WBR) + (size_t)(l * 3 + i) * 1024 * 512, 16, 0, scr, r % I_BR, lane); continue; } r -= 3 * I_BR;
          { transpose_item(A.in[I_WOUT] + (size_t)l * 1024 * 1024, 1024, 1024, (bf16*)(F.ws + WS_WOUT) + (size_t)l * 1024 * 1024, 16, 0, scr, r, lane); } } }
}

constexpr int BG_W1 = 16 * 32, BG_W2 = 16 * 16, BG_PER_LAYER = 32 * (BG_W1 + BG_W2);
__device__ __forceinline__ void bg_item(Frame& F, int l, int r) {
    LAS float* scr = (LAS float*)(F.lds + RING_OFF + F.wave * 16640);
    if (r < 32 * BG_W1) { const int e = r / BG_W1; transpose_item(F.in(I_EW1) + (size_t)(l * 32 + e) * 1024 * 2048, 1024, 2048, (bf16*)(F.ws + WS_W1) + (size_t)(l * 32 + e) * 2048 * 1024, 32, 3, scr, r % BG_W1, F.lane); }
    else { r -= 32 * BG_W1; const int e = r / BG_W2; transpose_item(F.in(I_EW2) + (size_t)(l * 32 + e) * 1024 * 1024, 1024, 1024, (bf16*)(F.ws + WS_W2) + (size_t)(l * 32 + e) * 1024 * 1024, 16, 0, scr, r % BG_W2, F.lane); }
}
__device__ __forceinline__ void bg_site(Frame& F, int l, int lo, int hi, int nunits, int c) {
    const int r = nunits % F.G; int widx, nw;
    if (r == 0) { widx = c * 8 + F.wave; nw = F.G * 8; } else { if (c < r) return; widx = (c - r) * 8 + F.wave; nw = (F.G - r) * 8; }
#pragma unroll 1
    for (int it = lo + widx; it < hi; it += nw) bg_item(F, l, it);
}

__device__ __forceinline__ void mod_row_to_bf16(const float* xrow, const float* gain, const float* sc, const float* sh, bf16* orow, int lane) {
    const f32x4* xr = (const f32x4*)xrow + lane; f32x4 v[4], g[4], s[4], h[4]; float ss = 0.f;
#pragma unroll
    for (int j = 0; j < 4; ++j) { v[j] = xr[64 * j]; g[j] = ((const f32x4*)gain)[64 * j + lane]; s[j] = ((const f32x4*)sc)[64 * j + lane]; h[j] = ((const f32x4*)sh)[64 * j + lane]; }
#pragma unroll
    for (int j = 0; j < 4; ++j) ss += (v[j].x * v[j].x + v[j].y * v[j].y) + (v[j].z * v[j].z + v[j].w * v[j].w);
    const float rstd = __builtin_amdgcn_rsqf(wave_sum(ss) * (1.f / DM) + RMS_EPS);
    unsigned long long* o8 = (unsigned long long*)orow + lane;
#pragma unroll
    for (int j = 0; j < 4; ++j) { const float y0 = v[j].x * rstd * g[j].x * (1.f + s[j].x) + h[j].x, y1 = v[j].y * rstd * g[j].y * (1.f + s[j].y) + h[j].y, y2 = v[j].z * rstd * g[j].z * (1.f + s[j].z) + h[j].z, y3 = v[j].w * rstd * g[j].w * (1.f + s[j].w) + h[j].w;
        o8[64 * j] = (unsigned long long)cvt_pk(y0, y1) | ((unsigned long long)cvt_pk(y2, y3) << 32); }
}

typedef short bf16x8_t __attribute__((ext_vector_type(8)));
typedef float f32x16_t __attribute__((ext_vector_type(16)));
__device__ __forceinline__ void gmlp_unit(Frame& F, const float* gbs, const float* gvn, int l, int chunk, int nt) {
    const int lane = F.lane, g = F.wave, r32 = lane & 31, hi = lane >> 5;
    const bf16* vn = (const bf16*)(F.ws + WS_VN) + (size_t)chunk * 128 * 512 + g * 64; const float* ssv = (const float*)(F.ws + WS_SSV);
    const bf16* ua = (const bf16*)(F.ws + WS_UACT) + (size_t)chunk * 128 * 512 + g * 64;
    bf16* go = (bf16*)(F.ws + WS_GM) + (size_t)chunk * 128 * 512 + g * 64;
    const bf16* wsb = (const bf16*)(F.ws + WS_WS) + (size_t)(l * 8 + g) * 128 * 128;
    const float* bs = gbs + (size_t)(l * 8 + g) * 128;
    LAS bf16* vt = (LAS bf16*)(F.lds + RING_OFF + g * 19456); LAS bf16* ut = vt + 32 * 136; LAS float* bl = (LAS float*)(ut + 128 * 32);
    { const int dd = (lane & 3) * 8; const f32x4 ga = *(const f32x4*)(gvn + l * 512 + g * 64 + nt * 32 + dd), gb = *(const f32x4*)(gvn + l * 512 + g * 64 + nt * 32 + dd + 4);
      v4u raw[8], uraw[8]; float s0[8], s1[8];
#pragma unroll
      for (int ps = 0; ps < 8; ++ps) { const int q = ps * 16 + (lane >> 2); raw[ps] = *(const v4u*)(vn + (size_t)q * 512 + nt * 32 + dd); uraw[ps] = *(const v4u*)(ua + (size_t)q * 512 + nt * 32 + dd);
          const float* sp = ssv + ((size_t)chunk * 128 + q) * 2; s0[ps] = sp[0]; s1[ps] = sp[1]; }
      const float b0 = bs[lane], b1 = bs[64 + lane];
#pragma unroll
      for (int ps = 0; ps < 8; ++ps) { const int q = ps * 16 + (lane >> 2); float fv[8]; unpack8(raw[ps], fv);
          const float rstd = __builtin_amdgcn_rsqf((s0[ps] + s1[ps]) * (1.f / 512.f) + RMS_EPS);
#pragma unroll
          for (int i = 0; i < 8; ++i) vt[(dd + i) * 136 + q] = (bf16)(cvt_pk(fv[i] * rstd * (i < 4 ? ga[i] : gb[i - 4]), 0.f) & 0xffffu);
          *(LAS v4u*)(ut + q * 32 + dd) = uraw[ps]; }
      bl[lane] = b0; bl[64 + lane] = b1; }
    LDS_WAIT(); asm volatile("" ::: "memory");
#pragma unroll 1
    for (int mh = 0; mh < 2; ++mh) {
        f32x16_t acc[2]; acc[0] = (f32x16_t){}; acc[1] = (f32x16_t){};
        size_t zo = (size_t)mh * 64 * 128; asm volatile("" : "+v"(zo));
        const bf16* wsl = wsb + zo; bf16x8_t afr[8][2];
#pragma unroll
        for (int ks = 0; ks < 8; ++ks)
#pragma unroll
            for (int mt = 0; mt < 2; ++mt) afr[ks][mt] = *(const bf16x8_t*)(wsl + (size_t)(mt * 32 + r32) * 128 + ks * 16 + hi * 8);
#pragma unroll
        for (int ks = 0; ks < 8; ++ks) { const bf16x8_t bfr = *(const LAS bf16x8_t*)(vt + r32 * 136 + ks * 16 + hi * 8);
#pragma unroll
            for (int mt = 0; mt < 2; ++mt) acc[mt] = __builtin_amdgcn_mfma_f32_32x32x16_bf16(afr[ks][mt], bfr, acc[mt], 0, 0, 0); }
#pragma unroll
        for (int mt = 0; mt < 2; ++mt)
#pragma unroll
            for (int rg = 0; rg < 16; ++rg) { const int p = mh * 64 + mt * 32 + (rg & 3) + 8 * (rg >> 2) + 4 * hi;
                const float u = __uint_as_float((unsigned)ut[p * 32 + r32] << 16);
                go[(size_t)p * 512 + nt * 32 + r32] = (bf16)(cvt_pk(u * (acc[mt][rg] + bl[p]), 0.f) & 0xffffu); } }
    LDS_WAIT(); asm volatile("" ::: "memory");
}
constexpr int T3_REC_E = 0, T3_REC_W = 8192, T3_REC_S = 16384, T3_HIST = 24576, T3_BASE = T3_HIST + 128;
__device__ __forceinline__ void t3_phase(Frame& F, int l, int T_l, const float* xin_lat, const float* xin_ctx, int cofs, bool dry) {
    float* const outp = F.out();
    const int lane = F.lane, tid = F.tid;
    LAS int* rec_e = (LAS int*)(F.lds + RING_OFF + T3_REC_E); LAS float* rec_w = (LAS float*)(F.lds + RING_OFF + T3_REC_W); LAS int* rec_s = (LAS int*)(F.lds + RING_OFF + T3_REC_S);
    LAS int* hist = (LAS int*)(F.lds + RING_OFF + T3_HIST); LAS int* base = (LAS int*)(F.lds + RING_OFF + T3_BASE);
    if (tid < 32) hist[tid] = 0;
    const int per = (T_l + F.G - 1) / F.G; const int r0 = F.bx * per; int ntok = T_l - r0; ntok = ntok < 0 ? 0 : (ntok > per ? per : ntok);
    const float* norms = F.in(I_NORMS) + (size_t)l * 4 * 1024; const float* modl = (const float*)(F.ws + WS_MOD) + (size_t)l * 3 * 6144;
    const bf16* Y = (const bf16*)(F.ws + WS_Y); bf16* XN = (bf16*)(F.ws + (dry ? WS_H : WS_XN)); bf16* XNL = (bf16*)(F.ws + WS_MERGEB);
    for (int j = F.wave; j < ntok; j += 8) {
        const int r = r0 + j; const bool lat = r < TL; const int who = lat ? (r >> 14) : 2;
        const float* xrow = lat ? xin_lat + (size_t)r * 1024 : xin_ctx + (size_t)(r - TL) * 1024;
        float* orow = dry ? (float*)(F.ws + WS_MERGE) + (size_t)r * 1024 : (lat ? outp + (size_t)r * 1024 : (float*)(F.ws + WS_XC) + (size_t)(r - TL) * 1024);
        const float* mo = modl + (size_t)who * 6144;
        float yv[16], xv[16]; v4u yr[2]; f32x4 xr4[4], g1v[4], gn1[4], gn2[4], scv[4], shv[4];
        { const v4u* yp = (const v4u*)(Y + (size_t)r * 1024); yr[0] = yp[lane]; yr[1] = yp[64 + lane]; }
#pragma unroll
        for (int hq = 0; hq < 4; ++hq) { const int d0 = (hq >> 1) * 512 + 8 * lane + 4 * (hq & 1);
            xr4[hq] = *(const f32x4*)(xrow + d0); g1v[hq] = *(const f32x4*)(mo + 2 * 1024 + d0); gn1[hq] = *(const f32x4*)(norms + 1024 + d0);
            gn2[hq] = *(const f32x4*)(norms + 2048 + d0); scv[hq] = *(const f32x4*)(mo + 4 * 1024 + d0); shv[hq] = *(const f32x4*)(mo + 3 * 1024 + d0); }
        { float a[8], b[8]; unpack8(yr[0], a); unpack8(yr[1], b);
#pragma unroll
          for (int i = 0; i < 8; ++i) { yv[i] = a[i]; yv[8 + i] = b[i]; } }
#pragma unroll
        for (int hq = 0; hq < 4; ++hq)
#pragma unroll
            for (int i = 0; i < 4; ++i) xv[hq * 4 + i] = xr4[hq][i];
        float ss = 0.f;
#pragma unroll
        for (int i = 0; i < 16; ++i) ss += yv[i] * yv[i];
        const float rstd = __builtin_amdgcn_rsqf(wave_sum(ss) * (1.f / DM) + RMS_EPS);
        float ss2 = 0.f;
#pragma unroll
        for (int hq = 0; hq < 4; ++hq) { const int d0 = (hq >> 1) * 512 + 8 * lane + 4 * (hq & 1); f32x4 o;
#pragma unroll
            for (int i = 0; i < 4; ++i) { const int k = hq * 4 + i; const float xn = xv[k] + g1v[hq][i] * (yv[k] * rstd * gn1[hq][i]); xv[k] = xn; o[i] = xn; ss2 += xn * xn; }
            *(f32x4*)(orow + d0) = o; }
        const float rstd2 = __builtin_amdgcn_rsqf(wave_sum(ss2) * (1.f / DM) + RMS_EPS);
#pragma unroll
        for (int h = 0; h < 2; ++h) { float hi8[8], lo8[8];
#pragma unroll
            for (int q = 0; q < 2; ++q) { const int hq = h * 2 + q;
#pragma unroll
                for (int i = 0; i < 4; ++i) hi8[q * 4 + i] = xv[hq * 4 + i] * rstd2 * gn2[hq][i] * (1.f + scv[hq][i]) + shv[hq][i]; }
            const v4u ph = pack8(hi8); float back[8]; unpack8(ph, back);
#pragma unroll
            for (int i = 0; i < 8; ++i) lo8[i] = hi8[i] - back[i];
            *(v4u*)(XN + (size_t)r * 1024 + h * 512 + 8 * lane) = ph; *(v4u*)(XNL + (size_t)r * 1024 + h * 512 + 8 * lane) = pack8(lo8); }
    }
    asm volatile("s_waitcnt vmcnt(0)" ::: "memory");
    __syncthreads();
    { const int r32 = lane & 31, hi = lane >> 5, w = F.wave; const int ntiles = (ntok + 31) >> 5;
      if (w < ntiles) {
        const int tloc = 32 * w + r32; const int rr = r0 + (tloc < ntok ? tloc : ntok - 1);
        const bf16* whi = (const bf16*)(F.ws + WS_RWT) + (size_t)l * 2 * 32 * 1024 + (size_t)r32 * 1024 + hi * 8; const bf16* wlo = whi + 32 * 1024;
        const bf16* thi = XN + (size_t)rr * 1024 + hi * 8; const bf16* tlo = XNL + (size_t)rr * 1024 + hi * 8;
        f32x16_t acc = (f32x16_t){};
#pragma unroll 1
        for (int k0 = 0; k0 < 64; k0 += 8) {
            bf16x8_t ah[8], al[8], bh[8], bl[8];
#pragma unroll
            for (int u = 0; u < 8; ++u) { ah[u] = *(const bf16x8_t*)(whi + (k0 + u) * 16); al[u] = *(const bf16x8_t*)(wlo + (k0 + u) * 16); bh[u] = *(const bf16x8_t*)(thi + (k0 + u) * 16); bl[u] = *(const bf16x8_t*)(tlo + (k0 + u) * 16); }
#pragma unroll
            for (int u = 0; u < 8; ++u) { acc = __builtin_amdgcn_mfma_f32_32x32x16_bf16(ah[u], bh[u], acc, 0, 0, 0); acc = __builtin_amdgcn_mfma_f32_32x32x16_bf16(ah[u], bl[u], acc, 0, 0, 0); acc = __builtin_amdgcn_mfma_f32_32x32x16_bf16(al[u], bh[u], acc, 0, 0, 0); } }
        const float* rb = F.in(I_RB) + l * 32; float v[16]; float ninf = -INFINITY; asm volatile("" : "+v"(ninf));
#pragma unroll
        for (int i = 0; i < 16; ++i) v[i] = acc[i] + rb[(i & 3) + 8 * (i >> 2) + 4 * hi];
        float cm[8]; int cid[8];
#pragma unroll
        for (int k = 0; k < 4; ++k) { float m = v[0];
#pragma unroll
            for (int i = 1; i < 16; ++i) m = fmaxf(m, v[i]);
            int sel = 15;
#pragma unroll
            for (int i = 14; i >= 0; --i) sel = (v[i] == m) ? i : sel;
            sel = (v[15] == m && sel == 15) ? 15 : sel;
            cm[k] = m; cid[k] = (sel & 3) + 8 * (sel >> 2) + 4 * hi;
#pragma unroll
            for (int i = 0; i < 16; ++i) v[i] = (i == sel) ? ninf : v[i]; }
#pragma unroll
        for (int k = 0; k < 4; ++k) { cm[4 + k] = __shfl_xor(cm[k], 32); cid[4 + k] = __shfl_xor(cid[k], 32); }
        float tl[4]; int te[4];
#pragma unroll
        for (int k = 0; k < 4; ++k) { float best = cm[0]; int bid = cid[0]; int bc = 0;
#pragma unroll
            for (int c = 1; c < 8; ++c) { const bool better = (cm[c] > best) || (cm[c] == best && cid[c] < bid); best = better ? cm[c] : best; bid = better ? cid[c] : bid; bc = better ? c : bc; }
            tl[k] = best; te[k] = bid;
#pragma unroll
            for (int c = 0; c < 8; ++c) cm[c] = (c == bc) ? ninf : cm[c]; }
        const float e1 = __expf(tl[1] - tl[0]), e2 = __expf(tl[2] - tl[0]), e3 = __expf(tl[3] - tl[0]); const float inv = 1.f / (1.f + e1 + e2 + e3);
        if (hi == 0 && tloc < ntok) { const float wv[4] = {inv, e1 * inv, e2 * inv, e3 * inv};
#pragma unroll
            for (int k = 0; k < 4; ++k) { const int ls = __hip_atomic_fetch_add(&hist[te[k]], 1, __ATOMIC_RELAXED, __HIP_MEMORY_SCOPE_WORKGROUP);
                rec_e[tloc * 4 + k] = te[k]; rec_w[tloc * 4 + k] = wv[k]; rec_s[tloc * 4 + k] = ls; } }
      } }
    __syncthreads();
    if (tid < 32) { const int n = hist[tid]; base[tid] = n ? (int)__hip_atomic_fetch_add((unsigned*)(F.ctl + CW_CNT + cofs + l * 32 + tid), (unsigned)n, RLX_AGENT) : 0; }
    __syncthreads();
    { int* rte = (int*)(F.ws + WS_RTE); int* rts = (int*)(F.ws + WS_RTS); int* ltok = (int*)(F.ws + WS_LTOK); float* lw = (float*)(F.ws + WS_LW);
      for (int i = tid; i < ntok * 4; i += 512) { const int e = rec_e[i], slot = base[e] + rec_s[i]; const int r = r0 + (i >> 2);
          rte[(size_t)r * 4 + (i & 3)] = e; rts[(size_t)r * 4 + (i & 3)] = slot; ltok[(size_t)e * TA + slot] = r; lw[(size_t)e * TA + slot] = rec_w[i]; } }
}

__device__ __forceinline__ void moe_tables(Frame& F, int l, int cofs) {
    LAS int* tab = (LAS int*)(F.lds + LDS_TAB);
    if (F.tid == 0) { int nb = 0;
#pragma unroll 1
        for (int e = 0; e < 32; ++e) { const int c = (int)__hip_atomic_load((unsigned*)(F.ctl + CW_CNT + cofs + l * 32 + e), RLX_AGENT); const int n = (c + 255) >> 8; tab[600 + e] = nb * 256; tab[640 + e] = c;
            for (int b = 0; b < n; ++b) tab[nb + b] = e; nb += n; }
        tab[632] = nb; }
    __syncthreads();
}
__device__ __forceinline__ void t4_phase(Frame& F, int l, int T_l, bool dummy) {
    float* const outp = F.out();
    const bool nextmod = (l + 1 < DEPTH);
    const float* ngain = F.in(I_NORMS) + (size_t)(l + 1 < DEPTH ? l + 1 : l) * 4 * 1024; const float* nmod = (const float*)(F.ws + WS_MOD) + (size_t)(l + 1 < DEPTH ? l + 1 : l) * 3 * 6144; bf16* XN = (bf16*)(F.ws + WS_XN);
    const LAS int* tab = (const LAS int*)(F.lds + LDS_TAB); const int gw = F.bx * 8 + F.wave, NGW = F.G * 8, lane = F.lane;
    const int* rte = (const int*)(F.ws + WS_RTE); const int* rts = (const int*)(F.ws + WS_RTS); const bf16* Yp = (const bf16*)(F.ws + WS_BIG);
    const float* gain = F.in(I_NORMS) + (size_t)l * 4 * 1024 + 3 * 1024; const float* modl = (const float*)(F.ws + WS_MOD) + (size_t)l * 3 * 6144;
    for (int r = gw; r < T_l; r += NGW) { const bool lat = r < TL; const int who = lat ? (r >> 14) : 2; const float* g2 = modl + (size_t)who * 6144 + 5 * 1024;
        float* xrow = lat ? outp + (size_t)r * 1024 : (float*)(F.ws + WS_XC) + (size_t)(r - TL) * 1024;
        float f[16]; int re[4], rs[4];
#pragma unroll
        for (int k = 0; k < 4; ++k) { re[k] = rte[(size_t)r * 4 + k]; rs[k] = rts[(size_t)r * 4 + k]; }
        v4u yr[4][2]; f32x4 xr4[4], gv4[4], mv4[4];
#pragma unroll
        for (int k = 0; k < 4; ++k) { const size_t dst = (size_t)(tab[600 + re[k]] + rs[k]); const v4u* yp = (const v4u*)(Yp + dst * 1024); yr[k][0] = yp[lane]; yr[k][1] = yp[64 + lane]; }
#pragma unroll
        for (int hq = 0; hq < 4; ++hq) { const int d0 = (hq >> 1) * 512 + 8 * lane + 4 * (hq & 1); xr4[hq] = *(const f32x4*)(xrow + d0); gv4[hq] = *(const f32x4*)(gain + d0); mv4[hq] = *(const f32x4*)(g2 + d0); }
        f32x4 ng4[4], ns4[4], nh4[4]; const float* mo = nmod + (size_t)who * 6144;
        if (nextmod) {
#pragma unroll
            for (int hq = 0; hq < 4; ++hq) { const int d0 = (hq >> 1) * 512 + 8 * lane + 4 * (hq & 1); ng4[hq] = *(const f32x4*)(ngain + d0); ns4[hq] = *(const f32x4*)(mo + 1024 + d0); nh4[hq] = *(const f32x4*)(mo + d0); } }
#pragma unroll
        for (int i = 0; i < 16; ++i) f[i] = 0.f;
#pragma unroll
        for (int k = 0; k < 4; ++k) { float a[8], b[8]; unpack8(yr[k][0], a); unpack8(yr[k][1], b);
#pragma unroll
            for (int i = 0; i < 8; ++i) { f[i] += a[i]; f[8 + i] += b[i]; } }
        float ss = 0.f;
#pragma unroll
        for (int i = 0; i < 16; ++i) ss += f[i] * f[i];
        const float rstd = __builtin_amdgcn_rsqf(wave_sum(ss) * (1.f / DM) + RMS_EPS);
        float ssn = 0.f;
#pragma unroll
        for (int hq = 0; hq < 4; ++hq) { const int d0 = (hq >> 1) * 512 + 8 * lane + 4 * (hq & 1); f32x4 xv = xr4[hq];
#pragma unroll
            for (int i = 0; i < 4; ++i) { xv[i] += mv4[hq][i] * (f[hq * 4 + i] * rstd * gv4[hq][i]); f[hq * 4 + i] = xv[i]; ssn += xv[i] * xv[i]; }
            *(f32x4*)((dummy ? (float*)(F.ws + WS_MERGE) + (size_t)r * 1024 : xrow) + d0) = xv; }
        if (nextmod) { const float rstdn = __builtin_amdgcn_rsqf(wave_sum(ssn) * (1.f / DM) + RMS_EPS);
#pragma unroll
            for (int h = 0; h < 2; ++h) { float y[8];
#pragma unroll
                for (int q = 0; q < 2; ++q) { const int hq = h * 2 + q;
#pragma unroll
                    for (int i = 0; i < 4; ++i) y[q * 4 + i] = f[hq * 4 + i] * rstdn * ng4[hq][i] * (1.f + ns4[hq][i]) + nh4[hq][i]; }
                *(v4u*)(XN + (size_t)r * 1024 + h * 512 + 8 * lane) = pack8(y); } } }
}

#ifndef PH_MASK
#define PH_MASK 0xFFFFFFFFu
#endif
#define PH(k) ((PH_MASK >> (k)) & 1u)
#ifndef PH_TWICE
#define PH_TWICE 0u
#endif
#ifndef BG_A
#define BG_A 5504
#endif
#ifndef BG_B
#define BG_B 19392
#endif
#ifndef BG_C
#define BG_C 23360
#endif
#ifndef BG_D
#define BG_D 4096
#endif
#ifndef BG_E
#define BG_E 8192
#endif
#ifndef BG_F
#define BG_F 13696
#endif
#define REP(k) _Pragma("unroll") for (int rep_ = 0; rep_ < (((PH_TWICE >> (k)) & 1u) ? 2 : 1); ++rep_)
__global__ void __launch_bounds__(512, 2) fwd_kernel(Args A) {
    extern __shared__ __attribute__((aligned(16))) unsigned char lds[];
    Frame F;
    F.lds = (LAS unsigned char*)lds; F.MISC = (volatile LAS unsigned*)(F.lds + MISC_OFF);
    F.tid = threadIdx.x; F.lane = F.tid & 63; F.wave = __builtin_amdgcn_readfirstlane(F.tid >> 6);
    F.G = gridDim.x; F.bx = blockIdx.x; F.ws = (unsigned char*)(GAS unsigned char*)(unsigned long long)(uintptr_t)A.ws; F.ctl = (gu32*)(A.ws + WS_CTL);
    int vcu = (F.G % 8 == 0) ? (F.bx % 8) * (F.G / 8) + F.bx / 8 : F.bx;
    if (F.tid < 64) F.MISC[F.tid] = 0u;
    __syncthreads();
    XcdBarrier bar = xcd_barrier_post((unsigned*)(F.ctl + CW_BAR), F.MISC + 8);
#define GRID_BAR() do { { unsigned* bp_ = (unsigned*)(F.ctl + CW_BAR); unsigned x_ = bar.x; asm volatile("" : "+s"(bp_), "+s"(x_)); bar.bar = bp_; bar.x = x_; } xcd_barrier(bar); \
        { int t_ = threadIdx.x; asm volatile("" : "+v"(t_)); F.tid = t_; F.lane = t_ & 63; unsigned long long w_ = (unsigned long long)(uintptr_t)A.ws; int g_ = gridDim.x, b_ = blockIdx.x; asm volatile("" : "+s"(w_), "+s"(g_), "+s"(b_)); \
          F.ws = (unsigned char*)(GAS unsigned char*)w_; ws = F.ws; F.ctl = (gu32*)(w_ + WS_CTL * 1ull); F.G = g_; F.bx = b_; vcu = (g_ % 8 == 0) ? (b_ % 8) * (g_ / 8) + b_ / 8 : b_; gw = b_ * 8 + F.wave; NGW = g_ * 8; } } while (0)
    int gw = F.bx * 8 + F.wave, NGW = F.G * 8;
    unsigned char* ws = F.ws;

    if (PH(0)) REP(0) p_prologue(F, A);
    GRID_BAR();

#pragma unroll
    for (int l = 0; l < DEPTH; ++l) {
        const int T_l = (l == 0) ? TA : TL;

        if (PH(1) && l == 0) REP(1) { const float* xin_lat = (l == 0) ? F.in(I_X) : F.out(); const float* xin_ctx = (l == 0) ? F.in(I_CTX) : (const float*)(ws + WS_XC);
          const float* norms = F.in(I_NORMS) + (size_t)l * 4 * 1024; const float* modl = (const float*)(ws + WS_MOD) + (size_t)l * 3 * 6144;
          for (int r = gw; r < TA; r += NGW) { const bool lat = r < TL; const int who = lat ? (r >> 14) : 2; const float* mo = modl + (size_t)who * 6144;
            mod_row_to_bf16(lat ? xin_lat + (size_t)r * 1024 : xin_ctx + (size_t)(r - TL) * 1024, norms, mo + 1024, mo, (bf16*)(ws + WS_XN) + (size_t)r * 1024, F.lane); } }
        if (l == 0) GRID_BAR();

        if (PH(2)) REP(2) { pg8::Gemm g{(const bf16*)(ws + WS_XN), (const bf16*)(ws + WS_WIN) + (size_t)l * ZW * 1024, TA, ZW, 1024}; pg8::StaticOrder S; S.init(TA, ZW, F.G, F.bx);
          pg8::EpiInproj E{ws, F.in(I_QKN) + (size_t)l * 128, F.in(I_MQN) + (size_t)l * 256, F.in(I_MKVN) + (size_t)l * 128, (LAS float*)(F.lds + LDS_X)};
          pg8::gemm_phase<pg8::EpiInproj, pg8::StaticOrder, true, true>(F.lds + RING_OFF, g, S, E); }
        __syncthreads(); bg_site(F, l, (l == 0) ? 0 : BG_E, (l == 0) ? BG_A : BG_F, (TA / 256) * (ZW / 256), F.bx);
        GRID_BAR();

        if (PH(4)) REP(4) { pg8::Gemm g{(const bf16*)(ws + WS_CQN), (const bf16*)(ws + WS_WUQ) + (size_t)l * 768 * 256, T_l, 768, 256}; pg8::StaticOrder S; S.init(T_l, 768, F.G, F.bx);
          pg8::EpiUq E{(bf16*)(ws + WS_QM), (const float*)(ws + WS_COSM), (const float*)(ws + WS_SINM)};
          pg8::gemm_phase<pg8::EpiUq, pg8::StaticOrder, true, true>(F.lds + RING_OFF, g, S, E); }
        if (PH(5)) REP(5) { pg8::Gemm g{(const bf16*)(ws + WS_CKVN), (const bf16*)(ws + WS_WUKV) + (size_t)l * 1024 * 128, TA, 1024, 128}; pg8::StaticOrder S; S.init(TA, 1024, F.G, (F.bx + F.G / 2) % F.G);
          pg8::EpiUkv E{(bf16*)(ws + WS_KM), (bf16*)(ws + WS_VM)};
          pg8::gemm_phase<pg8::EpiUkv, pg8::StaticOrder, true, true>(F.lds + RING_OFF, g, S, E); }
        if (PH(6)) REP(6) { const float* gbs = F.in(I_GBS); const float* gvn = F.in(I_GVN); for (int hu = (F.bx + F.G / 4) % F.G; hu < 2 * (T_l / 128); hu += F.G) gmlp_unit(F, gbs, gvn, l, hu >> 1, hu & 1); }
        GRID_BAR();

#define BG_ATTN(CEXPR) do { __syncthreads(); Frame F2 = F; { int t2_ = threadIdx.x; asm volatile("" : "+v"(t2_)); unsigned long long w2_ = (unsigned long long)(uintptr_t)A.ws; int g2_ = gridDim.x, b2_ = blockIdx.x; asm volatile("" : "+s"(w2_), "+s"(g2_), "+s"(b2_)); \
            F2.tid = t2_; F2.lane = t2_ & 63; F2.wave = __builtin_amdgcn_readfirstlane(t2_ >> 6); F2.ws = (unsigned char*)(GAS unsigned char*)w2_; F2.G = g2_; F2.bx = b2_; \
            int lo2_ = (l == 0) ? BG_C : BG_F, hi2_ = BG_PER_LAYER; asm volatile("" : "+s"(lo2_), "+s"(hi2_)); bg_site(F2, l, lo2_, hi2_, 0, (CEXPR)); } __syncthreads(); } while (0)
        { const int per = (1024 + F.G - 1) / F.G; char* shm = (char*)lds + RING_OFF;
          if (PH(7)) REP(7) for (int i = 0; i <= per; ++i) { size_t row0; int b, h, nt, t0;
              if (i < per) { if (F.G == 256 && i == (F.bx & 3) && !(F.bx & 4)) { BG_ATTN(b2_ / 8 * 4 + (b2_ & 3)); }
                const int L = vcu * per + i; if (L >= 1024) continue; const int bh = L >> 6, qb = L & 63; b = bh >> 3; h = bh & 7; row0 = (size_t)b * SEQ + (size_t)qb * 256; t0 = 0; nt = NTILE; }
              else { if (l != 0 || F.bx >= 16) continue; const int bh = F.bx; b = bh >> 3; h = bh & 7; row0 = (size_t)TL + (size_t)b * CTX; t0 = SEQ / 64; nt = CTX / 64; }
              attn_body::attn_unit<4, 512, 128, 128, 512, 8, false, false>((const bf16*)(ws + WS_QG) + row0 * 512 + h * 64, (const bf16*)(ws + WS_KG) + ((size_t)(b * 2 + (h >> 2)) * NTILE + t0) * 4096, (const bf16*)(ws + WS_VG) + ((size_t)(b * 2 + (h >> 2)) * NTILE + t0) * 4096,
                                                             (bf16*)(ws + WS_OG) + row0 * 512 + h * 64, nt, shm); }
          if (PH(8)) REP(8) for (int i = 0; i <= per; ++i) { size_t row0; int b, h, nt, t0;
              if (i < per) { if (F.G == 256 && i == (F.bx & 3) && (F.bx & 4)) { BG_ATTN(g2_ / 2 + b2_ / 8 * 4 + (b2_ & 3)); }
                const int L = vcu * per + i; if (L >= 1024) continue; const int bh = L >> 6, qb = L & 63; b = bh >> 3; h = bh & 7; row0 = (size_t)b * SEQ + (size_t)qb * 256; t0 = 0; nt = NTILE; }
              else { if (l != 0 || F.bx < 16 || F.bx >= 32) continue; const int bh = F.bx - 16; b = bh >> 3; h = bh & 7; row0 = (size_t)TL + (size_t)b * CTX; t0 = SEQ / 64; nt = CTX / 64; }
              attn_body::attn_unit<6, 768, 768, 512, 512, 8, false, false>((const bf16*)(ws + WS_QM) + row0 * 768 + h * 96, (const bf16*)(ws + WS_KM) + ((size_t)(b * 8 + h) * NTILE + t0) * 6144, (const bf16*)(ws + WS_VM) + ((size_t)(b * 8 + h) * NTILE + t0) * 4096,
                                                             (bf16*)(ws + WS_OM) + row0 * 512 + h * 64, nt, shm); } }
        GRID_BAR();

        if (PH(10)) REP(10) { pg8::StaticOrder S; S.init(T_l, 1024, F.G, F.bx); const bf16* wbr = (const bf16*)(ws + WS_WBR) + (size_t)l * 3 * 1024 * 512;
          { pg8::Gemm g{(const bf16*)(ws + WS_OG), wbr, T_l, 1024, 512}; pg8::EpiBranch<0> E{(const bf16*)(ws + WS_BIG), (bf16*)(ws + WS_MERGEB)};
            pg8::gemm_phase<pg8::EpiBranch<0>, pg8::StaticOrder, true, true>(F.lds + RING_OFF, g, S, E); }
          { pg8::Gemm g{(const bf16*)(ws + WS_OM), wbr + (size_t)1024 * 512, T_l, 1024, 512}; pg8::EpiBranch<1> E{(const bf16*)(ws + WS_BIG), (bf16*)(ws + WS_MERGEB)};
            pg8::gemm_phase<pg8::EpiBranch<1>, pg8::StaticOrder, true, true>(F.lds + RING_OFF, g, S, E); }
          { pg8::Gemm g{(const bf16*)(ws + WS_GM), wbr + (size_t)2 * 1024 * 512, T_l, 1024, 512}; pg8::EpiBranch<2> E{(const bf16*)(ws + WS_BIG), (bf16*)(ws + WS_MERGEB)};
            pg8::gemm_phase<pg8::EpiBranch<2>, pg8::StaticOrder, true, true>(F.lds + RING_OFF, g, S, E); } }
        if (l == 0) { __syncthreads(); bg_site(F, 0, BG_A, BG_B, (T_l / 256) * 4, F.bx); }
        GRID_BAR();

        if (PH(11)) REP(11) { pg8::Gemm g{(const bf16*)(ws + WS_MERGEB), (const bf16*)(ws + WS_WOUT) + (size_t)l * 1024 * 1024, T_l, 1024, 1024}; pg8::StaticOrder S; S.init(T_l, 1024, F.G, F.bx);
          pg8::EpiPlain E{(bf16*)(ws + WS_Y), 1024};
          pg8::gemm_phase<pg8::EpiPlain, pg8::StaticOrder, true, true>(F.lds + RING_OFF, g, S, E); }
        if (l == 0) { __syncthreads(); bg_site(F, 0, BG_B, BG_C, (T_l / 256) * 4, F.bx); }
        GRID_BAR();

        if (F.G != 256) { bg_site(F, l, (l == 0) ? BG_C : BG_F, BG_PER_LAYER, 0, F.bx); __syncthreads(); }
        if (PH(12)) REP(12) { const float* xin_lat = (l == 0) ? F.in(I_X) : F.out(); const float* xin_ctx = (l == 0) ? F.in(I_CTX) : (const float*)(ws + WS_XC); t3_phase(F, l, T_l, xin_lat, xin_ctx, (((PH_TWICE >> 12) & 1u) && rep_ == 0) ? 64 : 0, ((PH_TWICE >> 12) & 1u) && rep_ == 0); }
        GRID_BAR();

        moe_tables(F, l, 0);

        if (PH(14)) REP(14) { const LAS int* tab = (const LAS int*)(F.lds + LDS_TAB); const int nblk = __builtin_amdgcn_readfirstlane(tab[632]);
          LAS int* rowtok = (LAS int*)(F.lds + LDS_ROWTOK);
          { const int* ltok = (const int*)(ws + WS_LTOK); const int nun = nblk * 8;
            int tk[10];
#pragma unroll
            for (int jj = 0; jj < 10; ++jj) { const int idx = F.tid + 512 * jj; const int i = idx >> 8, r = idx & 255; const long L = (long)i * F.G + vcu; tk[jj] = -1;
                if (L < nun) { const int blk = (int)(L >> 3), e = tab[blk], slot = blk * 256 + r - tab[600 + e]; if (slot < tab[640 + e]) tk[jj] = ltok[(size_t)e * TA + slot]; } }
#pragma unroll
            for (int jj = 0; jj < 10; ++jj) rowtok[F.tid + 512 * jj] = tk[jj] < 0 ? 0 : tk[jj];
            __syncthreads(); }
          pg8::Gemm g{(const bf16*)(ws + WS_XN), (const bf16*)(ws + WS_W1) + (size_t)l * 32 * 2048 * 1024, TA, 32 * 2048, 1024};
          pg8::MoeOrder<8> S{nblk * 8, F.G, vcu, tab, rowtok}; pg8::EpiMoe1 E{(bf16*)(ws + WS_H), F.in(I_EB1) + (size_t)l * 32 * 2048};
          pg8::gemm_phase<pg8::EpiMoe1, pg8::MoeOrder<8>, true, true, true>(F.lds + RING_OFF, g, S, E);
          if (l == 0) { __syncthreads(); bg_site(F, 1, 0, BG_D, nblk * 8, vcu); } }
        GRID_BAR();

        if (PH(15)) REP(15) { const LAS int* tab = (const LAS int*)(F.lds + LDS_TAB); const int nblk = __builtin_amdgcn_readfirstlane(tab[632]);
          pg8::Gemm g{(const bf16*)(ws + WS_H), (const bf16*)(ws + WS_W2) + (size_t)l * 32 * 1024 * 1024, MOE_ROWS, 32 * 1024, 1024};
          pg8::MoeOrder<4> S{nblk * 4, F.G, vcu, tab, tab}; pg8::EpiMoe2 E{(bf16*)(ws + WS_BIG), F.in(I_EB2) + (size_t)l * 32 * 1024, (const float*)(ws + WS_LW), tab};
          pg8::gemm_phase<pg8::EpiMoe2, pg8::MoeOrder<4>, true, true>(F.lds + RING_OFF, g, S, E);
          if (l == 0) { __syncthreads(); bg_site(F, 1, BG_D, BG_E, nblk * 4, vcu); } }
        GRID_BAR();

        if (PH(16)) REP(16) t4_phase(F, l, T_l, ((PH_TWICE >> 16) & 1u) && rep_ == 0);
        GRID_BAR();
    }
#undef GRID_BAR
}

extern "C" void kernel_launch(void* const* d_in, const int* in_sizes, int n_in, void* d_out, int out_size, void* d_ws, size_t ws_size, hipStream_t stream) {
    static int grid = 0;
    if (grid == 0) {
        if (n_in != 24 || out_size != TL * DM || ws_size < WS_END) { fprintf(stderr, "kernel_launch: unexpected problem: n_in %d out %d ws %zu (need %zu)\n", n_in, out_size, ws_size, (size_t)WS_END); grid = -1; return; }
        int dev = 0, cus = 0;
        if (hipGetDevice(&dev) != hipSuccess || hipDeviceGetAttribute(&cus, hipDeviceAttributeMultiprocessorCount, dev) != hipSuccess) { grid = -1; return; }
        if (hipFuncSetAttribute((const void*)fwd_kernel, hipFuncAttributeMaxDynamicSharedMemorySize, LDS_BYTES) != hipSuccess) { fprintf(stderr, "kernel_launch: hipFuncSetAttribute failed\n"); grid = -1; return; }
        int per_cu = 0;
        if (hipOccupancyMaxActiveBlocksPerMultiprocessor(&per_cu, (const void*)fwd_kernel, 512, LDS_BYTES) != hipSuccess || per_cu < 1) fprintf(stderr, "kernel_launch: occupancy query reports %d\n", per_cu);
        (void)hipGetLastError();
        grid = cus > 256 ? 256 : cus;
    }
    if (grid < 0) return;
    if (hipMemsetAsync((char*)d_ws + WS_CTL, 0, CTL_ZERO_BYTES, stream) != hipSuccess) return;
    Args a{};
    for (int i = 0; i < 24; ++i) a.in[i] = (const float*)d_in[i];
    a.out = (float*)d_out; a.ws = (unsigned char*)d_ws;
    hipLaunchKernelGGL(fwd_kernel, dim3(grid), dim3(512), LDS_BYTES, stream, a);
}
```

```cpp
#include <hip/hip_runtime.h>
#include <cstdio>
#include <cstdint>

typedef unsigned short bf16;

constexpr int DM = 1024, NBATCH = 2, SEQ = 16384, CTX = 256, DEPTH = 2;
constexpr int TL = NBATCH * SEQ;
constexpr int TC = NBATCH * CTX;
constexpr int TA = TL + TC;
constexpr int KPB = SEQ + CTX;
constexpr int KR = NBATCH * KPB;
constexpr int ZW = 5376;
constexpr int Z_Q = 0, Z_K = 512, Z_V = 640, Z_CQ = 768, Z_CKV = 1024, Z_KR = 1152, Z_U = 1280, Z_VG = 1792, Z_GATE = 2304;
constexpr int NEXP = 32, TOPK = 4, DEXP = 1024, MOE_ROWS = 552 * 256;
constexpr float RMS_EPS = 1e-6f;
constexpr float LOG2E = 1.4426950408889634f;
constexpr float C2G = 0.125f * LOG2E;
constexpr float C2M = 0.10206207261596577f * LOG2E;

constexpr size_t MiB = 1u << 20;
constexpr size_t WS_CTL = 0, CTL_ZERO_BYTES = 128 * 1024;
constexpr size_t WS_MOD = 1 * MiB;
constexpr size_t WS_PTAB = 1 * MiB + 512 * 1024;
constexpr size_t WS_COSG = 2 * MiB, WS_SING = 4 * MiB, WS_COSM = 6 * MiB, WS_SINM = 7 * MiB;
constexpr size_t WS_WS = 8 * MiB;
constexpr size_t WS_RWT = 8 * MiB + 512 * 1024;
constexpr size_t WS_SSV = 1 * MiB + 640 * 1024;
static_assert(WS_SSV + (size_t)TA * 2 * 4 <= 2 * MiB && WS_RWT + (size_t)DEPTH * 2 * 32 * 1024 * 2 <= 9 * MiB, "ws map small regions");
constexpr size_t WS_WUQ = 9 * MiB;
constexpr size_t WS_WUKV = 10 * MiB;
constexpr size_t WS_WBR = 11 * MiB;
constexpr size_t WS_WOUT = 17 * MiB;
constexpr size_t WS_WIN = 21 * MiB;
constexpr size_t WS_W1 = 42 * MiB;
constexpr size_t WS_W2 = 298 * MiB;
constexpr size_t WS_XC = 426 * MiB;
constexpr size_t WS_RTE = 428 * MiB;
constexpr size_t WS_RTS = 429 * MiB;
constexpr size_t WS_LTOK = 430 * MiB;
constexpr size_t WS_LW = 435 * MiB;
constexpr size_t WS_XN = 441 * MiB;
constexpr size_t WS_QG = 506 * MiB;
constexpr size_t WS_KG = 539 * MiB;
constexpr size_t WS_VG = 548 * MiB;
constexpr size_t WS_CQN = 557 * MiB;
constexpr size_t WS_CKVN = 574 * MiB;
constexpr size_t WS_QM = 583 * MiB;
constexpr size_t WS_KM = 632 * MiB;
constexpr size_t WS_VM = 681 * MiB;
constexpr size_t WS_OG = 714 * MiB;
constexpr size_t WS_OM = 747 * MiB;
constexpr size_t WS_GM = 780 * MiB;
constexpr size_t WS_UACT = 813 * MiB;
constexpr size_t WS_VN = 846 * MiB;
constexpr size_t WS_MERGE = 879 * MiB;
constexpr size_t WS_XB = WS_MERGE;
constexpr size_t WS_MERGEB = 1009 * MiB;
constexpr size_t WS_Y = 1074 * MiB;
constexpr size_t WS_H = 1139 * MiB;
constexpr size_t WS_BIG = 1415 * MiB;
constexpr size_t WS_END = 1757 * MiB;
static_assert(WS_BIG + (size_t)TA * ZW * 2 <= WS_END && WS_BIG + (size_t)MOE_ROWS * 1024 * 2 <= WS_END && WS_H + (size_t)MOE_ROWS * 1024 * 2 <= WS_BIG, "ws map");
static_assert(WS_W1 + (size_t)DEPTH * 32 * 2048 * 1024 * 2 <= WS_W2 && WS_W2 + (size_t)DEPTH * 32 * 1024 * 1024 * 2 <= WS_XC, "ws map weights");
static_assert(WS_MERGE + (size_t)TA * 1024 * 4 <= WS_MERGEB && WS_XN + (size_t)TA * 1024 * 2 <= WS_QG && WS_QM + (size_t)TA * 768 * 2 <= WS_KM, "ws map acts");
constexpr int CW_BAR = 4096;
constexpr int CW_CNT = 16384;
constexpr int CW_BGQ = 16384 + 512;
static_assert((CW_BGQ + 1) * 4 <= (int)CTL_ZERO_BYTES && (CW_BAR + 3456) * 4 <= (int)CTL_ZERO_BYTES, "control words inside the per-call memset");

constexpr int RING_OFF = 0, RING_BYTES = 131072;
constexpr int LDS_X = RING_BYTES + 4096;
constexpr int LDS_SVEC = LDS_X;
constexpr int LDS_ROWTOK = LDS_X;
constexpr int MISC_OFF = 159744;
constexpr int LDS_TAB = 160000;
constexpr int LDS_BYTES = 163840;
static_assert(LDS_SVEC + 3 * 1024 * 4 <= MISC_OFF && LDS_ROWTOK + 20 * 1024 <= MISC_OFF && LDS_TAB + 704 * 4 <= LDS_BYTES, "LDS map");

#define GAS __attribute__((address_space(1)))
#define LAS __attribute__((address_space(3)))
typedef unsigned v4u __attribute__((ext_vector_type(4)));
typedef float f32x4 __attribute__((ext_vector_type(4)));
typedef GAS unsigned gu32;
#define RLX_AGENT __ATOMIC_RELAXED, __HIP_MEMORY_SCOPE_AGENT
#define LDS_WAIT() asm volatile("s_waitcnt lgkmcnt(0)" ::: "memory")
#define VM_WAIT() asm volatile("s_waitcnt vmcnt(0)" ::: "memory")

__device__ __forceinline__ unsigned cvt_pk(float lo, float hi) { unsigned r; asm volatile("v_cvt_pk_bf16_f32 %0, %1, %2" : "=v"(r) : "v"(lo), "v"(hi)); return r; }
__device__ __forceinline__ float bf_lo(unsigned u) { return __uint_as_float(u << 16); }
__device__ __forceinline__ float bf_hi(unsigned u) { return __uint_as_float(u & 0xffff0000u); }
__device__ __forceinline__ void unpack8(v4u r, float (&f)[8]) { f[0] = bf_lo(r.x); f[1] = bf_hi(r.x); f[2] = bf_lo(r.y); f[3] = bf_hi(r.y); f[4] = bf_lo(r.z); f[5] = bf_hi(r.z); f[6] = bf_lo(r.w); f[7] = bf_hi(r.w); }
__device__ __forceinline__ v4u pack8(const float (&f)[8]) { v4u o; o.x = cvt_pk(f[0], f[1]); o.y = cvt_pk(f[2], f[3]); o.z = cvt_pk(f[4], f[5]); o.w = cvt_pk(f[6], f[7]); return o; }
__device__ __forceinline__ float sigmoidf_(float x) { return __builtin_amdgcn_rcpf(1.f + __builtin_amdgcn_exp2f(-LOG2E * x)); }
__device__ __forceinline__ float wave_sum(float v) {
#pragma unroll
    for (int o = 1; o < 64; o <<= 1) v += __shfl_xor(v, o);
    return v;
}
__device__ __forceinline__ float gelu_tanh(float x) { const float u = 1.5957691216057308f * (x + 0.044715f * x * x * x); return x * __builtin_amdgcn_rcpf(1.f + __builtin_amdgcn_exp2f(-LOG2E * u)); }
constexpr int NTILE = KPB / 64;
__device__ __forceinline__ void bpos_of(int r, int& b, int& pos) { if (r < TL) { b = r >> 14; pos = r & (SEQ - 1); } else { b = (r - TL) >> 8; pos = SEQ + ((r - TL) & (CTX - 1)); } }
__device__ __forceinline__ size_t ktile_off(int strm, int pos, int chunk, int nch) { return (((size_t)strm * NTILE + (pos >> 6)) * nch + chunk) * 512 + (size_t)(pos & 63) * 8; }
__device__ __forceinline__ size_t vtile_off(int strm, int pos, int d) { const int piece = (d >> 5) * 4 + ((pos & 63) >> 4), ln = (pos & 15) * 4 + ((d >> 3) & 3); return (((size_t)strm * NTILE + (pos >> 6)) * 8 + piece) * 512 + (size_t)ln * 8; }
__device__ __forceinline__ int krow_of(int r) { return r < TL ? (r >> 14) * KPB + (r & (SEQ - 1)) : ((r - TL) >> 8) * KPB + SEQ + ((r - TL) & (CTX - 1)); }

__device__ const float INVF16[16] = {1.0f, 0.5623413324356079f, 0.3162277638912201f, 0.17782793939113617f, 0.10000000149011612f, 0.05623413249850273f, 0.03162277489900589f, 0.017782794311642647f,
                                     0.009999999776482582f, 0.005623413249850273f, 0.003162277629598975f, 0.0017782794311642647f, 0.0010000000474974513f, 0.000562341301701963f, 0.0003162277571391314f, 0.00017782794020604342f};
namespace pg8 {
#define PG8_LAS __attribute__((address_space(3)))
typedef unsigned short bf16_t;
typedef short bf16x8 __attribute__((ext_vector_type(8)));
typedef float f32x4 __attribute__((ext_vector_type(4)));
typedef unsigned u32x4 __attribute__((ext_vector_type(4)));
constexpr int BM = 256, BK = 64, HALF = 128, HTB = HALF * BK * 2  , STAGE_BYTES = 8 * HTB, NXCD = 8, WGM = 8;

__host__ __device__ __forceinline__ int lds_byte(int r, int c) { const int st = (r >> 4) * 2 + (c >> 5), rr = r & 15, cc = c & 31, ob = rr * 64 + cc * 2; return st * 1024 + (ob ^ (((ob >> 9) & 1) << 5)); }
__host__ __device__ __forceinline__ void stage_rc(int b, int& R, int& C) { const int st = b / 1024, sb = b % 1024, swz = sb ^ (((sb >> 9) & 1) << 5); R = (st >> 1) * 16 + swz / 64; C = (st & 1) * 32 + (swz % 64) / 2; }
__host__ __device__ __forceinline__ int perm32(int rho) { const int n = rho >> 4, i = rho & 15; return 8 * (i >> 2) + 4 * n + (i & 3); }

struct Unit { int pm, pn; };
struct Gemm { const bf16_t* A; const bf16_t* Bt; int M, N, K; };

struct StaticOrder {
    int nM, nN, nwg, G, c;
    __device__ void init(int M, int N, int G_, int c_) { asm volatile("" : "+s"(M), "+s"(N));
        nM = M / BM; nN = N / BM; nwg = nM * nN; G = G_; c = c_; }
    __host__ __device__ bool next(int i, Unit& u) const {
        const long L = (long)i * G + c; if (L >= nwg) return false;
        int wgid = (int)L; { const int q = nwg / NXCD, r = nwg % NXCD, xcd = wgid % NXCD, off = wgid / NXCD; wgid = (xcd < r ? xcd * (q + 1) : r * (q + 1) + (xcd - r) * q) + off; }
        const int nig = WGM * nN, gid = wgid / nig, fm = gid * WGM, gsz = (nM - fm) < WGM ? (nM - fm) : WGM;
        u.pm = fm + ((wgid % nig) % gsz); u.pn = (wgid % nig) / gsz; return true;
    }
    __device__ __forceinline__ void a_ready(const Unit&) const {}
    __device__ __forceinline__ void done(const Unit&) const {}
};

template <class Epi, class Sched, bool ALIGN_EPI = false, bool SP2 = false, bool GATHER = false>
__device__ __forceinline__ void gemm_phase(PG8_LAS unsigned char* lds, const Gemm g, const Sched& S, const Epi& E) {
    static_assert(!GATHER || SP2, "GATHER is implemented for the SP2 loop only");
    int tid_ = threadIdx.x; asm volatile("" : "+v"(tid_));
    const int tid = tid_, wid = __builtin_amdgcn_readfirstlane(tid >> 6), lane = tid & 63, wr = wid >> 2, wc = wid & 3, fr = lane & 15, fq = lane >> 4;
    int K_ = g.K; asm volatile("" : "+s"(K_));
    const int K = K_, nt = K / BK;
    unsigned voffA[2], voffB[2];
#pragma unroll
    for (int i = 0; i < 2; ++i) { int R, C; stage_rc(tid * 16 + i * 8192, R, C); const int Rb = Epi::PERM ? ((R & ~31) + perm32(R & 31)) : R;
        voffA[i] = (unsigned)(R * K + C) * 2u; voffB[i] = (unsigned)(Rb * K + C) * 2u; }
    unsigned vAc0[2] = {0u, 0u}, vAc1[2] = {0u, 0u}, vAn0[2] = {0u, 0u}, vAn1[2] = {0u, 0u}, vsel0[2] = {0u, 0u}, vsel1[2] = {0u, 0u};
#define PG8_GOFF(dst0, dst1, uidx) do { _Pragma("unroll") for (int i_ = 0; i_ < 2; ++i_) { int R_, C_; stage_rc(tid * 16 + i_ * 8192, R_, C_); \
        dst0[i_] = ((unsigned)S.tok((uidx), R_) * (unsigned)K + (unsigned)C_) * 2u; dst1[i_] = ((unsigned)S.tok((uidx), HALF + R_) * (unsigned)K + (unsigned)C_) * 2u; } } while (0)
#define PG8_STG_A(bufoff, base, H, SEL) do { if constexpr (GATHER) { if (SEL) { PG8_STAGE(bufoff, base, vsel##H); } else { PG8_STAGE(bufoff, base, vAc##H); } } else { PG8_STAGE(bufoff, (base) + (H) * hstep, voffA); } } while (0)
    const size_t kstep = (size_t)(BK * 2);
    const size_t hstep = (size_t)HALF * K * 2;
    const size_t tstep = 2 * hstep;
    const unsigned ldsw = (unsigned)wid * 1024u;
    const int aoff = lds_byte(wr * 64 + fr, fq * 8), boff = lds_byte(wc * 32 + fr, fq * 8);
#define PG8_SA(b, h) (((b) * 2 + (h)) * HTB)
#define PG8_SB(b, h) ((4 + (b) * 2 + (h)) * HTB)
#define PG8_STAGE(bufoff, gbase, voff) do { _Pragma("unroll") for (int _i = 0; _i < 2; ++_i) \
        __builtin_amdgcn_global_load_lds((const unsigned*)((const char*)(gbase) + (voff)[_i]), (PG8_LAS unsigned*)(lds + (bufoff) + ldsw + _i * 8192), 16, 0, 0); } while (0)
#define PG8_LDA(dst, b, h) do { _Pragma("unroll") for (int m = 0; m < 4; ++m) _Pragma("unroll") for (int k = 0; k < 2; ++k) dst[m][k] = *(const PG8_LAS bf16x8*)(lds + PG8_SA(b, h) + aoff + m * 2048 + k * 1024); } while (0)
#define PG8_LDB(dst, b, h) do { _Pragma("unroll") for (int n = 0; n < 2; ++n) _Pragma("unroll") for (int k = 0; k < 2; ++k) dst[n][k] = *(const PG8_LAS bf16x8*)(lds + PG8_SB(b, h) + boff + n * 2048 + k * 1024); } while (0)
#define PG8_MMA(ai, bj, At, Bt) do { __builtin_amdgcn_s_setprio(1); _Pragma("unroll") for (int m = 0; m < 4; ++m) _Pragma("unroll") for (int n = 0; n < 2; ++n) _Pragma("unroll") for (int k = 0; k < 2; ++k) \
        acc[ai][bj][m][n] = __builtin_amdgcn_mfma_f32_16x16x32_bf16(Bt[n][k], At[m][k], acc[ai][bj][m][n], 0, 0, 0); __builtin_amdgcn_s_setprio(0); } while (0)
#define PG8_WAIT_V(n) asm volatile("s_waitcnt vmcnt(" #n ")" ::: "memory")
#define PG8_WAIT_L(n) asm volatile("s_waitcnt lgkmcnt(" #n ")" ::: "memory")
#define PG8_BAR __builtin_amdgcn_s_barrier()
#define PG8_SCHED __builtin_amdgcn_sched_barrier(0)
    Unit cur, nxt; int ui = 0;
    if (!S.next(0, cur)) return;
    f32x4 acc[2][2][4][2];
#pragma unroll
    for (int a = 0; a < 2; ++a)
#pragma unroll
        for (int b = 0; b < 2; ++b)
#pragma unroll
            for (int m = 0; m < 4; ++m)
#pragma unroll
                for (int n = 0; n < 2; ++n) acc[a][b][m][n] = (f32x4){0.f, 0.f, 0.f, 0.f};
    bf16x8 At[4][2], B0[2][2], B1[2][2];
    const char* cA = GATHER ? (const char*)g.A : (const char*)g.A + (size_t)cur.pm * tstep; const char* cB = (const char*)g.Bt + (size_t)cur.pn * tstep;
    if constexpr (GATHER) { PG8_GOFF(vAc0, vAc1, 0); }
    S.a_ready(cur);
    if constexpr (SP2) {
        PG8_STAGE(PG8_SB(0, 0), cB, voffB); PG8_STAGE(PG8_SB(0, 1), cB + hstep, voffB); PG8_STG_A(PG8_SA(0, 0), cA, 0, false); PG8_STG_A(PG8_SA(0, 1), cA, 1, false);
        if (wr == 1) PG8_BAR;
        PG8_WAIT_V(2); PG8_BAR;
        PG8_STAGE(PG8_SB(1, 0), cB + kstep, voffB); PG8_STG_A(PG8_SA(1, 0), cA + kstep, 0, false); PG8_STAGE(PG8_SB(1, 1), cB + hstep + kstep, voffB);
        PG8_WAIT_V(6); PG8_BAR;
    } else {
        PG8_STAGE(PG8_SB(0, 0), cB, voffB); PG8_STAGE(PG8_SA(0, 0), cA, voffA); PG8_STAGE(PG8_SB(0, 1), cB + hstep, voffB); PG8_STAGE(PG8_SA(0, 1), cA + hstep, voffA);
        if (wr == 1) PG8_BAR;
        PG8_WAIT_V(4); PG8_BAR;
        PG8_STAGE(PG8_SB(1, 0), cB + kstep, voffB); PG8_STAGE(PG8_SA(1, 0), cA + kstep, voffA); PG8_STAGE(PG8_SB(1, 1), cB + hstep + kstep, voffB);
        PG8_WAIT_V(6); PG8_BAR;
    }
    for (;;) {
        const bool has_next = S.next(ui + 1, nxt);
        const char* nA = GATHER ? (const char*)g.A : (has_next ? (const char*)g.A + (size_t)nxt.pm * tstep : cA);
        if constexpr (GATHER) { if (has_next) { PG8_GOFF(vAn0, vAn1, ui + 1); } else { vAn0[0] = vAc0[0]; vAn0[1] = vAc0[1]; vAn1[0] = vAc1[0]; vAn1[1] = vAc1[1]; } } const char* nB = has_next ? (const char*)g.Bt + (size_t)nxt.pn * tstep : cB;
        for (int t = 0; t < nt; t += 2) {
            const bool last = (t == nt - 2);
            const char* a1 = cA + (size_t)(t + 1) * kstep;
            const char* a2 = last ? nA : cA + (size_t)(t + 2) * kstep; const char* b2 = last ? nB : cB + (size_t)(t + 2) * kstep;
            const char* a3 = a2 + kstep; const char* b3 = b2 + kstep;
            if (last && has_next) S.a_ready(nxt);
            if constexpr (GATHER) { vsel0[0] = last ? vAn0[0] : vAc0[0]; vsel0[1] = last ? vAn0[1] : vAc0[1]; vsel1[0] = last ? vAn1[0] : vAc1[0]; vsel1[1] = last ? vAn1[1] : vAc1[1]; }
            if constexpr (SP2) {
            PG8_LDB(B0, 0, 0); PG8_LDB(B1, 0, 1); PG8_SCHED; PG8_LDA(At, 0, 0); PG8_STG_A(PG8_SA(1, 1), a1, 1, false);
            PG8_WAIT_V(8); PG8_WAIT_L(0); PG8_BAR; PG8_MMA(0, 0, At, B0); PG8_MMA(0, 1, At, B1); PG8_BAR; PG8_SCHED;
            PG8_LDA(At, 0, 1); PG8_STAGE(PG8_SB(0, 0), b2, voffB); PG8_STAGE(PG8_SB(0, 1), b2 + hstep, voffB); PG8_STG_A(PG8_SA(0, 0), a2, 0, true);
            PG8_WAIT_V(8); PG8_WAIT_L(0); PG8_BAR; PG8_MMA(1, 0, At, B0); PG8_MMA(1, 1, At, B1); PG8_BAR; PG8_SCHED;
            PG8_LDB(B0, 1, 0); PG8_LDB(B1, 1, 1); PG8_SCHED; PG8_LDA(At, 1, 0); PG8_STG_A(PG8_SA(0, 1), a2, 1, true);
            PG8_WAIT_V(8); PG8_WAIT_L(0); PG8_BAR; PG8_MMA(0, 0, At, B0); PG8_MMA(0, 1, At, B1); PG8_BAR; PG8_SCHED;
            PG8_LDA(At, 1, 1); PG8_STAGE(PG8_SB(1, 0), b3, voffB); PG8_STAGE(PG8_SB(1, 1), b3 + hstep, voffB); PG8_STG_A(PG8_SA(1, 0), a3, 0, true);
            PG8_WAIT_V(8); PG8_WAIT_L(0); PG8_BAR; PG8_MMA(1, 0, At, B0); PG8_MMA(1, 1, At, B1); PG8_BAR; PG8_SCHED;
            } else {
            PG8_LDB(B0, 0, 0); PG8_SCHED; PG8_LDA(At, 0, 0); PG8_STAGE(PG8_SA(1, 1), a1 + hstep, voffA);
            PG8_WAIT_L(8); PG8_BAR; PG8_WAIT_L(0); PG8_MMA(0, 0, At, B0); PG8_BAR; PG8_SCHED;
            PG8_LDB(B1, 0, 1); PG8_STAGE(PG8_SB(0, 0), b2, voffB);
            PG8_BAR; PG8_WAIT_L(0); PG8_MMA(0, 1, At, B1); PG8_BAR;
            PG8_LDA(At, 0, 1); PG8_STAGE(PG8_SA(0, 0), a2, voffA);
            PG8_BAR; PG8_WAIT_L(0); PG8_MMA(1, 0, At, B0); PG8_BAR; PG8_SCHED;
            PG8_STAGE(PG8_SB(0, 1), b2 + hstep, voffB);
            PG8_WAIT_V(6); PG8_BAR; PG8_MMA(1, 1, At, B1); PG8_BAR;
            PG8_LDB(B0, 1, 0); PG8_SCHED; PG8_LDA(At, 1, 0); PG8_STAGE(PG8_SA(0, 1), a2 + hstep, voffA);
            PG8_WAIT_L(8); PG8_BAR; PG8_WAIT_L(0); PG8_MMA(0, 0, At, B0); PG8_BAR; PG8_SCHED;
            PG8_LDB(B1, 1, 1); PG8_STAGE(PG8_SB(1, 0), b3, voffB);
            PG8_BAR; PG8_WAIT_L(0); PG8_MMA(0, 1, At, B1); PG8_BAR;
            PG8_LDA(At, 1, 1); PG8_STAGE(PG8_SA(1, 0), a3, voffA);
            PG8_BAR; PG8_WAIT_L(0); PG8_MMA(1, 0, At, B0); PG8_BAR; PG8_SCHED;
            PG8_STAGE(PG8_SB(1, 1), b3 + hstep, voffB);
            PG8_WAIT_V(6); PG8_BAR; PG8_MMA(1, 1, At, B1); PG8_BAR;
            }
        }
        if constexpr (ALIGN_EPI) { if (wr == 0) PG8_BAR; }
        if constexpr (!Epi::AFTER_DRAIN) { E(acc, cur, wr, wc, fr, fq); S.done(cur); }
        if (!has_next) break;
#pragma unroll
        for (int a = 0; a < 2; ++a)
#pragma unroll
            for (int b = 0; b < 2; ++b)
#pragma unroll
                for (int m = 0; m < 4; ++m)
#pragma unroll
                    for (int n = 0; n < 2; ++n) acc[a][b][m][n] = (f32x4){0.f, 0.f, 0.f, 0.f};
        cur = nxt; cA = nA; cB = nB; ++ui;
        if constexpr (GATHER) { vAc0[0] = vAn0[0]; vAc0[1] = vAn0[1]; vAc1[0] = vAn1[0]; vAc1[1] = vAn1[1]; }
        if constexpr (ALIGN_EPI) { if (wr == 1) PG8_BAR; }
    }
    PG8_WAIT_V(0);
    if constexpr (!ALIGN_EPI) { if (wr == 0) PG8_BAR; }
    PG8_BAR;
    if constexpr (Epi::AFTER_DRAIN) { E.fused(acc, cur, wr, wc, fr, fq, lds, wid, lane); S.done(cur); }
#undef PG8_SA
#undef PG8_SB
#undef PG8_STAGE
#undef PG8_LDA
#undef PG8_LDB
#undef PG8_MMA
#undef PG8_WAIT_V
#undef PG8_WAIT_L
#undef PG8_BAR
#undef PG8_SCHED
#undef PG8_GOFF
#undef PG8_STG_A
}
}
namespace pg8 {
#define EPI_ROWS(u, wr, fr) const int row00 = (u).pm * BM + (wr) * 64 + (fr)
#define EPI_GET8(v, ai, bj, m) float v[8] = {acc[ai][bj][m][0][0], acc[ai][bj][m][0][1], acc[ai][bj][m][0][2], acc[ai][bj][m][0][3], acc[ai][bj][m][1][0], acc[ai][bj][m][1][1], acc[ai][bj][m][1][2], acc[ai][bj][m][1][3]}

struct EpiPlain {
    static constexpr bool PERM = true, AFTER_DRAIN = false;
    bf16_t* O; int ldc;
    __device__ __forceinline__ void operator()(const f32x4 (&acc)[2][2][4][2], const Unit& u, int wr, int wc, int fr, int fq) const {
        asm volatile("" : "+v"(fr), "+v"(fq));
        EPI_ROWS(u, wr, fr); const int col0 = u.pn * BM + wc * 32 + 8 * fq;
#pragma unroll
        for (int ai = 0; ai < 2; ++ai)
#pragma unroll
            for (int m = 0; m < 4; ++m) { bf16_t* rowp = O + (size_t)(row00 + ai * HALF + m * 16) * ldc + col0;
#pragma unroll
                for (int bj = 0; bj < 2; ++bj) { EPI_GET8(v, ai, bj, m); *(u32x4*)(rowp + bj * HALF) = pack8(v); } }
    }
};

struct EpiInproj {
    static constexpr bool PERM = true, AFTER_DRAIN = false;
    unsigned char* ws; const float *qkn, *mqn, *mkvn; PG8_LAS float* xs;
    __device__ __forceinline__ void operator()(const f32x4 (&acc)[2][2][4][2], const Unit& u, int wr, int wc, int fr, int fq) const {
        asm volatile("" : "+v"(fr), "+v"(fq));
        EPI_ROWS(u, wr, fr); const int pn = u.pn; const bool lat = (u.pm * BM) < TL;
        if (pn >= 9) {
            const int col0 = (pn - 9) * BM + wc * 32 + 8 * fq;
#pragma unroll
            for (int ai = 0; ai < 2; ++ai)
#pragma unroll
                for (int m = 0; m < 4; ++m) { bf16_t* rowp = (bf16_t*)(ws + WS_BIG) + (size_t)(row00 + ai * HALF + m * 16) * 3072 + col0;
#pragma unroll
                    for (int bj = 0; bj < 2; ++bj) { EPI_GET8(v, ai, bj, m); *(u32x4*)(rowp + bj * HALF) = pack8(v); } }
        } else if (pn <= 2) {
            if (pn == 2 && wc >= 2) {
#pragma unroll
                for (int ai = 0; ai < 2; ++ai)
#pragma unroll
                    for (int m = 0; m < 4; ++m) { const int row = row00 + ai * HALF + m * 16; int b_, pos_; bpos_of(row, b_, pos_); bf16_t* vb = (bf16_t*)(ws + WS_VG); const int st = b_ * 2 + (wc - 2);
                        EPI_GET8(x1, ai, 0, m); EPI_GET8(x2, ai, 1, m); *(u32x4*)(vb + vtile_off(st, pos_, 8 * fq)) = pack8(x1); *(u32x4*)(vb + vtile_off(st, pos_, 32 + 8 * fq)) = pack8(x2); }
            } else {
                const bool isq = pn < 2; const float* gn = qkn + (isq ? 0 : 64) + 8 * fq;
                const f32x4 ga0 = *(const f32x4*)gn, ga1 = *(const f32x4*)(gn + 4), gb0 = *(const f32x4*)(gn + 32), gb1 = *(const f32x4*)(gn + 36);
                const float g1[8] = {ga0[0], ga0[1], ga0[2], ga0[3], ga1[0], ga1[1], ga1[2], ga1[3]}, g2[8] = {gb0[0], gb0[1], gb0[2], gb0[3], gb1[0], gb1[1], gb1[2], gb1[3]};
                const float sc = isq ? C2G : 1.f;
#pragma unroll
                for (int am = 0; am < 4; ++am) { const int ai = am >> 1, m0 = 2 * (am & 1);
                    f32x4 tc[2][2], ts[2][2];
#pragma unroll
                    for (int mm = 0; mm < 2; ++mm) { const int pos = lat ? ((row00 + ai * HALF + (m0 + mm) * 16) & (SEQ - 1)) : 0; const f32x4* cp = (const f32x4*)((const float*)(ws + WS_COSG) + (size_t)pos * 32 + 8 * fq); const f32x4* sp = (const f32x4*)((const float*)(ws + WS_SING) + (size_t)pos * 32 + 8 * fq);
                        tc[mm][0] = cp[0]; tc[mm][1] = cp[1]; ts[mm][0] = sp[0]; ts[mm][1] = sp[1]; }
#pragma unroll
                    for (int mm = 0; mm < 2; ++mm) { const int m = m0 + mm; const int row = row00 + ai * HALF + m * 16; const f32x4 c0 = tc[mm][0], c1 = tc[mm][1], s0 = ts[mm][0], s1 = ts[mm][1];
                        EPI_GET8(x1, ai, 0, m); EPI_GET8(x2, ai, 1, m); float ss = 0.f;
#pragma unroll
                        for (int i = 0; i < 8; ++i) ss += x1[i] * x1[i] + x2[i] * x2[i];
                        ss += __shfl_xor(ss, 16); ss += __shfl_xor(ss, 32);
                        const float rstd = __builtin_amdgcn_rsqf(ss * (1.f / 64.f) + RMS_EPS); float o1[8], o2[8];
#pragma unroll
                        for (int i = 0; i < 8; ++i) { const float y1 = x1[i] * rstd * g1[i], y2 = x2[i] * rstd * g2[i]; const float c = lat ? (i < 4 ? c0[i & 3] : c1[i & 3]) : 1.f, s = lat ? (i < 4 ? s0[i & 3] : s1[i & 3]) : 0.f;
                            o1[i] = (y1 * c - y2 * s) * sc; o2[i] = (y2 * c + y1 * s) * sc; }
                        if (isq) { bf16_t* p = (bf16_t*)(ws + WS_QG) + (size_t)row * 512 + (4 * pn + wc) * 64 + 8 * fq; *(u32x4*)p = pack8(o1); *(u32x4*)(p + 32) = pack8(o2); }
                        else { int b_, pos_; bpos_of(row, b_, pos_); bf16_t* kb = (bf16_t*)(ws + WS_KG); const int st = b_ * 2 + wc; *(u32x4*)(kb + ktile_off(st, pos_, fq, 8)) = pack8(o1); *(u32x4*)(kb + ktile_off(st, pos_, 4 + fq, 8)) = pack8(o2); } }
                    asm volatile("" ::: "memory"); }
            }
        } else if (pn == 3 || pn == 4 || pn == 7 || pn == 8) {
            const bool vg = pn >= 7; const bool part = (pn == 4) ? (wc < 2) : true;
            float ssr[2][4];
#pragma unroll
            for (int ai = 0; ai < 2; ++ai)
#pragma unroll
                for (int m = 0; m < 4; ++m) { float ss = 0.f;
#pragma unroll
                    for (int bj = 0; bj < 2; ++bj) { EPI_GET8(v, ai, bj, m);
#pragma unroll
                        for (int i = 0; i < 8; ++i) { const float t = vg ? gelu_tanh(v[i]) : v[i]; ss += t * t; } }
                    ss += __shfl_xor(ss, 16); ss += __shfl_xor(ss, 32); ssr[ai][m] = part ? ss : 0.f;
                    if (fq == 0) xs[(ai * HALF + wr * 64 + m * 16 + fr) * 4 + wc] = ssr[ai][m]; }
            asm volatile("s_waitcnt lgkmcnt(0)\n\ts_barrier" ::: "memory");
#pragma unroll
            for (int ai = 0; ai < 2; ++ai)
#pragma unroll
                for (int m = 0; m < 4; ++m) { const f32x4 t = *(const PG8_LAS f32x4*)(xs + (ai * HALF + wr * 64 + m * 16 + fr) * 4); ssr[ai][m] = (t[0] + t[1]) + (t[2] + t[3]); }
            asm volatile("s_waitcnt lgkmcnt(0)\n\ts_barrier" ::: "memory");
            if (pn == 3) {
                const int col0 = wc * 32 + 8 * fq;
#pragma unroll
                for (int ai = 0; ai < 2; ++ai)
#pragma unroll
                    for (int m = 0; m < 4; ++m) { const int row = row00 + ai * HALF + m * 16; const float rstd = __builtin_amdgcn_rsqf(ssr[ai][m] * (1.f / 256.f) + RMS_EPS);
#pragma unroll
                        for (int bj = 0; bj < 2; ++bj) { EPI_GET8(v, ai, bj, m); const int col = col0 + bj * HALF; const f32x4 ga = *(const f32x4*)(mqn + col), gb = *(const f32x4*)(mqn + col + 4);
#pragma unroll
                            for (int i = 0; i < 8; ++i) v[i] *= rstd * (i < 4 ? ga[i] : gb[i - 4]);
                            *(u32x4*)((bf16_t*)(ws + WS_CQN) + (size_t)row * 256 + col) = pack8(v); } }
            } else if (pn == 4) {
                if (wc < 2) {
#pragma unroll
                    for (int ai = 0; ai < 2; ++ai)
#pragma unroll
                        for (int m = 0; m < 4; ++m) { const int row = row00 + ai * HALF + m * 16; const float rstd = __builtin_amdgcn_rsqf(ssr[ai][m] * (1.f / 128.f) + RMS_EPS);
#pragma unroll
                            for (int bj = 0; bj < 2; ++bj) { EPI_GET8(v, ai, bj, m); const int col = wc * 64 + bj * 32 + 8 * fq; const f32x4 ga = *(const f32x4*)(mkvn + col), gb = *(const f32x4*)(mkvn + col + 4);
#pragma unroll
                                for (int i = 0; i < 8; ++i) v[i] *= rstd * (i < 4 ? ga[i] : gb[i - 4]);
                                *(u32x4*)((bf16_t*)(ws + WS_CKVN) + (size_t)row * 128 + col) = pack8(v); } }
                } else if (wc == 2 && fq < 2) {
#pragma unroll
                    for (int ai = 0; ai < 2; ++ai)
#pragma unroll
                        for (int m = 0; m < 4; ++m) { const int row = row00 + ai * HALF + m * 16; const int pos = row & (SEQ - 1);
                            EPI_GET8(x1, ai, 0, m); EPI_GET8(x2, ai, 1, m); float o1[8], o2[8];
                            if (lat) { const f32x4* cp = (const f32x4*)((const float*)(ws + WS_COSM) + (size_t)pos * 16 + 8 * fq); const f32x4* sp = (const f32x4*)((const float*)(ws + WS_SINM) + (size_t)pos * 16 + 8 * fq); const f32x4 c0 = cp[0], c1 = cp[1], s0 = sp[0], s1 = sp[1];
#pragma unroll
                                for (int i = 0; i < 8; ++i) { const float c = i < 4 ? c0[i] : c1[i - 4], s = i < 4 ? s0[i] : s1[i - 4]; o1[i] = x1[i] * c - x2[i] * s; o2[i] = x2[i] * c + x1[i] * s; } }
                            else {
#pragma unroll
                                for (int i = 0; i < 8; ++i) { o1[i] = x1[i]; o2[i] = x2[i]; } }
                            const u32x4 p1 = pack8(o1), p2 = pack8(o2); int b_, pos_; bpos_of(row, b_, pos_); bf16_t* kb = (bf16_t*)(ws + WS_KM);
#pragma unroll
                            for (int h = 0; h < 8; ++h) { *(u32x4*)(kb + ktile_off(b_ * 8 + h, pos_, 8 + fq, 12)) = p1; *(u32x4*)(kb + ktile_off(b_ * 8 + h, pos_, 10 + fq, 12)) = p2; } }
                }
            } else {
                const int half = pn - 7, col0 = half * BM + wc * 32 + 8 * fq;
#pragma unroll
                for (int ai = 0; ai < 2; ++ai)
#pragma unroll
                    for (int m = 0; m < 4; ++m) { const int row = row00 + ai * HALF + m * 16;
#pragma unroll
                        for (int bj = 0; bj < 2; ++bj) { EPI_GET8(v, ai, bj, m);
#pragma unroll
                            for (int i = 0; i < 8; ++i) v[i] = gelu_tanh(v[i]);
                            *(u32x4*)((bf16_t*)(ws + WS_VN) + (size_t)row * 512 + col0 + bj * HALF) = pack8(v); }
                        if (wc == 0 && fq == 0) ((float*)(ws + WS_SSV))[(size_t)row * 2 + half] = ssr[ai][m]; }
            }
        } else {
            const int col0 = (pn - 5) * BM + wc * 32 + 8 * fq;
#pragma unroll
            for (int ai = 0; ai < 2; ++ai)
#pragma unroll
                for (int m = 0; m < 4; ++m) { const int row = row00 + ai * HALF + m * 16;
#pragma unroll
                    for (int bj = 0; bj < 2; ++bj) { EPI_GET8(v, ai, bj, m);
#pragma unroll
                        for (int i = 0; i < 8; ++i) v[i] = gelu_tanh(v[i]);
                        *(u32x4*)((bf16_t*)(ws + WS_UACT) + (size_t)row * 512 + col0 + bj * HALF) = pack8(v); } }
        }
    }
};

struct EpiUq {
    static constexpr bool PERM = true, AFTER_DRAIN = false;
    bf16_t* Qm; const float* cosM; const float* sinM;
    __device__ __forceinline__ void operator()(const f32x4 (&acc)[2][2][4][2], const Unit& u, int wr, int wc, int fr, int fq) const {
        asm volatile("" : "+v"(fr), "+v"(fq));
        EPI_ROWS(u, wr, fr);
        if (u.pn < 2) {
#pragma unroll
            for (int ai = 0; ai < 2; ++ai)
#pragma unroll
                for (int m = 0; m < 4; ++m) { const int row = row00 + ai * HALF + m * 16;
#pragma unroll
                    for (int bj = 0; bj < 2; ++bj) { const int col = u.pn * BM + bj * HALF + wc * 32 + 8 * fq; const int head = col >> 6, d = col & 63;
                        EPI_GET8(v, ai, bj, m);
#pragma unroll
                        for (int i = 0; i < 8; ++i) v[i] *= C2M;
                        *(u32x4*)(Qm + (size_t)row * 768 + head * 96 + d) = pack8(v); } asm volatile("" ::: "memory"); }
        } else {
            const int cc = wc * 32 + 8 * fq, hh = cc >> 4, j0 = cc & 15;
            const bool lat = (u.pm * BM) < TL;
#pragma unroll
            for (int ai = 0; ai < 2; ++ai) {
                f32x4 tc[4][2], ts[4][2];
#pragma unroll
                for (int m = 0; m < 4; ++m) { const int pos = lat ? ((row00 + ai * HALF + m * 16) & (SEQ - 1)) : 0; const f32x4* cp = (const f32x4*)(cosM + (size_t)pos * 16 + j0); const f32x4* sp = (const f32x4*)(sinM + (size_t)pos * 16 + j0);
                    tc[m][0] = cp[0]; tc[m][1] = cp[1]; ts[m][0] = sp[0]; ts[m][1] = sp[1]; }
#pragma unroll
                for (int m = 0; m < 4; ++m) { const int row = row00 + ai * HALF + m * 16;
                    EPI_GET8(x1, ai, 0, m); EPI_GET8(x2, ai, 1, m);
                    float cs[8], sn[8];
#pragma unroll
                    for (int i = 0; i < 8; ++i) { cs[i] = lat ? tc[m][i >> 2][i & 3] : 1.f; sn[i] = lat ? ts[m][i >> 2][i & 3] : 0.f; }
                    float o1[8], o2[8];
#pragma unroll
                    for (int i = 0; i < 8; ++i) { o1[i] = (x1[i] * cs[i] - x2[i] * sn[i]) * C2M; o2[i] = (x2[i] * cs[i] + x1[i] * sn[i]) * C2M; }
                    bf16_t* qp = Qm + (size_t)row * 768 + hh * 96 + 64 + j0;
                    *(u32x4*)(qp) = pack8(o1); *(u32x4*)(qp + 16) = pack8(o2); }
                asm volatile("" ::: "memory"); }
        }
    }
};

struct EpiUkv {
    static constexpr bool PERM = true, AFTER_DRAIN = false;
    bf16_t* Km; bf16_t* Vm;
    __device__ __forceinline__ void operator()(const f32x4 (&acc)[2][2][4][2], const Unit& u, int wr, int wc, int fr, int fq) const {
        asm volatile("" : "+v"(fr), "+v"(fq));
        EPI_ROWS(u, wr, fr); const int within = wc * 32 + 8 * fq;
#pragma unroll
        for (int ai = 0; ai < 2; ++ai)
#pragma unroll
            for (int m = 0; m < 4; ++m) { const int row = row00 + ai * HALF + m * 16; int b_, pos_; bpos_of(row, b_, pos_);
#pragma unroll
                for (int bj = 0; bj < 2; ++bj) { const int head = u.pn * 2 + bj; EPI_GET8(v, ai, bj, m);
                    bf16_t* p = (within < 64) ? (Km + ktile_off(b_ * 8 + head, pos_, within >> 3, 12)) : (Vm + vtile_off(b_ * 8 + head, pos_, within - 64));
                    *(u32x4*)p = pack8(v); } asm volatile("" ::: "memory"); }
    }
};

template <int IDX> struct EpiBranch {
    static constexpr bool PERM = true, AFTER_DRAIN = false;
    const bf16_t* Z; bf16_t* MERGEB;
    __device__ __forceinline__ void operator()(const f32x4 (&acc)[2][2][4][2], const Unit& u, int wr, int wc, int fr, int fq) const {
        asm volatile("" : "+v"(fr), "+v"(fq));
        EPI_ROWS(u, wr, fr); const int col0 = u.pn * BM + wc * 32 + 8 * fq;
#pragma unroll
        for (int ai = 0; ai < 2; ++ai) {
            u32x4 gr[4][2], mr[4][2];
#pragma unroll
            for (int m = 0; m < 4; ++m) { const int row = row00 + ai * HALF + m * 16;
#pragma unroll
                for (int bj = 0; bj < 2; ++bj) { const int col = col0 + bj * HALF; gr[m][bj] = *(const u32x4*)(Z + (size_t)row * 3072 + IDX * 1024 + col);
                    if (IDX != 0) mr[m][bj] = *(const u32x4*)(MERGEB + (size_t)row * 1024 + col); } }
#pragma unroll
            for (int m = 0; m < 4; ++m) { const int row = row00 + ai * HALF + m * 16;
#pragma unroll
                for (int bj = 0; bj < 2; ++bj) { const int col = col0 + bj * HALF; EPI_GET8(v, ai, bj, m); float g[8], a[8], r[8]; unpack8(gr[m][bj], g);
                    if (IDX != 0) unpack8(mr[m][bj], a);
#pragma unroll
                    for (int i = 0; i < 8; ++i) r[i] = (IDX != 0 ? a[i] : 0.f) + sigmoidf_(g[i]) * v[i];
                    *(u32x4*)(MERGEB + (size_t)row * 1024 + col) = pack8(r); } }
            asm volatile("" ::: "memory"); }
    }
};

struct EpiMoe1 {
    static constexpr bool PERM = true, AFTER_DRAIN = false;
    bf16_t* H; const float* b1;
    __device__ __forceinline__ void operator()(const f32x4 (&acc)[2][2][4][2], const Unit& u, int wr, int wc, int fr, int fq) const {
        asm volatile("" : "+v"(fr), "+v"(fq));
        EPI_ROWS(u, wr, fr); const int e = u.pn >> 3, pnl = u.pn & 7, cc = pnl * 128 + wc * 32 + 8 * fq;
        const float* bp = b1 + (size_t)e * 2048 + cc;
        const f32x4 bg0 = *(const f32x4*)bp, bg1 = *(const f32x4*)(bp + 4), bl0 = *(const f32x4*)(bp + 1024), bl1 = *(const f32x4*)(bp + 1028);
        float lim = 7.0f; asm volatile("" : "+v"(lim));
#pragma unroll
        for (int ai = 0; ai < 2; ++ai)
#pragma unroll
            for (int m = 0; m < 4; ++m) { const int row = row00 + ai * HALF + m * 16;
                EPI_GET8(g, ai, 0, m); EPI_GET8(l, ai, 1, m); float r[8];
#pragma unroll
                for (int i = 0; i < 8; ++i) { float glu = g[i] + (i < 4 ? bg0[i] : bg1[i - 4]); float lin = l[i] + (i < 4 ? bl0[i] : bl1[i - 4]);
                    glu = fminf(glu, lim); lin = fminf(fmaxf(lin, -lim), lim);
                    r[i] = glu * sigmoidf_(1.702f * glu) * (lin + 1.0f); }
                *(u32x4*)(H + (size_t)row * 1024 + cc) = pack8(r); }
    }
};

struct EpiMoe2 {
    static constexpr bool PERM = true, AFTER_DRAIN = false;
    bf16_t* Yp; const float* b2; const float* lw; const PG8_LAS int* tab;
    __device__ __forceinline__ void operator()(const f32x4 (&acc)[2][2][4][2], const Unit& u, int wr, int wc, int fr, int fq) const {
        asm volatile("" : "+v"(fr), "+v"(fq));
        EPI_ROWS(u, wr, fr); const int e = u.pn >> 2, pnl = u.pn & 3, col0 = pnl * BM + wc * 32 + 8 * fq;
        f32x4 bv[2][2];
#pragma unroll
        for (int bj = 0; bj < 2; ++bj) { bv[bj][0] = *(const f32x4*)(b2 + (size_t)e * 1024 + col0 + bj * HALF); bv[bj][1] = *(const f32x4*)(b2 + (size_t)e * 1024 + col0 + bj * HALF + 4); }
        float wrow[2][4]; { const int ps_ = tab[600 + e], cn_ = tab[640 + e];
#pragma unroll
            for (int ai = 0; ai < 2; ++ai)
#pragma unroll
                for (int m = 0; m < 4; ++m) { const int slot = row00 + ai * HALF + m * 16 - ps_; wrow[ai][m] = lw[(size_t)e * TA + (slot < cn_ ? slot : 0)]; if (slot >= cn_) wrow[ai][m] = 0.f; } }
#pragma unroll
        for (int ai = 0; ai < 2; ++ai)
#pragma unroll
            for (int m = 0; m < 4; ++m) { const int row = row00 + ai * HALF + m * 16; const float w = wrow[ai][m];
#pragma unroll
                for (int bj = 0; bj < 2; ++bj) { EPI_GET8(v, ai, bj, m); float r[8];
#pragma unroll
                    for (int i = 0; i < 8; ++i) r[i] = (v[i] + (i < 4 ? bv[bj][0][i] : bv[bj][1][i - 4])) * w;
                    *(u32x4*)(Yp + (size_t)row * 1024 + col0 + bj * HALF) = pack8(r); } }
    }
};

template <int NPN> struct MoeOrder {
    int nunits, G, v; const PG8_LAS int* tab; const PG8_LAS int* rowtok;
    __device__ __forceinline__ int tok(int i, int r) const { return rowtok[i * 256 + r]; }
    __device__ __forceinline__ bool next(int i, Unit& u) const {
        const long L = (long)i * G + v; if (L >= nunits) return false;
        const int blk = (int)L / NPN, pnl = (int)L % NPN; const int e = __builtin_amdgcn_readfirstlane(tab[blk]);
        u.pm = blk; u.pn = e * NPN + pnl; return true;
    }
    __device__ __forceinline__ void a_ready(const Unit&) const {}
    __device__ __forceinline__ void done(const Unit&) const {}
};
}
namespace attn_body {
using bf16x8=__attribute__((ext_vector_type(8)))short;
using s16x4=__attribute__((ext_vector_type(4)))short;
using f32x16=__attribute__((ext_vector_type(16)))float;
using u32x4=__attribute__((ext_vector_type(4)))unsigned;
constexpr int NW=8,QBLK=32,QB=QBLK*NW,KVBLK=64;
__device__ __forceinline__ int crow(int r,int hi){return (r&3)+8*(r>>2)+4*hi;}
#define SBAR() __builtin_amdgcn_sched_barrier(0)
constexpr int NSLOT=3, SLOTB=8192;
__device__ __forceinline__ void glds16(const void*gsrc,unsigned lds_dst){unsigned keep;
  asm volatile("s_mov_b32 %0, m0\n\ts_mov_b32 m0, %2\n\ts_nop 0\n\tglobal_load_lds_dwordx4 %1, off\n\ts_mov_b32 m0, %0":"=&s"(keep):"v"(gsrc),"s"(lds_dst):"memory");}
__device__ __forceinline__ float max3f(float a,float b,float c){float r;asm("v_max3_f32 %0, %1, %2, %3":"=v"(r):"v"(a),"v"(b),"v"(c));return r;}
__device__ __forceinline__ float max2f(float a,float b){float r;asm("v_max_f32_e32 %0, %1, %2":"=v"(r):"v"(a),"v"(b));return r;}
__device__ __forceinline__ float fadd_s(float a,float b){float r;asm("v_add_f32_e32 %0, %1, %2":"=v"(r):"v"(a),"v"(b));return r;}
__device__ __forceinline__ float fsub_s(float a,float b){float r;asm("v_sub_f32_e32 %0, %1, %2":"=v"(r):"v"(a),"v"(b));return r;}
typedef float f32x2_t __attribute__((ext_vector_type(2))); typedef __bf16 bf16x2_t __attribute__((ext_vector_type(2)));
__device__ __forceinline__ unsigned cvtpk_s(float lo,float hi){f32x2_t v={lo,hi};bf16x2_t b=__builtin_convertvector(v,bf16x2_t);return __builtin_bit_cast(unsigned,b);}
#define WAIT_BAR(N) asm volatile("s_waitcnt vmcnt(" #N ") lgkmcnt(0)\n\ts_barrier":::"memory")
typedef __attribute__((address_space(3))) const char* lds_cptr;
typedef short v4i16_t __attribute__((ext_vector_type(4)));
__device__ __forceinline__ void kload2(bf16x8*kf,lds_cptr kp,int j){ kf[2*j]=*(const __attribute__((address_space(3))) bf16x8*)(kp+j*2048); kf[2*j+1]=*(const __attribute__((address_space(3))) bf16x8*)(kp+j*2048+512); }
__device__ __forceinline__ s16x4 vtr(lds_cptr p){ return __builtin_bit_cast(s16x4,__builtin_amdgcn_ds_read_tr16_b64_v4i16((__attribute__((address_space(3))) v4i16_t*)p)); }
__device__ __forceinline__ float rowmax(const f32x16&p0,const f32x16&p1){
  float a=max3f(p0[0],p0[1],p1[0]),b=max3f(p0[2],p0[3],p1[1]);a=max3f(a,p1[2],p1[3]);
  #pragma unroll
  for(int r=4;r<16;r+=4){a=max3f(a,p0[r],p0[r+1]);b=max3f(b,p0[r+2],p0[r+3]);a=max3f(a,p1[r],p1[r+1]);b=max3f(b,p1[r+2],p1[r+3]);}
  const float m=max2f(a,b);
  auto rr=__builtin_amdgcn_permlane32_swap(__float_as_uint(m),__float_as_uint(m),false,false);
  return max2f(__uint_as_float(rr[0]),__uint_as_float(rr[1]));
}
__device__ __forceinline__ void pv(f32x16*o,int vb,bf16x8 pa0,bf16x8 pa1,bf16x8 pa2,bf16x8 pa3){
  #pragma unroll
  for(int d0=0;d0<2;++d0){s16x4 lo[4],hi[4];
    #pragma unroll
    for(int ks=0;ks<4;++ks){
      asm volatile("ds_read_b64_tr_b16 %0,%1 offset:%c2":"=&v"(lo[ks]):"v"(vb),"i"(d0*4096+ks*1024):"memory");
      asm volatile("ds_read_b64_tr_b16 %0,%1 offset:%c2":"=&v"(hi[ks]):"v"(vb),"i"(d0*4096+ks*1024+512):"memory");}
    asm volatile("s_waitcnt lgkmcnt(0)":::"memory");SBAR();
    #define PK(k) (bf16x8){lo[k][0],lo[k][1],lo[k][2],lo[k][3],hi[k][0],hi[k][1],hi[k][2],hi[k][3]}
    o[d0]=__builtin_amdgcn_mfma_f32_32x32x16_bf16(pa0,PK(0),o[d0],0,0,0);
    o[d0]=__builtin_amdgcn_mfma_f32_32x32x16_bf16(pa1,PK(1),o[d0],0,0,0);
    o[d0]=__builtin_amdgcn_mfma_f32_32x32x16_bf16(pa2,PK(2),o[d0],0,0,0);
    o[d0]=__builtin_amdgcn_mfma_f32_32x32x16_bf16(pa3,PK(3),o[d0],0,0,0);
    #undef PK
  }
}
template<int NKS> struct AttnLds {
  static constexpr int SLOTK=NKS*2048;
  static constexpr int LDS_K=0, LDS_V=NSLOT*SLOTK, LDS_WS=LDS_V+NSLOT*SLOTB, LDS_OST=LDS_WS+NW*64*4, LDS_BYTES=LDS_OST+NW*4096;
};
template<int NKS,int QP,int KP,int VP,int OP,int THRL,bool LS,bool SK>
__device__ __forceinline__ void attn_unit(const bf16*Qu,const bf16*__restrict__ Ku,const bf16*__restrict__ Vu,bf16*Ou,const int NT,char*shm){
  using L=AttnLds<NKS>;
  constexpr int SLOTK=L::SLOTK, LDS_K=L::LDS_K, LDS_V=L::LDS_V, LDS_WS=L::LDS_WS, LDS_OST=L::LDS_OST;
  int tid_=threadIdx.x; asm volatile("":"+v"(tid_));
  const int tid=tid_,lane=tid&63,r32=lane&31,hi=lane>>5; const int wid=__builtin_amdgcn_readfirstlane(tid>>6);
  const bf16*Qw=Qu+(long)(wid*QBLK)*QP;
  const unsigned lds0=(unsigned)(uintptr_t)shm;
  float*wsf=(float*)(shm+LDS_WS)+wid*64;
  const bf16*ksrc=Ku+wid*512+lane*8;
  const bf16*ksrc2=Ku+(8+(wid&3))*512+lane*8;
  const bf16*vsrc=Vu+wid*512+lane*8;
  const unsigned kdst=lds0+LDS_K+wid*1024, kdst2=lds0+LDS_K+(8+(wid&3))*1024, vdst=lds0+LDS_V+wid*1024;
  #define DMA_K(t,slot) do{ glds16(ksrc+(long)(t)*(NKS*1024),(unsigned)__builtin_amdgcn_readfirstlane(kdst+(slot))); \
      if constexpr(NKS==6){ glds16(ksrc2+(long)(t)*(NKS*1024),(unsigned)__builtin_amdgcn_readfirstlane(kdst2+(slot))); } }while(0)
  #define DMA_V(t,slot) glds16(vsrc+(long)(t)*4096,(unsigned)__builtin_amdgcn_readfirstlane(vdst+(slot)))
  #define WAIT_C()  do{ if constexpr(NKS==6){WAIT_BAR(3);}else{WAIT_BAR(2);} }while(0)
  #define WAIT_P()  do{ if constexpr(NKS==6){WAIT_BAR(5);}else{WAIT_BAR(3);} }while(0)
  #define WAITA_K() do{ if constexpr(NKS==6){WAIT_BAR(2);}else{WAIT_BAR(1);} }while(0)
  #define BARONLY() asm volatile("s_barrier":::"memory")
  const int vb0=(int)(lds0+LDS_V)+((lane>>4)&1)*32+(lane&3)*8+(4*hi+((lane&15)>>2))*64;
  const char*Kbase=shm+LDS_K; bf16x8 kf[2*NKS];
  const lds_cptr shm3=(lds_cptr)shm; const lds_cptr kp0=shm3+LDS_K+hi*1024+r32*16; const lds_cptr vp0=shm3+LDS_V+((lane>>4)&1)*32+(lane&3)*8+(4*hi+((lane&15)>>2))*64;
  DMA_K(0,0);DMA_V(0,0);DMA_K(1,SLOTK);
  bf16x8 qr[NKS];
  #pragma unroll
  for(int d0=0;d0<NKS;++d0)qr[d0]=*reinterpret_cast<const bf16x8*>(&Qw[(long)r32*QP+d0*16+hi*8]);
  float mhat=0.f,l_reg=0.f;f32x16 o[2];o[0]=f32x16{};o[1]=f32x16{};f32x16 negm=f32x16{};asm volatile("":"+v"(negm));
  f32x16 o2=f32x16{}; const bf16x8 ONES=(bf16x8){(short)0x3F80,(short)0x3F80,(short)0x3F80,(short)0x3F80,(short)0x3F80,(short)0x3F80,(short)0x3F80,(short)0x3F80};
  bool resc=false;
  #define START(P0,P1) do{ const float rm=rowmax(P0,P1); resc=false; \
    { const float dl=rm; mhat=fadd_s(mhat,dl); \
      _Pragma("unroll") for(int r=0;r<16;++r){P0[r]=fsub_s(P0[r],dl);P1[r]=fsub_s(P1[r],dl);} \
      _Pragma("unroll") for(int r=0;r<16;++r)negm[r]=-mhat; asm volatile("":"+v"(negm)); } \
    _Pragma("unroll") for(int r=0;r<16;++r)P0[r]=__builtin_amdgcn_exp2f(P0[r]); }while(0)
  #define RESC() do{ if(resc){ asm volatile("s_waitcnt lgkmcnt(0)":::"memory"); \
      _Pragma("unroll") for(int d_=0;d_<2;++d_) _Pragma("unroll") for(int r=0;r<16;++r)o[d_][r]*=wsf[crow(r,hi)]; \
      if constexpr(LS){ _Pragma("unroll") for(int r=0;r<16;++r)o2[r]*=wsf[crow(r,hi)]; } } }while(0)
  f32x16 pA0,pA1,pB0,pB1;
  int kl_cur=0,kl_next=SLOTK;
  int sl_prev=0,sl_cur=0,sl_next=SLOTB;
  #define ROT() do{sl_prev=sl_cur;sl_cur=sl_next;sl_next=(sl_next==(NSLOT-1)*SLOTB)?0:sl_next+SLOTB; kl_cur=kl_next;kl_next=(kl_next==(NSLOT-1)*SLOTK)?0:kl_next+SLOTK;}while(0)
  DMA_K(2,2*SLOTK);
  WAIT_P();
  { const char*kb=Kbase+hi*1024+r32*16;
    #pragma unroll
    for(int d0=0;d0<NKS;++d0){
      const bf16x8 b0=*reinterpret_cast<const bf16x8*>(kb+d0*2048);
      const bf16x8 b1=*reinterpret_cast<const bf16x8*>(kb+d0*2048+512);
      if(d0==0){pA0=__builtin_amdgcn_mfma_f32_32x32x16_bf16(b0,qr[0],negm,0,0,0);pA1=__builtin_amdgcn_mfma_f32_32x32x16_bf16(b1,qr[0],negm,0,0,0);}
      else{pA0=__builtin_amdgcn_mfma_f32_32x32x16_bf16(b0,qr[d0],pA0,0,0,0);pA1=__builtin_amdgcn_mfma_f32_32x32x16_bf16(b1,qr[d0],pA1,0,0,0);}} }
  asm volatile("s_nop 15\n\ts_nop 7":"+v"(pA0),"+v"(pA1));
  START(pA0,pA1);
  _Pragma("unroll") for(int r=0;r<16;++r)pA1[r]=__builtin_amdgcn_exp2f(pA1[r]);
  WAIT_BAR(0);
  if constexpr(SK){ DMA_V(1,SLOTB);DMA_K(3,0); } else { DMA_K(3,0);DMA_V(1,SLOTB); }
  ROT();
  _Pragma("unroll") for(int j=0;j<NKS;++j)kload2(kf,kp0+kl_cur,j);
  WAIT_C();
  if constexpr(SK){ if(wid>=4){ BARONLY(); } }
  s16x4 vlo[8],vhi[8]; u32x4 pw0,pw1,pw2,pw3;
  #define PKW(P,B) cvtpk_s(P[B],P[B+1])
  #define PAF(k) __builtin_bit_cast(bf16x8,pw##k)
  #define VFR(i) (bf16x8){vlo[i][0],vlo[i][1],vlo[i][2],vlo[i][3],vhi[i][0],vhi[i][1],vhi[i][2],vhi[i][3]}
  #define PIN(x) asm volatile("":"+v"(x))
  #define MX3(a,b,c) __builtin_fmaxf(__builtin_fmaxf((a),(b)),(c))
  #define GAPA(MF,A0,A1,A2,A3,W0,W1,PW) do{ MF; if constexpr(!LS){ sacc+=A0; sacc+=A1; sacc+=A2; sacc+=A3; PIN(sacc); } W0; W1; PIN(PW); SBAR(); }while(0)
  #define LSM(k) do{ if constexpr(LS){ o2=MF32(PAF(k),ONES,o2); SBAR(); } }while(0)
  #define EX(v) __builtin_amdgcn_exp2f(v)
  #define GAPB(MF,X,B) do{ MF; X[B]=EX(X[B]); X[B+1]=EX(X[B+1]); X[B+2]=EX(X[B+2]); X[B+3]=EX(X[B+3]); PIN(X); SBAR(); }while(0)
  #define VRD(i) do{ vlo[i]=vtr(vp_+(((i)>>2)*4096+((i)&3)*1024)); vhi[i]=vtr(vp_+(((i)>>2)*4096+((i)&3)*1024+512)); }while(0)
  #define KRD(G,j) do{ if(G){ kload2(kf,kp0+kl_next,j); SBAR(); } }while(0)
  #define MF32(a,b,c) __builtin_amdgcn_mfma_f32_32x32x16_bf16(a,b,c,0,0,0)
  #define STEP(C0,C1,P0,P1,t,GK,GV,GL,CK,MW) do{ SBAR(); \
    const lds_cptr vp_=vp0+sl_prev; \
    VRD(0); SBAR(); float sacc=LS?0.f:(P0[0]+P0[1]); \
    GAPA(C0=MF32(kf[0],qr[0],negm), P0[2],P0[3],P0[4],P0[5],     pw0[0]=PKW(P0,0), pw0[1]=PKW(P0,2), pw0); \
    VRD(4); SBAR(); GAPA(C1=MF32(kf[1],qr[0],negm), P0[6],P0[7],P0[8],P0[9],     pw0[2]=PKW(P0,4), pw0[3]=PKW(P0,6), pw0); \
    VRD(1); SBAR(); GAPA(C0=MF32(kf[2],qr[1],C0),   P0[10],P0[11],P0[12],P0[13], pw1[0]=PKW(P0,8), pw1[1]=PKW(P0,10), pw1); \
    VRD(5); SBAR(); GAPA(C1=MF32(kf[3],qr[1],C1),   P0[14],P0[15],P1[0],P1[1],   pw1[2]=PKW(P0,12),pw1[3]=PKW(P0,14), pw1); \
    VRD(2); SBAR(); GAPA(C0=MF32(kf[4],qr[2],C0),   P1[2],P1[3],P1[4],P1[5],     pw2[0]=PKW(P1,0), pw2[1]=PKW(P1,2), pw2); \
    VRD(6); SBAR(); GAPA(C1=MF32(kf[5],qr[2],C1),   P1[6],P1[7],P1[8],P1[9],     pw2[2]=PKW(P1,4), pw2[3]=PKW(P1,6), pw2); \
    VRD(3); SBAR(); GAPA(C0=MF32(kf[6],qr[3],C0),   P1[10],P1[11],P1[12],P1[13], pw3[0]=PKW(P1,8), pw3[1]=PKW(P1,10), pw3); \
    VRD(7); SBAR(); GAPA(C1=MF32(kf[7],qr[3],C1),   P1[14],P1[15],0.f,0.f,       pw3[2]=PKW(P1,12),pw3[3]=PKW(P1,14), pw3); \
    if constexpr(NKS==6){ C0=MF32(kf[8],qr[4],C0); SBAR(); C1=MF32(kf[9],qr[4],C1); SBAR(); C0=MF32(kf[10],qr[5],C0); SBAR(); C1=MF32(kf[11],qr[5],C1); SBAR(); } \
    if constexpr(!LS){ l_reg+=sacc; } \
    if constexpr(SK){ MW; if(GV){DMA_V((t)+1,sl_next);} if(GK){DMA_K((t)+3,kl_cur);} } else { if(GK){DMA_K((t)+3,kl_cur);} if(GV){DMA_V((t)+1,sl_next);} } \
    if(CK){ float a=MX3(C0[0],C0[1],C1[0]),b=MX3(C0[2],C0[3],C1[1]); a=MX3(a,C1[2],C1[3]); \
      _Pragma("unroll") for(int r=4;r<16;r+=4){a=MX3(a,C0[r],C0[r+1]);b=MX3(b,C0[r+2],C0[r+3]);a=MX3(a,C1[r],C1[r+1]);b=MX3(b,C1[r+2],C1[r+3]);} \
      float rm=__builtin_fmaxf(a,b); { auto rr=__builtin_amdgcn_permlane32_swap(__float_as_uint(rm),__float_as_uint(rm),false,false); rm=__builtin_fmaxf(__uint_as_float(rr[0]),__uint_as_float(rr[1])); } \
      resc=false; \
      if(__builtin_expect(__any(rm>(float)THRL),0)){ const float dl=__builtin_fmaxf(rm,0.f); mhat+=dl; \
        _Pragma("unroll") for(int r=0;r<16;++r){C0[r]-=dl;C1[r]-=dl;} \
        _Pragma("unroll") for(int r=0;r<16;++r)negm[r]=-mhat; asm volatile("":"+v"(negm)); \
        const float f=__builtin_amdgcn_exp2f(-dl); l_reg*=f; if(hi==0)wsf[r32]=f; resc=true; } } else { resc=false; } \
    SBAR(); \
    GAPB(o[0]=MF32(PAF(0),VFR(0),o[0]), C0,0); \
    GAPB(o[1]=MF32(PAF(0),VFR(4),o[1]), C0,4); LSM(0); \
    KRD(GL,0); GAPB(o[0]=MF32(PAF(1),VFR(1),o[0]), C0,8); \
    KRD(GL,1); GAPB(o[1]=MF32(PAF(1),VFR(5),o[1]), C0,12); LSM(1); \
    KRD(GL,2); GAPB(o[0]=MF32(PAF(2),VFR(2),o[0]), C1,0); \
    KRD(GL,3); GAPB(o[1]=MF32(PAF(2),VFR(6),o[1]), C1,4); LSM(2); \
    if constexpr(NKS==6){ KRD(GL,4); } GAPB(o[0]=MF32(PAF(3),VFR(3),o[0]), C1,8); \
    if constexpr(NKS==6){ KRD(GL,5); } GAPB(o[1]=MF32(PAF(3),VFR(7),o[1]), C1,12); LSM(3); \
    }while(0)
  int t=1;
  for(;t+11<NT;t+=8){
    STEP(pB0,pB1,pA0,pA1,t,true,true,true,true,WAITA_K());      WAIT_C(); RESC(); ROT();
    STEP(pA0,pA1,pB0,pB1,t+1,true,true,true,false,WAITA_K());   WAIT_C(); ROT();
    STEP(pB0,pB1,pA0,pA1,t+2,true,true,true,false,WAITA_K());   WAIT_C(); ROT();
    STEP(pA0,pA1,pB0,pB1,t+3,true,true,true,false,WAITA_K());   WAIT_C(); ROT();
    STEP(pB0,pB1,pA0,pA1,t+4,true,true,true,false,WAITA_K());   WAIT_C(); ROT();
    STEP(pA0,pA1,pB0,pB1,t+5,true,true,true,false,WAITA_K());   WAIT_C(); ROT();
    STEP(pB0,pB1,pA0,pA1,t+6,true,true,true,false,WAITA_K());   WAIT_C(); ROT();
    STEP(pA0,pA1,pB0,pB1,t+7,true,true,true,false,WAITA_K());   WAIT_C(); ROT();
  }
  for(;t+5<NT;t+=2){
    STEP(pB0,pB1,pA0,pA1,t,true,true,true,true,WAITA_K());     WAIT_C(); RESC(); ROT();
    STEP(pA0,pA1,pB0,pB1,t+1,true,true,true,true,WAITA_K());   WAIT_C(); RESC(); ROT();
  }
  #define ENDW(tt) do{ if constexpr(SK){ if((tt)+3<NT){WAIT_C();} else if((tt)+1<NT){WAIT_BAR(1);} else {WAIT_BAR(0);} } \
                       else { if((tt)+3<NT){WAIT_C();} else if((tt)+2<NT){WAIT_BAR(1);} else {WAIT_BAR(0);} } }while(0)
  #define ENDA(tt) do{ if((tt)+2<NT){WAITA_K();} else {WAIT_BAR(0);} }while(0)
  for(;t+1<NT;t+=2){
    STEP(pB0,pB1,pA0,pA1,t,(t+3<NT),(t+1<NT),(t+1<NT),true,ENDA(t));         ENDW(t);   RESC(); ROT();
    STEP(pA0,pA1,pB0,pB1,t+1,(t+4<NT),(t+2<NT),(t+2<NT),true,ENDA(t+1));     ENDW(t+1); RESC(); ROT();
  }
  STEP(pB0,pB1,pA0,pA1,NT-1,false,false,false,true,WAIT_BAR(0)); if constexpr(SK){ WAIT_BAR(0); } RESC();
  { if constexpr(!LS){ float sacc=pB0[0]+pB0[1]; _Pragma("unroll") for(int r=2;r<16;++r)sacc+=pB0[r]; _Pragma("unroll") for(int r=0;r<16;++r)sacc+=pB1[r]; l_reg+=sacc; }
    pw0=(u32x4){PKW(pB0,0),PKW(pB0,2),PKW(pB0,4),PKW(pB0,6)};pw1=(u32x4){PKW(pB0,8),PKW(pB0,10),PKW(pB0,12),PKW(pB0,14)};pw2=(u32x4){PKW(pB1,0),PKW(pB1,2),PKW(pB1,4),PKW(pB1,6)};pw3=(u32x4){PKW(pB1,8),PKW(pB1,10),PKW(pB1,12),PKW(pB1,14)};
    SBAR(); pv(o,vb0+sl_cur,PAF(0),PAF(1),PAF(2),PAF(3)); LSM(0); LSM(1); LSM(2); LSM(3); }
  if constexpr(SK){ if(wid<4){ BARONLY(); } }
  #undef PKW
  #undef PAF
  #undef VFR
  #undef PIN
  #undef MX3
  #undef GAPA
  #undef GAPB
  #undef EX
  #undef VRD
  #undef KRD
  #undef LSM
  #undef MF32
  #undef STEP
  #undef ENDW
  #undef ENDA
  float rli[16];
  if constexpr(LS){
    #pragma unroll
    for(int r=0;r<16;++r)rli[r]=__builtin_amdgcn_rcpf(o2[r]);
  } else {
    {auto rr=__builtin_amdgcn_permlane32_swap(__float_as_uint(l_reg),__float_as_uint(l_reg),false,false);l_reg=__uint_as_float(rr[0])+__uint_as_float(rr[1]);}
    if(hi==0)wsf[32+r32]=l_reg;asm volatile("s_waitcnt lgkmcnt(0)":::"memory");
    #pragma unroll
    for(int r=0;r<16;++r)rli[r]=__builtin_amdgcn_rcpf(wsf[32+crow(r,hi)]);
  }
  bf16*Ow=Ou+(long)(wid*QBLK)*OP;
  { bf16*stg=(bf16*)(shm+LDS_OST)+wid*2048;
    #pragma unroll
    for(int r=0;r<16;++r){const int orow=crow(r,hi);
      #pragma unroll
      for(int d0=0;d0<2;++d0)stg[orow*64+d0*32+r32]=(bf16)(cvtpk_s(o[d0][r]*rli[r],0.f)&0xffffu);}
    asm volatile("s_waitcnt lgkmcnt(0)":::"memory");
    #pragma unroll
    for(int i=0;i<4;++i){const int row=i*8+(lane>>3),ch=lane&7; const u32x4 v=*(const u32x4*)(stg+row*64+ch*8); *(u32x4*)(Ow+(long)row*OP+ch*8)=v;} }
  asm volatile("s_waitcnt lgkmcnt(0)\n\ts_barrier":::"memory");
  #undef DMA_K
  #undef DMA_V
  #undef WAIT_C
  #undef WAIT_P
  #undef WAITA_K
  #undef BARONLY
  #undef START
  #undef RESC
  #undef ROT
}
#undef SBAR
#undef WAIT_BAR
}
#define XB_TMO      128
#define XB_XCNT(j)  (256  + 64 * (j))
#define XB_XSUB(j)  (1280 + 64 * (j))
#define XB_XGEN(j)  (2304 + 64 * (j))
#define XB_TOP      3328
#define XB_TOPGEN   3392
#define XCD_BAR_WORDS 3456
#define XB_SPIN_CAP (1u << 20)

__device__ __forceinline__ unsigned xb_ld(unsigned* p)              { return __hip_atomic_load(p, __ATOMIC_RELAXED, __HIP_MEMORY_SCOPE_AGENT); }
__device__ __forceinline__ unsigned xb_add(unsigned* p, unsigned v) { return __hip_atomic_fetch_add(p, v, __ATOMIC_RELAXED, __HIP_MEMORY_SCOPE_AGENT); }
__device__ __forceinline__ unsigned xb_xcc_id() { return (unsigned)__builtin_amdgcn_s_getreg((3 << 11) | 20) & 0xFu; }
#define XB_SPIN(cond, bar) do { unsigned _sp = 0; while (cond) { __builtin_amdgcn_s_sleep(1); \
    if ((++_sp & 255u) == 0u) { if (xb_ld(&(bar)[XB_TMO])) break; if (_sp > XB_SPIN_CAP) { atomicAdd(&(bar)[XB_TMO], 1u); break; } } } } while (0)

struct XcdBarrier {
    unsigned* bar; unsigned x;
    volatile LAS unsigned* st;
};
__device__ __forceinline__ XcdBarrier xcd_barrier_post(unsigned* bar, volatile LAS unsigned* st) {
    XcdBarrier b; b.bar = bar; b.x = xb_xcc_id(); b.st = st;
    if (threadIdx.x == 0) (void)xb_add(&bar[XB_XCNT(b.x)], 1u);
    return b;
}
__device__ __forceinline__ void xcd_barrier_complete(unsigned* bar, unsigned x, unsigned& nloc, unsigned& nx) {
    const unsigned G = gridDim.x * gridDim.y * gridDim.z;
    unsigned sum, cnt, mine, sp = 0u;
    for (;;) {
        sum = 0u; cnt = 0u; mine = 0u;
        unsigned cj[16];
#pragma unroll
        for (unsigned j = 0; j < 16; ++j) cj[j] = xb_ld(&bar[XB_XCNT(j)]);
#pragma unroll
        for (unsigned j = 0; j < 16; ++j) { const unsigned c = cj[j]; sum += c; cnt += (c > 0u) ? 1u : 0u; mine = (j == x) ? c : mine; }
        if (sum == G) break;
        __builtin_amdgcn_s_sleep(1);
        if ((++sp & 255u) == 0u) { if (xb_ld(&bar[XB_TMO])) break; if (sp > XB_SPIN_CAP) { atomicAdd(&bar[XB_TMO], 1u); break; } }
    }
    nloc = mine > 0u ? mine : 1u; nx = cnt > 0u ? cnt : 1u;
}
__device__ __forceinline__ void xcd_barrier(const XcdBarrier& b) {
    asm volatile("s_waitcnt vmcnt(0)" ::: "memory");
    __syncthreads();
    if (threadIdx.x == 0) {
        unsigned* bar = b.bar;
        __builtin_amdgcn_s_waitcnt(0);
        unsigned nloc = b.st[0], nx = b.st[1];
        if (nloc == 0u) { xcd_barrier_complete(bar, b.x, nloc, nx); b.st[0] = nloc; b.st[1] = nx; }
        const unsigned old = xb_add(&bar[XB_XSUB(b.x)], 1u);
        const unsigned gen = old / nloc;
        if (old + 1u == (gen + 1u) * nloc) {
            __builtin_amdgcn_fence(__ATOMIC_RELEASE, "agent");
            asm volatile("s_waitcnt vmcnt(0)" ::: "memory");
            const unsigned og = xb_add(&bar[XB_TOP], 1u);
            const unsigned tg = og / nx;
            if (og + 1u == (tg + 1u) * nx) xb_add(&bar[XB_TOPGEN], 1u);
            else XB_SPIN(xb_ld(&bar[XB_TOPGEN]) == tg, bar);
            __builtin_amdgcn_fence(__ATOMIC_ACQUIRE, "agent");
            xb_add(&bar[XB_XGEN(b.x)], 1u);
            asm volatile("s_waitcnt vmcnt(0)" ::: "memory");
        } else {
            XB_SPIN(xb_ld(&bar[XB_XGEN(b.x)]) == gen, bar);
            __builtin_amdgcn_fence(__ATOMIC_ACQUIRE, "agent");
            asm volatile("s_waitcnt vmcnt(0)" ::: "memory");
        }
    }
    __syncthreads();
}

struct Args { const float* in[24]; float* out; unsigned char* ws; };
enum { I_X = 0, I_C, I_CTX, I_CCTX, I_WMOD, I_BMOD, I_NORMS, I_WIN, I_QKN, I_MQN, I_MKVN, I_WUQ, I_WUKV, I_GVN, I_GWS, I_GBS, I_WBR, I_WOUT, I_RW, I_RB, I_EW1, I_EB1, I_EW2, I_EB2 };

struct Frame {
    LAS unsigned char* lds;
    volatile LAS unsigned* MISC;
    gu32* ctl;
    int tid, lane, wave, G, bx;
    unsigned char* ws;
    __device__ __forceinline__ const float* in(int i) const { const unsigned long long v = __hip_atomic_load((const unsigned long long*)(ws + WS_PTAB) + i, __ATOMIC_RELAXED, __HIP_MEMORY_SCOPE_AGENT);
        const unsigned lo = __builtin_amdgcn_readfirstlane((unsigned)v), hi = __builtin_amdgcn_readfirstlane((unsigned)(v >> 32));
        return (const float*)(const GAS float*)(((unsigned long long)hi << 32) | lo); }
    __device__ __forceinline__ float* out() const { return (float*)in(24); }
};

__device__ __forceinline__ int map_col(int kind, int n) {
    if (kind == 1) { const int pn = n >> 8, c = n & 255, bj = (c >> 7) & 1, wc = (c >> 5) & 3, j = c & 31;
        if (pn < 2) return (4 * pn + wc) * 64 + 32 * bj + j;
        if (pn == 2) return 512 + wc * 64 + 32 * bj + j;
        if (pn == 3) return 768 + c;
        if (pn == 4) { if (wc < 2) return 1024 + wc * 64 + 32 * bj + j; if (wc == 2 && j < 16) return 1152 + 16 * bj + j; return -1; }
        if (pn < 9) return 1184 + (pn - 5) * 256 + c;
        return 2208 + (pn - 9) * 256 + c; }
    if (kind == 2) { if (n < 512) return (n >> 6) * 96 + (n & 63); const int t = n - 512; return ((t & 127) >> 4) * 96 + 64 + 16 * (t >> 7) + (t & 15); }
    if (kind == 3) { return ((n >> 7) & 1) * 1024 + (n >> 8) * 128 + (n & 127); }
    return n;
}
__device__ __forceinline__ void transpose_item(const float* W, int K, int Nsrc, bf16* WT, int nblk, int kind, LAS float* scr, int item, int lane) {
    const int kb = item / nblk, nb = item % nblk, k0 = 64 * kb, n0 = 64 * nb;
    const int src = map_col(kind, n0 + 4 * (lane & 15));
    f32x4 v[16];
#pragma unroll
    for (int i = 0; i < 16; ++i) { const int kk = 4 * i + (lane >> 4); v[i] = (src >= 0) ? *(const f32x4*)(W + (size_t)(k0 + kk) * Nsrc + src) : (f32x4){0.f, 0.f, 0.f, 0.f}; }
#pragma unroll
    for (int i = 0; i < 16; ++i) { const int kk = 4 * i + (lane >> 4); LAS float* d = scr + kk * 65 + 4 * (lane & 15); d[0] = v[i][0]; d[1] = v[i][1]; d[2] = v[i][2]; d[3] = v[i][3]; }
    LDS_WAIT(); asm volatile("" ::: "memory");
    const int c = lane & 7;
#pragma unroll
    for (int j = 0; j < 8; ++j) { const int n = (lane >> 3) + 8 * j; const LAS float* s = scr + (8 * c) * 65 + n;
        v4u o; o.x = cvt_pk(s[0 * 65], s[1 * 65]); o.y = cvt_pk(s[2 * 65], s[3 * 65]); o.z = cvt_pk(s[4 * 65], s[5 * 65]); o.w = cvt_pk(s[6 * 65], s[7 * 65]);
        *(GAS v4u*)(WT + (size_t)(n0 + n) * K + k0 + 8 * c) = o; }
    LDS_WAIT(); asm volatile("" ::: "memory");
}
__device__ __forceinline__ void sincos_acc(float ang, float& c, float& s) {
    const double x = (double)ang; const double n = __builtin_rint(x * 0.6366197723675814);
    double r = __builtin_fma(-n, 1.5707963267948966, x); r = __builtin_fma(-n, 6.123233995736766e-17, r);
    const double r2 = r * r;
    double sp = -2.5052108385441720e-08; sp = sp * r2 + 2.7557319223985893e-06; sp = sp * r2 - 1.9841269841269841e-04; sp = sp * r2 + 8.3333333333333332e-03; sp = sp * r2 - 1.6666666666666666e-01; sp = sp * r2 * r + r;
    double cp = 2.0876756987868099e-09; cp = cp * r2 - 2.7557319223985888e-07; cp = cp * r2 + 2.4801587301587302e-05; cp = cp * r2 - 1.3888888888888889e-03; cp = cp * r2 + 4.1666666666666664e-02; cp = cp * r2 - 0.5; cp = cp * r2 + 1.0;
    const int q = ((int)n) & 3;
    const double sv = (q == 0) ? sp : (q == 1) ? cp : (q == 2) ? -sp : -cp;
    const double cv = (q == 0) ? cp : (q == 1) ? -sp : (q == 2) ? -cp : sp;
    c = (float)cv; s = (float)sv;
}

__device__ __forceinline__ void p_prologue(Frame& F, const Args& A) {
    const int gw = F.bx * 8 + F.wave, NGW = F.G * 8, lane = F.lane;
    if (F.bx == 0 && F.tid < 25) { ((unsigned long long*)(F.ws + WS_PTAB))[F.tid] = (F.tid < 24) ? (unsigned long long)(uintptr_t)A.in[F.tid] : (unsigned long long)(uintptr_t)A.out; }
    { LAS float* sv = (LAS float*)(F.lds + LDS_SVEC);
      for (int i = F.tid; i < 3 * 1024; i += 512) { const float v = (i < 2048) ? A.in[I_C][i] : A.in[I_CCTX][i - 2048]; sv[i] = v * sigmoidf_(v); }
      __syncthreads(); }
    { const LAS float* sv = (const LAS float*)(F.lds + LDS_SVEC); float* mod = (float*)(F.ws + WS_MOD); LAS float* red = (LAS float*)(F.lds + RING_OFF);
      for (int item = F.bx; item < DEPTH * 96; item += F.G) { const int l = item / 96, col0 = (item % 96) * 64, c4 = (lane & 15) * 4, kr = lane >> 4;
          const float* W = A.in[I_WMOD] + (size_t)l * 1024 * 6144 + col0 + c4; f32x4 a0 = {0.f, 0.f, 0.f, 0.f}, a1 = a0, a2 = a0;
#pragma unroll
          for (int j0 = 0; j0 < 32; j0 += 16) { f32x4 w[16];
#pragma unroll
              for (int j = 0; j < 16; ++j) { const int k = 128 * F.wave + 4 * (j0 + j) + kr; w[j] = *(const f32x4*)(W + (size_t)k * 6144); }
#pragma unroll
              for (int j = 0; j < 16; ++j) { const int k = 128 * F.wave + 4 * (j0 + j) + kr; const float s0 = sv[k], s1 = sv[1024 + k], s2 = sv[2048 + k];
#pragma unroll
                  for (int c = 0; c < 4; ++c) { a0[c] += s0 * w[j][c]; a1[c] += s1 * w[j][c]; a2[c] += s2 * w[j][c]; } } }
#pragma unroll
          for (int c = 0; c < 4; ++c) { a0[c] += __shfl_xor(a0[c], 16); a1[c] += __shfl_xor(a1[c], 16); a2[c] += __shfl_xor(a2[c], 16); a0[c] += __shfl_xor(a0[c], 32); a1[c] += __shfl_xor(a1[c], 32); a2[c] += __shfl_xor(a2[c], 32); }
          if (lane < 16) {
#pragma unroll
              for (int c = 0; c < 4; ++c) { red[(F.wave * 3 + 0) * 64 + c4 + c] = a0[c]; red[(F.wave * 3 + 1) * 64 + c4 + c] = a1[c]; red[(F.wave * 3 + 2) * 64 + c4 + c] = a2[c]; } }
          __syncthreads();
          if (F.tid < 192) { const int who = F.tid >> 6, c = F.tid & 63; float sm = 0.f;
#pragma unroll
              for (int w8 = 0; w8 < 8; ++w8) sm += red[(w8 * 3 + who) * 64 + c];
              mod[(size_t)l * 3 * 6144 + (size_t)who * 6144 + col0 + c] = sm + A.in[I_BMOD][l * 6144 + col0 + c]; }
          __syncthreads(); } }
    { float* cg = (float*)(F.ws + WS_COSG); float* sg = (float*)(F.ws + WS_SING); float* cm = (float*)(F.ws + WS_COSM); float* sm = (float*)(F.ws + WS_SINM);
      const int gt = F.bx * 512 + F.tid, NT_ = F.G * 512;
      for (int i = gt; i < SEQ * 48; i += NT_) { const int pos = i / 48, j = i % 48; const float rowf = (float)(pos >> 6), colf = (float)(pos & 63); float c, s;
          if (j < 32) { const float ang = (j < 16) ? rowf * INVF16[j] : colf * INVF16[j - 16]; sincos_acc(ang, c, s); cg[pos * 32 + j] = c; sg[pos * 32 + j] = s; }
          else { const int jj = j - 32; const float ang = (jj < 8) ? rowf * INVF16[2 * jj] : colf * INVF16[2 * (jj - 8)]; sincos_acc(ang, c, s); cm[pos * 16 + jj] = c; sm[pos * 16 + jj] = s; } } }
    { bf16* wsb = (bf16*)(F.ws + WS_WS); const float* src = A.in[I_GWS]; const int gt = F.bx * 512 + F.tid, NT_ = F.G * 512;
      for (int i = gt; i < DEPTH * 8 * 128 * 128 / 2; i += NT_) { ((unsigned*)wsb)[i] = cvt_pk(src[2 * i], src[2 * i + 1]); } }
    { bf16* rwt = (bf16*)(F.ws + WS_RWT); const float* src = A.in[I_RW]; const int gt = F.bx * 512 + F.tid, NT_ = F.G * 512;
      for (int i = gt; i < DEPTH * 32 * 1024; i += NT_) { const int l = i >> 15, e = (i >> 10) & 31, d = i & 1023; const float w = src[(size_t)l * 32768 + d * 32 + e];
          const unsigned h16 = cvt_pk(w, 0.f) & 0xffffu; const float back = __uint_as_float(h16 << 16);
          rwt[(size_t)l * 65536 + e * 1024 + d] = (bf16)h16; rwt[(size_t)l * 65536 + 32768 + e * 1024 + d] = (bf16)(cvt_pk(w - back, 0.f) & 0xffffu); } }
    { LAS float* scr = (LAS float*)(F.lds + RING_OFF + F.wave * 16640);
      constexpr int I_IN = 16 * 84, I_UQ = 4 * 12, I_UKV = 2 * 16, I_BR = 8 * 16, I_OUT = 16 * 16;
      constexpr int PER_LAYER = I_IN + I_UQ + I_UKV + 3 * I_BR + I_OUT;
      for (int it = gw; it < DEPTH * PER_LAYER; it += NGW) { const int l = it / PER_LAYER; int r = it % PER_LAYER;
          if (r < I_IN) { transpose_item(A.in[I_WIN] + (size_t)l * 1024 * 5280, 1024, 5280, (bf16*)(F.ws + WS_WIN) + (size_t)l * ZW * 1024, 84, 1, scr, r, lane); continue; } r -= I_IN;
          if (r < I_UQ) { transpose_item(A.in[I_WUQ] + (size_t)l * 256 * 768, 256, 768, (bf16*)(F.ws + WS_WUQ) + (size_t)l * 768 * 256, 12, 2, scr, r, lane); continue; } r -= I_UQ;
          if (r < I_UKV) { transpose_item(A.in[I_WUKV] + (size_t)l * 128 * 1024, 128, 1024, (bf16*)(F.ws + WS_WUKV) + (size_t)l * 1024 * 128, 16, 0, scr, r, lane); continue; } r -= I_UKV;
          if (r < 3 * I_BR) { const int i = r / I_BR; transpose_item(A.in[I_WBR] + (size_t)(l * 3 + i) * 512 * 1024, 512, 1024, (bf16*)(F.ws + WS_WBR) + (size_t)(l * 3 + i) * 1024 * 512, 16, 0, scr, r % I_BR, lane); continue; } r -= 3 * I_BR;
          { transpose_item(A.in[I_WOUT] + (size_t)l * 1024 * 1024, 1024, 1024, (bf16*)(F.ws + WS_WOUT) + (size_t)l * 1024 * 1024, 16, 0, scr, r, lane); } } }
}

constexpr int BG_W1 = 16 * 32, BG_W2 = 16 * 16, BG_PER_LAYER = 32 * (BG_W1 + BG_W2);
__device__ __forceinline__ void bg_item(Frame& F, int l, int r) {
    LAS float* scr = (LAS float*)(F.lds + RING_OFF + F.wave * 16640);
    if (r < 32 * BG_W1) { const int e = r / BG_W1; transpose_item(F.in(I_EW1) + (size_t)(l * 32 + e) * 1024 * 2048, 1024, 2048, (bf16*)(F.ws + WS_W1) + (size_t)(l * 32 + e) * 2048 * 1024, 32, 3, scr, r % BG_W1, F.lane); }
    else { r -= 32 * BG_W1; const int e = r / BG_W2; transpose_item(F.in(I_EW2) + (size_t)(l * 32 + e) * 1024 * 1024, 1024, 1024, (bf16*)(F.ws + WS_W2) + (size_t)(l * 32 + e) * 1024 * 1024, 16, 0, scr, r % BG_W2, F.lane); }
}
__device__ __forceinline__ void bg_site(Frame& F, int l, int lo, int hi, int nunits, int c) {
    const int r = nunits % F.G; int widx, nw;
    if (r == 0) { widx = c * 8 + F.wave; nw = F.G * 8; } else { if (c < r) return; widx = (c - r) * 8 + F.wave; nw = (F.G - r) * 8; }
#pragma unroll 1
    for (int it = lo + widx; it < hi; it += nw) bg_item(F, l, it);
}

__device__ __forceinline__ void mod_row_to_bf16(const float* xrow, const float* gain, const float* sc, const float* sh, bf16* orow, int lane) {
    const f32x4* xr = (const f32x4*)xrow + lane; f32x4 v[4], g[4], s[4], h[4]; float ss = 0.f;
#pragma unroll
    for (int j = 0; j < 4; ++j) { v[j] = xr[64 * j]; g[j] = ((const f32x4*)gain)[64 * j + lane]; s[j] = ((const f32x4*)sc)[64 * j + lane]; h[j] = ((const f32x4*)sh)[64 * j + lane]; }
#pragma unroll
    for (int j = 0; j < 4; ++j) ss += (v[j].x * v[j].x + v[j].y * v[j].y) + (v[j].z * v[j].z + v[j].w * v[j].w);
    const float rstd = __builtin_amdgcn_rsqf(wave_sum(ss) * (1.f / DM) + RMS_EPS);
    unsigned long long* o8 = (unsigned long long*)orow + lane;
#pragma unroll
    for (int j = 0; j < 4; ++j) { const float y0 = v[j].x * rstd * g[j].x * (1.f + s[j].x) + h[j].x, y1 = v[j].y * rstd * g[j].y * (1.f + s[j].y) + h[j].y, y2 = v[j].z * rstd * g[j].z * (1.f + s[j].z) + h[j].z, y3 = v[j].w * rstd * g[j].w * (1.f + s[j].w) + h[j].w;
        o8[64 * j] = (unsigned long long)cvt_pk(y0, y1) | ((unsigned long long)cvt_pk(y2, y3) << 32); }
}

typedef short bf16x8_t __attribute__((ext_vector_type(8)));
typedef float f32x16_t __attribute__((ext_vector_type(16)));
__device__ __forceinline__ void gmlp_unit(Frame& F, const float* gbs, const float* gvn, int l, int chunk, int nt) {
    const int lane = F.lane, g = F.wave, r32 = lane & 31, hi = lane >> 5;
    const bf16* vn = (const bf16*)(F.ws + WS_VN) + (size_t)chunk * 128 * 512 + g * 64; const float* ssv = (const float*)(F.ws + WS_SSV);
    const bf16* ua = (const bf16*)(F.ws + WS_UACT) + (size_t)chunk * 128 * 512 + g * 64;
    bf16* go = (bf16*)(F.ws + WS_GM) + (size_t)chunk * 128 * 512 + g * 64;
    const bf16* wsb = (const bf16*)(F.ws + WS_WS) + (size_t)(l * 8 + g) * 128 * 128;
    const float* bs = gbs + (size_t)(l * 8 + g) * 128;
    LAS bf16* vt = (LAS bf16*)(F.lds + RING_OFF + g * 19456); LAS bf16* ut = vt + 32 * 136; LAS float* bl = (LAS float*)(ut + 128 * 32);
    { const int dd = (lane & 3) * 8; const f32x4 ga = *(const f32x4*)(gvn + l * 512 + g * 64 + nt * 32 + dd), gb = *(const f32x4*)(gvn + l * 512 + g * 64 + nt * 32 + dd + 4);
      v4u raw[8], uraw[8]; float s0[8], s1[8];
#pragma unroll
      for (int ps = 0; ps < 8; ++ps) { const int q = ps * 16 + (lane >> 2); raw[ps] = *(const v4u*)(vn + (size_t)q * 512 + nt * 32 + dd); uraw[ps] = *(const v4u*)(ua + (size_t)q * 512 + nt * 32 + dd);
          const float* sp = ssv + ((size_t)chunk * 128 + q) * 2; s0[ps] = sp[0]; s1[ps] = sp[1]; }
      const float b0 = bs[lane], b1 = bs[64 + lane];
#pragma unroll
      for (int ps = 0; ps < 8; ++ps) { const int q = ps * 16 + (lane >> 2); float fv[8]; unpack8(raw[ps], fv);
          const float rstd = __builtin_amdgcn_rsqf((s0[ps] + s1[ps]) * (1.f / 512.f) + RMS_EPS);
#pragma unroll
          for (int i = 0; i < 8; ++i) vt[(dd + i) * 136 + q] = (bf16)(cvt_pk(fv[i] * rstd * (i < 4 ? ga[i] : gb[i - 4]), 0.f) & 0xffffu);
          *(LAS v4u*)(ut + q * 32 + dd) = uraw[ps]; }
      bl[lane] = b0; bl[64 + lane] = b1; }
    LDS_WAIT(); asm volatile("" ::: "memory");
#pragma unroll 1
    for (int mh = 0; mh < 2; ++mh) {
        f32x16_t acc[2]; acc[0] = (f32x16_t){}; acc[1] = (f32x16_t){};
        size_t zo = (size_t)mh * 64 * 128; asm volatile("" : "+v"(zo));
        const bf16* wsl = wsb + zo; bf16x8_t afr[8][2];
#pragma unroll
        for (int ks = 0; ks < 8; ++ks)
#pragma unroll
            for (int mt = 0; mt < 2; ++mt) afr[ks][mt] = *(const bf16x8_t*)(wsl + (size_t)(mt * 32 + r32) * 128 + ks * 16 + hi * 8);
#pragma unroll
        for (int ks = 0; ks < 8; ++ks) { const bf16x8_t bfr = *(const LAS bf16x8_t*)(vt + r32 * 136 + ks * 16 + hi * 8);
#pragma unroll
            for (int mt = 0; mt < 2; ++mt) acc[mt] = __builtin_amdgcn_mfma_f32_32x32x16_bf16(afr[ks][mt], bfr, acc[mt], 0, 0, 0); }
#pragma unroll
        for (int mt = 0; mt < 2; ++mt)
#pragma unroll
            for (int rg = 0; rg < 16; ++rg) { const int p = mh * 64 + mt * 32 + (rg & 3) + 8 * (rg >> 2) + 4 * hi;
                const float u = __uint_as_float((unsigned)ut[p * 32 + r32] << 16);
                go[(size_t)p * 512 + nt * 32 + r32] = (bf16)(cvt_pk(u * (acc[mt][rg] + bl[p]), 0.f) & 0xffffu); } }
    LDS_WAIT(); asm volatile("" ::: "memory");
}
constexpr int T3_REC_E = 0, T3_REC_W = 8192, T3_REC_S = 16384, T3_HIST = 24576, T3_BASE = T3_HIST + 128;
__device__ __forceinline__ void t3_phase(Frame& F, int l, int T_l, const float* xin_lat, const float* xin_ctx, int cofs, bool dry) {
    float* const outp = F.out();
    const int lane = F.lane, tid = F.tid;
    LAS int* rec_e = (LAS int*)(F.lds + RING_OFF + T3_REC_E); LAS float* rec_w = (LAS float*)(F.lds + RING_OFF + T3_REC_W); LAS int* rec_s = (LAS int*)(F.lds + RING_OFF + T3_REC_S);
    LAS int* hist = (LAS int*)(F.lds + RING_OFF + T3_HIST); LAS int* base = (LAS int*)(F.lds + RING_OFF + T3_BASE);
    if (tid < 32) hist[tid] = 0;
    const int per = (T_l + F.G - 1) / F.G; const int r0 = F.bx * per; int ntok = T_l - r0; ntok = ntok < 0 ? 0 : (ntok > per ? per : ntok);
    const float* norms = F.in(I_NORMS) + (size_t)l * 4 * 1024; const float* modl = (const float*)(F.ws + WS_MOD) + (size_t)l * 3 * 6144;
    const bf16* Y = (const bf16*)(F.ws + WS_Y); bf16* XN = (bf16*)(F.ws + (dry ? WS_H : WS_XN)); bf16* XNL = (bf16*)(F.ws + WS_MERGEB);
    bf16* XB = (bf16*)(F.ws + WS_XB);
    f32x4 g1v[4], gn1[4], gn2[4], scv[4], shv[4]; int cur_who = -1;
#pragma unroll
    for (int hq = 0; hq < 4; ++hq) { const int d0 = (hq >> 1) * 512 + 8 * lane + 4 * (hq & 1); gn1[hq] = *(const f32x4*)(norms + 1024 + d0); gn2[hq] = *(const f32x4*)(norms + 2048 + d0); }
    v4u yn[2] = {}, xbn[2] = {}; f32x4 xn4[4] = {};
#define T3_LOAD(JJ) do { const int r_ = r0 + (JJ); const v4u* yp_ = (const v4u*)(Y + (size_t)r_ * 1024); yn[0] = yp_[lane]; yn[1] = yp_[64 + lane]; \
        if (l != 0) { const v4u* xp_ = (const v4u*)(XB + (size_t)r_ * 1024); xbn[0] = xp_[lane]; xbn[1] = xp_[64 + lane]; } \
        else { const float* xrow_ = (r_ < TL) ? xin_lat + (size_t)r_ * 1024 : xin_ctx + (size_t)(r_ - TL) * 1024; \
            _Pragma("unroll") for (int hq = 0; hq < 4; ++hq) xn4[hq] = *(const f32x4*)(xrow_ + (hq >> 1) * 512 + 8 * lane + 4 * (hq & 1)); } } while (0)
    if (F.wave < ntok) T3_LOAD(F.wave);
#pragma unroll 1
    for (int j = F.wave; j < ntok; j += 8) {
        const int r = r0 + j; const bool lat = r < TL; const int who = lat ? (r >> 14) : 2;
        bf16* orow = (dry ? (bf16*)(F.ws + WS_H) + (size_t)TA * 1024 : XB) + (size_t)r * 1024;
        if (who != cur_who) { cur_who = who; const float* mo = modl + (size_t)who * 6144;
#pragma unroll
            for (int hq = 0; hq < 4; ++hq) { const int d0 = (hq >> 1) * 512 + 8 * lane + 4 * (hq & 1); g1v[hq] = *(const f32x4*)(mo + 2 * 1024 + d0); scv[hq] = *(const f32x4*)(mo + 4 * 1024 + d0); shv[hq] = *(const f32x4*)(mo + 3 * 1024 + d0); } }
        float yv[16], xv[16]; v4u yr[2], xb[2]; f32x4 xr4[4];
        yr[0] = yn[0]; yr[1] = yn[1]; xb[0] = xbn[0]; xb[1] = xbn[1];
#pragma unroll
        for (int hq = 0; hq < 4; ++hq) xr4[hq] = xn4[hq];
        if (j + 8 < ntok) T3_LOAD(j + 8);
        { float a[8], b[8]; unpack8(yr[0], a); unpack8(yr[1], b);
#pragma unroll
          for (int i = 0; i < 8; ++i) { yv[i] = a[i]; yv[8 + i] = b[i]; } }
        if (l == 0) {
#pragma unroll
            for (int hq = 0; hq < 4; ++hq)
#pragma unroll
                for (int i = 0; i < 4; ++i) xv[hq * 4 + i] = xr4[hq][i]; }
        else { float a[8], b[8]; unpack8(xb[0], a); unpack8(xb[1], b);
#pragma unroll
            for (int i = 0; i < 8; ++i) { xv[i] = a[i]; xv[8 + i] = b[i]; } }
        float ss = 0.f;
#pragma unroll
        for (int i = 0; i < 16; ++i) ss += yv[i] * yv[i];
        const float rstd = __builtin_amdgcn_rsqf(wave_sum(ss) * (1.f / DM) + RMS_EPS);
        float ss2 = 0.f;
#pragma unroll
        for (int hq = 0; hq < 4; ++hq) {
#pragma unroll
            for (int i = 0; i < 4; ++i) { const int k = hq * 4 + i; const float xn = xv[k] + g1v[hq][i] * (yv[k] * rstd * gn1[hq][i]); xv[k] = xn; ss2 += xn * xn; } }
        { float a[8], b[8];
#pragma unroll
          for (int i = 0; i < 8; ++i) { a[i] = xv[i]; b[i] = xv[8 + i]; }
          *(v4u*)(orow + 8 * lane) = pack8(a); *(v4u*)(orow + 512 + 8 * lane) = pack8(b); }
        const float rstd2 = __builtin_amdgcn_rsqf(wave_sum(ss2) * (1.f / DM) + RMS_EPS);
#pragma unroll
        for (int h = 0; h < 2; ++h) { float hi8[8], lo8[8];
#pragma unroll
            for (int q = 0; q < 2; ++q) { const int hq = h * 2 + q;
#pragma unroll
                for (int i = 0; i < 4; ++i) hi8[q * 4 + i] = xv[hq * 4 + i] * rstd2 * gn2[hq][i] * (1.f + scv[hq][i]) + shv[hq][i]; }
            const v4u ph = pack8(hi8); float back[8]; unpack8(ph, back);
#pragma unroll
            for (int i = 0; i < 8; ++i) lo8[i] = hi8[i] - back[i];
            *(v4u*)(XN + (size_t)r * 1024 + h * 512 + 8 * lane) = ph; *(v4u*)(XNL + (size_t)r * 1024 + h * 512 + 8 * lane) = pack8(lo8); }
    }
    asm volatile("s_waitcnt vmcnt(0)" ::: "memory");
    __syncthreads();
    { const int r32 = lane & 31, hi = lane >> 5, w = F.wave; const int ntiles = (ntok + 31) >> 5;
      if (w < ntiles) {
        const int tloc = 32 * w + r32; const int rr = r0 + (tloc < ntok ? tloc : ntok - 1);
        const bf16* whi = (const bf16*)(F.ws + WS_RWT) + (size_t)l * 2 * 32 * 1024 + (size_t)r32 * 1024 + hi * 8; const bf16* wlo = whi + 32 * 1024;
        const bf16* thi = XN + (size_t)rr * 1024 + hi * 8; const bf16* tlo = XNL + (size_t)rr * 1024 + hi * 8;
        f32x16_t acc = (f32x16_t){};
#pragma unroll 1
        for (int k0 = 0; k0 < 64; k0 += 8) {
            bf16x8_t ah[8], al[8], bh[8], bl[8];
#pragma unroll
            for (int u = 0; u < 8; ++u) { ah[u] = *(const bf16x8_t*)(whi + (k0 + u) * 16); al[u] = *(const bf16x8_t*)(wlo + (k0 + u) * 16); bh[u] = *(const bf16x8_t*)(thi + (k0 + u) * 16); bl[u] = *(const bf16x8_t*)(tlo + (k0 + u) * 16); }
#pragma unroll
            for (int u = 0; u < 8; ++u) { acc = __builtin_amdgcn_mfma_f32_32x32x16_bf16(ah[u], bh[u], acc, 0, 0, 0); acc = __builtin_amdgcn_mfma_f32_32x32x16_bf16(ah[u], bl[u], acc, 0, 0, 0); acc = __builtin_amdgcn_mfma_f32_32x32x16_bf16(al[u], bh[u], acc, 0, 0, 0); } }
        const float* rb = F.in(I_RB) + l * 32; float v[16]; float ninf = -INFINITY; asm volatile("" : "+v"(ninf));
#pragma unroll
        for (int i = 0; i < 16; ++i) v[i] = acc[i] + rb[(i & 3) + 8 * (i >> 2) + 4 * hi];
        float cm[8]; int cid[8];
#pragma unroll
        for (int k = 0; k < 4; ++k) { float m = v[0];
#pragma unroll
            for (int i = 1; i < 16; ++i) m = fmaxf(m, v[i]);
            int sel = 15;
#pragma unroll
            for (int i = 14; i >= 0; --i) sel = (v[i] == m) ? i : sel;
            sel = (v[15] == m && sel == 15) ? 15 : sel;
            cm[k] = m; cid[k] = (sel & 3) + 8 * (sel >> 2) + 4 * hi;
#pragma unroll
            for (int i = 0; i < 16; ++i) v[i] = (i == sel) ? ninf : v[i]; }
#pragma unroll
        for (int k = 0; k < 4; ++k) { cm[4 + k] = __shfl_xor(cm[k], 32); cid[4 + k] = __shfl_xor(cid[k], 32); }
        float tl[4]; int te[4];
#pragma unroll
        for (int k = 0; k < 4; ++k) { float best = cm[0]; int bid = cid[0]; int bc = 0;
#pragma unroll
            for (int c = 1; c < 8; ++c) { const bool better = (cm[c] > best) || (cm[c] == best && cid[c] < bid); best = better ? cm[c] : best; bid = better ? cid[c] : bid; bc = better ? c : bc; }
            tl[k] = best; te[k] = bid;
#pragma unroll
            for (int c = 0; c < 8; ++c) cm[c] = (c == bc) ? ninf : cm[c]; }
        const float e1 = __expf(tl[1] - tl[0]), e2 = __expf(tl[2] - tl[0]), e3 = __expf(tl[3] - tl[0]); const float inv = 1.f / (1.f + e1 + e2 + e3);
        if (hi == 0 && tloc < ntok) { const float wv[4] = {inv, e1 * inv, e2 * inv, e3 * inv};
#pragma unroll
            for (int k = 0; k < 4; ++k) { const int ls = __hip_atomic_fetch_add(&hist[te[k]], 1, __ATOMIC_RELAXED, __HIP_MEMORY_SCOPE_WORKGROUP);
                rec_e[tloc * 4 + k] = te[k]; rec_w[tloc * 4 + k] = wv[k]; rec_s[tloc * 4 + k] = ls; } }
      } }
    __syncthreads();
    if (tid < 32) { const int n = hist[tid]; base[tid] = n ? (int)__hip_atomic_fetch_add((unsigned*)(F.ctl + CW_CNT + cofs + l * 32 + tid), (unsigned)n, RLX_AGENT) : 0; }
    __syncthreads();
    { int* rte = (int*)(F.ws + WS_RTE); int* rts = (int*)(F.ws + WS_RTS); int* ltok = (int*)(F.ws + WS_LTOK); float* lw = (float*)(F.ws + WS_LW);
      for (int i = tid; i < ntok * 4; i += 512) { const int e = rec_e[i], slot = base[e] + rec_s[i]; const int r = r0 + (i >> 2);
          rte[(size_t)r * 4 + (i & 3)] = e; rts[(size_t)r * 4 + (i & 3)] = slot; ltok[(size_t)e * TA + slot] = r; lw[(size_t)e * TA + slot] = rec_w[i]; } }
}

__device__ __forceinline__ void moe_tables(Frame& F, int l, int cofs) {
    LAS int* tab = (LAS int*)(F.lds + LDS_TAB);
    if (F.tid == 0) { int nb = 0;
#pragma unroll 1
        for (int e = 0; e < 32; ++e) { const int c = (int)__hip_atomic_load((unsigned*)(F.ctl + CW_CNT + cofs + l * 32 + e), RLX_AGENT); const int n = (c + 255) >> 8; tab[600 + e] = nb * 256; tab[640 + e] = c;
            for (int b = 0; b < n; ++b) tab[nb + b] = e; nb += n; }
        tab[632] = nb; }
    __syncthreads();
}
__device__ __forceinline__ void t4_phase(Frame& F, int l, int T_l, bool dummy) {
    float* const outp = F.out();
    const bool nextmod = (l + 1 < DEPTH);
    const float* ngain = F.in(I_NORMS) + (size_t)(l + 1 < DEPTH ? l + 1 : l) * 4 * 1024; const float* nmod = (const float*)(F.ws + WS_MOD) + (size_t)(l + 1 < DEPTH ? l + 1 : l) * 3 * 6144; bf16* XN = (bf16*)(F.ws + WS_XN);
    const LAS int* tab = (const LAS int*)(F.lds + LDS_TAB); const int gw = F.bx * 8 + F.wave, NGW = F.G * 8, lane = F.lane;
    const int* rte = (const int*)(F.ws + WS_RTE); const int* rts = (const int*)(F.ws + WS_RTS); const bf16* Yp = (const bf16*)(F.ws + WS_BIG);
    const float* gain = F.in(I_NORMS) + (size_t)l * 4 * 1024 + 3 * 1024; const float* modl = (const float*)(F.ws + WS_MOD) + (size_t)l * 3 * 6144;
    f32x4 gv4[4], mv4[4], ng4[4], ns4[4], nh4[4]; int cur_who = -1;
#pragma unroll
    for (int hq = 0; hq < 4; ++hq) { const int d0 = (hq >> 1) * 512 + 8 * lane + 4 * (hq & 1); gv4[hq] = *(const f32x4*)(gain + d0); if (nextmod) ng4[hq] = *(const f32x4*)(ngain + d0); }
    v4u yn[4][2] = {}, xbn[2] = {}; int ren[4] = {0, 0, 0, 0}, rsn[4] = {0, 0, 0, 0};
#define T4_ROUTE(R) do { _Pragma("unroll") for (int k = 0; k < 4; ++k) { ren[k] = rte[(size_t)(R) * 4 + k]; rsn[k] = rts[(size_t)(R) * 4 + k]; } } while (0)
#define T4_DATA(R) do { _Pragma("unroll") for (int k = 0; k < 4; ++k) { const size_t dst_ = (size_t)(tab[600 + ren[k]] + rsn[k]); const v4u* yp_ = (const v4u*)(Yp + dst_ * 1024); yn[k][0] = yp_[lane]; yn[k][1] = yp_[64 + lane]; } \
        { const v4u* xp_ = (const v4u*)((const bf16*)(F.ws + WS_XB) + (size_t)(R) * 1024); xbn[0] = xp_[lane]; xbn[1] = xp_[64 + lane]; } } while (0)
    if (gw < T_l) { T4_ROUTE(gw); T4_DATA(gw); if (gw + NGW < T_l) T4_ROUTE(gw + NGW); }
#pragma unroll 1
    for (int r = gw; r < T_l; r += NGW) { const bool lat = r < TL; const int who = lat ? (r >> 14) : 2;
        bf16* xrow = (bf16*)(F.ws + WS_XB) + (size_t)r * 1024;
        if (who != cur_who) { cur_who = who; const float* g2 = modl + (size_t)who * 6144 + 5 * 1024; const float* mo = nmod + (size_t)who * 6144;
#pragma unroll
            for (int hq = 0; hq < 4; ++hq) { const int d0 = (hq >> 1) * 512 + 8 * lane + 4 * (hq & 1); mv4[hq] = *(const f32x4*)(g2 + d0); if (nextmod) { ns4[hq] = *(const f32x4*)(mo + 1024 + d0); nh4[hq] = *(const f32x4*)(mo + d0); } } }
        float f[16]; v4u yr[4][2], xb[2];
#pragma unroll
        for (int k = 0; k < 4; ++k) { yr[k][0] = yn[k][0]; yr[k][1] = yn[k][1]; }
        xb[0] = xbn[0]; xb[1] = xbn[1];
        if (r + NGW < T_l) { T4_DATA(r + NGW); if (r + 2 * NGW < T_l) T4_ROUTE(r + 2 * NGW); }
#pragma unroll
        for (int i = 0; i < 16; ++i) f[i] = 0.f;
#pragma unroll
        for (int k = 0; k < 4; ++k) { float a[8], b[8]; unpack8(yr[k][0], a); unpack8(yr[k][1], b);
#pragma unroll
            for (int i = 0; i < 8; ++i) { f[i] += a[i]; f[8 + i] += b[i]; } }
        float ss = 0.f;
#pragma unroll
        for (int i = 0; i < 16; ++i) ss += f[i] * f[i];
        const float rstd = __builtin_amdgcn_rsqf(wave_sum(ss) * (1.f / DM) + RMS_EPS);
        float ssn = 0.f; float xf[16];
        { float a[8], b[8]; unpack8(xb[0], a); unpack8(xb[1], b);
#pragma unroll
          for (int i = 0; i < 8; ++i) { xf[i] = a[i]; xf[8 + i] = b[i]; } }
#pragma unroll
        for (int hq = 0; hq < 4; ++hq) { const int d0 = (hq >> 1) * 512 + 8 * lane + 4 * (hq & 1); f32x4 xv;
#pragma unroll
            for (int i = 0; i < 4; ++i) { xv[i] = xf[hq * 4 + i] + mv4[hq][i] * (f[hq * 4 + i] * rstd * gv4[hq][i]); f[hq * 4 + i] = xv[i]; ssn += xv[i] * xv[i]; }
            if (!nextmod) *(f32x4*)((dummy ? (float*)(F.ws + WS_H) + (size_t)r * 1024 : outp + (size_t)r * 1024) + d0) = xv; }
        if (nextmod) { float a[8], b[8]; bf16* xo = dummy ? (bf16*)(F.ws + WS_H) + (size_t)r * 1024 : xrow;
#pragma unroll
            for (int i = 0; i < 8; ++i) { a[i] = f[i]; b[i] = f[8 + i]; }
            *(v4u*)(xo + 8 * lane) = pack8(a); *(v4u*)(xo + 512 + 8 * lane) = pack8(b); }
        if (nextmod) { const float rstdn = __builtin_amdgcn_rsqf(wave_sum(ssn) * (1.f / DM) + RMS_EPS);
#pragma unroll
            for (int h = 0; h < 2; ++h) { float y[8];
#pragma unroll
                for (int q = 0; q < 2; ++q) { const int hq = h * 2 + q;
#pragma unroll
                    for (int i = 0; i < 4; ++i) y[q * 4 + i] = f[hq * 4 + i] * rstdn * ng4[hq][i] * (1.f + ns4[hq][i]) + nh4[hq][i]; }
                *(v4u*)(XN + (size_t)r * 1024 + h * 512 + 8 * lane) = pack8(y); } } }
}

#ifndef PH_MASK
#define PH_MASK 0xFFFFFFFFu
#endif
#define PH(k) ((PH_MASK >> (k)) & 1u)
#ifndef PH_TWICE
#define PH_TWICE 0u
#endif
#ifndef BG_A
#define BG_A 5504
#endif
#ifndef BG_B
#define BG_B 19392
#endif
#ifndef BG_C
#define BG_C 23360
#endif
#ifndef BG_D
#define BG_D 4096
#endif
#ifndef BG_E
#define BG_E 8192
#endif
#ifndef BG_F
#define BG_F 13696
#endif
#define REP(k) _Pragma("unroll") for (int rep_ = 0; rep_ < (((PH_TWICE >> (k)) & 1u) ? 2 : 1); ++rep_)
__global__ void __launch_bounds__(512, 2) fwd_kernel(Args A) {
    extern __shared__ __attribute__((aligned(16))) unsigned char lds[];
    Frame F;
    F.lds = (LAS unsigned char*)lds; F.MISC = (volatile LAS unsigned*)(F.lds + MISC_OFF);
    F.tid = threadIdx.x; F.lane = F.tid & 63; F.wave = __builtin_amdgcn_readfirstlane(F.tid >> 6);
    F.G = gridDim.x; F.bx = blockIdx.x; F.ws = (unsigned char*)(GAS unsigned char*)(unsigned long long)(uintptr_t)A.ws; F.ctl = (gu32*)(A.ws + WS_CTL);
    int vcu = (F.G % 8 == 0) ? (F.bx % 8) * (F.G / 8) + F.bx / 8 : F.bx;
    if (F.tid < 64) F.MISC[F.tid] = 0u;
    __syncthreads();
    XcdBarrier bar = xcd_barrier_post((unsigned*)(F.ctl + CW_BAR), F.MISC + 8);
#define GRID_BAR() do { { unsigned* bp_ = (unsigned*)(F.ctl + CW_BAR); unsigned x_ = bar.x; asm volatile("" : "+s"(bp_), "+s"(x_)); bar.bar = bp_; bar.x = x_; } xcd_barrier(bar); \
        { int t_ = threadIdx.x; asm volatile("" : "+v"(t_)); F.tid = t_; F.lane = t_ & 63; unsigned long long w_ = (unsigned long long)(uintptr_t)A.ws; int g_ = gridDim.x, b_ = blockIdx.x; asm volatile("" : "+s"(w_), "+s"(g_), "+s"(b_)); \
          F.ws = (unsigned char*)(GAS unsigned char*)w_; ws = F.ws; F.ctl = (gu32*)(w_ + WS_CTL * 1ull); F.G = g_; F.bx = b_; vcu = (g_ % 8 == 0) ? (b_ % 8) * (g_ / 8) + b_ / 8 : b_; gw = b_ * 8 + F.wave; NGW = g_ * 8; } } while (0)
    int gw = F.bx * 8 + F.wave, NGW = F.G * 8;
    unsigned char* ws = F.ws;

    if (PH(0)) REP(0) p_prologue(F, A);
    GRID_BAR();

#pragma unroll
    for (int l = 0; l < DEPTH; ++l) {
        const int T_l = (l == 0) ? TA : TL;

        if (PH(1) && l == 0) REP(1) { const float* xin_lat = (l == 0) ? F.in(I_X) : F.out(); const float* xin_ctx = (l == 0) ? F.in(I_CTX) : (const float*)(ws + WS_XC);
          const float* norms = F.in(I_NORMS) + (size_t)l * 4 * 1024; const float* modl = (const float*)(ws + WS_MOD) + (size_t)l * 3 * 6144;
          for (int r = gw; r < TA; r += NGW) { const bool lat = r < TL; const int who = lat ? (r >> 14) : 2; const float* mo = modl + (size_t)who * 6144;
            mod_row_to_bf16(lat ? xin_lat + (size_t)r * 1024 : xin_ctx + (size_t)(r - TL) * 1024, norms, mo + 1024, mo, (bf16*)(ws + WS_XN) + (size_t)r * 1024, F.lane); } }
        if (l == 0) GRID_BAR();

        if (PH(2)) REP(2) { pg8::Gemm g{(const bf16*)(ws + WS_XN), (const bf16*)(ws + WS_WIN) + (size_t)l * ZW * 1024, TA, ZW, 1024}; pg8::StaticOrder S; S.init(TA, ZW, F.G, F.bx);
          pg8::EpiInproj E{ws, F.in(I_QKN) + (size_t)l * 128, F.in(I_MQN) + (size_t)l * 256, F.in(I_MKVN) + (size_t)l * 128, (LAS float*)(F.lds + LDS_X)};
          pg8::gemm_phase<pg8::EpiInproj, pg8::StaticOrder, true, true>(F.lds + RING_OFF, g, S, E); }
        __syncthreads(); bg_site(F, l, (l == 0) ? 0 : BG_E, (l == 0) ? BG_A : BG_F, (TA / 256) * (ZW / 256), F.bx);
        GRID_BAR();

        if (PH(4)) REP(4) { pg8::Gemm g{(const bf16*)(ws + WS_CQN), (const bf16*)(ws + WS_WUQ) + (size_t)l * 768 * 256, T_l, 768, 256}; pg8::StaticOrder S; S.init(T_l, 768, F.G, F.bx);
          pg8::EpiUq E{(bf16*)(ws + WS_QM), (const float*)(ws + WS_COSM), (const float*)(ws + WS_SINM)};
          pg8::gemm_phase<pg8::EpiUq, pg8::StaticOrder, true, true>(F.lds + RING_OFF, g, S, E); }
        if (PH(5)) REP(5) { pg8::Gemm g{(const bf16*)(ws + WS_CKVN), (const bf16*)(ws + WS_WUKV) + (size_t)l * 1024 * 128, TA, 1024, 128}; pg8::StaticOrder S; S.init(TA, 1024, F.G, (F.bx + F.G / 2) % F.G);
          pg8::EpiUkv E{(bf16*)(ws + WS_KM), (bf16*)(ws + WS_VM)};
          pg8::gemm_phase<pg8::EpiUkv, pg8::StaticOrder, true, true>(F.lds + RING_OFF, g, S, E); }
        if (PH(6)) REP(6) { const float* gbs = F.in(I_GBS); const float* gvn = F.in(I_GVN); for (int hu = (F.bx + F.G / 4) % F.G; hu < 2 * (T_l / 128); hu += F.G) gmlp_unit(F, gbs, gvn, l, hu >> 1, hu & 1); }
        GRID_BAR();

#define BG_ATTN(CEXPR) do { __syncthreads(); Frame F2 = F; { int t2_ = threadIdx.x; asm volatile("" : "+v"(t2_)); unsigned long long w2_ = (unsigned long long)(uintptr_t)A.ws; int g2_ = gridDim.x, b2_ = blockIdx.x; asm volatile("" : "+s"(w2_), "+s"(g2_), "+s"(b2_)); \
            F2.tid = t2_; F2.lane = t2_ & 63; F2.wave = __builtin_amdgcn_readfirstlane(t2_ >> 6); F2.ws = (unsigned char*)(GAS unsigned char*)w2_; F2.G = g2_; F2.bx = b2_; \
            int lo2_ = (l == 0) ? BG_C : BG_F, hi2_ = BG_PER_LAYER; asm volatile("" : "+s"(lo2_), "+s"(hi2_)); bg_site(F2, l, lo2_, hi2_, 0, (CEXPR)); } __syncthreads(); } while (0)
        { const int per = (1024 + F.G - 1) / F.G; char* shm = (char*)lds + RING_OFF;
          if (PH(7)) REP(7) for (int i = 0; i <= per; ++i) { size_t row0; int b, h, nt, t0;
              if (i < per) { if (F.G == 256 && i == (F.bx & 3) && !(F.bx & 4)) { BG_ATTN(b2_ / 8 * 4 + (b2_ & 3)); }
                const int L = vcu * per + i; if (L >= 1024) continue; const int bh = L >> 6, qb = L & 63; b = bh >> 3; h = bh & 7; row0 = (size_t)b * SEQ + (size_t)qb * 256; t0 = 0; nt = NTILE; }
              else { if (l != 0 || F.bx >= 16) continue; const int bh = F.bx; b = bh >> 3; h = bh & 7; row0 = (size_t)TL + (size_t)b * CTX; t0 = SEQ / 64; nt = CTX / 64; }
              attn_body::attn_unit<4, 512, 128, 128, 512, 8, false, false>((const bf16*)(ws + WS_QG) + row0 * 512 + h * 64, (const bf16*)(ws + WS_KG) + ((size_t)(b * 2 + (h >> 2)) * NTILE + t0) * 4096, (const bf16*)(ws + WS_VG) + ((size_t)(b * 2 + (h >> 2)) * NTILE + t0) * 4096,
                                                             (bf16*)(ws + WS_OG) + row0 * 512 + h * 64, nt, shm); }
          if (PH(8)) REP(8) for (int i = 0; i <= per; ++i) { size_t row0; int b, h, nt, t0;
              if (i < per) { if (F.G == 256 && i == (F.bx & 3) && (F.bx & 4)) { BG_ATTN(g2_ / 2 + b2_ / 8 * 4 + (b2_ & 3)); }
                const int L = vcu * per + i; if (L >= 1024) continue; const int bh = L >> 6, qb = L & 63; b = bh >> 3; h = bh & 7; row0 = (size_t)b * SEQ + (size_t)qb * 256; t0 = 0; nt = NTILE; }
              else { if (l != 0 || F.bx < 16 || F.bx >= 32) continue; const int bh = F.bx - 16; b = bh >> 3; h = bh & 7; row0 = (size_t)TL + (size_t)b * CTX; t0 = SEQ / 64; nt = CTX / 64; }
              attn_body::attn_unit<6, 768, 768, 512, 512, 8, false, false>((const bf16*)(ws + WS_QM) + row0 * 768 + h * 96, (const bf16*)(ws + WS_KM) + ((size_t)(b * 8 + h) * NTILE + t0) * 6144, (const bf16*)(ws + WS_VM) + ((size_t)(b * 8 + h) * NTILE + t0) * 4096,
                                                             (bf16*)(ws + WS_OM) + row0 * 512 + h * 64, nt, shm); } }
        GRID_BAR();

        if (PH(10)) REP(10) { pg8::StaticOrder S; S.init(T_l, 1024, F.G, F.bx); const bf16* wbr = (const bf16*)(ws + WS_WBR) + (size_t)l * 3 * 1024 * 512;
          { pg8::Gemm g{(const bf16*)(ws + WS_OG), wbr, T_l, 1024, 512}; pg8::EpiBranch<0> E{(const bf16*)(ws + WS_BIG), (bf16*)(ws + WS_MERGEB)};
            pg8::gemm_phase<pg8::EpiBranch<0>, pg8::StaticOrder, true, true>(F.lds + RING_OFF, g, S, E); }
          { pg8::Gemm g{(const bf16*)(ws + WS_OM), wbr + (size_t)1024 * 512, T_l, 1024, 512}; pg8::EpiBranch<1> E{(const bf16*)(ws + WS_BIG), (bf16*)(ws + WS_MERGEB)};
            pg8::gemm_phase<pg8::EpiBranch<1>, pg8::StaticOrder, true, true>(F.lds + RING_OFF, g, S, E); }
          { pg8::Gemm g{(const bf16*)(ws + WS_GM), wbr + (size_t)2 * 1024 * 512, T_l, 1024, 512}; pg8::EpiBranch<2> E{(const bf16*)(ws + WS_BIG), (bf16*)(ws + WS_MERGEB)};
            pg8::gemm_phase<pg8::EpiBranch<2>, pg8::StaticOrder, true, true>(F.lds + RING_OFF, g, S, E); } }
        if (l == 0) { __syncthreads(); bg_site(F, 0, BG_A, BG_B, (T_l / 256) * 4, F.bx); }
        GRID_BAR();

        if (PH(11)) REP(11) { pg8::Gemm g{(const bf16*)(ws + WS_MERGEB), (const bf16*)(ws + WS_WOUT) + (size_t)l * 1024 * 1024, T_l, 1024, 1024}; pg8::StaticOrder S; S.init(T_l, 1024, F.G, F.bx);
          pg8::EpiPlain E{(bf16*)(ws + WS_Y), 1024};
          pg8::gemm_phase<pg8::EpiPlain, pg8::StaticOrder, true, true>(F.lds + RING_OFF, g, S, E); }
        if (l == 0) { __syncthreads(); bg_site(F, 0, BG_B, BG_C, (T_l / 256) * 4, F.bx); }
        GRID_BAR();

        if (F.G != 256) { bg_site(F, l, (l == 0) ? BG_C : BG_F, BG_PER_LAYER, 0, F.bx); __syncthreads(); }
        if (PH(12)) REP(12) { const float* xin_lat = (l == 0) ? F.in(I_X) : F.out(); const float* xin_ctx = (l == 0) ? F.in(I_CTX) : (const float*)(ws + WS_XC); t3_phase(F, l, T_l, xin_lat, xin_ctx, (((PH_TWICE >> 12) & 1u) && rep_ == 0) ? 64 : 0, ((PH_TWICE >> 12) & 1u) && rep_ == 0); }
        GRID_BAR();

        moe_tables(F, l, 0);

        if (PH(14)) REP(14) { const LAS int* tab = (const LAS int*)(F.lds + LDS_TAB); const int nblk = __builtin_amdgcn_readfirstlane(tab[632]);
          LAS int* rowtok = (LAS int*)(F.lds + LDS_ROWTOK);
          { const int* ltok = (const int*)(ws + WS_LTOK); const int nun = nblk * 8;
            int tk[10];
#pragma unroll
            for (int jj = 0; jj < 10; ++jj) { const int idx = F.tid + 512 * jj; const int i = idx >> 8, r = idx & 255; const long L = (long)i * F.G + vcu; tk[jj] = -1;
                if (L < nun) { const int blk = (int)(L >> 3), e = tab[blk], slot = blk * 256 + r - tab[600 + e]; if (slot < tab[640 + e]) tk[jj] = ltok[(size_t)e * TA + slot]; } }
#pragma unroll
            for (int jj = 0; jj < 10; ++jj) rowtok[F.tid + 512 * jj] = tk[jj] < 0 ? 0 : tk[jj];
            __syncthreads(); }
          pg8::Gemm g{(const bf16*)(ws + WS_XN), (const bf16*)(ws + WS_W1) + (size_t)l * 32 * 2048 * 1024, TA, 32 * 2048, 1024};
          pg8::MoeOrder<8> S{nblk * 8, F.G, vcu, tab, rowtok}; pg8::EpiMoe1 E{(bf16*)(ws + WS_H), F.in(I_EB1) + (size_t)l * 32 * 2048};
          pg8::gemm_phase<pg8::EpiMoe1, pg8::MoeOrder<8>, true, true, true>(F.lds + RING_OFF, g, S, E);
          if (l == 0) { __syncthreads(); bg_site(F, 1, 0, BG_D, nblk * 8, vcu); } }
        GRID_BAR();

        if (PH(15)) REP(15) { const LAS int* tab = (const LAS int*)(F.lds + LDS_TAB); const int nblk = __builtin_amdgcn_readfirstlane(tab[632]);
          pg8::Gemm g{(const bf16*)(ws + WS_H), (const bf16*)(ws + WS_W2) + (size_t)l * 32 * 1024 * 1024, MOE_ROWS, 32 * 1024, 1024};
          pg8::MoeOrder<4> S{nblk * 4, F.G, vcu, tab, tab}; pg8::EpiMoe2 E{(bf16*)(ws + WS_BIG), F.in(I_EB2) + (size_t)l * 32 * 1024, (const float*)(ws + WS_LW), tab};
          pg8::gemm_phase<pg8::EpiMoe2, pg8::MoeOrder<4>, true, true>(F.lds + RING_OFF, g, S, E);
          if (l == 0) { __syncthreads(); bg_site(F, 1, BG_D, BG_E, nblk * 4, vcu); } }
        GRID_BAR();

        if (PH(16)) REP(16) t4_phase(F, l, T_l, ((PH_TWICE >> 16) & 1u) && rep_ == 0);
        GRID_BAR();
    }
#undef GRID_BAR
}

extern "C" void kernel_launch(void* const* d_in, const int* in_sizes, int n_in, void* d_out, int out_size, void* d_ws, size_t ws_size, hipStream_t stream) {
    static int grid = 0;
    if (grid == 0) {
        if (n_in != 24 || out_size != TL * DM || ws_size < WS_END) { fprintf(stderr, "kernel_launch: unexpected problem: n_in %d out %d ws %zu (need %zu)\n", n_in, out_size, ws_size, (size_t)WS_END); grid = -1; return; }
        int dev = 0, cus = 0;
        if (hipGetDevice(&dev) != hipSuccess || hipDeviceGetAttribute(&cus, hipDeviceAttributeMultiprocessorCount, dev) != hipSuccess) { grid = -1; return; }
        if (hipFuncSetAttribute((const void*)fwd_kernel, hipFuncAttributeMaxDynamicSharedMemorySize, LDS_BYTES) != hipSuccess) { fprintf(stderr, "kernel_launch: hipFuncSetAttribute failed\n"); grid = -1; return; }
        int per_cu = 0;
        if (hipOccupancyMaxActiveBlocksPerMultiprocessor(&per_cu, (const void*)fwd_kernel, 512, LDS_BYTES) != hipSuccess || per_cu < 1) fprintf(stderr, "kernel_launch: occupancy query reports %d\n", per_cu);
        (void)hipGetLastError();
        grid = cus > 256 ? 256 : cus;
    }
    if (grid < 0) return;
    if (hipMemsetAsync((char*)d_ws + WS_CTL, 0, CTL_ZERO_BYTES, stream) != hipSuccess) return;
    Args a{};
    for (int i = 0; i < 24; ++i) a.in[i] = (const float*)d_in[i];
    a.out = (float*)d_out; a.ws = (unsigned char*)d_ws;
    hipLaunchKernelGGL(fwd_kernel, dim3(grid), dim3(512), LDS_BYTES, stream, a);
}
```

```cpp
#include <hip/hip_runtime.h>
#include <cstdio>
#include <cstdint>

typedef unsigned short bf16;

constexpr int DM = 1024, NBATCH = 2, SEQ = 16384, CTX = 256, DEPTH = 2;
constexpr int TL = NBATCH * SEQ;
constexpr int TC = NBATCH * CTX;
constexpr int TA = TL + TC;
constexpr int KPB = SEQ + CTX;
constexpr int KR = NBATCH * KPB;
constexpr int ZW = 5376;
constexpr int Z_Q = 0, Z_K = 512, Z_V = 640, Z_CQ = 768, Z_CKV = 1024, Z_KR = 1152, Z_U = 1280, Z_VG = 1792, Z_GATE = 2304;
constexpr int NEXP = 32, TOPK = 4, DEXP = 1024, MOE_ROWS = 552 * 256;
constexpr float RMS_EPS = 1e-6f;
constexpr float LOG2E = 1.4426950408889634f;
constexpr float C2G = 0.125f * LOG2E;
constexpr float C2M = 0.10206207261596577f * LOG2E;

constexpr size_t MiB = 1u << 20;
constexpr size_t WS_CTL = 0, CTL_ZERO_BYTES = 128 * 1024;
constexpr size_t WS_MOD = 1 * MiB;
constexpr size_t WS_PTAB = 1 * MiB + 512 * 1024;
constexpr size_t WS_COSG = 2 * MiB, WS_SING = 4 * MiB, WS_COSM = 6 * MiB, WS_SINM = 7 * MiB;
constexpr size_t WS_WS = 8 * MiB;
constexpr size_t WS_RWT = 8 * MiB + 512 * 1024;
constexpr size_t WS_SSV = 1 * MiB + 640 * 1024;
static_assert(WS_SSV + (size_t)TA * 2 * 4 <= 2 * MiB && WS_RWT + (size_t)DEPTH * 2 * 32 * 1024 * 2 <= 9 * MiB, "ws map small regions");
constexpr size_t WS_WUQ = 9 * MiB;
constexpr size_t WS_WUKV = 10 * MiB;
constexpr size_t WS_WBR = 11 * MiB;
constexpr size_t WS_WOUT = 17 * MiB;
constexpr size_t WS_WIN = 21 * MiB;
constexpr size_t WS_W1 = 42 * MiB;
constexpr size_t WS_W2 = 298 * MiB;
constexpr size_t WS_XC = 426 * MiB;
constexpr size_t WS_RTE = 428 * MiB;
constexpr size_t WS_RTS = 429 * MiB;
constexpr size_t WS_LTOK = 430 * MiB;
constexpr size_t WS_LW = 435 * MiB;
constexpr size_t WS_XN = 441 * MiB;
constexpr size_t WS_QG = 506 * MiB;
constexpr size_t WS_KG = 539 * MiB;
constexpr size_t WS_VG = 548 * MiB;
constexpr size_t WS_CQN = 557 * MiB;
constexpr size_t WS_CKVN = 574 * MiB;
constexpr size_t WS_QM = 583 * MiB;
constexpr size_t WS_KM = 632 * MiB;
constexpr size_t WS_VM = 681 * MiB;
constexpr size_t WS_OG = 714 * MiB;
constexpr size_t WS_OM = 747 * MiB;
constexpr size_t WS_GM = 780 * MiB;
constexpr size_t WS_UACT = 813 * MiB;
constexpr size_t WS_VN = 846 * MiB;
constexpr size_t WS_MERGE = 879 * MiB;
constexpr size_t WS_XB = WS_MERGE;
constexpr size_t WS_MERGEB = 1009 * MiB;
constexpr size_t WS_Y = 1074 * MiB;
constexpr size_t WS_H = 1139 * MiB;
constexpr size_t WS_BIG = 1415 * MiB;
constexpr size_t WS_END = 1757 * MiB;
static_assert(WS_BIG + (size_t)TA * ZW * 2 <= WS_END && WS_BIG + (size_t)MOE_ROWS * 1024 * 2 <= WS_END && WS_H + (size_t)MOE_ROWS * 1024 * 2 <= WS_BIG, "ws map");
static_assert(WS_W1 + (size_t)DEPTH * 32 * 2048 * 1024 * 2 <= WS_W2 && WS_W2 + (size_t)DEPTH * 32 * 1024 * 1024 * 2 <= WS_XC, "ws map weights");
static_assert(WS_MERGE + (size_t)TA * 1024 * 4 <= WS_MERGEB && WS_XN + (size_t)TA * 1024 * 2 <= WS_QG && WS_QM + (size_t)TA * 768 * 2 <= WS_KM, "ws map acts");
constexpr int CW_BAR = 4096;
constexpr int CW_CNT = 16384;
constexpr int CW_BGQ = 16384 + 512;
static_assert((CW_BGQ + 1) * 4 <= (int)CTL_ZERO_BYTES && (CW_BAR + 3456) * 4 <= (int)CTL_ZERO_BYTES, "control words inside the per-call memset");

constexpr int RING_OFF = 0, RING_BYTES = 131072;
constexpr int LDS_X = RING_BYTES + 4096;
constexpr int LDS_SVEC = LDS_X;
constexpr int LDS_ROWTOK = LDS_X;
constexpr int MISC_OFF = 159744;
constexpr int LDS_TAB = 160000;
constexpr int LDS_BYTES = 163840;
static_assert(LDS_SVEC + 3 * 1024 * 4 <= MISC_OFF && LDS_ROWTOK + 20 * 1024 <= MISC_OFF && LDS_TAB + 704 * 4 <= LDS_BYTES, "LDS map");

#define GAS __attribute__((address_space(1)))
#define LAS __attribute__((address_space(3)))
typedef unsigned v4u __attribute__((ext_vector_type(4)));
typedef float f32x4 __attribute__((ext_vector_type(4)));
typedef GAS unsigned gu32;
#define RLX_AGENT __ATOMIC_RELAXED, __HIP_MEMORY_SCOPE_AGENT
#define LDS_WAIT() asm volatile("s_waitcnt lgkmcnt(0)" ::: "memory")
#define VM_WAIT() asm volatile("s_waitcnt vmcnt(0)" ::: "memory")

__device__ __forceinline__ unsigned cvt_pk(float lo, float hi) { unsigned r; asm volatile("v_cvt_pk_bf16_f32 %0, %1, %2" : "=v"(r) : "v"(lo), "v"(hi)); return r; }
__device__ __forceinline__ float bf_lo(unsigned u) { return __uint_as_float(u << 16); }
__device__ __forceinline__ float bf_hi(unsigned u) { return __uint_as_float(u & 0xffff0000u); }
__device__ __forceinline__ void unpack8(v4u r, float (&f)[8]) { f[0] = bf_lo(r.x); f[1] = bf_hi(r.x); f[2] = bf_lo(r.y); f[3] = bf_hi(r.y); f[4] = bf_lo(r.z); f[5] = bf_hi(r.z); f[6] = bf_lo(r.w); f[7] = bf_hi(r.w); }
__device__ __forceinline__ v4u pack8(const float (&f)[8]) { v4u o; o.x = cvt_pk(f[0], f[1]); o.y = cvt_pk(f[2], f[3]); o.z = cvt_pk(f[4], f[5]); o.w = cvt_pk(f[6], f[7]); return o; }
__device__ __forceinline__ float sigmoidf_(float x) { return __builtin_amdgcn_rcpf(1.f + __builtin_amdgcn_exp2f(-LOG2E * x)); }
__device__ __forceinline__ float wave_sum(float v) {
#pragma unroll
    for (int o = 1; o < 64; o <<= 1) v += __shfl_xor(v, o);
    return v;
}
__device__ __forceinline__ float gelu_tanh(float x) { const float u = 1.5957691216057308f * (x + 0.044715f * x * x * x); return x * __builtin_amdgcn_rcpf(1.f + __builtin_amdgcn_exp2f(-LOG2E * u)); }
constexpr int NTILE = KPB / 64;
__device__ __forceinline__ void bpos_of(int r, int& b, int& pos) { if (r < TL) { b = r >> 14; pos = r & (SEQ - 1); } else { b = (r - TL) >> 8; pos = SEQ + ((r - TL) & (CTX - 1)); } }
__device__ __forceinline__ size_t ktile_off(int strm, int pos, int chunk, int nch) { return (((size_t)strm * NTILE + (pos >> 6)) * nch + chunk) * 512 + (size_t)(pos & 63) * 8; }
__device__ __forceinline__ size_t vtile_off(int strm, int pos, int d) { const int piece = (d >> 5) * 4 + ((pos & 63) >> 4), ln = (pos & 15) * 4 + ((d >> 3) & 3); return (((size_t)strm * NTILE + (pos >> 6)) * 8 + piece) * 512 + (size_t)ln * 8; }
__device__ __forceinline__ int krow_of(int r) { return r < TL ? (r >> 14) * KPB + (r & (SEQ - 1)) : ((r - TL) >> 8) * KPB + SEQ + ((r - TL) & (CTX - 1)); }

__device__ const float INVF16[16] = {1.0f, 0.5623413324356079f, 0.3162277638912201f, 0.17782793939113617f, 0.10000000149011612f, 0.05623413249850273f, 0.03162277489900589f, 0.017782794311642647f,
                                     0.009999999776482582f, 0.005623413249850273f, 0.003162277629598975f, 0.0017782794311642647f, 0.0010000000474974513f, 0.000562341301701963f, 0.0003162277571391314f, 0.00017782794020604342f};
namespace pg8 {
#define PG8_LAS __attribute__((address_space(3)))
typedef unsigned short bf16_t;
typedef short bf16x8 __attribute__((ext_vector_type(8)));
typedef float f32x4 __attribute__((ext_vector_type(4)));
typedef unsigned u32x4 __attribute__((ext_vector_type(4)));
constexpr int BM = 256, BK = 64, HALF = 128, HTB = HALF * BK * 2  , STAGE_BYTES = 8 * HTB, NXCD = 8, WGM = 8;

__host__ __device__ __forceinline__ int lds_byte(int r, int c) { const int st = (r >> 4) * 2 + (c >> 5), rr = r & 15, cc = c & 31, ob = rr * 64 + cc * 2; return st * 1024 + (ob ^ (((ob >> 9) & 1) << 5)); }
__host__ __device__ __forceinline__ void stage_rc(int b, int& R, int& C) { const int st = b / 1024, sb = b % 1024, swz = sb ^ (((sb >> 9) & 1) << 5); R = (st >> 1) * 16 + swz / 64; C = (st & 1) * 32 + (swz % 64) / 2; }
__host__ __device__ __forceinline__ int perm32(int rho) { const int n = rho >> 4, i = rho & 15; return 8 * (i >> 2) + 4 * n + (i & 3); }

struct Unit { int pm, pn; };
struct Gemm { const bf16_t* A; const bf16_t* Bt; int M, N, K; };

struct StaticOrder {
    int nM, nN, nwg, G, c;
    __device__ void init(int M, int N, int G_, int c_) { asm volatile("" : "+s"(M), "+s"(N));
        nM = M / BM; nN = N / BM; nwg = nM * nN; G = G_; c = c_; }
    __host__ __device__ bool next(int i, Unit& u) const {
        const long L = (long)i * G + c; if (L >= nwg) return false;
        int wgid = (int)L; { const int q = nwg / NXCD, r = nwg % NXCD, xcd = wgid % NXCD, off = wgid / NXCD; wgid = (xcd < r ? xcd * (q + 1) : r * (q + 1) + (xcd - r) * q) + off; }
        const int nig = WGM * nN, gid = wgid / nig, fm = gid * WGM, gsz = (nM - fm) < WGM ? (nM - fm) : WGM;
        u.pm = fm + ((wgid % nig) % gsz); u.pn = (wgid % nig) / gsz; return true;
    }
    __device__ __forceinline__ void a_ready(const Unit&) const {}
    __device__ __forceinline__ void done(const Unit&) const {}
};

template <class Epi, class Sched, bool ALIGN_EPI = false, bool SP2 = false, bool GATHER = false>
__device__ __forceinline__ void gemm_phase(PG8_LAS unsigned char* lds, const Gemm g, const Sched& S, const Epi& E) {
    static_assert(!GATHER || SP2, "GATHER is implemented for the SP2 loop only");
    int tid_ = threadIdx.x; asm volatile("" : "+v"(tid_));
    const int tid = tid_, wid = __builtin_amdgcn_readfirstlane(tid >> 6), lane = tid & 63, wr = wid >> 2, wc = wid & 3, fr = lane & 15, fq = lane >> 4;
    int K_ = g.K; asm volatile("" : "+s"(K_));
    const int K = K_, nt = K / BK;
    unsigned voffA[2], voffB[2];
#pragma unroll
    for (int i = 0; i < 2; ++i) { int R, C; stage_rc(tid * 16 + i * 8192, R, C); const int Rb = Epi::PERM ? ((R & ~31) + perm32(R & 31)) : R;
        voffA[i] = (unsigned)(R * K + C) * 2u; voffB[i] = (unsigned)(Rb * K + C) * 2u; }
    unsigned vAc0[2] = {0u, 0u}, vAc1[2] = {0u, 0u}, vAn0[2] = {0u, 0u}, vAn1[2] = {0u, 0u}, vsel0[2] = {0u, 0u}, vsel1[2] = {0u, 0u};
#define PG8_GOFF(dst0, dst1, uidx) do { _Pragma("unroll") for (int i_ = 0; i_ < 2; ++i_) { int R_, C_; stage_rc(tid * 16 + i_ * 8192, R_, C_); \
        dst0[i_] = ((unsigned)S.tok((uidx), R_) * (unsigned)K + (unsigned)C_) * 2u; dst1[i_] = ((unsigned)S.tok((uidx), HALF + R_) * (unsigned)K + (unsigned)C_) * 2u; } } while (0)
#define PG8_STG_A(bufoff, base, H, SEL) do { if constexpr (GATHER) { if (SEL) { PG8_STAGE(bufoff, base, vsel##H); } else { PG8_STAGE(bufoff, base, vAc##H); } } else { PG8_STAGE(bufoff, (base) + (H) * hstep, voffA); } } while (0)
    const size_t kstep = (size_t)(BK * 2);
    const size_t hstep = (size_t)HALF * K * 2;
    const size_t tstep = 2 * hstep;
    const unsigned ldsw = (unsigned)wid * 1024u;
    const int aoff = lds_byte(wr * 64 + fr, fq * 8), boff = lds_byte(wc * 32 + fr, fq * 8);
#define PG8_SA(b, h) (((b) * 2 + (h)) * HTB)
#define PG8_SB(b, h) ((4 + (b) * 2 + (h)) * HTB)
#define PG8_STAGE(bufoff, gbase, voff) do { _Pragma("unroll") for (int _i = 0; _i < 2; ++_i) \
        __builtin_amdgcn_global_load_lds((const unsigned*)((const char*)(gbase) + (voff)[_i]), (PG8_LAS unsigned*)(lds + (bufoff) + ldsw + _i * 8192), 16, 0, 0); } while (0)
#define PG8_LDA(dst, b, h) do { _Pragma("unroll") for (int m = 0; m < 4; ++m) _Pragma("unroll") for (int k = 0; k < 2; ++k) dst[m][k] = *(const PG8_LAS bf16x8*)(lds + PG8_SA(b, h) + aoff + m * 2048 + k * 1024); } while (0)
#define PG8_LDB(dst, b, h) do { _Pragma("unroll") for (int n = 0; n < 2; ++n) _Pragma("unroll") for (int k = 0; k < 2; ++k) dst[n][k] = *(const PG8_LAS bf16x8*)(lds + PG8_SB(b, h) + boff + n * 2048 + k * 1024); } while (0)
#define PG8_MMA(ai, bj, At, Bt) do { __builtin_amdgcn_s_setprio(1); _Pragma("unroll") for (int m = 0; m < 4; ++m) _Pragma("unroll") for (int n = 0; n < 2; ++n) _Pragma("unroll") for (int k = 0; k < 2; ++k) \
        acc[ai][bj][m][n] = __builtin_amdgcn_mfma_f32_16x16x32_bf16(Bt[n][k], At[m][k], acc[ai][bj][m][n], 0, 0, 0); __builtin_amdgcn_s_setprio(0); } while (0)
#define PG8_WAIT_V(n) asm volatile("s_waitcnt vmcnt(" #n ")" ::: "memory")
#define PG8_WAIT_L(n) asm volatile("s_waitcnt lgkmcnt(" #n ")" ::: "memory")
#define PG8_BAR __builtin_amdgcn_s_barrier()
#define PG8_SCHED __builtin_amdgcn_sched_barrier(0)
    Unit cur, nxt; int ui = 0;
    if (!S.next(0, cur)) return;
    f32x4 acc[2][2][4][2];
#pragma unroll
    for (int a = 0; a < 2; ++a)
#pragma unroll
        for (int b = 0; b < 2; ++b)
#pragma unroll
            for (int m = 0; m < 4; ++m)
#pragma unroll
                for (int n = 0; n < 2; ++n) acc[a][b][m][n] = (f32x4){0.f, 0.f, 0.f, 0.f};
    bf16x8 At[4][2], B0[2][2], B1[2][2];
    const char* cA = GATHER ? (const char*)g.A : (const char*)g.A + (size_t)cur.pm * tstep; const char* cB = (const char*)g.Bt + (size_t)cur.pn * tstep;
    if constexpr (GATHER) { PG8_GOFF(vAc0, vAc1, 0); }
    S.a_ready(cur);
    if constexpr (SP2) {
        PG8_STAGE(PG8_SB(0, 0), cB, voffB); PG8_STAGE(PG8_SB(0, 1), cB + hstep, voffB); PG8_STG_A(PG8_SA(0, 0), cA, 0, false); PG8_STG_A(PG8_SA(0, 1), cA, 1, false);
        if (wr == 1) PG8_BAR;
        PG8_WAIT_V(2); PG8_BAR;
        PG8_STAGE(PG8_SB(1, 0), cB + kstep, voffB); PG8_STG_A(PG8_SA(1, 0), cA + kstep, 0, false); PG8_STAGE(PG8_SB(1, 1), cB + hstep + kstep, voffB);
        PG8_WAIT_V(6); PG8_BAR;
    } else {
        PG8_STAGE(PG8_SB(0, 0), cB, voffB); PG8_STAGE(PG8_SA(0, 0), cA, voffA); PG8_STAGE(PG8_SB(0, 1), cB + hstep, voffB); PG8_STAGE(PG8_SA(0, 1), cA + hstep, voffA);
        if (wr == 1) PG8_BAR;
        PG8_WAIT_V(4); PG8_BAR;
        PG8_STAGE(PG8_SB(1, 0), cB + kstep, voffB); PG8_STAGE(PG8_SA(1, 0), cA + kstep, voffA); PG8_STAGE(PG8_SB(1, 1), cB + hstep + kstep, voffB);
        PG8_WAIT_V(6); PG8_BAR;
    }
    for (;;) {
        const bool has_next = S.next(ui + 1, nxt);
        const char* nA = GATHER ? (const char*)g.A : (has_next ? (const char*)g.A + (size_t)nxt.pm * tstep : cA);
        if constexpr (GATHER) { if (has_next) { PG8_GOFF(vAn0, vAn1, ui + 1); } else { vAn0[0] = vAc0[0]; vAn0[1] = vAc0[1]; vAn1[0] = vAc1[0]; vAn1[1] = vAc1[1]; } } const char* nB = has_next ? (const char*)g.Bt + (size_t)nxt.pn * tstep : cB;
        for (int t = 0; t < nt; t += 2) {
            const bool last = (t == nt - 2);
            const char* a1 = cA + (size_t)(t + 1) * kstep;
            const char* a2 = last ? nA : cA + (size_t)(t + 2) * kstep; const char* b2 = last ? nB : cB + (size_t)(t + 2) * kstep;
            const char* a3 = a2 + kstep; const char* b3 = b2 + kstep;
            if (last && has_next) S.a_ready(nxt);
            if constexpr (GATHER) { vsel0[0] = last ? vAn0[0] : vAc0[0]; vsel0[1] = last ? vAn0[1] : vAc0[1]; vsel1[0] = last ? vAn1[0] : vAc1[0]; vsel1[1] = last ? vAn1[1] : vAc1[1]; }
            if constexpr (SP2) {
            PG8_LDB(B0, 0, 0); PG8_LDB(B1, 0, 1); PG8_SCHED; PG8_LDA(At, 0, 0); PG8_STG_A(PG8_SA(1, 1), a1, 1, false);
            PG8_WAIT_V(8); PG8_WAIT_L(0); PG8_BAR; PG8_MMA(0, 0, At, B0); PG8_MMA(0, 1, At, B1); PG8_BAR; PG8_SCHED;
            PG8_LDA(At, 0, 1); PG8_STAGE(PG8_SB(0, 0), b2, voffB); PG8_STAGE(PG8_SB(0, 1), b2 + hstep, voffB); PG8_STG_A(PG8_SA(0, 0), a2, 0, true);
            PG8_WAIT_V(8); PG8_WAIT_L(0); PG8_BAR; PG8_MMA(1, 0, At, B0); PG8_MMA(1, 1, At, B1); PG8_BAR; PG8_SCHED;
            PG8_LDB(B0, 1, 0); PG8_LDB(B1, 1, 1); PG8_SCHED; PG8_LDA(At, 1, 0); PG8_STG_A(PG8_SA(0, 1), a2, 1, true);
            PG8_WAIT_V(8); PG8_WAIT_L(0); PG8_BAR; PG8_MMA(0, 0, At, B0); PG8_MMA(0, 1, At, B1); PG8_BAR; PG8_SCHED;
            PG8_LDA(At, 1, 1); PG8_STAGE(PG8_SB(1, 0), b3, voffB); PG8_STAGE(PG8_SB(1, 1), b3 + hstep, voffB); PG8_STG_A(PG8_SA(1, 0), a3, 0, true);
            PG8_WAIT_V(8); PG8_WAIT_L(0); PG8_BAR; PG8_MMA(1, 0, At, B0); PG8_MMA(1, 1, At, B1); PG8_BAR; PG8_SCHED;
            } else {
            PG8_LDB(B0, 0, 0); PG8_SCHED; PG8_LDA(At, 0, 0); PG8_STAGE(PG8_SA(1, 1), a1 + hstep, voffA);
            PG8_WAIT_L(8); PG8_BAR; PG8_WAIT_L(0); PG8_MMA(0, 0, At, B0); PG8_BAR; PG8_SCHED;
            PG8_LDB(B1, 0, 1); PG8_STAGE(PG8_SB(0, 0), b2, voffB);
            PG8_BAR; PG8_WAIT_L(0); PG8_MMA(0, 1, At, B1); PG8_BAR;
            PG8_LDA(At, 0, 1); PG8_STAGE(PG8_SA(0, 0), a2, voffA);
            PG8_BAR; PG8_WAIT_L(0); PG8_MMA(1, 0, At, B0); PG8_BAR; PG8_SCHED;
            PG8_STAGE(PG8_SB(0, 1), b2 + hstep, voffB);
            PG8_WAIT_V(6); PG8_BAR; PG8_MMA(1, 1, At, B1); PG8_BAR;
            PG8_LDB(B0, 1, 0); PG8_SCHED; PG8_LDA(At, 1, 0); PG8_STAGE(PG8_SA(0, 1), a2 + hstep, voffA);
            PG8_WAIT_L(8); PG8_BAR; PG8_WAIT_L(0); PG8_MMA(0, 0, At, B0); PG8_BAR; PG8_SCHED;
            PG8_LDB(B1, 1, 1); PG8_STAGE(PG8_SB(1, 0), b3, voffB);
            PG8_BAR; PG8_WAIT_L(0); PG8_MMA(0, 1, At, B1); PG8_BAR;
            PG8_LDA(At, 1, 1); PG8_STAGE(PG8_SA(1, 0), a3, voffA);
            PG8_BAR; PG8_WAIT_L(0); PG8_MMA(1, 0, At, B0); PG8_BAR; PG8_SCHED;
            PG8_STAGE(PG8_SB(1, 1), b3 + hstep, voffB);
            PG8_WAIT_V(6); PG8_BAR; PG8_MMA(1, 1, At, B1); PG8_BAR;
            }
        }
        if constexpr (ALIGN_EPI) { if (wr == 0) PG8_BAR; }
        if constexpr (!Epi::AFTER_DRAIN) { E(acc, cur, wr, wc, fr, fq); S.done(cur); }
        if (!has_next) break;
#pragma unroll
        for (int a = 0; a < 2; ++a)
#pragma unroll
            for (int b = 0; b < 2; ++b)
#pragma unroll
                for (int m = 0; m < 4; ++m)
#pragma unroll
                    for (int n = 0; n < 2; ++n) acc[a][b][m][n] = (f32x4){0.f, 0.f, 0.f, 0.f};
        cur = nxt; cA = nA; cB = nB; ++ui;
        if constexpr (GATHER) { vAc0[0] = vAn0[0]; vAc0[1] = vAn0[1]; vAc1[0] = vAn1[0]; vAc1[1] = vAn1[1]; }
        if constexpr (ALIGN_EPI) { if (wr == 1) PG8_BAR; }
    }
    PG8_WAIT_V(0);
    if constexpr (!ALIGN_EPI) { if (wr == 0) PG8_BAR; }
    PG8_BAR;
    if constexpr (Epi::AFTER_DRAIN) { E.fused(acc, cur, wr, wc, fr, fq, lds, wid, lane); S.done(cur); }
#undef PG8_SA
#undef PG8_SB
#undef PG8_STAGE
#undef PG8_LDA
#undef PG8_LDB
#undef PG8_MMA
#undef PG8_WAIT_V
#undef PG8_WAIT_L
#undef PG8_BAR
#undef PG8_SCHED
#undef PG8_GOFF
#undef PG8_STG_A
}
}
namespace pg8 {
#define EPI_ROWS(u, wr, fr) const int row00 = (u).pm * BM + (wr) * 64 + (fr)
#define EPI_GET8(v, ai, bj, m) float v[8] = {acc[ai][bj][m][0][0], acc[ai][bj][m][0][1], acc[ai][bj][m][0][2], acc[ai][bj][m][0][3], acc[ai][bj][m][1][0], acc[ai][bj][m][1][1], acc[ai][bj][m][1][2], acc[ai][bj][m][1][3]}

struct EpiPlain {
    static constexpr bool PERM = true, AFTER_DRAIN = false;
    bf16_t* O; int ldc;
    __device__ __forceinline__ void operator()(const f32x4 (&acc)[2][2][4][2], const Unit& u, int wr, int wc, int fr, int fq) const {
        asm volatile("" : "+v"(fr), "+v"(fq));
        EPI_ROWS(u, wr, fr); const int col0 = u.pn * BM + wc * 32 + 8 * fq;
#pragma unroll
        for (int ai = 0; ai < 2; ++ai)
#pragma unroll
            for (int m = 0; m < 4; ++m) { bf16_t* rowp = O + (size_t)(row00 + ai * HALF + m * 16) * ldc + col0;
#pragma unroll
                for (int bj = 0; bj < 2; ++bj) { EPI_GET8(v, ai, bj, m); *(u32x4*)(rowp + bj * HALF) = pack8(v); } }
    }
};

struct EpiInproj {
    static constexpr bool PERM = true, AFTER_DRAIN = false;
    unsigned char* ws; const float *qkn, *mqn, *mkvn; PG8_LAS float* xs;
    __device__ __forceinline__ void operator()(const f32x4 (&acc)[2][2][4][2], const Unit& u, int wr, int wc, int fr, int fq) const {
        asm volatile("" : "+v"(fr), "+v"(fq));
        EPI_ROWS(u, wr, fr); const int pn = u.pn; const bool lat = (u.pm * BM) < TL;
        if (pn >= 9) {
            const int col0 = (pn - 9) * BM + wc * 32 + 8 * fq;
#pragma unroll
            for (int ai = 0; ai < 2; ++ai)
#pragma unroll
                for (int m = 0; m < 4; ++m) { bf16_t* rowp = (bf16_t*)(ws + WS_BIG) + (size_t)(row00 + ai * HALF + m * 16) * 3072 + col0;
#pragma unroll
                    for (int bj = 0; bj < 2; ++bj) { EPI_GET8(v, ai, bj, m); *(u32x4*)(rowp + bj * HALF) = pack8(v); } }
        } else if (pn <= 2) {
            if (pn == 2 && wc >= 2) {
#pragma unroll
                for (int ai = 0; ai < 2; ++ai)
#pragma unroll
                    for (int m = 0; m < 4; ++m) { const int row = row00 + ai * HALF + m * 16; int b_, pos_; bpos_of(row, b_, pos_); bf16_t* vb = (bf16_t*)(ws + WS_VG); const int st = b_ * 2 + (wc - 2);
                        EPI_GET8(x1, ai, 0, m); EPI_GET8(x2, ai, 1, m); *(u32x4*)(vb + vtile_off(st, pos_, 8 * fq)) = pack8(x1); *(u32x4*)(vb + vtile_off(st, pos_, 32 + 8 * fq)) = pack8(x2); }
            } else {
                const bool isq = pn < 2; const float* gn = qkn + (isq ? 0 : 64) + 8 * fq;
                const f32x4 ga0 = *(const f32x4*)gn, ga1 = *(const f32x4*)(gn + 4), gb0 = *(const f32x4*)(gn + 32), gb1 = *(const f32x4*)(gn + 36);
                const float g1[8] = {ga0[0], ga0[1], ga0[2], ga0[3], ga1[0], ga1[1], ga1[2], ga1[3]}, g2[8] = {gb0[0], gb0[1], gb0[2], gb0[3], gb1[0], gb1[1], gb1[2], gb1[3]};
                const float sc = isq ? C2G : 1.f;
#pragma unroll
                for (int am = 0; am < 4; ++am) { const int ai = am >> 1, m0 = 2 * (am & 1);
                    f32x4 tc[2][2], ts[2][2];
#pragma unroll
                    for (int mm = 0; mm < 2; ++mm) { const int pos = lat ? ((row00 + ai * HALF + (m0 + mm) * 16) & (SEQ - 1)) : 0; const f32x4* cp = (const f32x4*)((const float*)(ws + WS_COSG) + (size_t)pos * 32 + 8 * fq); const f32x4* sp = (const f32x4*)((const float*)(ws + WS_SING) + (size_t)pos * 32 + 8 * fq);
                        tc[mm][0] = cp[0]; tc[mm][1] = cp[1]; ts[mm][0] = sp[0]; ts[mm][1] = sp[1]; }
#pragma unroll
                    for (int mm = 0; mm < 2; ++mm) { const int m = m0 + mm; const int row = row00 + ai * HALF + m * 16; const f32x4 c0 = tc[mm][0], c1 = tc[mm][1], s0 = ts[mm][0], s1 = ts[mm][1];
                        EPI_GET8(x1, ai, 0, m); EPI_GET8(x2, ai, 1, m); float ss = 0.f;
#pragma unroll
                        for (int i = 0; i < 8; ++i) ss += x1[i] * x1[i] + x2[i] * x2[i];
                        ss += __shfl_xor(ss, 16); ss += __shfl_xor(ss, 32);
                        const float rstd = __builtin_amdgcn_rsqf(ss * (1.f / 64.f) + RMS_EPS); float o1[8], o2[8];
#pragma unroll
                        for (int i = 0; i < 8; ++i) { const float y1 = x1[i] * rstd * g1[i], y2 = x2[i] * rstd * g2[i]; const float c = lat ? (i < 4 ? c0[i & 3] : c1[i & 3]) : 1.f, s = lat ? (i < 4 ? s0[i & 3] : s1[i & 3]) : 0.f;
                            o1[i] = (y1 * c - y2 * s) * sc; o2[i] = (y2 * c + y1 * s) * sc; }
                        if (isq) { bf16_t* p = (bf16_t*)(ws + WS_QG) + (size_t)row * 512 + (4 * pn + wc) * 64 + 8 * fq; *(u32x4*)p = pack8(o1); *(u32x4*)(p + 32) = pack8(o2); }
                        else { int b_, pos_; bpos_of(row, b_, pos_); bf16_t* kb = (bf16_t*)(ws + WS_KG); const int st = b_ * 2 + wc; *(u32x4*)(kb + ktile_off(st, pos_, fq, 8)) = pack8(o1); *(u32x4*)(kb + ktile_off(st, pos_, 4 + fq, 8)) = pack8(o2); } }
                    asm volatile("" ::: "memory"); }
            }
        } else if (pn == 3 || pn == 4 || pn == 7 || pn == 8) {
            const bool vg = pn >= 7; const bool part = (pn == 4) ? (wc < 2) : true;
            float ssr[2][4];
#pragma unroll
            for (int ai = 0; ai < 2; ++ai)
#pragma unroll
                for (int m = 0; m < 4; ++m) { float ss = 0.f;
#pragma unroll
                    for (int bj = 0; bj < 2; ++bj) { EPI_GET8(v, ai, bj, m);
#pragma unroll
                        for (int i = 0; i < 8; ++i) { const float t = vg ? gelu_tanh(v[i]) : v[i]; ss += t * t; } }
                    ss += __shfl_xor(ss, 16); ss += __shfl_xor(ss, 32); ssr[ai][m] = part ? ss : 0.f;
                    if (fq == 0) xs[(ai * HALF + wr * 64 + m * 16 + fr) * 4 + wc] = ssr[ai][m]; }
            asm volatile("s_waitcnt lgkmcnt(0)\n\ts_barrier" ::: "memory");
#pragma unroll
            for (int ai = 0; ai < 2; ++ai)
#pragma unroll
                for (int m = 0; m < 4; ++m) { const f32x4 t = *(const PG8_LAS f32x4*)(xs + (ai * HALF + wr * 64 + m * 16 + fr) * 4); ssr[ai][m] = (t[0] + t[1]) + (t[2] + t[3]); }
            asm volatile("s_waitcnt lgkmcnt(0)\n\ts_barrier" ::: "memory");
            if (pn == 3) {
                const int col0 = wc * 32 + 8 * fq;
#pragma unroll
                for (int ai = 0; ai < 2; ++ai)
#pragma unroll
                    for (int m = 0; m < 4; ++m) { const int row = row00 + ai * HALF + m * 16; const float rstd = __builtin_amdgcn_rsqf(ssr[ai][m] * (1.f / 256.f) + RMS_EPS);
#pragma unroll
                        for (int bj = 0; bj < 2; ++bj) { EPI_GET8(v, ai, bj, m); const int col = col0 + bj * HALF; const f32x4 ga = *(const f32x4*)(mqn + col), gb = *(const f32x4*)(mqn + col + 4);
#pragma unroll
                            for (int i = 0; i < 8; ++i) v[i] *= rstd * (i < 4 ? ga[i] : gb[i - 4]);
                            *(u32x4*)((bf16_t*)(ws + WS_CQN) + (size_t)row * 256 + col) = pack8(v); } }
            } else if (pn == 4) {
                if (wc < 2) {
#pragma unroll
                    for (int ai = 0; ai < 2; ++ai)
#pragma unroll
                        for (int m = 0; m < 4; ++m) { const int row = row00 + ai * HALF + m * 16; const float rstd = __builtin_amdgcn_rsqf(ssr[ai][m] * (1.f / 128.f) + RMS_EPS);
#pragma unroll
                            for (int bj = 0; bj < 2; ++bj) { EPI_GET8(v, ai, bj, m); const int col = wc * 64 + bj * 32 + 8 * fq; const f32x4 ga = *(const f32x4*)(mkvn + col), gb = *(const f32x4*)(mkvn + col + 4);
#pragma unroll
                                for (int i = 0; i < 8; ++i) v[i] *= rstd * (i < 4 ? ga[i] : gb[i - 4]);
                                *(u32x4*)((bf16_t*)(ws + WS_CKVN) + (size_t)row * 128 + col) = pack8(v); } }
                } else if (wc == 2 && fq < 2) {
#pragma unroll
                    for (int ai = 0; ai < 2; ++ai)
#pragma unroll
                        for (int m = 0; m < 4; ++m) { const int row = row00 + ai * HALF + m * 16; const int pos = row & (SEQ - 1);
                            EPI_GET8(x1, ai, 0, m); EPI_GET8(x2, ai, 1, m); float o1[8], o2[8];
                            if (lat) { const f32x4* cp = (const f32x4*)((const float*)(ws + WS_COSM) + (size_t)pos * 16 + 8 * fq); const f32x4* sp = (const f32x4*)((const float*)(ws + WS_SINM) + (size_t)pos * 16 + 8 * fq); const f32x4 c0 = cp[0], c1 = cp[1], s0 = sp[0], s1 = sp[1];
#pragma unroll
                                for (int i = 0; i < 8; ++i) { const float c = i < 4 ? c0[i] : c1[i - 4], s = i < 4 ? s0[i] : s1[i - 4]; o1[i] = x1[i] * c - x2[i] * s; o2[i] = x2[i] * c + x1[i] * s; } }
                            else {
#pragma unroll
                                for (int i = 0; i < 8; ++i) { o1[i] = x1[i]; o2[i] = x2[i]; } }
                            const u32x4 p1 = pack8(o1), p2 = pack8(o2); int b_, pos_; bpos_of(row, b_, pos_); bf16_t* kb = (bf16_t*)(ws + WS_KM);
#pragma unroll
                            for (int h = 0; h < 8; ++h) { *(u32x4*)(kb + ktile_off(b_ * 8 + h, pos_, 8 + fq, 12)) = p1; *(u32x4*)(kb + ktile_off(b_ * 8 + h, pos_, 10 + fq, 12)) = p2; } }
                }
            } else {
                const int half = pn - 7, col0 = half * BM + wc * 32 + 8 * fq;
#pragma unroll
                for (int ai = 0; ai < 2; ++ai)
#pragma unroll
                    for (int m = 0; m < 4; ++m) { const int row = row00 + ai * HALF + m * 16;
#pragma unroll
                        for (int bj = 0; bj < 2; ++bj) { EPI_GET8(v, ai, bj, m);
#pragma unroll
                            for (int i = 0; i < 8; ++i) v[i] = gelu_tanh(v[i]);
                            *(u32x4*)((bf16_t*)(ws + WS_VN) + (size_t)row * 512 + col0 + bj * HALF) = pack8(v); }
                        if (wc == 0 && fq == 0) ((float*)(ws + WS_SSV))[(size_t)row * 2 + half] = ssr[ai][m]; }
            }
        } else {
            const int col0 = (pn - 5) * BM + wc * 32 + 8 * fq;
#pragma unroll
            for (int ai = 0; ai < 2; ++ai)
#pragma unroll
                for (int m = 0; m < 4; ++m) { const int row = row00 + ai * HALF + m * 16;
#pragma unroll
                    for (int bj = 0; bj < 2; ++bj) { EPI_GET8(v, ai, bj, m);
#pragma unroll
                        for (int i = 0; i < 8; ++i) v[i] = gelu_tanh(v[i]);
                        *(u32x4*)((bf16_t*)(ws + WS_UACT) + (size_t)row * 512 + col0 + bj * HALF) = pack8(v); } }
        }
    }
};

struct EpiUq {
    static constexpr bool PERM = true, AFTER_DRAIN = false;
    bf16_t* Qm; const float* cosM; const float* sinM;
    __device__ __forceinline__ void operator()(const f32x4 (&acc)[2][2][4][2], const Unit& u, int wr, int wc, int fr, int fq) const {
        asm volatile("" : "+v"(fr), "+v"(fq));
        EPI_ROWS(u, wr, fr);
        if (u.pn < 2) {
#pragma unroll
            for (int ai = 0; ai < 2; ++ai)
#pragma unroll
                for (int m = 0; m < 4; ++m) { const int row = row00 + ai * HALF + m * 16;
#pragma unroll
                    for (int bj = 0; bj < 2; ++bj) { const int col = u.pn * BM + bj * HALF + wc * 32 + 8 * fq; const int head = col >> 6, d = col & 63;
                        EPI_GET8(v, ai, bj, m);
#pragma unroll
                        for (int i = 0; i < 8; ++i) v[i] *= C2M;
                        *(u32x4*)(Qm + (size_t)row * 768 + head * 96 + d) = pack8(v); } asm volatile("" ::: "memory"); }
        } else {
            const int cc = wc * 32 + 8 * fq, hh = cc >> 4, j0 = cc & 15;
            const bool lat = (u.pm * BM) < TL;
#pragma unroll
            for (int ai = 0; ai < 2; ++ai) {
                f32x4 tc[4][2], ts[4][2];
#pragma unroll
                for (int m = 0; m < 4; ++m) { const int pos = lat ? ((row00 + ai * HALF + m * 16) & (SEQ - 1)) : 0; const f32x4* cp = (const f32x4*)(cosM + (size_t)pos * 16 + j0); const f32x4* sp = (const f32x4*)(sinM + (size_t)pos * 16 + j0);
                    tc[m][0] = cp[0]; tc[m][1] = cp[1]; ts[m][0] = sp[0]; ts[m][1] = sp[1]; }
#pragma unroll
                for (int m = 0; m < 4; ++m) { const int row = row00 + ai * HALF + m * 16;
                    EPI_GET8(x1, ai, 0, m); EPI_GET8(x2, ai, 1, m);
                    float cs[8], sn[8];
#pragma unroll
                    for (int i = 0; i < 8; ++i) { cs[i] = lat ? tc[m][i >> 2][i & 3] : 1.f; sn[i] = lat ? ts[m][i >> 2][i & 3] : 0.f; }
                    float o1[8], o2[8];
#pragma unroll
                    for (int i = 0; i < 8; ++i) { o1[i] = (x1[i] * cs[i] - x2[i] * sn[i]) * C2M; o2[i] = (x2[i] * cs[i] + x1[i] * sn[i]) * C2M; }
                    bf16_t* qp = Qm + (size_t)row * 768 + hh * 96 + 64 + j0;
                    *(u32x4*)(qp) = pack8(o1); *(u32x4*)(qp + 16) = pack8(o2); }
                asm volatile("" ::: "memory"); }
        }
    }
};

struct EpiUkv {
    static constexpr bool PERM = true, AFTER_DRAIN = false;
    bf16_t* Km; bf16_t* Vm;
    __device__ __forceinline__ void operator()(const f32x4 (&acc)[2][2][4][2], const Unit& u, int wr, int wc, int fr, int fq) const {
        asm volatile("" : "+v"(fr), "+v"(fq));
        EPI_ROWS(u, wr, fr); const int within = wc * 32 + 8 * fq;
#pragma unroll
        for (int ai = 0; ai < 2; ++ai)
#pragma unroll
            for (int m = 0; m < 4; ++m) { const int row = row00 + ai * HALF + m * 16; int b_, pos_; bpos_of(row, b_, pos_);
#pragma unroll
                for (int bj = 0; bj < 2; ++bj) { const int head = u.pn * 2 + bj; EPI_GET8(v, ai, bj, m);
                    bf16_t* p = (within < 64) ? (Km + ktile_off(b_ * 8 + head, pos_, within >> 3, 12)) : (Vm + vtile_off(b_ * 8 + head, pos_, within - 64));
                    *(u32x4*)p = pack8(v); } asm volatile("" ::: "memory"); }
    }
};

template <int IDX> struct EpiBranch {
    static constexpr bool PERM = true, AFTER_DRAIN = false;
    const bf16_t* Z; bf16_t* MERGEB;
    __device__ __forceinline__ void operator()(const f32x4 (&acc)[2][2][4][2], const Unit& u, int wr, int wc, int fr, int fq) const {
        asm volatile("" : "+v"(fr), "+v"(fq));
        EPI_ROWS(u, wr, fr); const int col0 = u.pn * BM + wc * 32 + 8 * fq;
#pragma unroll
        for (int ai = 0; ai < 2; ++ai) {
            u32x4 gr[4][2], mr[4][2];
#pragma unroll
            for (int m = 0; m < 4; ++m) { const int row = row00 + ai * HALF + m * 16;
#pragma unroll
                for (int bj = 0; bj < 2; ++bj) { const int col = col0 + bj * HALF; gr[m][bj] = *(const u32x4*)(Z + (size_t)row * 3072 + IDX * 1024 + col);
                    if (IDX != 0) mr[m][bj] = *(const u32x4*)(MERGEB + (size_t)row * 1024 + col); } }
#pragma unroll
            for (int m = 0; m < 4; ++m) { const int row = row00 + ai * HALF + m * 16;
#pragma unroll
                for (int bj = 0; bj < 2; ++bj) { const int col = col0 + bj * HALF; EPI_GET8(v, ai, bj, m); float g[8], a[8], r[8]; unpack8(gr[m][bj], g);
                    if (IDX != 0) unpack8(mr[m][bj], a);
#pragma unroll
                    for (int i = 0; i < 8; ++i) r[i] = (IDX != 0 ? a[i] : 0.f) + sigmoidf_(g[i]) * v[i];
                    *(u32x4*)(MERGEB + (size_t)row * 1024 + col) = pack8(r); } }
            asm volatile("" ::: "memory"); }
    }
};

struct EpiMoe1 {
    static constexpr bool PERM = true, AFTER_DRAIN = false;
    bf16_t* H; const float* b1;
    __device__ __forceinline__ void operator()(const f32x4 (&acc)[2][2][4][2], const Unit& u, int wr, int wc, int fr, int fq) const {
        asm volatile("" : "+v"(fr), "+v"(fq));
        EPI_ROWS(u, wr, fr); const int e = u.pn >> 3, pnl = u.pn & 7, cc = pnl * 128 + wc * 32 + 8 * fq;
        const float* bp = b1 + (size_t)e * 2048 + cc;
        const f32x4 bg0 = *(const f32x4*)bp, bg1 = *(const f32x4*)(bp + 4), bl0 = *(const f32x4*)(bp + 1024), bl1 = *(const f32x4*)(bp + 1028);
        float lim = 7.0f; asm volatile("" : "+v"(lim));
#pragma unroll
        for (int ai = 0; ai < 2; ++ai)
#pragma unroll
            for (int m = 0; m < 4; ++m) { const int row = row00 + ai * HALF + m * 16;
                EPI_GET8(g, ai, 0, m); EPI_GET8(l, ai, 1, m); float r[8];
#pragma unroll
                for (int i = 0; i < 8; ++i) { float glu = g[i] + (i < 4 ? bg0[i] : bg1[i - 4]); float lin = l[i] + (i < 4 ? bl0[i] : bl1[i - 4]);
                    glu = fminf(glu, lim); lin = fminf(fmaxf(lin, -lim), lim);
                    r[i] = glu * sigmoidf_(1.702f * glu) * (lin + 1.0f); }
                *(u32x4*)(H + (size_t)row * 1024 + cc) = pack8(r); }
    }
};

struct EpiMoe2 {
    static constexpr bool PERM = true, AFTER_DRAIN = false;
    bf16_t* Yp; const float* b2; const float* lw; const PG8_LAS int* tab;
    __device__ __forceinline__ void operator()(const f32x4 (&acc)[2][2][4][2], const Unit& u, int wr, int wc, int fr, int fq) const {
        asm volatile("" : "+v"(fr), "+v"(fq));
        EPI_ROWS(u, wr, fr); const int e = u.pn >> 2, pnl = u.pn & 3, col0 = pnl * BM + wc * 32 + 8 * fq;
        f32x4 bv[2][2];
#pragma unroll
        for (int bj = 0; bj < 2; ++bj) { bv[bj][0] = *(const f32x4*)(b2 + (size_t)e * 1024 + col0 + bj * HALF); bv[bj][1] = *(const f32x4*)(b2 + (size_t)e * 1024 + col0 + bj * HALF + 4); }
        float wrow[2][4]; { const int ps_ = tab[600 + e], cn_ = tab[640 + e];
#pragma unroll
            for (int ai = 0; ai < 2; ++ai)
#pragma unroll
                for (int m = 0; m < 4; ++m) { const int slot = row00 + ai * HALF + m * 16 - ps_; wrow[ai][m] = lw[(size_t)e * TA + (slot < cn_ ? slot : 0)]; if (slot >= cn_) wrow[ai][m] = 0.f; } }
#pragma unroll
        for (int ai = 0; ai < 2; ++ai)
#pragma unroll
            for (int m = 0; m < 4; ++m) { const int row = row00 + ai * HALF + m * 16; const float w = wrow[ai][m];
#pragma unroll
                for (int bj = 0; bj < 2; ++bj) { EPI_GET8(v, ai, bj, m); float r[8];
#pragma unroll
                    for (int i = 0; i < 8; ++i) r[i] = (v[i] + (i < 4 ? bv[bj][0][i] : bv[bj][1][i - 4])) * w;
                    *(u32x4*)(Yp + (size_t)row * 1024 + col0 + bj * HALF) = pack8(r); } }
    }
};

template <int NPN> struct MoeOrder {
    int nunits, G, v; const PG8_LAS int* tab; const PG8_LAS int* rowtok;
    __device__ __forceinline__ int tok(int i, int r) const { return rowtok[i * 256 + r]; }
    __device__ __forceinline__ bool next(int i, Unit& u) const {
        const long L = (long)i * G + v; if (L >= nunits) return false;
        const int blk = (int)L / NPN, pnl = (int)L % NPN; const int e = __builtin_amdgcn_readfirstlane(tab[blk]);
        u.pm = blk; u.pn = e * NPN + pnl; return true;
    }
    __device__ __forceinline__ void a_ready(const Unit&) const {}
    __device__ __forceinline__ void done(const Unit&) const {}
};
}
namespace attn_body {
using bf16x8=__attribute__((ext_vector_type(8)))short;
using s16x4=__attribute__((ext_vector_type(4)))short;
using f32x16=__attribute__((ext_vector_type(16)))float;
using u32x4=__attribute__((ext_vector_type(4)))unsigned;
constexpr int NW=8,QBLK=32,QB=QBLK*NW,KVBLK=64;
__device__ __forceinline__ int crow(int r,int hi){return (r&3)+8*(r>>2)+4*hi;}
#define SBAR() __builtin_amdgcn_sched_barrier(0)
constexpr int NSLOT=3, SLOTB=8192;
__device__ __forceinline__ void glds16(const void*gsrc,unsigned lds_dst){unsigned keep;
  asm volatile("s_mov_b32 %0, m0\n\ts_mov_b32 m0, %2\n\ts_nop 0\n\tglobal_load_lds_dwordx4 %1, off\n\ts_mov_b32 m0, %0":"=&s"(keep):"v"(gsrc),"s"(lds_dst):"memory");}
__device__ __forceinline__ float max3f(float a,float b,float c){float r;asm("v_max3_f32 %0, %1, %2, %3":"=v"(r):"v"(a),"v"(b),"v"(c));return r;}
__device__ __forceinline__ float max2f(float a,float b){float r;asm("v_max_f32_e32 %0, %1, %2":"=v"(r):"v"(a),"v"(b));return r;}
__device__ __forceinline__ float fadd_s(float a,float b){float r;asm("v_add_f32_e32 %0, %1, %2":"=v"(r):"v"(a),"v"(b));return r;}
__device__ __forceinline__ float fsub_s(float a,float b){float r;asm("v_sub_f32_e32 %0, %1, %2":"=v"(r):"v"(a),"v"(b));return r;}
typedef float f32x2_t __attribute__((ext_vector_type(2))); typedef __bf16 bf16x2_t __attribute__((ext_vector_type(2)));
__device__ __forceinline__ unsigned cvtpk_s(float lo,float hi){f32x2_t v={lo,hi};bf16x2_t b=__builtin_convertvector(v,bf16x2_t);return __builtin_bit_cast(unsigned,b);}
#define WAIT_BAR(N) asm volatile("s_waitcnt vmcnt(" #N ") lgkmcnt(0)\n\ts_barrier":::"memory")
typedef __attribute__((address_space(3))) const char* lds_cptr;
typedef short v4i16_t __attribute__((ext_vector_type(4)));
__device__ __forceinline__ void kload2(bf16x8*kf,lds_cptr kp,int j){ kf[2*j]=*(const __attribute__((address_space(3))) bf16x8*)(kp+j*2048); kf[2*j+1]=*(const __attribute__((address_space(3))) bf16x8*)(kp+j*2048+512); }
__device__ __forceinline__ s16x4 vtr(lds_cptr p){ return __builtin_bit_cast(s16x4,__builtin_amdgcn_ds_read_tr16_b64_v4i16((__attribute__((address_space(3))) v4i16_t*)p)); }
__device__ __forceinline__ float rowmax(const f32x16&p0,const f32x16&p1){
  float a=max3f(p0[0],p0[1],p1[0]),b=max3f(p0[2],p0[3],p1[1]);a=max3f(a,p1[2],p1[3]);
  #pragma unroll
  for(int r=4;r<16;r+=4){a=max3f(a,p0[r],p0[r+1]);b=max3f(b,p0[r+2],p0[r+3]);a=max3f(a,p1[r],p1[r+1]);b=max3f(b,p1[r+2],p1[r+3]);}
  const float m=max2f(a,b);
  auto rr=__builtin_amdgcn_permlane32_swap(__float_as_uint(m),__float_as_uint(m),false,false);
  return max2f(__uint_as_float(rr[0]),__uint_as_float(rr[1]));
}
__device__ __forceinline__ void pv(f32x16*o,int vb,bf16x8 pa0,bf16x8 pa1,bf16x8 pa2,bf16x8 pa3){
  #pragma unroll
  for(int d0=0;d0<2;++d0){s16x4 lo[4],hi[4];
    #pragma unroll
    for(int ks=0;ks<4;++ks){
      asm volatile("ds_read_b64_tr_b16 %0,%1 offset:%c2":"=&v"(lo[ks]):"v"(vb),"i"(d0*4096+ks*1024):"memory");
      asm volatile("ds_read_b64_tr_b16 %0,%1 offset:%c2":"=&v"(hi[ks]):"v"(vb),"i"(d0*4096+ks*1024+512):"memory");}
    asm volatile("s_waitcnt lgkmcnt(0)":::"memory");SBAR();
    #define PK(k) (bf16x8){lo[k][0],lo[k][1],lo[k][2],lo[k][3],hi[k][0],hi[k][1],hi[k][2],hi[k][3]}
    o[d0]=__builtin_amdgcn_mfma_f32_32x32x16_bf16(pa0,PK(0),o[d0],0,0,0);
    o[d0]=__builtin_amdgcn_mfma_f32_32x32x16_bf16(pa1,PK(1),o[d0],0,0,0);
    o[d0]=__builtin_amdgcn_mfma_f32_32x32x16_bf16(pa2,PK(2),o[d0],0,0,0);
    o[d0]=__builtin_amdgcn_mfma_f32_32x32x16_bf16(pa3,PK(3),o[d0],0,0,0);
    #undef PK
  }
}
template<int NKS> struct AttnLds {
  static constexpr int SLOTK=NKS*2048;
  static constexpr int LDS_K=0, LDS_V=NSLOT*SLOTK, LDS_WS=LDS_V+NSLOT*SLOTB, LDS_OST=LDS_WS+NW*64*4, LDS_BYTES=LDS_OST+NW*4096;
};
template<int NKS,int QP,int KP,int VP,int OP,int THRL,bool LS,bool SK>
__device__ __forceinline__ void attn_unit(const bf16*Qu,const bf16*__restrict__ Ku,const bf16*__restrict__ Vu,bf16*Ou,const int NT,char*shm){
  using L=AttnLds<NKS>;
  constexpr int SLOTK=L::SLOTK, LDS_K=L::LDS_K, LDS_V=L::LDS_V, LDS_WS=L::LDS_WS, LDS_OST=L::LDS_OST;
  int tid_=threadIdx.x; asm volatile("":"+v"(tid_));
  const int tid=tid_,lane=tid&63,r32=lane&31,hi=lane>>5; const int wid=__builtin_amdgcn_readfirstlane(tid>>6);
  const bf16*Qw=Qu+(long)(wid*QBLK)*QP;
  const unsigned lds0=(unsigned)(uintptr_t)shm;
  float*wsf=(float*)(shm+LDS_WS)+wid*64;
  const bf16*ksrc=Ku+wid*512+lane*8;
  const bf16*ksrc2=Ku+(8+(wid&3))*512+lane*8;
  const bf16*vsrc=Vu+wid*512+lane*8;
  const unsigned kdst=lds0+LDS_K+wid*1024, kdst2=lds0+LDS_K+(8+(wid&3))*1024, vdst=lds0+LDS_V+wid*1024;
  #define DMA_K(t,slot) do{ glds16(ksrc+(long)(t)*(NKS*1024),(unsigned)__builtin_amdgcn_readfirstlane(kdst+(slot))); \
      if constexpr(NKS==6){ glds16(ksrc2+(long)(t)*(NKS*1024),(unsigned)__builtin_amdgcn_readfirstlane(kdst2+(slot))); } }while(0)
  #define DMA_V(t,slot) glds16(vsrc+(long)(t)*4096,(unsigned)__builtin_amdgcn_readfirstlane(vdst+(slot)))
  #define WAIT_C()  do{ if constexpr(NKS==6){WAIT_BAR(3);}else{WAIT_BAR(2);} }while(0)
  #define WAIT_P()  do{ if constexpr(NKS==6){WAIT_BAR(5);}else{WAIT_BAR(3);} }while(0)
  #define WAITA_K() do{ if constexpr(NKS==6){WAIT_BAR(2);}else{WAIT_BAR(1);} }while(0)
  #define BARONLY() asm volatile("s_barrier":::"memory")
  const int vb0=(int)(lds0+LDS_V)+((lane>>4)&1)*32+(lane&3)*8+(4*hi+((lane&15)>>2))*64;
  const char*Kbase=shm+LDS_K; bf16x8 kf[2*NKS];
  const lds_cptr shm3=(lds_cptr)shm; const lds_cptr kp0=shm3+LDS_K+hi*1024+r32*16; const lds_cptr vp0=shm3+LDS_V+((lane>>4)&1)*32+(lane&3)*8+(4*hi+((lane&15)>>2))*64;
  DMA_K(0,0);DMA_V(0,0);DMA_K(1,SLOTK);
  bf16x8 qr[NKS];
  #pragma unroll
  for(int d0=0;d0<NKS;++d0)qr[d0]=*reinterpret_cast<const bf16x8*>(&Qw[(long)r32*QP+d0*16+hi*8]);
  float mhat=0.f,l_reg=0.f;f32x16 o[2];o[0]=f32x16{};o[1]=f32x16{};f32x16 negm=f32x16{};asm volatile("":"+v"(negm));
  f32x16 o2=f32x16{}; const bf16x8 ONES=(bf16x8){(short)0x3F80,(short)0x3F80,(short)0x3F80,(short)0x3F80,(short)0x3F80,(short)0x3F80,(short)0x3F80,(short)0x3F80};
  bool resc=false;
  #define START(P0,P1) do{ const float rm=rowmax(P0,P1); resc=false; \
    { const float dl=rm; mhat=fadd_s(mhat,dl); \
      _Pragma("unroll") for(int r=0;r<16;++r){P0[r]=fsub_s(P0[r],dl);P1[r]=fsub_s(P1[r],dl);} \
      _Pragma("unroll") for(int r=0;r<16;++r)negm[r]=-mhat; asm volatile("":"+v"(negm)); } \
    _Pragma("unroll") for(int r=0;r<16;++r)P0[r]=__builtin_amdgcn_exp2f(P0[r]); }while(0)
  #define RESC() do{ if(resc){ asm volatile("s_waitcnt lgkmcnt(0)":::"memory"); \
      _Pragma("unroll") for(int d_=0;d_<2;++d_) _Pragma("unroll") for(int r=0;r<16;++r)o[d_][r]*=wsf[crow(r,hi)]; \
      if constexpr(LS){ _Pragma("unroll") for(int r=0;r<16;++r)o2[r]*=wsf[crow(r,hi)]; } } }while(0)
  f32x16 pA0,pA1,pB0,pB1;
  int kl_cur=0,kl_next=SLOTK;
  int sl_prev=0,sl_cur=0,sl_next=SLOTB;
  #define ROT() do{sl_prev=sl_cur;sl_cur=sl_next;sl_next=(sl_next==(NSLOT-1)*SLOTB)?0:sl_next+SLOTB; kl_cur=kl_next;kl_next=(kl_next==(NSLOT-1)*SLOTK)?0:kl_next+SLOTK;}while(0)
  DMA_K(2,2*SLOTK);
  WAIT_P();
  { const char*kb=Kbase+hi*1024+r32*16;
    #pragma unroll
    for(int d0=0;d0<NKS;++d0){
      const bf16x8 b0=*reinterpret_cast<const bf16x8*>(kb+d0*2048);
      const bf16x8 b1=*reinterpret_cast<const bf16x8*>(kb+d0*2048+512);
      if(d0==0){pA0=__builtin_amdgcn_mfma_f32_32x32x16_bf16(b0,qr[0],negm,0,0,0);pA1=__builtin_amdgcn_mfma_f32_32x32x16_bf16(b1,qr[0],negm,0,0,0);}
      else{pA0=__builtin_amdgcn_mfma_f32_32x32x16_bf16(b0,qr[d0],pA0,0,0,0);pA1=__builtin_amdgcn_mfma_f32_32x32x16_bf16(b1,qr[d0],pA1,0,0,0);}} }
  asm volatile("s_nop 15\n\ts_nop 7":"+v"(pA0),"+v"(pA1));
  START(pA0,pA1);
  _Pragma("unroll") for(int r=0;r<16;++r)pA1[r]=__builtin_amdgcn_exp2f(pA1[r]);
  WAIT_BAR(0);
  if constexpr(SK){ DMA_V(1,SLOTB);DMA_K(3,0); } else { DMA_K(3,0);DMA_V(1,SLOTB); }
  ROT();
  _Pragma("unroll") for(int j=0;j<NKS;++j)kload2(kf,kp0+kl_cur,j);
  WAIT_C();
  if constexpr(SK){ if(wid>=4){ BARONLY(); } }
  s16x4 vlo[8],vhi[8]; u32x4 pw0,pw1,pw2,pw3;
  #define PKW(P,B) cvtpk_s(P[B],P[B+1])
  #define PAF(k) __builtin_bit_cast(bf16x8,pw##k)
  #define VFR(i) (bf16x8){vlo[i][0],vlo[i][1],vlo[i][2],vlo[i][3],vhi[i][0],vhi[i][1],vhi[i][2],vhi[i][3]}
  #define PIN(x) asm volatile("":"+v"(x))
  #define MX3(a,b,c) __builtin_fmaxf(__builtin_fmaxf((a),(b)),(c))
  #define GAPA(MF,A0,A1,A2,A3,W0,W1,PW) do{ MF; if constexpr(!LS){ sacc+=A0; sacc+=A1; sacc+=A2; sacc+=A3; PIN(sacc); } W0; W1; PIN(PW); SBAR(); }while(0)
  #define LSM(k) do{ if constexpr(LS){ o2=MF32(PAF(k),ONES,o2); SBAR(); } }while(0)
  #define EX(v) __builtin_amdgcn_exp2f(v)
  #define GAPB(MF,X,B) do{ MF; X[B]=EX(X[B]); X[B+1]=EX(X[B+1]); X[B+2]=EX(X[B+2]); X[B+3]=EX(X[B+3]); PIN(X); SBAR(); }while(0)
  #define VRD(i) do{ vlo[i]=vtr(vp_+(((i)>>2)*4096+((i)&3)*1024)); vhi[i]=vtr(vp_+(((i)>>2)*4096+((i)&3)*1024+512)); }while(0)
  #define KRD(G,j) do{ if(G){ kload2(kf,kp0+kl_next,j); SBAR(); } }while(0)
  #define MF32(a,b,c) __builtin_amdgcn_mfma_f32_32x32x16_bf16(a,b,c,0,0,0)
  #define STEP(C0,C1,P0,P1,t,GK,GV,GL,CK,MW) do{ SBAR(); \
    const lds_cptr vp_=vp0+sl_prev; \
    VRD(0); SBAR(); float sacc=LS?0.f:(P0[0]+P0[1]); \
    GAPA(C0=MF32(kf[0],qr[0],negm), P0[2],P0[3],P0[4],P0[5],     pw0[0]=PKW(P0,0), pw0[1]=PKW(P0,2), pw0); \
    VRD(4); SBAR(); GAPA(C1=MF32(kf[1],qr[0],negm), P0[6],P0[7],P0[8],P0[9],     pw0[2]=PKW(P0,4), pw0[3]=PKW(P0,6), pw0); \
    VRD(1); SBAR(); GAPA(C0=MF32(kf[2],qr[1],C0),   P0[10],P0[11],P0[12],P0[13], pw1[0]=PKW(P0,8), pw1[1]=PKW(P0,10), pw1); \
    VRD(5); SBAR(); GAPA(C1=MF32(kf[3],qr[1],C1),   P0[14],P0[15],P1[0],P1[1],   pw1[2]=PKW(P0,12),pw1[3]=PKW(P0,14), pw1); \
    VRD(2); SBAR(); GAPA(C0=MF32(kf[4],qr[2],C0),   P1[2],P1[3],P1[4],P1[5],     pw2[0]=PKW(P1,0), pw2[1]=PKW(P1,2), pw2); \
    VRD(6); SBAR(); GAPA(C1=MF32(kf[5],qr[2],C1),   P1[6],P1[7],P1[8],P1[9],     pw2[2]=PKW(P1,4), pw2[3]=PKW(P1,6), pw2); \
    VRD(3); SBAR(); GAPA(C0=MF32(kf[6],qr[3],C0),   P1[10],P1[11],P1[12],P1[13], pw3[0]=PKW(P1,8), pw3[1]=PKW(P1,10), pw3); \
    VRD(7); SBAR(); GAPA(C1=MF32(kf[7],qr[3],C1),   P1[14],P1[15],0.f,0.f,       pw3[2]=PKW(P1,12),pw3[3]=PKW(P1,14), pw3); \
    if constexpr(NKS==6){ C0=MF32(kf[8],qr[4],C0); SBAR(); C1=MF32(kf[9],qr[4],C1); SBAR(); C0=MF32(kf[10],qr[5],C0); SBAR(); C1=MF32(kf[11],qr[5],C1); SBAR(); } \
    if constexpr(!LS){ l_reg+=sacc; } \
    if constexpr(SK){ MW; if(GV){DMA_V((t)+1,sl_next);} if(GK){DMA_K((t)+3,kl_cur);} } else { if(GK){DMA_K((t)+3,kl_cur);} if(GV){DMA_V((t)+1,sl_next);} } \
    if(CK){ float a=MX3(C0[0],C0[1],C1[0]),b=MX3(C0[2],C0[3],C1[1]); a=MX3(a,C1[2],C1[3]); \
      _Pragma("unroll") for(int r=4;r<16;r+=4){a=MX3(a,C0[r],C0[r+1]);b=MX3(b,C0[r+2],C0[r+3]);a=MX3(a,C1[r],C1[r+1]);b=MX3(b,C1[r+2],C1[r+3]);} \
      float rm=__builtin_fmaxf(a,b); { auto rr=__builtin_amdgcn_permlane32_swap(__float_as_uint(rm),__float_as_uint(rm),false,false); rm=__builtin_fmaxf(__uint_as_float(rr[0]),__uint_as_float(rr[1])); } \
      resc=false; \
      if(__builtin_expect(__any(rm>(float)THRL),0)){ const float dl=__builtin_fmaxf(rm,0.f); mhat+=dl; \
        _Pragma("unroll") for(int r=0;r<16;++r){C0[r]-=dl;C1[r]-=dl;} \
        _Pragma("unroll") for(int r=0;r<16;++r)negm[r]=-mhat; asm volatile("":"+v"(negm)); \
        const float f=__builtin_amdgcn_exp2f(-dl); l_reg*=f; if(hi==0)wsf[r32]=f; resc=true; } } else { resc=false; } \
    SBAR(); \
    GAPB(o[0]=MF32(PAF(0),VFR(0),o[0]), C0,0); \
    GAPB(o[1]=MF32(PAF(0),VFR(4),o[1]), C0,4); LSM(0); \
    KRD(GL,0); GAPB(o[0]=MF32(PAF(1),VFR(1),o[0]), C0,8); \
    KRD(GL,1); GAPB(o[1]=MF32(PAF(1),VFR(5),o[1]), C0,12); LSM(1); \
    KRD(GL,2); GAPB(o[0]=MF32(PAF(2),VFR(2),o[0]), C1,0); \
    KRD(GL,3); GAPB(o[1]=MF32(PAF(2),VFR(6),o[1]), C1,4); LSM(2); \
    if constexpr(NKS==6){ KRD(GL,4); } GAPB(o[0]=MF32(PAF(3),VFR(3),o[0]), C1,8); \
    if constexpr(NKS==6){ KRD(GL,5); } GAPB(o[1]=MF32(PAF(3),VFR(7),o[1]), C1,12); LSM(3); \
    }while(0)
  int t=1;
  for(;t+11<NT;t+=8){
    STEP(pB0,pB1,pA0,pA1,t,true,true,true,true,WAITA_K());      WAIT_C(); RESC(); ROT();
    STEP(pA0,pA1,pB0,pB1,t+1,true,true,true,false,WAITA_K());   WAIT_C(); ROT();
    STEP(pB0,pB1,pA0,pA1,t+2,true,true,true,false,WAITA_K());   WAIT_C(); ROT();
    STEP(pA0,pA1,pB0,pB1,t+3,true,true,true,false,WAITA_K());   WAIT_C(); ROT();
    STEP(pB0,pB1,pA0,pA1,t+4,true,true,true,false,WAITA_K());   WAIT_C(); ROT();
    STEP(pA0,pA1,pB0,pB1,t+5,true,true,true,false,WAITA_K());   WAIT_C(); ROT();
    STEP(pB0,pB1,pA0,pA1,t+6,true,true,true,false,WAITA_K());   WAIT_C(); ROT();
    STEP(pA0,pA1,pB0,pB1,t+7,true,true,true,false,WAITA_K());   WAIT_C(); ROT();
  }
  for(;t+5<NT;t+=2){
    STEP(pB0,pB1,pA0,pA1,t,true,true,true,true,WAITA_K());     WAIT_C(); RESC(); ROT();
    STEP(pA0,pA1,pB0,pB1,t+1,true,true,true,true,WAITA_K());   WAIT_C(); RESC(); ROT();
  }
  #define ENDW(tt) do{ if constexpr(SK){ if((tt)+3<NT){WAIT_C();} else if((tt)+1<NT){WAIT_BAR(1);} else {WAIT_BAR(0);} } \
                       else { if((tt)+3<NT){WAIT_C();} else if((tt)+2<NT){WAIT_BAR(1);} else {WAIT_BAR(0);} } }while(0)
  #define ENDA(tt) do{ if((tt)+2<NT){WAITA_K();} else {WAIT_BAR(0);} }while(0)
  for(;t+1<NT;t+=2){
    STEP(pB0,pB1,pA0,pA1,t,(t+3<NT),(t+1<NT),(t+1<NT),true,ENDA(t));         ENDW(t);   RESC(); ROT();
    STEP(pA0,pA1,pB0,pB1,t+1,(t+4<NT),(t+2<NT),(t+2<NT),true,ENDA(t+1));     ENDW(t+1); RESC(); ROT();
  }
  STEP(pB0,pB1,pA0,pA1,NT-1,false,false,false,true,WAIT_BAR(0)); if constexpr(SK){ WAIT_BAR(0); } RESC();
  { if constexpr(!LS){ float sacc=pB0[0]+pB0[1]; _Pragma("unroll") for(int r=2;r<16;++r)sacc+=pB0[r]; _Pragma("unroll") for(int r=0;r<16;++r)sacc+=pB1[r]; l_reg+=sacc; }
    pw0=(u32x4){PKW(pB0,0),PKW(pB0,2),PKW(pB0,4),PKW(pB0,6)};pw1=(u32x4){PKW(pB0,8),PKW(pB0,10),PKW(pB0,12),PKW(pB0,14)};pw2=(u32x4){PKW(pB1,0),PKW(pB1,2),PKW(pB1,4),PKW(pB1,6)};pw3=(u32x4){PKW(pB1,8),PKW(pB1,10),PKW(pB1,12),PKW(pB1,14)};
    SBAR(); pv(o,vb0+sl_cur,PAF(0),PAF(1),PAF(2),PAF(3)); LSM(0); LSM(1); LSM(2); LSM(3); }
  if constexpr(SK){ if(wid<4){ BARONLY(); } }
  #undef PKW
  #undef PAF
  #undef VFR
  #undef PIN
  #undef MX3
  #undef GAPA
  #undef GAPB
  #undef EX
  #undef VRD
  #undef KRD
  #undef LSM
  #undef MF32
  #undef STEP
  #undef ENDW
  #undef ENDA
  float rli[16];
  if constexpr(LS){
    #pragma unroll
    for(int r=0;r<16;++r)rli[r]=__builtin_amdgcn_rcpf(o2[r]);
  } else {
    {auto rr=__builtin_amdgcn_permlane32_swap(__float_as_uint(l_reg),__float_as_uint(l_reg),false,false);l_reg=__uint_as_float(rr[0])+__uint_as_float(rr[1]);}
    if(hi==0)wsf[32+r32]=l_reg;asm volatile("s_waitcnt lgkmcnt(0)":::"memory");
    #pragma unroll
    for(int r=0;r<16;++r)rli[r]=__builtin_amdgcn_rcpf(wsf[32+crow(r,hi)]);
  }
  bf16*Ow=Ou+(long)(wid*QBLK)*OP;
  { bf16*stg=(bf16*)(shm+LDS_OST)+wid*2048;
    #pragma unroll
    for(int r=0;r<16;++r){const int orow=crow(r,hi);
      #pragma unroll
      for(int d0=0;d0<2;++d0)stg[orow*64+d0*32+r32]=(bf16)(cvtpk_s(o[d0][r]*rli[r],0.f)&0xffffu);}
    asm volatile("s_waitcnt lgkmcnt(0)":::"memory");
    #pragma unroll
    for(int i=0;i<4;++i){const int row=i*8+(lane>>3),ch=lane&7; const u32x4 v=*(const u32x4*)(stg+row*64+ch*8); *(u32x4*)(Ow+(long)row*OP+ch*8)=v;} }
  asm volatile("s_waitcnt lgkmcnt(0)\n\ts_barrier":::"memory");
  #undef DMA_K
  #undef DMA_V
  #undef WAIT_C
  #undef WAIT_P
  #undef WAITA_K
  #undef BARONLY
  #undef START
  #undef RESC
  #undef ROT
}
#undef SBAR
#undef WAIT_BAR
}
#define XB_TMO      128
#define XB_XCNT(j)  (256  + 64 * (j))
#define XB_XSUB(j)  (1280 + 64 * (j))
#define XB_XGEN(j)  (2304 + 64 * (j))
#define XB_TOP      3328
#define XB_TOPGEN   3392
#define XCD_BAR_WORDS 3456
#define XB_SPIN_CAP (1u << 20)

__device__ __forceinline__ unsigned xb_ld(unsigned* p)              { return __hip_atomic_load(p, __ATOMIC_RELAXED, __HIP_MEMORY_SCOPE_AGENT); }
__device__ __forceinline__ unsigned xb_add(unsigned* p, unsigned v) { return __hip_atomic_fetch_add(p, v, __ATOMIC_RELAXED, __HIP_MEMORY_SCOPE_AGENT); }
__device__ __forceinline__ unsigned xb_xcc_id() { return (unsigned)__builtin_amdgcn_s_getreg((3 << 11) | 20) & 0xFu; }
#define XB_SPIN(cond, bar) do { unsigned _sp = 0; while (cond) { __builtin_amdgcn_s_sleep(1); \
    if ((++_sp & 255u) == 0u) { if (xb_ld(&(bar)[XB_TMO])) break; if (_sp > XB_SPIN_CAP) { atomicAdd(&(bar)[XB_TMO], 1u); break; } } } } while (0)

struct XcdBarrier {
    unsigned* bar; unsigned x;
    volatile LAS unsigned* st;
};
__device__ __forceinline__ XcdBarrier xcd_barrier_post(unsigned* bar, volatile LAS unsigned* st) {
    XcdBarrier b; b.bar = bar; b.x = xb_xcc_id(); b.st = st;
    if (threadIdx.x == 0) (void)xb_add(&bar[XB_XCNT(b.x)], 1u);
    return b;
}
__device__ __forceinline__ void xcd_barrier_complete(unsigned* bar, unsigned x, unsigned& nloc, unsigned& nx) {
    const unsigned G = gridDim.x * gridDim.y * gridDim.z;
    unsigned sum, cnt, mine, sp = 0u;
    for (;;) {
        sum = 0u; cnt = 0u; mine = 0u;
        unsigned cj[16];
#pragma unroll
        for (unsigned j = 0; j < 16; ++j) cj[j] = xb_ld(&bar[XB_XCNT(j)]);
#pragma unroll
        for (unsigned j = 0; j < 16; ++j) { const unsigned c = cj[j]; sum += c; cnt += (c > 0u) ? 1u : 0u; mine = (j == x) ? c : mine; }
        if (sum == G) break;
        __builtin_amdgcn_s_sleep(1);
        if ((++sp & 255u) == 0u) { if (xb_ld(&bar[XB_TMO])) break; if (sp > XB_SPIN_CAP) { atomicAdd(&bar[XB_TMO], 1u); break; } }
    }
    nloc = mine > 0u ? mine : 1u; nx = cnt > 0u ? cnt : 1u;
}
__device__ __forceinline__ void xcd_barrier(const XcdBarrier& b) {
    asm volatile("s_waitcnt vmcnt(0)" ::: "memory");
    __syncthreads();
    if (threadIdx.x == 0) {
        unsigned* bar = b.bar;
        __builtin_amdgcn_s_waitcnt(0);
        unsigned nloc = b.st[0], nx = b.st[1];
        if (nloc == 0u) { xcd_barrier_complete(bar, b.x, nloc, nx); b.st[0] = nloc; b.st[1] = nx; }
        const unsigned old = xb_add(&bar[XB_XSUB(b.x)], 1u);
        const unsigned gen = old / nloc;
        if (old + 1u == (gen + 1u) * nloc) {
            __builtin_amdgcn_fence(__ATOMIC_RELEASE, "agent");
            asm volatile("s_waitcnt vmcnt(0)" ::: "memory");
            const unsigned og = xb_add(&bar[XB_TOP], 1u);
            const unsigned tg = og / nx;
            if (og + 1u == (tg + 1u) * nx) xb_add(&bar[XB_TOPGEN], 1u);
            else XB_SPIN(xb_ld(&bar[XB_TOPGEN]) == tg, bar);
            __builtin_amdgcn_fence(__ATOMIC_ACQUIRE, "agent");
            xb_add(&bar[XB_XGEN(b.x)], 1u);
            asm volatile("s_waitcnt vmcnt(0)" ::: "memory");
        } else {
            XB_SPIN(xb_ld(&bar[XB_XGEN(b.x)]) == gen, bar);
            __builtin_amdgcn_fence(__ATOMIC_ACQUIRE, "agent");
            asm volatile("s_waitcnt vmcnt(0)" ::: "memory");
        }
    }
    __syncthreads();
}

struct Args { const float* in[24]; float* out; unsigned char* ws; };
enum { I_X = 0, I_C, I_CTX, I_CCTX, I_WMOD, I_BMOD, I_NORMS, I_WIN, I_QKN, I_MQN, I_MKVN, I_WUQ, I_WUKV, I_GVN, I_GWS, I_GBS, I_WBR, I_WOUT, I_RW, I_RB, I_EW1, I_EB1, I_EW2, I_EB2 };

struct Frame {
    LAS unsigned char* lds;
    volatile LAS unsigned* MISC;
    gu32* ctl;
    int tid, lane, wave, G, bx;
    unsigned char* ws;
    __device__ __forceinline__ const float* in(int i) const { const unsigned long long v = __hip_atomic_load((const unsigned long long*)(ws + WS_PTAB) + i, __ATOMIC_RELAXED, __HIP_MEMORY_SCOPE_AGENT);
        const unsigned lo = __builtin_amdgcn_readfirstlane((unsigned)v), hi = __builtin_amdgcn_readfirstlane((unsigned)(v >> 32));
        return (const float*)(const GAS float*)(((unsigned long long)hi << 32) | lo); }
    __device__ __forceinline__ float* out() const { return (float*)in(24); }
};

__device__ __forceinline__ int map_col(int kind, int n) {
    if (kind == 1) { const int pn = n >> 8, c = n & 255, bj = (c >> 7) & 1, wc = (c >> 5) & 3, j = c & 31;
        if (pn < 2) return (4 * pn + wc) * 64 + 32 * bj + j;
        if (pn == 2) return 512 + wc * 64 + 32 * bj + j;
        if (pn == 3) return 768 + c;
        if (pn == 4) { if (wc < 2) return 1024 + wc * 64 + 32 * bj + j; if (wc == 2 && j < 16) return 1152 + 16 * bj + j; return -1; }
        if (pn < 9) return 1184 + (pn - 5) * 256 + c;
        return 2208 + (pn - 9) * 256 + c; }
    if (kind == 2) { if (n < 512) return (n >> 6) * 96 + (n & 63); const int t = n - 512; return ((t & 127) >> 4) * 96 + 64 + 16 * (t >> 7) + (t & 15); }
    if (kind == 3) { return ((n >> 7) & 1) * 1024 + (n >> 8) * 128 + (n & 127); }
    return n;
}
__device__ __forceinline__ void transpose_item(const float* W, int K, int Nsrc, bf16* WT, int nblk, int kind, LAS float* scr, int item, int lane) {
    const int kb = item / nblk, nb = item % nblk, k0 = 64 * kb, n0 = 64 * nb;
    const int src = map_col(kind, n0 + 4 * (lane & 15));
    f32x4 v[16];
#pragma unroll
    for (int i = 0; i < 16; ++i) { const int kk = 4 * i + (lane >> 4); v[i] = (src >= 0) ? *(const f32x4*)(W + (size_t)(k0 + kk) * Nsrc + src) : (f32x4){0.f, 0.f, 0.f, 0.f}; }
#pragma unroll
    for (int i = 0; i < 16; ++i) { const int kk = 4 * i + (lane >> 4); LAS float* d = scr + kk * 65 + 4 * (lane & 15); d[0] = v[i][0]; d[1] = v[i][1]; d[2] = v[i][2]; d[3] = v[i][3]; }
    LDS_WAIT(); asm volatile("" ::: "memory");
    const int c = lane & 7;
#pragma unroll
    for (int j = 0; j < 8; ++j) { const int n = (lane >> 3) + 8 * j; const LAS float* s = scr + (8 * c) * 65 + n;
        v4u o; o.x = cvt_pk(s[0 * 65], s[1 * 65]); o.y = cvt_pk(s[2 * 65], s[3 * 65]); o.z = cvt_pk(s[4 * 65], s[5 * 65]); o.w = cvt_pk(s[6 * 65], s[7 * 65]);
        *(GAS v4u*)(WT + (size_t)(n0 + n) * K + k0 + 8 * c) = o; }
    LDS_WAIT(); asm volatile("" ::: "memory");
}
__device__ __forceinline__ void sincos_acc(float ang, float& c, float& s) {
    const double x = (double)ang; const double n = __builtin_rint(x * 0.6366197723675814);
    double r = __builtin_fma(-n, 1.5707963267948966, x); r = __builtin_fma(-n, 6.123233995736766e-17, r);
    const double r2 = r * r;
    double sp = -2.5052108385441720e-08; sp = sp * r2 + 2.7557319223985893e-06; sp = sp * r2 - 1.9841269841269841e-04; sp = sp * r2 + 8.3333333333333332e-03; sp = sp * r2 - 1.6666666666666666e-01; sp = sp * r2 * r + r;
    double cp = 2.0876756987868099e-09; cp = cp * r2 - 2.7557319223985888e-07; cp = cp * r2 + 2.4801587301587302e-05; cp = cp * r2 - 1.3888888888888889e-03; cp = cp * r2 + 4.1666666666666664e-02; cp = cp * r2 - 0.5; cp = cp * r2 + 1.0;
    const int q = ((int)n) & 3;
    const double sv = (q == 0) ? sp : (q == 1) ? cp : (q == 2) ? -sp : -cp;
    const double cv = (q == 0) ? cp : (q == 1) ? -sp : (q == 2) ? -cp : sp;
    c = (float)cv; s = (float)sv;
}

__device__ __forceinline__ void p_prologue(Frame& F, const Args& A) {
    const int gw = F.bx * 8 + F.wave, NGW = F.G * 8, lane = F.lane;
    if (F.bx == 0 && F.tid < 25) { ((unsigned long long*)(F.ws + WS_PTAB))[F.tid] = (F.tid < 24) ? (unsigned long long)(uintptr_t)A.in[F.tid] : (unsigned long long)(uintptr_t)A.out; }
    { LAS float* sv = (LAS float*)(F.lds + LDS_SVEC);
      for (int i = F.tid; i < 3 * 1024; i += 512) { const float v = (i < 2048) ? A.in[I_C][i] : A.in[I_CCTX][i - 2048]; sv[i] = v * sigmoidf_(v); }
      __syncthreads(); }
    { const LAS float* sv = (const LAS float*)(F.lds + LDS_SVEC); float* mod = (float*)(F.ws + WS_MOD); LAS float* red = (LAS float*)(F.lds + RING_OFF);
      for (int item = F.bx; item < DEPTH * 96; item += F.G) { const int l = item / 96, col0 = (item % 96) * 64, c4 = (lane & 15) * 4, kr = lane >> 4;
          const float* W = A.in[I_WMOD] + (size_t)l * 1024 * 6144 + col0 + c4; f32x4 a0 = {0.f, 0.f, 0.f, 0.f}, a1 = a0, a2 = a0;
#pragma unroll
          for (int j0 = 0; j0 < 32; j0 += 16) { f32x4 w[16];
#pragma unroll
              for (int j = 0; j < 16; ++j) { const int k = 128 * F.wave + 4 * (j0 + j) + kr; w[j] = *(const f32x4*)(W + (size_t)k * 6144); }
#pragma unroll
              for (int j = 0; j < 16; ++j) { const int k = 128 * F.wave + 4 * (j0 + j) + kr; const float s0 = sv[k], s1 = sv[1024 + k], s2 = sv[2048 + k];
#pragma unroll
                  for (int c = 0; c < 4; ++c) { a0[c] += s0 * w[j][c]; a1[c] += s1 * w[j][c]; a2[c] += s2 * w[j][c]; } } }
#pragma unroll
          for (int c = 0; c < 4; ++c) { a0[c] += __shfl_xor(a0[c], 16); a1[c] += __shfl_xor(a1[c], 16); a2[c] += __shfl_xor(a2[c], 16); a0[c] += __shfl_xor(a0[c], 32); a1[c] += __shfl_xor(a1[c], 32); a2[c] += __shfl_xor(a2[c], 32); }
          if (lane < 16) {
#pragma unroll
              for (int c = 0; c < 4; ++c) { red[(F.wave * 3 + 0) * 64 + c4 + c] = a0[c]; red[(F.wave * 3 + 1) * 64 + c4 + c] = a1[c]; red[(F.wave * 3 + 2) * 64 + c4 + c] = a2[c]; } }
          __syncthreads();
          if (F.tid < 192) { const int who = F.tid >> 6, c = F.tid & 63; float sm = 0.f;
#pragma unroll
              for (int w8 = 0; w8 < 8; ++w8) sm += red[(w8 * 3 + who) * 64 + c];
              mod[(size_t)l * 3 * 6144 + (size_t)who * 6144 + col0 + c] = sm + A.in[I_BMOD][l * 6144 + col0 + c]; }
          __syncthreads(); } }
    { float* cg = (float*)(F.ws + WS_COSG); float* sg = (float*)(F.ws + WS_SING); float* cm = (float*)(F.ws + WS_COSM); float* sm = (float*)(F.ws + WS_SINM);
      const int gt = F.bx * 512 + F.tid, NT_ = F.G * 512;
      for (int i = gt; i < SEQ * 48; i += NT_) { const int pos = i / 48, j = i % 48; const float rowf = (float)(pos >> 6), colf = (float)(pos & 63); float c, s;
          if (j < 32) { const float ang = (j < 16) ? rowf * INVF16[j] : colf * INVF16[j - 16]; sincos_acc(ang, c, s); cg[pos * 32 + j] = c; sg[pos * 32 + j] = s; }
          else { const int jj = j - 32; const float ang = (jj < 8) ? rowf * INVF16[2 * jj] : colf * INVF16[2 * (jj - 8)]; sincos_acc(ang, c, s); cm[pos * 16 + jj] = c; sm[pos * 16 + jj] = s; } } }
    { bf16* wsb = (bf16*)(F.ws + WS_WS); const float* src = A.in[I_GWS]; const int gt = F.bx * 512 + F.tid, NT_ = F.G * 512;
      for (int i = gt; i < DEPTH * 8 * 128 * 128 / 2; i += NT_) { ((unsigned*)wsb)[i] = cvt_pk(src[2 * i], src[2 * i + 1]); } }
    { bf16* rwt = (bf16*)(F.ws + WS_RWT); const float* src = A.in[I_RW]; const int gt = F.bx * 512 + F.tid, NT_ = F.G * 512;
      for (int i = gt; i < DEPTH * 32 * 1024; i += NT_) { const int l = i >> 15, e = (i >> 10) & 31, d = i & 1023; const float w = src[(size_t)l * 32768 + d * 32 + e];
          const unsigned h16 = cvt_pk(w, 0.f) & 0xffffu; const float back = __uint_as_float(h16 << 16);
          rwt[(size_t)l * 65536 + e * 1024 + d] = (bf16)h16; rwt[(size_t)l * 65536 + 32768 + e * 1024 + d] = (bf16)(cvt_pk(w - back, 0.f) & 0xffffu); } }
    { LAS float* scr = (LAS float*)(F.lds + RING_OFF + F.wave * 16640);
      constexpr int I_IN = 16 * 84, I_UQ = 4 * 12, I_UKV = 2 * 16, I_BR = 8 * 16, I_OUT = 16 * 16;
      constexpr int PER_LAYER = I_IN + I_UQ + I_UKV + 3 * I_BR + I_OUT;
      for (int it = gw; it < DEPTH * PER_LAYER; it += NGW) { const int l = it / PER_LAYER; int r = it % PER_LAYER;
          if (r < I_IN) { transpose_item(A.in[I_WIN] + (size_t)l * 1024 * 5280, 1024, 5280, (bf16*)(F.ws + WS_WIN) + (size_t)l * ZW * 1024, 84, 1, scr, r, lane); continue; } r -= I_IN;
          if (r < I_UQ) { transpose_item(A.in[I_WUQ] + (size_t)l * 256 * 768, 256, 768, (bf16*)(F.ws + WS_WUQ) + (size_t)l * 768 * 256, 12, 2, scr, r, lane); continue; } r -= I_UQ;
          if (r < I_UKV) { transpose_item(A.in[I_WUKV] + (size_t)l * 128 * 1024, 128, 1024, (bf16*)(F.ws + WS_WUKV) + (size_t)l * 1024 * 128, 16, 0, scr, r, lane); continue; } r -= I_UKV;
          if (r < 3 * I_BR) { const int i = r / I_BR; transpose_item(A.in[I_WBR] + (size_t)(l * 3 + i) * 512 * 1024, 512, 1024, (bf16*)(F.ws + WS_WBR) + (size_t)(l * 3 + i) * 1024 * 512, 16, 0, scr, r % I_BR, lane); continue; } r -= 3 * I_BR;
          { transpose_item(A.in[I_WOUT] + (size_t)l * 1024 * 1024, 1024, 1024, (bf16*)(F.ws + WS_WOUT) + (size_t)l * 1024 * 1024, 16, 0, scr, r, lane); } } }
}

constexpr int BG_W1 = 16 * 32, BG_W2 = 16 * 16, BG_PER_LAYER = 32 * (BG_W1 + BG_W2);
__device__ __forceinline__ void bg_item(Frame& F, int l, int r) {
    LAS float* scr = (LAS float*)(F.lds + RING_OFF + F.wave * 16640);
    if (r < 32 * BG_W1) { const int e = r / BG_W1; transpose_item(F.in(I_EW1) + (size_t)(l * 32 + e) * 1024 * 2048, 1024, 2048, (bf16*)(F.ws + WS_W1) + (size_t)(l * 32 + e) * 2048 * 1024, 32, 3, scr, r % BG_W1, F.lane); }
    else { r -= 32 * BG_W1; const int e = r / BG_W2; transpose_item(F.in(I_EW2) + (size_t)(l * 32 + e) * 1024 * 1024, 1024, 1024, (bf16*)(F.ws + WS_W2) + (size_t)(l * 32 + e) * 1024 * 1024, 16, 0, scr, r % BG_W2, F.lane); }
}
__device__ __forceinline__ void bg_site(Frame& F, int l, int lo, int hi, int nunits, int c) {
    const int r = nunits % F.G; int widx, nw;
    if (r == 0) { widx = c * 8 + F.wave; nw = F.G * 8; } else { if (c < r) return; widx = (c - r) * 8 + F.wave; nw = (F.G - r) * 8; }
#pragma unroll 1
    for (int it = lo + widx; it < hi; it += nw) bg_item(F, l, it);
}

__device__ __forceinline__ void mod_row_to_bf16(const float* xrow, const float* gain, const float* sc, const float* sh, bf16* orow, int lane) {
    const f32x4* xr = (const f32x4*)xrow + lane; f32x4 v[4], g[4], s[4], h[4]; float ss = 0.f;
#pragma unroll
    for (int j = 0; j < 4; ++j) { v[j] = xr[64 * j]; g[j] = ((const f32x4*)gain)[64 * j + lane]; s[j] = ((const f32x4*)sc)[64 * j + lane]; h[j] = ((const f32x4*)sh)[64 * j + lane]; }
#pragma unroll
    for (int j = 0; j < 4; ++j) ss += (v[j].x * v[j].x + v[j].y * v[j].y) + (v[j].z * v[j].z + v[j].w * v[j].w);
    const float rstd = __builtin_amdgcn_rsqf(wave_sum(ss) * (1.f / DM) + RMS_EPS);
    unsigned long long* o8 = (unsigned long long*)orow + lane;
#pragma unroll
    for (int j = 0; j < 4; ++j) { const float y0 = v[j].x * rstd * g[j].x * (1.f + s[j].x) + h[j].x, y1 = v[j].y * rstd * g[j].y * (1.f + s[j].y) + h[j].y, y2 = v[j].z * rstd * g[j].z * (1.f + s[j].z) + h[j].z, y3 = v[j].w * rstd * g[j].w * (1.f + s[j].w) + h[j].w;
        o8[64 * j] = (unsigned long long)cvt_pk(y0, y1) | ((unsigned long long)cvt_pk(y2, y3) << 32); }
}

typedef short bf16x8_t __attribute__((ext_vector_type(8)));
typedef float f32x16_t __attribute__((ext_vector_type(16)));
__device__ __forceinline__ void gmlp_unit(Frame& F, const float* gbs, const float* gvn, int l, int chunk, int nt) {
    const int lane = F.lane, g = F.wave, r32 = lane & 31, hi = lane >> 5;
    const bf16* vn = (const bf16*)(F.ws + WS_VN) + (size_t)chunk * 128 * 512 + g * 64; const float* ssv = (const float*)(F.ws + WS_SSV);
    const bf16* ua = (const bf16*)(F.ws + WS_UACT) + (size_t)chunk * 128 * 512 + g * 64;
    bf16* go = (bf16*)(F.ws + WS_GM) + (size_t)chunk * 128 * 512 + g * 64;
    const bf16* wsb = (const bf16*)(F.ws + WS_WS) + (size_t)(l * 8 + g) * 128 * 128;
    const float* bs = gbs + (size_t)(l * 8 + g) * 128;
    LAS bf16* vt = (LAS bf16*)(F.lds + RING_OFF + g * 19456); LAS bf16* ut = vt + 32 * 136; LAS float* bl = (LAS float*)(ut + 128 * 32);
    { const int dd = (lane & 3) * 8; const f32x4 ga = *(const f32x4*)(gvn + l * 512 + g * 64 + nt * 32 + dd), gb = *(const f32x4*)(gvn + l * 512 + g * 64 + nt * 32 + dd + 4);
      v4u raw[8], uraw[8]; float s0[8], s1[8];
#pragma unroll
      for (int ps = 0; ps < 8; ++ps) { const int q = ps * 16 + (lane >> 2); raw[ps] = *(const v4u*)(vn + (size_t)q * 512 + nt * 32 + dd); uraw[ps] = *(const v4u*)(ua + (size_t)q * 512 + nt * 32 + dd);
          const float* sp = ssv + ((size_t)chunk * 128 + q) * 2; s0[ps] = sp[0]; s1[ps] = sp[1]; }
      const float b0 = bs[lane], b1 = bs[64 + lane];
#pragma unroll
      for (int ps = 0; ps < 8; ++ps) { const int q = ps * 16 + (lane >> 2); float fv[8]; unpack8(raw[ps], fv);
          const float rstd = __builtin_amdgcn_rsqf((s0[ps] + s1[ps]) * (1.f / 512.f) + RMS_EPS);
#pragma unroll
          for (int i = 0; i < 8; ++i) vt[(dd + i) * 136 + q] = (bf16)(cvt_pk(fv[i] * rstd * (i < 4 ? ga[i] : gb[i - 4]), 0.f) & 0xffffu);
          *(LAS v4u*)(ut + q * 32 + dd) = uraw[ps]; }
      bl[lane] = b0; bl[64 + lane] = b1; }
    LDS_WAIT(); asm volatile("" ::: "memory");
#pragma unroll 1
    for (int mh = 0; mh < 2; ++mh) {
        f32x16_t acc[2]; acc[0] = (f32x16_t){}; acc[1] = (f32x16_t){};
        size_t zo = (size_t)mh * 64 * 128; asm volatile("" : "+v"(zo));
        const bf16* wsl = wsb + zo; bf16x8_t afr[8][2];
#pragma unroll
        for (int ks = 0; ks < 8; ++ks)
#pragma unroll
            for (int mt = 0; mt < 2; ++mt) afr[ks][mt] = *(const bf16x8_t*)(wsl + (size_t)(mt * 32 + r32) * 128 + ks * 16 + hi * 8);
#pragma unroll
        for (int ks = 0; ks < 8; ++ks) { const bf16x8_t bfr = *(const LAS bf16x8_t*)(vt + r32 * 136 + ks * 16 + hi * 8);
#pragma unroll
            for (int mt = 0; mt < 2; ++mt) acc[mt] = __builtin_amdgcn_mfma_f32_32x32x16_bf16(afr[ks][mt], bfr, acc[mt], 0, 0, 0); }
#pragma unroll
        for (int mt = 0; mt < 2; ++mt)
#pragma unroll
            for (int rg = 0; rg < 16; ++rg) { const int p = mh * 64 + mt * 32 + (rg & 3) + 8 * (rg >> 2) + 4 * hi;
                const float u = __uint_as_float((unsigned)ut[p * 32 + r32] << 16);
                go[(size_t)p * 512 + nt * 32 + r32] = (bf16)(cvt_pk(u * (acc[mt][rg] + bl[p]), 0.f) & 0xffffu); } }
    LDS_WAIT(); asm volatile("" ::: "memory");
}
constexpr int T3_REC_E = 0, T3_REC_W = 8192, T3_REC_S = 16384, T3_HIST = 24576, T3_BASE = T3_HIST + 128;
__device__ __forceinline__ void t3_phase(Frame& F, int l, int T_l, const float* xin_lat, const float* xin_ctx, int cofs, bool dry) {
    float* const outp = F.out();
    const int lane = F.lane, tid = F.tid;
    LAS int* rec_e = (LAS int*)(F.lds + RING_OFF + T3_REC_E); LAS float* rec_w = (LAS float*)(F.lds + RING_OFF + T3_REC_W); LAS int* rec_s = (LAS int*)(F.lds + RING_OFF + T3_REC_S);
    LAS int* hist = (LAS int*)(F.lds + RING_OFF + T3_HIST); LAS int* base = (LAS int*)(F.lds + RING_OFF + T3_BASE);
    if (tid < 32) hist[tid] = 0;
    const int per = (T_l + F.G - 1) / F.G; const int r0 = F.bx * per; int ntok = T_l - r0; ntok = ntok < 0 ? 0 : (ntok > per ? per : ntok);
    const float* norms = F.in(I_NORMS) + (size_t)l * 4 * 1024; const float* modl = (const float*)(F.ws + WS_MOD) + (size_t)l * 3 * 6144;
    const bf16* Y = (const bf16*)(F.ws + WS_Y); bf16* XN = (bf16*)(F.ws + (dry ? WS_H : WS_XN)); bf16* XNL = (bf16*)(F.ws + WS_MERGEB);
    bf16* XB = (bf16*)(F.ws + WS_XB);
    f32x4 g1v[4] = {}, gn1[4], gn2[4], scv[4] = {}, shv[4] = {}; int cur_who = -1;
#pragma unroll
    for (int hq = 0; hq < 4; ++hq) { const int d0 = (hq >> 1) * 512 + 8 * lane + 4 * (hq & 1); gn1[hq] = *(const f32x4*)(norms + 1024 + d0); gn2[hq] = *(const f32x4*)(norms + 2048 + d0); }
    v4u yn[2] = {}, xbn[2] = {}; f32x4 xn4[4] = {};
#define T3_LOAD(JJ) do { const int r_ = r0 + (JJ); const v4u* yp_ = (const v4u*)(Y + (size_t)r_ * 1024); yn[0] = yp_[lane]; yn[1] = yp_[64 + lane]; \
        if (l != 0) { const v4u* xp_ = (const v4u*)(XB + (size_t)r_ * 1024); xbn[0] = xp_[lane]; xbn[1] = xp_[64 + lane]; } \
        else { const float* xrow_ = (r_ < TL) ? xin_lat + (size_t)r_ * 1024 : xin_ctx + (size_t)(r_ - TL) * 1024; \
            _Pragma("unroll") for (int hq = 0; hq < 4; ++hq) xn4[hq] = *(const f32x4*)(xrow_ + (hq >> 1) * 512 + 8 * lane + 4 * (hq & 1)); } } while (0)
    if (F.wave < ntok) T3_LOAD(F.wave);
#pragma unroll 1
    for (int j = F.wave; j < ntok; j += 8) {
        const int r = r0 + j; const bool lat = r < TL; const int who = lat ? (r >> 14) : 2;
        bf16* orow = (dry ? (bf16*)(F.ws + WS_H) + (size_t)TA * 1024 : XB) + (size_t)r * 1024;
        if (who != cur_who) { cur_who = who; const float* mo = modl + (size_t)who * 6144;
#pragma unroll
            for (int hq = 0; hq < 4; ++hq) { const int d0 = (hq >> 1) * 512 + 8 * lane + 4 * (hq & 1); g1v[hq] = *(const f32x4*)(mo + 2 * 1024 + d0); scv[hq] = *(const f32x4*)(mo + 4 * 1024 + d0); shv[hq] = *(const f32x4*)(mo + 3 * 1024 + d0); } }
        float yv[16], xv[16]; v4u yr[2], xb[2]; f32x4 xr4[4];
        yr[0] = yn[0]; yr[1] = yn[1]; xb[0] = xbn[0]; xb[1] = xbn[1];
#pragma unroll
        for (int hq = 0; hq < 4; ++hq) xr4[hq] = xn4[hq];
        if (j + 8 < ntok) T3_LOAD(j + 8);
        { float a[8], b[8]; unpack8(yr[0], a); unpack8(yr[1], b);
#pragma unroll
          for (int i = 0; i < 8; ++i) { yv[i] = a[i]; yv[8 + i] = b[i]; } }
        if (l == 0) {
#pragma unroll
            for (int hq = 0; hq < 4; ++hq)
#pragma unroll
                for (int i = 0; i < 4; ++i) xv[hq * 4 + i] = xr4[hq][i]; }
        else { float a[8], b[8]; unpack8(xb[0], a); unpack8(xb[1], b);
#pragma unroll
            for (int i = 0; i < 8; ++i) { xv[i] = a[i]; xv[8 + i] = b[i]; } }
        float ss = 0.f;
#pragma unroll
        for (int i = 0; i < 16; ++i) ss += yv[i] * yv[i];
        const float rstd = __builtin_amdgcn_rsqf(wave_sum(ss) * (1.f / DM) + RMS_EPS);
        float ss2 = 0.f;
#pragma unroll
        for (int hq = 0; hq < 4; ++hq) {
#pragma unroll
            for (int i = 0; i < 4; ++i) { const int k = hq * 4 + i; const float xn = xv[k] + g1v[hq][i] * (yv[k] * rstd * gn1[hq][i]); xv[k] = xn; ss2 += xn * xn; } }
        { float a[8], b[8];
#pragma unroll
          for (int i = 0; i < 8; ++i) { a[i] = xv[i]; b[i] = xv[8 + i]; }
          *(v4u*)(orow + 8 * lane) = pack8(a); *(v4u*)(orow + 512 + 8 * lane) = pack8(b); }
        const float rstd2 = __builtin_amdgcn_rsqf(wave_sum(ss2) * (1.f / DM) + RMS_EPS);
#pragma unroll
        for (int h = 0; h < 2; ++h) { float hi8[8], lo8[8];
#pragma unroll
            for (int q = 0; q < 2; ++q) { const int hq = h * 2 + q;
#pragma unroll
                for (int i = 0; i < 4; ++i) hi8[q * 4 + i] = xv[hq * 4 + i] * rstd2 * gn2[hq][i] * (1.f + scv[hq][i]) + shv[hq][i]; }
            const v4u ph = pack8(hi8); float back[8]; unpack8(ph, back);
#pragma unroll
            for (int i = 0; i < 8; ++i) lo8[i] = hi8[i] - back[i];
            *(v4u*)(XN + (size_t)r * 1024 + h * 512 + 8 * lane) = ph; *(v4u*)(XNL + (size_t)r * 1024 + h * 512 + 8 * lane) = pack8(lo8); }
    }
    asm volatile("s_waitcnt vmcnt(0)" ::: "memory");
    __syncthreads();
    { const int r32 = lane & 31, hi = lane >> 5, w = F.wave; const int ntiles = (ntok + 31) >> 5;
      if (w < ntiles) {
        const int tloc = 32 * w + r32; const int rr = r0 + (tloc < ntok ? tloc : ntok - 1);
        const bf16* whi = (const bf16*)(F.ws + WS_RWT) + (size_t)l * 2 * 32 * 1024 + (size_t)r32 * 1024 + hi * 8; const bf16* wlo = whi + 32 * 1024;
        const bf16* thi = XN + (size_t)rr * 1024 + hi * 8; const bf16* tlo = XNL + (size_t)rr * 1024 + hi * 8;
        f32x16_t acc = (f32x16_t){};
        bf16x8_t fa[16], fb[16];
#define T3_LD(BUF, K0) do { _Pragma("unroll") for (int u = 0; u < 4; ++u) { BUF[u] = *(const bf16x8_t*)(whi + ((K0) + u) * 16); BUF[4 + u] = *(const bf16x8_t*)(wlo + ((K0) + u) * 16); \
            BUF[8 + u] = *(const bf16x8_t*)(thi + ((K0) + u) * 16); BUF[12 + u] = *(const bf16x8_t*)(tlo + ((K0) + u) * 16); } } while (0)
#define T3_MM(BUF) do { _Pragma("unroll") for (int u = 0; u < 4; ++u) { acc = __builtin_amdgcn_mfma_f32_32x32x16_bf16(BUF[u], BUF[8 + u], acc, 0, 0, 0); acc = __builtin_amdgcn_mfma_f32_32x32x16_bf16(BUF[u], BUF[12 + u], acc, 0, 0, 0); \
            acc = __builtin_amdgcn_mfma_f32_32x32x16_bf16(BUF[4 + u], BUF[8 + u], acc, 0, 0, 0); } } while (0)
        T3_LD(fa, 0);
#pragma unroll 1
        for (int k0 = 0; k0 < 64; k0 += 8) { T3_LD(fb, k0 + 4); T3_MM(fa); if (k0 + 8 < 64) T3_LD(fa, k0 + 8); T3_MM(fb); }
        const float* rb = F.in(I_RB) + l * 32; float v[16]; float ninf = -INFINITY; asm volatile("" : "+v"(ninf));
#pragma unroll
        for (int i = 0; i < 16; ++i) v[i] = acc[i] + rb[(i & 3) + 8 * (i >> 2) + 4 * hi];
        float cm[8]; int cid[8];
#pragma unroll
        for (int k = 0; k < 4; ++k) { float m = v[0];
#pragma unroll
            for (int i = 1; i < 16; ++i) m = fmaxf(m, v[i]);
            int sel = 15;
#pragma unroll
            for (int i = 14; i >= 0; --i) sel = (v[i] == m) ? i : sel;
            sel = (v[15] == m && sel == 15) ? 15 : sel;
            cm[k] = m; cid[k] = (sel & 3) + 8 * (sel >> 2) + 4 * hi;
#pragma unroll
            for (int i = 0; i < 16; ++i) v[i] = (i == sel) ? ninf : v[i]; }
#pragma unroll
        for (int k = 0; k < 4; ++k) { cm[4 + k] = __shfl_xor(cm[k], 32); cid[4 + k] = __shfl_xor(cid[k], 32); }
        float tl[4]; int te[4];
#pragma unroll
        for (int k = 0; k < 4; ++k) { float best = cm[0]; int bid = cid[0]; int bc = 0;
#pragma unroll
            for (int c = 1; c < 8; ++c) { const bool better = (cm[c] > best) || (cm[c] == best && cid[c] < bid); best = better ? cm[c] : best; bid = better ? cid[c] : bid; bc = better ? c : bc; }
            tl[k] = best; te[k] = bid;
#pragma unroll
            for (int c = 0; c < 8; ++c) cm[c] = (c == bc) ? ninf : cm[c]; }
        const float e1 = __expf(tl[1] - tl[0]), e2 = __expf(tl[2] - tl[0]), e3 = __expf(tl[3] - tl[0]); const float inv = 1.f / (1.f + e1 + e2 + e3);
        if (hi == 0 && tloc < ntok) { const float wv[4] = {inv, e1 * inv, e2 * inv, e3 * inv};
#pragma unroll
            for (int k = 0; k < 4; ++k) { const int ls = __hip_atomic_fetch_add(&hist[te[k]], 1, __ATOMIC_RELAXED, __HIP_MEMORY_SCOPE_WORKGROUP);
                rec_e[tloc * 4 + k] = te[k]; rec_w[tloc * 4 + k] = wv[k]; rec_s[tloc * 4 + k] = ls; } }
      } }
    __syncthreads();
    if (tid < 32) { const int n = hist[tid]; base[tid] = n ? (int)__hip_atomic_fetch_add((unsigned*)(F.ctl + CW_CNT + cofs + l * 32 + tid), (unsigned)n, RLX_AGENT) : 0; }
    __syncthreads();
    { int* rte = (int*)(F.ws + WS_RTE); int* rts = (int*)(F.ws + WS_RTS); int* ltok = (int*)(F.ws + WS_LTOK); float* lw = (float*)(F.ws + WS_LW);
      for (int i = tid; i < ntok * 4; i += 512) { const int e = rec_e[i], slot = base[e] + rec_s[i]; const int r = r0 + (i >> 2);
          rte[(size_t)r * 4 + (i & 3)] = e; rts[(size_t)r * 4 + (i & 3)] = slot; ltok[(size_t)e * TA + slot] = r; lw[(size_t)e * TA + slot] = rec_w[i]; } }
}

__device__ __forceinline__ void moe_tables(Frame& F, int l, int cofs) {
    LAS int* tab = (LAS int*)(F.lds + LDS_TAB);
    if (F.tid < 64) { const int e = F.tid & 31;
        const int c = (int)__hip_atomic_load((unsigned*)(F.ctl + CW_CNT + cofs + l * 32 + e), RLX_AGENT); const int n = (c + 255) >> 8;
        int inc = n;
#pragma unroll
        for (int d = 1; d < 32; d <<= 1) { const int t = __shfl_up(inc, d, 32); inc += ((F.tid & 31) >= d) ? t : 0; }
        const int nb0 = inc - n;
        if (F.tid < 32) { tab[600 + e] = nb0 * 256; tab[640 + e] = c; if (e == 31) tab[632] = inc;
#pragma unroll 1
            for (int b = 0; b < n; ++b) tab[nb0 + b] = e; } }
    __syncthreads();
}
__device__ __forceinline__ void t4_phase(Frame& F, int l, int T_l, bool dummy) {
    float* const outp = F.out();
    const bool nextmod = (l + 1 < DEPTH);
    const float* ngain = F.in(I_NORMS) + (size_t)(l + 1 < DEPTH ? l + 1 : l) * 4 * 1024; const float* nmod = (const float*)(F.ws + WS_MOD) + (size_t)(l + 1 < DEPTH ? l + 1 : l) * 3 * 6144; bf16* XN = (bf16*)(F.ws + WS_XN);
    const LAS int* tab = (const LAS int*)(F.lds + LDS_TAB); const int gw = F.bx * 8 + F.wave, NGW = F.G * 8, lane = F.lane;
    const int* rte = (const int*)(F.ws + WS_RTE); const int* rts = (const int*)(F.ws + WS_RTS); const bf16* Yp = (const bf16*)(F.ws + WS_BIG);
    const float* gain = F.in(I_NORMS) + (size_t)l * 4 * 1024 + 3 * 1024; const float* modl = (const float*)(F.ws + WS_MOD) + (size_t)l * 3 * 6144;
    f32x4 gv4[4], mv4[4] = {}, ng4[4] = {}, ns4[4] = {}, nh4[4] = {}; int cur_who = -1;
#pragma unroll
    for (int hq = 0; hq < 4; ++hq) { const int d0 = (hq >> 1) * 512 + 8 * lane + 4 * (hq & 1); gv4[hq] = *(const f32x4*)(gain + d0); if (nextmod) ng4[hq] = *(const f32x4*)(ngain + d0); }
    v4u yn[4][2] = {}, xbn[2] = {}; int ren[4] = {0, 0, 0, 0}, rsn[4] = {0, 0, 0, 0};
#define T4_ROUTE(R) do { _Pragma("unroll") for (int k = 0; k < 4; ++k) { ren[k] = rte[(size_t)(R) * 4 + k]; rsn[k] = rts[(size_t)(R) * 4 + k]; } } while (0)
#define T4_DATA(R) do { _Pragma("unroll") for (int k = 0; k < 4; ++k) { const size_t dst_ = (size_t)(tab[600 + ren[k]] + rsn[k]); const v4u* yp_ = (const v4u*)(Yp + dst_ * 1024); yn[k][0] = yp_[lane]; yn[k][1] = yp_[64 + lane]; } \
        { const v4u* xp_ = (const v4u*)((const bf16*)(F.ws + WS_XB) + (size_t)(R) * 1024); xbn[0] = xp_[lane]; xbn[1] = xp_[64 + lane]; } } while (0)
    if (gw < T_l) { T4_ROUTE(gw); T4_DATA(gw); if (gw + NGW < T_l) T4_ROUTE(gw + NGW); }
#pragma unroll 1
    for (int r = gw; r < T_l; r += NGW) { const bool lat = r < TL; const int who = lat ? (r >> 14) : 2;
        bf16* xrow = (bf16*)(F.ws + WS_XB) + (size_t)r * 1024;
        if (who != cur_who) { cur_who = who; const float* g2 = modl + (size_t)who * 6144 + 5 * 1024; const float* mo = nmod + (size_t)who * 6144;
#pragma unroll
            for (int hq = 0; hq < 4; ++hq) { const int d0 = (hq >> 1) * 512 + 8 * lane + 4 * (hq & 1); mv4[hq] = *(const f32x4*)(g2 + d0); if (nextmod) { ns4[hq] = *(const f32x4*)(mo + 1024 + d0); nh4[hq] = *(const f32x4*)(mo + d0); } } }
        float f[16]; v4u yr[4][2], xb[2];
#pragma unroll
        for (int k = 0; k < 4; ++k) { yr[k][0] = yn[k][0]; yr[k][1] = yn[k][1]; }
        xb[0] = xbn[0]; xb[1] = xbn[1];
        if (r + NGW < T_l) { T4_DATA(r + NGW); if (r + 2 * NGW < T_l) T4_ROUTE(r + 2 * NGW); }
#pragma unroll
        for (int i = 0; i < 16; ++i) f[i] = 0.f;
#pragma unroll
        for (int k = 0; k < 4; ++k) { float a[8], b[8]; unpack8(yr[k][0], a); unpack8(yr[k][1], b);
#pragma unroll
            for (int i = 0; i < 8; ++i) { f[i] += a[i]; f[8 + i] += b[i]; } }
        float ss = 0.f;
#pragma unroll
        for (int i = 0; i < 16; ++i) ss += f[i] * f[i];
        const float rstd = __builtin_amdgcn_rsqf(wave_sum(ss) * (1.f / DM) + RMS_EPS);
        float ssn = 0.f; float xf[16];
        { float a[8], b[8]; unpack8(xb[0], a); unpack8(xb[1], b);
#pragma unroll
          for (int i = 0; i < 8; ++i) { xf[i] = a[i]; xf[8 + i] = b[i]; } }
#pragma unroll
        for (int hq = 0; hq < 4; ++hq) { const int d0 = (hq >> 1) * 512 + 8 * lane + 4 * (hq & 1); f32x4 xv;
#pragma unroll
            for (int i = 0; i < 4; ++i) { xv[i] = xf[hq * 4 + i] + mv4[hq][i] * (f[hq * 4 + i] * rstd * gv4[hq][i]); f[hq * 4 + i] = xv[i]; ssn += xv[i] * xv[i]; }
            if (!nextmod) *(f32x4*)((dummy ? (float*)(F.ws + WS_H) + (size_t)r * 1024 : outp + (size_t)r * 1024) + d0) = xv; }
        if (nextmod) { float a[8], b[8]; bf16* xo = dummy ? (bf16*)(F.ws + WS_H) + (size_t)r * 1024 : xrow;
#pragma unroll
            for (int i = 0; i < 8; ++i) { a[i] = f[i]; b[i] = f[8 + i]; }
            *(v4u*)(xo + 8 * lane) = pack8(a); *(v4u*)(xo + 512 + 8 * lane) = pack8(b); }
        if (nextmod) { const float rstdn = __builtin_amdgcn_rsqf(wave_sum(ssn) * (1.f / DM) + RMS_EPS);
#pragma unroll
            for (int h = 0; h < 2; ++h) { float y[8];
#pragma unroll
                for (int q = 0; q < 2; ++q) { const int hq = h * 2 + q;
#pragma unroll
                    for (int i = 0; i < 4; ++i) y[q * 4 + i] = f[hq * 4 + i] * rstdn * ng4[hq][i] * (1.f + ns4[hq][i]) + nh4[hq][i]; }
                *(v4u*)(XN + (size_t)r * 1024 + h * 512 + 8 * lane) = pack8(y); } } }
}

#ifndef PH_MASK
#define PH_MASK 0xFFFFFFFFu
#endif
#define PH(k) ((PH_MASK >> (k)) & 1u)
#ifndef PH_TWICE
#define PH_TWICE 0u
#endif
#ifndef BG_A
#define BG_A 5504
#endif
#ifndef BG_B
#define BG_B 19392
#endif
#ifndef BG_C
#define BG_C 23360
#endif
#ifndef BG_D
#define BG_D 4096
#endif
#ifndef BG_E
#define BG_E 8192
#endif
#ifndef BG_F
#define BG_F 13696
#endif
#define REP(k) _Pragma("unroll") for (int rep_ = 0; rep_ < (((PH_TWICE >> (k)) & 1u) ? 2 : 1); ++rep_)
__global__ void __launch_bounds__(512, 2) fwd_kernel(Args A) {
    extern __shared__ __attribute__((aligned(16))) unsigned char lds[];
    Frame F;
    F.lds = (LAS unsigned char*)lds; F.MISC = (volatile LAS unsigned*)(F.lds + MISC_OFF);
    F.tid = threadIdx.x; F.lane = F.tid & 63; F.wave = __builtin_amdgcn_readfirstlane(F.tid >> 6);
    F.G = gridDim.x; F.bx = blockIdx.x; F.ws = (unsigned char*)(GAS unsigned char*)(unsigned long long)(uintptr_t)A.ws; F.ctl = (gu32*)(A.ws + WS_CTL);
    int vcu = (F.G % 8 == 0) ? (F.bx % 8) * (F.G / 8) + F.bx / 8 : F.bx;
    if (F.tid < 64) F.MISC[F.tid] = 0u;
    __syncthreads();
    XcdBarrier bar = xcd_barrier_post((unsigned*)(F.ctl + CW_BAR), F.MISC + 8);
#define GRID_BAR() do { { unsigned* bp_ = (unsigned*)(F.ctl + CW_BAR); unsigned x_ = bar.x; asm volatile("" : "+s"(bp_), "+s"(x_)); bar.bar = bp_; bar.x = x_; } xcd_barrier(bar); \
        { int t_ = threadIdx.x; asm volatile("" : "+v"(t_)); F.tid = t_; F.lane = t_ & 63; unsigned long long w_ = (unsigned long long)(uintptr_t)A.ws; int g_ = gridDim.x, b_ = blockIdx.x; asm volatile("" : "+s"(w_), "+s"(g_), "+s"(b_)); \
          F.ws = (unsigned char*)(GAS unsigned char*)w_; ws = F.ws; F.ctl = (gu32*)(w_ + WS_CTL * 1ull); F.G = g_; F.bx = b_; vcu = (g_ % 8 == 0) ? (b_ % 8) * (g_ / 8) + b_ / 8 : b_; gw = b_ * 8 + F.wave; NGW = g_ * 8; } } while (0)
    int gw = F.bx * 8 + F.wave, NGW = F.G * 8;
    unsigned char* ws = F.ws;

    if (PH(0)) REP(0) p_prologue(F, A);
    GRID_BAR();

#pragma unroll
    for (int l = 0; l < DEPTH; ++l) {
        const int T_l = (l == 0) ? TA : TL;

        if (PH(1) && l == 0) REP(1) { const float* xin_lat = (l == 0) ? F.in(I_X) : F.out(); const float* xin_ctx = (l == 0) ? F.in(I_CTX) : (const float*)(ws + WS_XC);
          const float* norms = F.in(I_NORMS) + (size_t)l * 4 * 1024; const float* modl = (const float*)(ws + WS_MOD) + (size_t)l * 3 * 6144;
          f32x4 g[4], sc[4] = {}, sh[4] = {}, xnx[4] = {}; int cur_who = -1; int lane_ = F.lane; asm volatile("" : "+v"(lane_)); const int lane = lane_;
#pragma unroll
          for (int j = 0; j < 4; ++j) g[j] = ((const f32x4*)norms)[64 * j + lane];
#define T0_LOAD(R) do { const int r_ = (R); const float* xr_ = (r_ < TL) ? xin_lat + (size_t)r_ * 1024 : xin_ctx + (size_t)(r_ - TL) * 1024; _Pragma("unroll") for (int j = 0; j < 4; ++j) xnx[j] = ((const f32x4*)xr_)[64 * j + lane]; } while (0)
          if (gw < TA) T0_LOAD(gw);
#pragma unroll 1
          for (int r = gw; r < TA; r += NGW) { const bool lat = r < TL; const int who = lat ? (r >> 14) : 2;
            if (who != cur_who) { cur_who = who; const float* mo = modl + (size_t)who * 6144;
#pragma unroll
                for (int j = 0; j < 4; ++j) { sc[j] = ((const f32x4*)(mo + 1024))[64 * j + lane]; sh[j] = ((const f32x4*)mo)[64 * j + lane]; } }
            f32x4 v[4]; float ss = 0.f;
#pragma unroll
            for (int j = 0; j < 4; ++j) v[j] = xnx[j];
            if (r + NGW < TA) T0_LOAD(r + NGW);
#pragma unroll
            for (int j = 0; j < 4; ++j) ss += (v[j].x * v[j].x + v[j].y * v[j].y) + (v[j].z * v[j].z + v[j].w * v[j].w);
            const float rstd = __builtin_amdgcn_rsqf(wave_sum(ss) * (1.f / DM) + RMS_EPS);
            unsigned long long* o8 = (unsigned long long*)((bf16*)(ws + WS_XN) + (size_t)r * 1024) + lane;
#pragma unroll
            for (int j = 0; j < 4; ++j) { const float y0 = v[j].x * rstd * g[j].x * (1.f + sc[j].x) + sh[j].x, y1 = v[j].y * rstd * g[j].y * (1.f + sc[j].y) + sh[j].y, y2 = v[j].z * rstd * g[j].z * (1.f + sc[j].z) + sh[j].z, y3 = v[j].w * rstd * g[j].w * (1.f + sc[j].w) + sh[j].w;
                o8[64 * j] = (unsigned long long)cvt_pk(y0, y1) | ((unsigned long long)cvt_pk(y2, y3) << 32); } } }
        if (l == 0) GRID_BAR();

        if (PH(2)) REP(2) { pg8::Gemm g{(const bf16*)(ws + WS_XN), (const bf16*)(ws + WS_WIN) + (size_t)l * ZW * 1024, TA, ZW, 1024}; pg8::StaticOrder S; S.init(TA, ZW, F.G, F.bx);
          pg8::EpiInproj E{ws, F.in(I_QKN) + (size_t)l * 128, F.in(I_MQN) + (size_t)l * 256, F.in(I_MKVN) + (size_t)l * 128, (LAS float*)(F.lds + LDS_X)};
          pg8::gemm_phase<pg8::EpiInproj, pg8::StaticOrder, true, true>(F.lds + RING_OFF, g, S, E); }
        __syncthreads(); bg_site(F, l, (l == 0) ? 0 : BG_E, (l == 0) ? BG_A : BG_F, (TA / 256) * (ZW / 256), F.bx);
        GRID_BAR();

        if (PH(4)) REP(4) { pg8::Gemm g{(const bf16*)(ws + WS_CQN), (const bf16*)(ws + WS_WUQ) + (size_t)l * 768 * 256, T_l, 768, 256}; pg8::StaticOrder S; S.init(T_l, 768, F.G, F.bx);
          pg8::EpiUq E{(bf16*)(ws + WS_QM), (const float*)(ws + WS_COSM), (const float*)(ws + WS_SINM)};
          pg8::gemm_phase<pg8::EpiUq, pg8::StaticOrder, true, true>(F.lds + RING_OFF, g, S, E); }
        if (PH(5)) REP(5) { pg8::Gemm g{(const bf16*)(ws + WS_CKVN), (const bf16*)(ws + WS_WUKV) + (size_t)l * 1024 * 128, TA, 1024, 128}; pg8::StaticOrder S; S.init(TA, 1024, F.G, (F.bx + F.G / 2) % F.G);
          pg8::EpiUkv E{(bf16*)(ws + WS_KM), (bf16*)(ws + WS_VM)};
          pg8::gemm_phase<pg8::EpiUkv, pg8::StaticOrder, true, true>(F.lds + RING_OFF, g, S, E); }
        if (PH(6)) REP(6) { const float* gbs = F.in(I_GBS); const float* gvn = F.in(I_GVN); for (int hu = (F.bx + F.G / 4) % F.G; hu < 2 * (T_l / 128); hu += F.G) gmlp_unit(F, gbs, gvn, l, hu >> 1, hu & 1); }
        GRID_BAR();

#define BG_ATTN(CEXPR) do { __syncthreads(); Frame F2 = F; { int t2_ = threadIdx.x; asm volatile("" : "+v"(t2_)); unsigned long long w2_ = (unsigned long long)(uintptr_t)A.ws; int g2_ = gridDim.x, b2_ = blockIdx.x; asm volatile("" : "+s"(w2_), "+s"(g2_), "+s"(b2_)); \
            F2.tid = t2_; F2.lane = t2_ & 63; F2.wave = __builtin_amdgcn_readfirstlane(t2_ >> 6); F2.ws = (unsigned char*)(GAS unsigned char*)w2_; F2.G = g2_; F2.bx = b2_; \
            int lo2_ = (l == 0) ? BG_C : BG_F, hi2_ = BG_PER_LAYER; asm volatile("" : "+s"(lo2_), "+s"(hi2_)); bg_site(F2, l, lo2_, hi2_, 0, (CEXPR)); } __syncthreads(); } while (0)
        { const int per = (1024 + F.G - 1) / F.G; char* shm = (char*)lds + RING_OFF;
          if (PH(7)) REP(7) for (int i = 0; i <= per; ++i) { size_t row0; int b, h, nt, t0;
              if (i < per) { if (F.G == 256 && i == (F.bx & 3) && !(F.bx & 4)) { BG_ATTN(b2_ / 8 * 4 + (b2_ & 3)); }
                const int L = vcu * per + i; if (L >= 1024) continue; const int bh = L >> 6, qb = L & 63; b = bh >> 3; h = bh & 7; row0 = (size_t)b * SEQ + (size_t)qb * 256; t0 = 0; nt = NTILE; }
              else { if (l != 0 || F.bx >= 16) continue; const int bh = F.bx; b = bh >> 3; h = bh & 7; row0 = (size_t)TL + (size_t)b * CTX; t0 = SEQ / 64; nt = CTX / 64; }
              attn_body::attn_unit<4, 512, 128, 128, 512, 8, false, false>((const bf16*)(ws + WS_QG) + row0 * 512 + h * 64, (const bf16*)(ws + WS_KG) + ((size_t)(b * 2 + (h >> 2)) * NTILE + t0) * 4096, (const bf16*)(ws + WS_VG) + ((size_t)(b * 2 + (h >> 2)) * NTILE + t0) * 4096,
                                                             (bf16*)(ws + WS_OG) + row0 * 512 + h * 64, nt, shm); }
          if (PH(8)) REP(8) for (int i = 0; i <= per; ++i) { size_t row0; int b, h, nt, t0;
              if (i < per) { if (F.G == 256 && i == (F.bx & 3) && (F.bx & 4)) { BG_ATTN(g2_ / 2 + b2_ / 8 * 4 + (b2_ & 3)); }
                const int L = vcu * per + i; if (L >= 1024) continue; const int bh = L >> 6, qb = L & 63; b = bh >> 3; h = bh & 7; row0 = (size_t)b * SEQ + (size_t)qb * 256; t0 = 0; nt = NTILE; }
              else { if (l != 0 || F.bx < 16 || F.bx >= 32) continue; const int bh = F.bx - 16; b = bh >> 3; h = bh & 7; row0 = (size_t)TL + (size_t)b * CTX; t0 = SEQ / 64; nt = CTX / 64; }
              attn_body::attn_unit<6, 768, 768, 512, 512, 8, false, false>((const bf16*)(ws + WS_QM) + row0 * 768 + h * 96, (const bf16*)(ws + WS_KM) + ((size_t)(b * 8 + h) * NTILE + t0) * 6144, (const bf16*)(ws + WS_VM) + ((size_t)(b * 8 + h) * NTILE + t0) * 4096,
                                                             (bf16*)(ws + WS_OM) + row0 * 512 + h * 64, nt, shm); } }
        GRID_BAR();

        if (PH(10)) REP(10) { pg8::StaticOrder S; S.init(T_l, 1024, F.G, F.bx); const bf16* wbr = (const bf16*)(ws + WS_WBR) + (size_t)l * 3 * 1024 * 512;
          { pg8::Gemm g{(const bf16*)(ws + WS_OG), wbr, T_l, 1024, 512}; pg8::EpiBranch<0> E{(const bf16*)(ws + WS_BIG), (bf16*)(ws + WS_MERGEB)};
            pg8::gemm_phase<pg8::EpiBranch<0>, pg8::StaticOrder, true, true>(F.lds + RING_OFF, g, S, E); }
          { pg8::Gemm g{(const bf16*)(ws + WS_OM), wbr + (size_t)1024 * 512, T_l, 1024, 512}; pg8::EpiBranch<1> E{(const bf16*)(ws + WS_BIG), (bf16*)(ws + WS_MERGEB)};
            pg8::gemm_phase<pg8::EpiBranch<1>, pg8::StaticOrder, true, true>(F.lds + RING_OFF, g, S, E); }
          { pg8::Gemm g{(const bf16*)(ws + WS_GM), wbr + (size_t)2 * 1024 * 512, T_l, 1024, 512}; pg8::EpiBranch<2> E{(const bf16*)(ws + WS_BIG), (bf16*)(ws + WS_MERGEB)};
            pg8::gemm_phase<pg8::EpiBranch<2>, pg8::StaticOrder, true, true>(F.lds + RING_OFF, g, S, E); } }
        if (l == 0) { __syncthreads(); bg_site(F, 0, BG_A, BG_B, (T_l / 256) * 4, F.bx); }
        GRID_BAR();

        if (PH(11)) REP(11) { pg8::Gemm g{(const bf16*)(ws + WS_MERGEB), (const bf16*)(ws + WS_WOUT) + (size_t)l * 1024 * 1024, T_l, 1024, 1024}; pg8::StaticOrder S; S.init(T_l, 1024, F.G, F.bx);
          pg8::EpiPlain E{(bf16*)(ws + WS_Y), 1024};
          pg8::gemm_phase<pg8::EpiPlain, pg8::StaticOrder, true, true>(F.lds + RING_OFF, g, S, E); }
        if (l == 0) { __syncthreads(); bg_site(F, 0, BG_B, BG_C, (T_l / 256) * 4, F.bx); }
        GRID_BAR();

        if (F.G != 256) { bg_site(F, l, (l == 0) ? BG_C : BG_F, BG_PER_LAYER, 0, F.bx); __syncthreads(); }
        if (PH(12)) REP(12) { const float* xin_lat = (l == 0) ? F.in(I_X) : F.out(); const float* xin_ctx = (l == 0) ? F.in(I_CTX) : (const float*)(ws + WS_XC); t3_phase(F, l, T_l, xin_lat, xin_ctx, (((PH_TWICE >> 12) & 1u) && rep_ == 0) ? 64 : 0, ((PH_TWICE >> 12) & 1u) && rep_ == 0); }
        GRID_BAR();

        moe_tables(F, l, 0);

        if (PH(14)) REP(14) { const LAS int* tab = (const LAS int*)(F.lds + LDS_TAB); const int nblk = __builtin_amdgcn_readfirstlane(tab[632]);
          LAS int* rowtok = (LAS int*)(F.lds + LDS_ROWTOK);
          { const int* ltok = (const int*)(ws + WS_LTOK); const int nun = nblk * 8;
            int tk[10];
#pragma unroll
            for (int jj = 0; jj < 10; ++jj) { const int idx = F.tid + 512 * jj; const int i = idx >> 8, r = idx & 255; const long L = (long)i * F.G + vcu; tk[jj] = -1;
                if (L < nun) { const int blk = (int)(L >> 3), e = tab[blk], slot = blk * 256 + r - tab[600 + e]; if (slot < tab[640 + e]) tk[jj] = ltok[(size_t)e * TA + slot]; } }
#pragma unroll
            for (int jj = 0; jj < 10; ++jj) rowtok[F.tid + 512 * jj] = tk[jj] < 0 ? 0 : tk[jj];
            __syncthreads(); }
          pg8::Gemm g{(const bf16*)(ws + WS_XN), (const bf16*)(ws + WS_W1) + (size_t)l * 32 * 2048 * 1024, TA, 32 * 2048, 1024};
          pg8::MoeOrder<8> S{nblk * 8, F.G, vcu, tab, rowtok}; pg8::EpiMoe1 E{(bf16*)(ws + WS_H), F.in(I_EB1) + (size_t)l * 32 * 2048};
          pg8::gemm_phase<pg8::EpiMoe1, pg8::MoeOrder<8>, true, true, true>(F.lds + RING_OFF, g, S, E);
          if (l == 0) { __syncthreads(); bg_site(F, 1, 0, BG_D, nblk * 8, vcu); } }
        GRID_BAR();

        if (PH(15)) REP(15) { const LAS int* tab = (const LAS int*)(F.lds + LDS_TAB); const int nblk = __builtin_amdgcn_readfirstlane(tab[632]);
          pg8::Gemm g{(const bf16*)(ws + WS_H), (const bf16*)(ws + WS_W2) + (size_t)l * 32 * 1024 * 1024, MOE_ROWS, 32 * 1024, 1024};
          pg8::MoeOrder<4> S{nblk * 4, F.G, vcu, tab, tab}; pg8::EpiMoe2 E{(bf16*)(ws + WS_BIG), F.in(I_EB2) + (size_t)l * 32 * 1024, (const float*)(ws + WS_LW), tab};
          pg8::gemm_phase<pg8::EpiMoe2, pg8::MoeOrder<4>, true, true>(F.lds + RING_OFF, g, S, E);
          if (l == 0) { __syncthreads(); bg_site(F, 1, BG_D, BG_E, nblk * 4, vcu); } }
        GRID_BAR();

        if (PH(16)) REP(16) t4_phase(F, l, T_l, ((PH_TWICE >> 16) & 1u) && rep_ == 0);
        GRID_BAR();
    }
#undef GRID_BAR
}

extern "C" void kernel_launch(void* const* d_in, const int* in_sizes, int n_in, void* d_out, int out_size, void* d_ws, size_t ws_size, hipStream_t stream) {
    static int grid = 0;
    if (grid == 0) {
        if (n_in != 24 || out_size != TL * DM || ws_size < WS_END) { fprintf(stderr, "kernel_launch: unexpected problem: n_in %d out %d ws %zu (need %zu)\n", n_in, out_size, ws_size, (size_t)WS_END); grid = -1; return; }
        int dev = 0, cus = 0;
        if (hipGetDevice(&dev) != hipSuccess || hipDeviceGetAttribute(&cus, hipDeviceAttributeMultiprocessorCount, dev) != hipSuccess) { grid = -1; return; }
        if (hipFuncSetAttribute((const void*)fwd_kernel, hipFuncAttributeMaxDynamicSharedMemorySize, LDS_BYTES) != hipSuccess) { fprintf(stderr, "kernel_launch: hipFuncSetAttribute failed\n"); grid = -1; return; }
        int per_cu = 0;
        if (hipOccupancyMaxActiveBlocksPerMultiprocessor(&per_cu, (const void*)fwd_kernel, 512, LDS_BYTES) != hipSuccess || per_cu < 1) fprintf(stderr, "kernel_launch: occupancy query reports %d\n", per_cu);
        (void)hipGetLastError();
        grid = cus > 256 ? 256 : cus;
    }
    if (grid < 0) return;
    if (hipMemsetAsync((char*)d_ws + WS_CTL, 0, CTL_ZERO_BYTES, stream) != hipSuccess) return;
    Args a{};
    for (int i = 0; i < 24; ++i) a.in[i] = (const float*)d_in[i];
    a.out = (float*)d_out; a.ws = (unsigned char*)d_ws;
    hipLaunchKernelGGL(fwd_kernel, dim3(grid), dim3(512), LDS_BYTES, stream, a);
}
```
